# Optimizing an MI355X kernel written in HIP

```python
import math
import jax, jax.numpy as jnp
from jax import lax
import numpy as np

D_MODEL = 1024
BATCH = 32
SEQ = 256
DEPTH = 4
DEC_BATCH = 2
DEC_SEQ = 1024
PAST_LEN = 512

GRID_W = 64
N_MIXERS = 2
N_SSD = (DEPTH + 1) // 2
N_FNO = DEPTH // 2
EXPAND = 2
D_INNER = EXPAND * D_MODEL
HEAD_DIM = 64
N_HEADS = D_INNER // HEAD_DIM
N_GROUPS = 4
D_STATE = 128
CONV_W = 3
CHUNK = 128
D_XBC = D_INNER + 2 * N_GROUPS * D_STATE
D_IN_PROJ = D_INNER + D_XBC + 2 * N_HEADS
N_FGROUPS = 4
D_FF = 4 * D_MODEL
EPS = 1e-6

kernel_name = "bidir_ssd_fnet_hybrid_diffusion_step"


def rmsnorm(x, w):
    xf = x.astype(jnp.float32)
    xf = xf * lax.rsqrt(jnp.mean(xf * xf, axis=-1, keepdims=True) + EPS)
    return xf.astype(x.dtype) * w


def ada_modulation(cond, w, b):
    m = jax.nn.silu(cond) @ w + b
    return jnp.split(m[:, None, :], 6, axis=-1)


def centred_dwconv(x, w, bias, n_seg):
    b, L, C = x.shape
    seg = L // n_seg
    xs = x.reshape(b * n_seg, seg, C)
    pad = CONV_W // 2
    xp = jnp.pad(xs, ((0, 0), (pad, pad), (0, 0)))
    out = sum(xp[:, k:k + seg] * w[k] for k in range(CONV_W)) + bias
    return out.reshape(b, L, C)


def ssd_scan(x, dt, A, Bm, Cm, h0):
    b, L, H, P = x.shape
    G, N = Bm.shape[2], Bm.shape[3]
    R = H // G
    nc = L // CHUNK
    f32 = jnp.float32
    xc = x.astype(f32).reshape(b, nc, CHUNK, G, R, P)
    dtc = dt.astype(f32).reshape(b, nc, CHUNK, G, R)
    Bc = Bm.astype(f32).reshape(b, nc, CHUNK, G, N)
    Cc = Cm.astype(f32).reshape(b, nc, CHUNK, G, N)
    dA = dtc * A.astype(f32).reshape(G, R)
    cs = jnp.cumsum(dA, axis=2)
    seg = cs[:, :, :, None] - cs[:, :, None, :]
    mask = jnp.tril(jnp.ones((CHUNK, CHUNK), dtype=bool))[:, :, None, None]
    decay = jnp.exp(jnp.where(mask, seg, -jnp.inf))
    CB = jnp.einsum("bclgn,bcsgn->bclsg", Cc, Bc)
    y_diag = jnp.einsum("bclsg,bclsgr,bcsgr,bcsgrp->bclgrp", CB, decay, dtc, xc)
    decay_to_end = jnp.exp(cs[:, :, -1:] - cs)
    states = jnp.einsum("bclgn,bclgr,bclgrp->bcgrpn", Bc, decay_to_end * dtc, xc)
    chunk_decay = jnp.exp(cs[:, :, -1])

    def step(h, inp):
        s, d = inp
        return h * d[..., None, None] + s, h

    h_final, h_starts = lax.scan(step, h0.astype(f32).reshape(b, G, R, P, N),
                                 (jnp.moveaxis(states, 1, 0), jnp.moveaxis(chunk_decay, 1, 0)))
    h_starts = jnp.moveaxis(h_starts, 0, 1)
    y_off = jnp.einsum("bclgn,bcgrpn,bclgr->bclgrp", Cc, h_starts, jnp.exp(cs))
    y = (y_diag + y_off).reshape(b, L, H, P)
    return y.astype(x.dtype), h_final.reshape(b, H, P, N)


def ssd_mixer(h, n_seg, h0_f, h0_b, w_in, conv_w, conv_b, dt_bias, a_log, d_skip, norm_w, w_out):
    b, L, _ = h.shape
    proj = h @ w_in
    z = proj[..., :D_INNER]
    xbc = proj[..., D_INNER:D_INNER + D_XBC]
    dt_raw = proj[..., D_INNER + D_XBC:].reshape(b, L, 2, N_HEADS)
    xbc = jax.nn.silu(centred_dwconv(xbc, conv_w, conv_b, n_seg))
    xs = xbc[..., :D_INNER].reshape(b, L, N_HEADS, HEAD_DIM)
    Bm = xbc[..., D_INNER:D_INNER + N_GROUPS * D_STATE].reshape(b, L, N_GROUPS, D_STATE)
    Cm = xbc[..., D_INNER + N_GROUPS * D_STATE:].reshape(b, L, N_GROUPS, D_STATE)
    dt = jax.nn.softplus((dt_raw + dt_bias).astype(jnp.float32))
    A = -jnp.exp(a_log.astype(jnp.float32))
    y_f, hf = ssd_scan(xs, dt[:, :, 0], A[0], Bm, Cm, h0_f)
    y_b, hb = ssd_scan(jnp.flip(xs, 1), jnp.flip(dt[:, :, 1], 1), A[1],
                       jnp.flip(Bm, 1), jnp.flip(Cm, 1), h0_b)
    y = y_f + jnp.flip(y_b, 1) + d_skip[:, None] * xs
    y = y.reshape(b, L, D_INNER) * jax.nn.silu(z)
    return rmsnorm(y, norm_w) @ w_out, hf, hb


def fourier_mixer(h, w_out, b_out):
    b, L, D = h.shape
    hg = h.astype(jnp.float32).reshape(b, L, N_FGROUPS, D // N_FGROUPS)
    f = jnp.fft.fft2(hg, axes=(1, 3), norm="ortho").real
    return f.reshape(b, L, D).astype(h.dtype) @ w_out + b_out


def sq_relu_mlp(h, w1, w2):
    return jnp.square(jax.nn.relu(h @ w1)) @ w2


def setup_inputs(seed: int = 0) -> dict:
    key = jax.random.key(seed)
    ks = jax.random.split(key, 24)
    nrm = jax.random.normal
    dt0 = jnp.exp(jax.random.uniform(ks[0], (N_SSD, 2, N_HEADS),
                                     minval=math.log(1e-3), maxval=math.log(1e-1)))
    dt_bias = dt0 + jnp.log(-jnp.expm1(-dt0))
    a_log = jnp.log(jax.random.uniform(ks[1], (N_SSD, 2, N_HEADS), minval=1.0, maxval=16.0))
    return {
        "x_prompt": nrm(ks[2], (BATCH, SEQ, D_MODEL), jnp.float32),
        "x_sample": nrm(ks[3], (DEC_BATCH, DEC_SEQ, D_MODEL), jnp.float32),
        "state_ssd": 0.5 * nrm(ks[4], (DEC_BATCH, N_SSD, 2, N_HEADS, HEAD_DIM, D_STATE), jnp.float32),
        "c": nrm(ks[5], (DEC_BATCH, D_MODEL), jnp.float32),
        "c_ctx": nrm(ks[6], (D_MODEL,), jnp.float32),
        "ada_w": 0.5 * D_MODEL ** -0.5 * nrm(ks[7], (DEPTH, D_MODEL, 6 * D_MODEL), jnp.float32),
        "ada_b": 0.02 * nrm(ks[8], (DEPTH, 6 * D_MODEL), jnp.float32),
        "norm_mix_w": 1.0 + 0.02 * nrm(ks[9], (DEPTH, D_MODEL), jnp.float32),
        "norm_mlp_w": 1.0 + 0.02 * nrm(ks[10], (DEPTH, D_MODEL), jnp.float32),
        "ssd_w_in": D_MODEL ** -0.5 * nrm(ks[11], (N_SSD, D_MODEL, D_IN_PROJ), jnp.float32),
        "ssd_conv_w": CONV_W ** -0.5 * nrm(ks[12], (N_SSD, CONV_W, D_XBC), jnp.float32),
        "ssd_conv_b": 0.02 * nrm(ks[13], (N_SSD, D_XBC), jnp.float32),
        "ssd_dt_bias": dt_bias,
        "ssd_a_log": a_log,
        "ssd_d": 1.0 + 0.1 * nrm(ks[14], (N_SSD, N_HEADS), jnp.float32),
        "ssd_norm_w": 1.0 + 0.02 * nrm(ks[15], (N_SSD, D_INNER), jnp.float32),
        "ssd_w_out": D_INNER ** -0.5 * nrm(ks[16], (N_SSD, D_INNER, D_MODEL), jnp.float32),
        "fno_w_out": D_MODEL ** -0.5 * nrm(ks[17], (N_FNO, D_MODEL, D_MODEL), jnp.float32),
        "fno_b_out": 0.02 * nrm(ks[18], (N_FNO, D_MODEL), jnp.float32),
        "mlp_w1": D_MODEL ** -0.5 * nrm(ks[19], (DEPTH, D_MODEL, D_FF), jnp.float32),
        "mlp_w2": D_FF ** -0.5 * nrm(ks[20], (DEPTH, D_FF, D_MODEL), jnp.float32),
        "final_norm_w": 1.0 + 0.02 * nrm(ks[21], (D_MODEL,), jnp.float32),
    }


def reference(x_prompt, x_sample, state_ssd, c, c_ctx, ada_w, ada_b, norm_mix_w, norm_mlp_w,
              ssd_w_in, ssd_conv_w, ssd_conv_b, ssd_dt_bias, ssd_a_log, ssd_d, ssd_norm_w,
              ssd_w_out, fno_w_out, fno_b_out, mlp_w1, mlp_w2, final_norm_w):
    rows = x_sample.shape[1] // GRID_W
    b_ctx = x_prompt.shape[0]
    xp, xs = x_prompt, x_sample
    zeros_state = jnp.zeros((b_ctx, N_HEADS, HEAD_DIM, D_STATE), jnp.float32)
    new_states = []
    for i in range(DEPTH):
        sm_p, cm_p, gm_p, sf_p, cf_p, gf_p = ada_modulation(c_ctx[None], ada_w[i], ada_b[i])
        sm_s, cm_s, gm_s, sf_s, cf_s, gf_s = ada_modulation(c, ada_w[i], ada_b[i])
        hp = rmsnorm(xp, norm_mix_w[i]) * (1.0 + cm_p) + sm_p
        hs = rmsnorm(xs, norm_mix_w[i]) * (1.0 + cm_s) + sm_s
        if i % N_MIXERS == 0:
            j = i // N_MIXERS
            prm = (ssd_w_in[j], ssd_conv_w[j], ssd_conv_b[j], ssd_dt_bias[j], ssd_a_log[j],
                   ssd_d[j], ssd_norm_w[j], ssd_w_out[j])
            op, hf, hb = ssd_mixer(hp, 1, zeros_state, zeros_state, *prm)
            new_states.append(jnp.stack([hf, hb], axis=1).astype(x_prompt.dtype))
            os_, _, _ = ssd_mixer(hs, rows, state_ssd[:, j, 0], state_ssd[:, j, 1], *prm)
        else:
            j = i // N_MIXERS
            op = fourier_mixer(hp, fno_w_out[j], fno_b_out[j])
            os_ = fourier_mixer(hs, fno_w_out[j], fno_b_out[j])
        xp = xp + gm_p * op
        xs = xs + gm_s * os_
        hp = rmsnorm(xp, norm_mlp_w[i]) * (1.0 + cf_p) + sf_p
        hs = rmsnorm(xs, norm_mlp_w[i]) * (1.0 + cf_s) + sf_s
        xp = xp + gf_p * sq_relu_mlp(hp, mlp_w1[i], mlp_w2[i])
        xs = xs + gf_s * sq_relu_mlp(hs, mlp_w1[i], mlp_w2[i])
    new_state_ssd = jnp.stack(new_states, axis=1)
    y_prompt = rmsnorm(xp, final_norm_w)
    y_sample = rmsnorm(xs, final_norm_w)
    return (y_prompt, y_sample, new_state_ssd)
```

```cpp
#include <hip/hip_runtime.h>
#include <stdint.h>
#include <stdio.h>

#ifndef PH_MASK
#define PH_MASK 0xFFFF
#endif
#define PH_ON(k) ((PH_MASK >> (k)) & 1)
#ifndef NAIVE_GEMM
#define NAIVE_GEMM 0
#endif
#define GN(k) ((NAIVE_GEMM >> (k)) & 1)
#ifndef NAIVE_SCAN
#define NAIVE_SCAN 0
#endif
#ifndef N_LAUNCH_MODE
#define N_LAUNCH_MODE 1
#endif

typedef unsigned short bf16_t;
typedef short bf16x8 __attribute__((ext_vector_type(8)));
typedef short bf16x4 __attribute__((ext_vector_type(4)));
typedef float f32x4 __attribute__((ext_vector_type(4)));
typedef unsigned u32x4 __attribute__((ext_vector_type(4)));
typedef unsigned u32x2 __attribute__((ext_vector_type(2)));
#define LAS __attribute__((address_space(3)))

constexpr int D = 1024, NCTX = 8192, NLAT = 2048, NTOK = 10240;
constexpr int DI = 2048, DXBC = 3072, DPROJ = 5184, NZX = 5120, NH = 32, DFF = 4096;
constexpr float EPS = 1e-6f;
constexpr int NPHASE = 32;

constexpr size_t al256(size_t x) { return (x + 255) & ~(size_t)255; }
constexpr size_t WS_CTL  = 0;
constexpr size_t CTL_BYTES = 65536;
constexpr size_t WS_MOD  = WS_CTL + CTL_BYTES;
constexpr size_t WS_WIN  = al256(WS_MOD + 4 * 3 * 6144 * 4);
constexpr size_t WS_WOUT = WS_WIN + (size_t)2 * DPROJ * D * 2;
constexpr size_t WS_WFNO = WS_WOUT + (size_t)2 * D * DI * 2;
constexpr size_t WS_W1   = WS_WFNO + (size_t)2 * D * D * 2;
constexpr size_t WS_W2   = WS_W1 + (size_t)4 * DFF * D * 2;
constexpr size_t WS_T1   = WS_W2 + (size_t)4 * DFF * D * 2;
constexpr size_t WS_T2C  = WS_T1 + (size_t)512 * 256 * 2;
constexpr size_t WS_T2L  = WS_T2C + (size_t)256 * 512 * 2;
constexpr size_t WS_H    = WS_T2L + (size_t)1024 * 2048 * 2;
constexpr size_t WS_S    = WS_H + (size_t)NTOK * D * 2;
constexpr size_t S_Z     = WS_S;
constexpr size_t S_XBC   = S_Z + (size_t)NTOK * DI * 2;
constexpr size_t S_DT    = S_XBC + (size_t)NTOK * DXBC * 2;
constexpr size_t S_SSQ   = S_DT + (size_t)NTOK * 64 * 4;
constexpr size_t S_YG    = S_SSQ + (size_t)NTOK * 32 * 4;
constexpr size_t S_RAW   = S_YG + (size_t)NTOK * DI * 2;
constexpr size_t WS_END  = S_RAW + (size_t)NTOK * DXBC * 2;
constexpr size_t S_HID   = WS_S;
constexpr size_t S_UVT   = WS_S;
constexpr size_t S_F     = WS_S + (size_t)NTOK * 2048 * 2;

constexpr int LDS_BYTES = 77824;

typedef __bf16 bf16x2_t __attribute__((ext_vector_type(2)));
typedef float f32x2_t __attribute__((ext_vector_type(2)));
__device__ __forceinline__ unsigned pk2(float lo, float hi) { const f32x2_t f = {lo, hi}; return __builtin_bit_cast(unsigned, __builtin_convertvector(f, bf16x2_t)); }
__device__ __forceinline__ float bflo(unsigned u) { return __uint_as_float(u << 16); }
__device__ __forceinline__ float bfhi(unsigned u) { return __uint_as_float(u & 0xffff0000u); }
__device__ __forceinline__ float wave_sum(float v) {
#pragma unroll
    for (int o = 1; o < 64; o <<= 1) v += __shfl_xor(v, o);
    return v;
}
__device__ __forceinline__ float silu_f(float x) { return x / (1.0f + __expf(-x)); }
__device__ __forceinline__ int cond_of(int tok) { return tok < NCTX ? 0 : (tok < NCTX + 1024 ? 1 : 2); }

#define XB_TMO      128
#define XB_XCNT(j)  (256  + 64 * (j))
#define XB_XSUB(j)  (1280 + 64 * (j))
#define XB_XGEN(j)  (2304 + 64 * (j))
#define XB_TOP      3328
#define XB_TOPGEN   3392
#define XCD_BAR_WORDS 3456
#define XB_SPIN_CAP (1u << 20)
__device__ __forceinline__ unsigned xb_ld(unsigned* p)              { return __hip_atomic_load(p, __ATOMIC_RELAXED, __HIP_MEMORY_SCOPE_AGENT); }
__device__ __forceinline__ unsigned xb_add(unsigned* p, unsigned v) { return __hip_atomic_fetch_add(p, v, __ATOMIC_RELAXED, __HIP_MEMORY_SCOPE_AGENT); }
__device__ __forceinline__ unsigned xb_xcc_id() { return (unsigned)__builtin_amdgcn_s_getreg((3 << 11) | 20) & 0xFu; }
#define XB_SPIN(cond, bar) do { unsigned _sp = 0; while (cond) { __builtin_amdgcn_s_sleep(1); \
    if ((++_sp & 255u) == 0u) { if (xb_ld(&(bar)[XB_TMO])) break; if (_sp > XB_SPIN_CAP) { atomicAdd(&(bar)[XB_TMO], 1u); break; } } } } while (0)
struct XcdBarrier { unsigned* bar; unsigned x; volatile LAS unsigned* st; };
__device__ __forceinline__ XcdBarrier xcd_barrier_post(unsigned* bar, volatile LAS unsigned* st) {
    XcdBarrier b; b.bar = bar; b.x = xb_xcc_id(); b.st = st;
    if (threadIdx.x == 0) (void)xb_add(&bar[XB_XCNT(b.x)], 1u);
    return b;
}
__device__ __forceinline__ void xcd_barrier_complete(unsigned* bar, unsigned x, unsigned& nloc, unsigned& nx) {
    const unsigned G = gridDim.x * gridDim.y * gridDim.z;
    unsigned sum, cnt, mine, sp = 0u;
    for (;;) {
        sum = 0u; cnt = 0u; mine = 0u;
#pragma unroll
        for (unsigned j = 0; j < 16; ++j) { const unsigned c = xb_ld(&bar[XB_XCNT(j)]); sum += c; cnt += (c > 0u) ? 1u : 0u; mine = (j == x) ? c : mine; }
        if (sum == G) break;
        __builtin_amdgcn_s_sleep(1);
        if ((++sp & 255u) == 0u) { if (xb_ld(&bar[XB_TMO])) break; if (sp > XB_SPIN_CAP) { atomicAdd(&bar[XB_TMO], 1u); break; } }
    }
    nloc = mine > 0u ? mine : 1u; nx = cnt > 0u ? cnt : 1u;
}
__device__ __forceinline__ void xcd_barrier(const XcdBarrier& b) {
    asm volatile("s_waitcnt vmcnt(0)" ::: "memory");
    __syncthreads();
    if (threadIdx.x == 0) {
        unsigned* bar = b.bar;
        __builtin_amdgcn_s_waitcnt(0);
        unsigned nloc = b.st[0], nx = b.st[1];
        if (nloc == 0u) { xcd_barrier_complete(bar, b.x, nloc, nx); b.st[0] = nloc; b.st[1] = nx; }
        const unsigned old = xb_add(&bar[XB_XSUB(b.x)], 1u);
        const unsigned gen = old / nloc;
        if (old + 1u == (gen + 1u) * nloc) {
            __builtin_amdgcn_fence(__ATOMIC_RELEASE, "agent");
            asm volatile("s_waitcnt vmcnt(0)" ::: "memory");
            const unsigned og = xb_add(&bar[XB_TOP], 1u);
            const unsigned tg = og / nx;
            if (og + 1u == (tg + 1u) * nx) xb_add(&bar[XB_TOPGEN], 1u);
            else XB_SPIN(xb_ld(&bar[XB_TOPGEN]) == tg, bar);
            __builtin_amdgcn_fence(__ATOMIC_ACQUIRE, "agent");
            xb_add(&bar[XB_XGEN(b.x)], 1u);
            asm volatile("s_waitcnt vmcnt(0)" ::: "memory");
        } else {
            XB_SPIN(xb_ld(&bar[XB_XGEN(b.x)]) == gen, bar);
            __builtin_amdgcn_fence(__ATOMIC_ACQUIRE, "agent");
            asm volatile("s_waitcnt vmcnt(0)" ::: "memory");
        }
    }
    __syncthreads();
}

struct Args {
    const float* in[22];
    float* out;
    unsigned char* ws;
    int ph_lo, ph_hi;
};

struct Ctx {
    char* lds;
    int tid, lane, wid;
    int vb, G;
    const Args __attribute__((address_space(4)))* a;
};

template <int TB> struct GT { static constexpr int ROWS = 128 + 32 * TB, STAGE = ROWS * 128, NI = ROWS / 8; };

template <int TB>
__device__ __forceinline__ void gemm_stage(char* st, const bf16_t* Ag, int lda, const bf16_t* Bg, int ldb, int k0, int wid, int lane) {
    constexpr int NI = GT<TB>::NI;
    const int rsub = lane >> 3, lch = (lane & 7) ^ rsub;
#pragma unroll
    for (int i = 0; i < (NI + 3) / 4; ++i) {
        const int q = wid + 4 * i;
        if (q < NI) {
            const int row = q * 8 + rsub;
            const bf16_t* src = (q < 16) ? (Ag + (size_t)row * lda + k0 + lch * 8) : (Bg + (size_t)(row - 128) * ldb + k0 + lch * 8);
            __builtin_amdgcn_global_load_lds((const unsigned*)src, (LAS unsigned*)(st + q * 1024 + lane * 16), 16, 0, 0);
        }
    }
}
__device__ __forceinline__ bf16x8 frag128(const char* tile, int row, int chunk) {
    return *(const bf16x8*)(tile + row * 128 + ((chunk ^ (row & 7)) << 4));
}

template <int TB, bool NAIVE, class Epi>
__device__ __forceinline__ void gemm_tile(const Ctx& c, const bf16_t* Ag, int lda, const bf16_t* Bg, int ldb, int K, int a0, int b0, const Epi& epi) {
    constexpr int STAGE = GT<TB>::STAGE;
    const int wr = c.wid >> 1, wc = c.wid & 1, fr = c.lane & 15, fq = c.lane >> 4;
    f32x4 acc[4][TB];
#pragma unroll
    for (int i = 0; i < 4; ++i)
#pragma unroll
        for (int j = 0; j < TB; ++j) acc[i][j] = (f32x4){0.f, 0.f, 0.f, 0.f};
    if (NAIVE) {
        const bf16_t* ar = Ag + (size_t)(wr * 64 + fq * 4) * lda;
        const bf16_t* br = Bg + (size_t)(wc * 16 * TB + fr) * ldb;
#pragma unroll
        for (int j = 0; j < TB; ++j) {
#pragma unroll 1
            for (int k = 0; k < K; k += 8) {
                float bv[8];
                { const u32x4 v = *(const u32x4*)(br + (size_t)(j * 16) * ldb + k);
#pragma unroll
                  for (int e = 0; e < 4; ++e) { bv[2 * e] = bflo(v[e]); bv[2 * e + 1] = bfhi(v[e]); } }
#pragma unroll
                for (int i = 0; i < 4; ++i)
#pragma unroll
                    for (int r = 0; r < 4; ++r) {
                        const u32x4 v = *(const u32x4*)(ar + (size_t)(i * 16 + r) * lda + k);
#pragma unroll
                        for (int e = 0; e < 4; ++e) acc[i][j][r] += bflo(v[e]) * bv[2 * e] + bfhi(v[e]) * bv[2 * e + 1];
                    }
                asm volatile("" ::: "memory");
            }
        }
        epi(acc, a0 + wr * 64, b0 + wc * (16 * TB), fr, fq);
        return;
    }
    const int nt = K >> 6;
    __syncthreads();
    gemm_stage<TB>(c.lds, Ag, lda, Bg, ldb, 0, c.wid, c.lane);
    for (int t = 0; t < nt; ++t) {
        asm volatile("s_waitcnt vmcnt(0)" ::: "memory");
        __syncthreads();
        const char* cur = c.lds + (t & 1) * STAGE;
        if (t + 1 < nt) gemm_stage<TB>(c.lds + ((t + 1) & 1) * STAGE, Ag, lda, Bg, ldb, (t + 1) << 6, c.wid, c.lane);
#pragma unroll
        for (int kk = 0; kk < 2; ++kk) {
            bf16x8 af[4], bfr[TB];
#pragma unroll
            for (int i = 0; i < 4; ++i) af[i] = frag128(cur, wr * 64 + i * 16 + fr, kk * 4 + fq);
#pragma unroll
            for (int j = 0; j < TB; ++j) bfr[j] = frag128(cur, 128 + wc * (16 * TB) + j * 16 + fr, kk * 4 + fq);
#pragma unroll
            for (int i = 0; i < 4; ++i)
#pragma unroll
                for (int j = 0; j < TB; ++j) acc[i][j] = __builtin_amdgcn_mfma_f32_16x16x32_bf16(af[i], bfr[j], acc[i][j], 0, 0, 0);
        }
    }
    epi(acc, a0 + wr * 64, b0 + wc * (16 * TB), fr, fq);
}

struct EpiInProj {
    bf16_t* Z; bf16_t* RAW;
    __device__ __forceinline__ void operator()(f32x4 (&acc)[4][5], int ab, int bb, int fr, int fq) const {
#pragma unroll
        for (int j = 0; j < 5; ++j) {
            const int tok = bb + j * 16 + fr;
#pragma unroll
            for (int i = 0; i < 4; ++i) {
                const int n = ab + i * 16 + fq * 4;
                u32x2 v; v.x = pk2(acc[i][j][0], acc[i][j][1]); v.y = pk2(acc[i][j][2], acc[i][j][3]);
                bf16_t* dst = (n < DI) ? (Z + (size_t)tok * DI + n) : (RAW + (size_t)tok * DXBC + (n - DI));
                *(u32x2*)dst = v;
            }
        }
    }
};
struct EpiResid {
    float* X; const float* gate  ; const float* bias; const float* rs_lds  ; int tok_base;
    __device__ __forceinline__ void operator()(f32x4 (&acc)[4][5], int ab, int bb, int fr, int fq) const {
#pragma unroll
        for (int j = 0; j < 5; ++j) {
            const int tok = bb + j * 16 + fr;
            const float rs = rs_lds ? rs_lds[tok - tok_base] : 1.0f;
            const float* g = gate + cond_of(tok) * 6144;
#pragma unroll
            for (int i = 0; i < 4; ++i) {
                const int n = ab + i * 16 + fq * 4;
                const f32x4 gv = *(const f32x4*)(g + n);
                f32x4 bv = (f32x4){0.f, 0.f, 0.f, 0.f};
                if (bias) bv = *(const f32x4*)(bias + n);
                f32x4* xp = (f32x4*)(X + (size_t)tok * D + n);
                f32x4 xv = *xp;
                xv = xv + gv * (acc[i][j] * rs + bv);
                *xp = xv;
            }
            asm volatile("" ::: "memory");
        }
    }
};
struct EpiMlpUp {
    bf16_t* HID;
    __device__ __forceinline__ void operator()(f32x4 (&acc)[4][5], int ab, int bb, int fr, int fq) const {
#pragma unroll
        for (int j = 0; j < 5; ++j) {
            const int tok = bb + j * 16 + fr;
#pragma unroll
            for (int i = 0; i < 4; ++i) {
                const int n = ab + i * 16 + fq * 4;
                f32x4 a = acc[i][j];
                a[0] = fmaxf(a[0], 0.f); a[1] = fmaxf(a[1], 0.f); a[2] = fmaxf(a[2], 0.f); a[3] = fmaxf(a[3], 0.f);
                u32x2 v; v.x = pk2(a[0] * a[0], a[1] * a[1]); v.y = pk2(a[2] * a[2], a[3] * a[3]);
                *(u32x2*)(HID + (size_t)tok * DFF + n) = v;
            }
        }
    }
};
struct EpiDt {
    float* DT;
    __device__ __forceinline__ void operator()(f32x4 (&acc)[4][2], int ab, int bb, int fr, int fq) const {
#pragma unroll
        for (int j = 0; j < 2; ++j) {
            const int col = bb + j * 16 + fr;
#pragma unroll
            for (int i = 0; i < 4; ++i) {
                const int tok = ab + i * 16 + fq * 4;
#pragma unroll
                for (int r = 0; r < 4; ++r) DT[(size_t)(tok + r) * 64 + col] = acc[i][j][r];
            }
        }
    }
};
struct EpiF1 {
    bf16_t* UVT; int g;
    __device__ __forceinline__ void operator()(f32x4 (&acc)[4][4], int ab, int bb, int fr, int fq) const {
#pragma unroll
        for (int j = 0; j < 4; ++j) {
            const int nn = bb + j * 16 + fr, part = nn >> 8, ch = g * 256 + (nn & 255);
#pragma unroll
            for (int i = 0; i < 4; ++i) {
                const int tok = ab + i * 16 + fq * 4;
                bf16_t* dst;
                if (tok < NCTX) { const int s = tok >> 8, l = tok & 255; dst = UVT + ((size_t)(s * 1024 + ch) * 512 + part * 256 + l); }
                else { const int tt = tok - NCTX, s = tt >> 10, l = tt & 1023; dst = UVT + (size_t)NCTX * 2048 + ((size_t)(s * 1024 + ch) * 2048 + part * 1024 + l); }
                u32x2 v; v.x = pk2(acc[i][j][0], acc[i][j][1]); v.y = pk2(acc[i][j][2], acc[i][j][3]);
                *(u32x2*)dst = v;
            }
        }
    }
};
struct EpiF2 {
    bf16_t* F; int tok0;
    __device__ __forceinline__ void operator()(f32x4 (&acc)[4][4], int ab, int bb, int fr, int fq) const {
#pragma unroll
        for (int j = 0; j < 4; ++j) {
            const int tok = tok0 + bb + j * 16 + fr;
#pragma unroll
            for (int i = 0; i < 4; ++i) {
                const int n = ab + i * 16 + fq * 4;
                u32x2 v; v.x = pk2(acc[i][j][0], acc[i][j][1]); v.y = pk2(acc[i][j][2], acc[i][j][3]);
                *(u32x2*)(F + (size_t)tok * D + n) = v;
            }
        }
    }
};

__device__ __forceinline__ void transpose_item(const Ctx& c, const float* W, int K, int N, bf16_t* WT, int item) {
    float* tile = (float*)c.lds;
    const int nb = N >> 6, kb = item / nb, nbi = item - kb * nb, k0 = kb * 64, n0 = nbi * 64;
    __syncthreads();
    {
        const int cl = c.tid & 15, rl = c.tid >> 4;
#pragma unroll
        for (int p = 0; p < 4; ++p) {
            const int k = p * 16 + rl;
            const f32x4 v = *(const f32x4*)(W + (size_t)(k0 + k) * N + n0 + cl * 4);
            tile[k * 65 + cl * 4 + 0] = v[0]; tile[k * 65 + cl * 4 + 1] = v[1]; tile[k * 65 + cl * 4 + 2] = v[2]; tile[k * 65 + cl * 4 + 3] = v[3];
        }
    }
    __syncthreads();
#pragma unroll
    for (int p = 0; p < 2; ++p) {
        const int idx = c.tid + p * 256, n = idx >> 3, kc = idx & 7;
        const float* s = tile + (kc * 8) * 65 + n;
        u32x4 o; o.x = pk2(s[0], s[65]); o.y = pk2(s[2 * 65], s[3 * 65]); o.z = pk2(s[4 * 65], s[5 * 65]); o.w = pk2(s[6 * 65], s[7 * 65]);
        *(u32x4*)(WT + (size_t)(n0 + n) * K + k0 + kc * 8) = o;
    }
}

__device__ __forceinline__ void ada_item(const Ctx& c, int item) {
    const Args __attribute__((address_space(4)))& a = *c.a;
    const int layer = item / 96, cg = item - layer * 96, n0 = cg * 64;
    const float* W = a.in[5] + (size_t)layer * D * 6144;
    const float* sc = (const float*)(c.lds + 32768);
    float* red = (float*)c.lds;
    const int cl = c.tid & 15, kl = c.tid >> 4;
    f32x4 a0 = {0, 0, 0, 0}, a1 = {0, 0, 0, 0}, a2 = {0, 0, 0, 0};
#pragma unroll 8
    for (int it = 0; it < 64; ++it) {
        const int k = it * 16 + kl;
        const f32x4 w = *(const f32x4*)(W + (size_t)k * 6144 + n0 + cl * 4);
        a0 += w * sc[k]; a1 += w * sc[1024 + k]; a2 += w * sc[2048 + k];
    }
    __syncthreads();
    *(f32x4*)(red + (kl * 3 + 0) * 64 + cl * 4) = a0;
    *(f32x4*)(red + (kl * 3 + 1) * 64 + cl * 4) = a1;
    *(f32x4*)(red + (kl * 3 + 2) * 64 + cl * 4) = a2;
    __syncthreads();
    if (c.tid < 192) {
        const int cond = c.tid >> 6, col = c.tid & 63;
        float s = 0.f;
#pragma unroll
        for (int k = 0; k < 16; ++k) s += red[(k * 3 + cond) * 64 + col];
        s += a.in[6][layer * 6144 + n0 + col];
        ((float*)(a.ws + WS_MOD))[(layer * 3 + cond) * 6144 + n0 + col] = s;
    }
}

__device__ __forceinline__ void phase_prep(const Ctx& c) {
    const Args __attribute__((address_space(4)))& a = *c.a;
    {
        float* sc = (float*)(c.lds + 32768);
        for (int i = c.tid; i < 3072; i += 256) {
            const int cond = i >> 10, k = i & 1023;
            const float v = cond == 0 ? a.in[4][k] : a.in[3][(cond - 1) * 1024 + k];
            sc[i] = silu_f(v);
        }
        __syncthreads();
    }
    constexpr int I_ADA = 384;
    constexpr int I_WIN = 16 * 81, I_WOUT = 32 * 16, I_FNO = 16 * 16, I_W1 = 16 * 64, I_W2 = 64 * 16;
    constexpr int I_TR = 2 * I_WIN + 2 * I_WOUT + 2 * I_FNO + 4 * I_W1 + 4 * I_W2;
    constexpr int I_CP = NTOK / 16;
    constexpr int I_TB = 32 + 32 + 512;
    constexpr int I_ALL = I_ADA + I_TR + I_CP + I_TB;
    for (int it = c.vb; it < I_ALL; it += c.G) {
        int r = it;
        if (r < I_ADA) { ada_item(c, r); continue; }
        r -= I_ADA;
        if (r < I_TR) {
            if (r < 2 * I_WIN) { const int j = r / I_WIN; transpose_item(c, a.in[9] + (size_t)j * D * DPROJ, D, DPROJ, (bf16_t*)(a.ws + WS_WIN) + (size_t)j * DPROJ * D, r - j * I_WIN); continue; }
            r -= 2 * I_WIN;
            if (r < 2 * I_WOUT) { const int j = r / I_WOUT; transpose_item(c, a.in[16] + (size_t)j * DI * D, DI, D, (bf16_t*)(a.ws + WS_WOUT) + (size_t)j * D * DI, r - j * I_WOUT); continue; }
            r -= 2 * I_WOUT;
            if (r < 2 * I_FNO) { const int j = r / I_FNO; transpose_item(c, a.in[17] + (size_t)j * D * D, D, D, (bf16_t*)(a.ws + WS_WFNO) + (size_t)j * D * D, r - j * I_FNO); continue; }
            r -= 2 * I_FNO;
            if (r < 4 * I_W1) { const int j = r / I_W1; transpose_item(c, a.in[19] + (size_t)j * D * DFF, D, DFF, (bf16_t*)(a.ws + WS_W1) + (size_t)j * DFF * D, r - j * I_W1); continue; }
            r -= 4 * I_W1;
            { const int j = r / I_W2; transpose_item(c, a.in[20] + (size_t)j * DFF * D, DFF, D, (bf16_t*)(a.ws + WS_W2) + (size_t)j * D * DFF, r - j * I_W2); continue; }
        }
        r -= I_TR;
        if (r < I_CP) {
            const int row0 = r * 16;
#pragma unroll
            for (int p = 0; p < 16; ++p) {
                const int row = row0 + p;
                const float* src = row < NCTX ? a.in[0] + (size_t)row * D : a.in[1] + (size_t)(row - NCTX) * D;
                *(f32x4*)(a.out + (size_t)row * D + c.tid * 4) = *(const f32x4*)(src + c.tid * 4);
            }
            continue;
        }
        r -= I_CP;
        {
#pragma unroll 4
            for (int e = 0; e < 16; ++e) {
                int idx = r * 4096 + e * 256 + c.tid;
                if (idx < 131072) {
                    const int nn = idx >> 8, cc = idx & 255, m = nn & 255, ph = (m * cc) & 255;
                    const float ang = (float)ph * (1.0f / 128.0f);
                    const float v = nn < 256 ? cospif(ang) : sinpif(ang);
                    ((bf16_t*)(a.ws + WS_T1))[idx] = (bf16_t)(pk2(v, 0.f) & 0xffff);
                } else if (idx < 262144) {
                    idx -= 131072;
                    const int k = idx >> 9, k2 = idx & 511, l = k2 & 255, ph = (k * l) & 255;
                    const float ang = (float)ph * (1.0f / 128.0f);
                    const float v = (k2 < 256 ? cospif(ang) : -sinpif(ang)) * (1.0f / 256.0f);
                    ((bf16_t*)(a.ws + WS_T2C))[idx] = (bf16_t)(pk2(v, 0.f) & 0xffff);
                } else {
                    idx -= 262144;
                    const int k = idx >> 11, k2 = idx & 2047, l = k2 & 1023, ph = (k * l) & 1023;
                    const float ang = (float)ph * (1.0f / 512.0f);
                    const float v = (k2 < 1024 ? cospif(ang) : -sinpif(ang)) * (1.0f / 512.0f);
                    ((bf16_t*)(a.ws + WS_T2L))[idx] = (bf16_t)(pk2(v, 0.f) & 0xffff);
                }
            }
        }
    }
}

__device__ __forceinline__ void phase_norm(const Ctx& c, const float* nw, const float* mod  , int off_shift, int off_scale, bool final_norm) {
    const Args __attribute__((address_space(4)))& a = *c.a;
    const int gw = c.vb * 4 + c.wid, NGW = c.G * 4;
    bf16_t* H = (bf16_t*)(a.ws + WS_H);
    for (int row = gw; row < NTOK; row += NGW) {
        float* xr = a.out + (size_t)row * D;
        f32x4 v[4]; float ss = 0.f;
#pragma unroll
        for (int j = 0; j < 4; ++j) { v[j] = *(const f32x4*)(xr + j * 256 + c.lane * 4); ss += v[j][0] * v[j][0] + v[j][1] * v[j][1] + v[j][2] * v[j][2] + v[j][3] * v[j][3]; }
        ss = wave_sum(ss);
        const float rstd = rsqrtf(ss * (1.0f / D) + EPS);
        if (final_norm) {
#pragma unroll
            for (int j = 0; j < 4; ++j) { const f32x4 w = *(const f32x4*)(nw + j * 256 + c.lane * 4); *(f32x4*)(xr + j * 256 + c.lane * 4) = v[j] * rstd * w; }
        } else {
            const float* m = mod + cond_of(row) * 6144;
#pragma unroll
            for (int j = 0; j < 4; ++j) {
                const int col = j * 256 + c.lane * 4;
                const f32x4 w = *(const f32x4*)(nw + col), sc = *(const f32x4*)(m + off_scale + col), sh = *(const f32x4*)(m + off_shift + col);
                const f32x4 h = v[j] * rstd * w * (sc + 1.0f) + sh;
                u32x2 o; o.x = pk2(h[0], h[1]); o.y = pk2(h[2], h[3]);
                *(u32x2*)(H + (size_t)row * D + col) = o;
            }
        }
    }
}

__device__ __forceinline__ void phase_inproj(const Ctx& c, int j) {
    const Args __attribute__((address_space(4)))& a = *c.a;
    const bf16_t* W = (const bf16_t*)(a.ws + WS_WIN) + (size_t)j * DPROJ * D;
    const bf16_t* H = (const bf16_t*)(a.ws + WS_H);
    EpiInProj epi{(bf16_t*)(a.ws + S_Z), (bf16_t*)(a.ws + S_RAW)};
    constexpr int NC = NZX / 128, NT = (NTOK / 160) * NC;
    for (int t = c.vb; t < NT; t += c.G) {
        const int rt = t / NC, ct = t - rt * NC;
        gemm_tile<5, GN(2)>(c, W + (size_t)ct * 128 * D, D, H + (size_t)rt * 160 * D, D, D, ct * 128, rt * 160, epi);
    }
}
__device__ __forceinline__ void phase_mlp_up(const Ctx& c, int layer) {
    const Args __attribute__((address_space(4)))& a = *c.a;
    const bf16_t* W = (const bf16_t*)(a.ws + WS_W1) + (size_t)layer * DFF * D;
    const bf16_t* H = (const bf16_t*)(a.ws + WS_H);
    EpiMlpUp epi{(bf16_t*)(a.ws + S_HID)};
    constexpr int NC = DFF / 128, NT = (NTOK / 160) * NC;
    for (int t = c.vb; t < NT; t += c.G) {
        const int rt = t / NC, ct = t - rt * NC;
        gemm_tile<5, GN(8)>(c, W + (size_t)ct * 128 * D, D, H + (size_t)rt * 160 * D, D, D, ct * 128, rt * 160, epi);
    }
}
__device__ __forceinline__ void phase_resid_gemm(const Ctx& c, const bf16_t* WT, const bf16_t* Act, int K, const float* gate, const float* bias, const float* ssq) {
    const Args __attribute__((address_space(4)))& a = *c.a;
    constexpr int NC = D / 128, NT = (NTOK / 160) * NC;
    float* rs = (float*)(c.lds + 2 * GT<5>::STAGE);
    for (int t = c.vb; t < NT; t += c.G) {
        const int rt = t / NC, ct = t - rt * NC;
        if (ssq) {
            __syncthreads();
            if (c.tid < 160) {
                const float* p = ssq + (size_t)(rt * 160 + c.tid) * 32;
                float s = 0.f;
#pragma unroll
                for (int q = 0; q < 8; ++q) { const f32x4 v = *(const f32x4*)(p + q * 4); s += v[0] + v[1] + v[2] + v[3]; }
                rs[c.tid] = rsqrtf(s * (1.0f / DI) + EPS);
            }
            __syncthreads();
        }
        EpiResid epi{a.out, gate, bias, ssq ? rs : nullptr, rt * 160};
        gemm_tile<5, GN(5)>(c, WT + (size_t)ct * 128 * K, K, Act + (size_t)rt * 160 * K, K, K, ct * 128, rt * 160, epi);
    }
}
__device__ __forceinline__ void phase_f1(const Ctx& c) {
    const Args __attribute__((address_space(4)))& a = *c.a;
    const bf16_t* H = (const bf16_t*)(a.ws + WS_H);
    const bf16_t* T1 = (const bf16_t*)(a.ws + WS_T1);
    constexpr int NT = (NTOK / 128) * 16;
    for (int t = c.vb; t < NT; t += c.G) {
        const int rt = t >> 4, g = (t >> 2) & 3, ct = t & 3;
        EpiF1 epi{(bf16_t*)(a.ws + S_UVT), g};
        gemm_tile<4, GN(6)>(c, H + (size_t)rt * 128 * D + g * 256, D, T1 + (size_t)ct * 128 * 256, 256, 256, rt * 128, ct * 128, epi);
    }
}
__device__ __forceinline__ void phase_f2(const Ctx& c) {
    const Args __attribute__((address_space(4)))& a = *c.a;
    const bf16_t* UVT = (const bf16_t*)(a.ws + S_UVT);
    bf16_t* F = (bf16_t*)(a.ws + S_F);
    constexpr int NT = 128 + 512;
    for (int t = c.vb; t < NT; t += c.G) {
        if (t < 128) {
            const int s = t >> 6, nt = (t >> 3) & 7, kt = t & 7;
            EpiF2 epi{F, NCTX + s * 1024};
            gemm_tile<4, GN(7)>(c, UVT + (size_t)NCTX * 2048 + ((size_t)s * 1024 + nt * 128) * 2048, 2048, (const bf16_t*)(a.ws + WS_T2L) + (size_t)kt * 128 * 2048, 2048, 2048, nt * 128, kt * 128, epi);
        } else {
            const int u = t - 128, s = u >> 4, nt = (u >> 1) & 7, kt = u & 1;
            EpiF2 epi{F, s * 256};
            gemm_tile<4, GN(7)>(c, UVT + ((size_t)s * 1024 + nt * 128) * 512, 512, (const bf16_t*)(a.ws + WS_T2C) + (size_t)kt * 128 * 512, 512, 512, nt * 128, kt * 128, epi);
        }
    }
}

__device__ __forceinline__ void phase_conv(const Ctx& c, int j) {
    const Args __attribute__((address_space(4)))& a = *c.a;
    {
        const bf16_t* W = (const bf16_t*)(a.ws + WS_WIN) + (size_t)j * DPROJ * D + (size_t)NZX * D;
        const bf16_t* H = (const bf16_t*)(a.ws + WS_H);
        EpiDt epi{(float*)(a.ws + S_DT)};
        for (int t = c.vb; t < NTOK / 128; t += c.G) gemm_tile<2, GN(3)>(c, H + (size_t)t * 128 * D, D, W, D, D, t * 128, 0, epi);
    }
    const bf16_t* RAW = (const bf16_t*)(a.ws + S_RAW);
    bf16_t* XBC = (bf16_t*)(a.ws + S_XBC);
    const float* cw = a.in[10] + (size_t)j * 3 * DXBC;
    const float* cb = a.in[11] + (size_t)j * DXBC;
    constexpr int NIT = (NTOK / 32) * 3;
    for (int it = c.G - 1 - c.vb; it < NIT; it += c.G) {
        const int tg = it / 3, third = it - tg * 3;
        const int ch = third * 1024 + (c.tid & 127) * 8;
        const int r0 = tg * 32 + (c.tid >> 7) * 16;
        float w0[8], w1[8], w2[8], bb[8];
#pragma unroll
        for (int q = 0; q < 2; ++q) {
            const f32x4 t0 = *(const f32x4*)(cw + ch + q * 4), t1 = *(const f32x4*)(cw + DXBC + ch + q * 4), t2 = *(const f32x4*)(cw + 2 * DXBC + ch + q * 4), t3 = *(const f32x4*)(cb + ch + q * 4);
#pragma unroll
            for (int e = 0; e < 4; ++e) { w0[q * 4 + e] = t0[e]; w1[q * 4 + e] = t1[e]; w2[q * 4 + e] = t2[e]; bb[q * 4 + e] = t3[e]; }
        }
        const int seg = r0 < NCTX ? 256 : 64;
        u32x4 prev = {0, 0, 0, 0}, cur, nxt;
        if ((r0 % seg) != 0) prev = *(const u32x4*)(RAW + (size_t)(r0 - 1) * DXBC + ch);
        cur = *(const u32x4*)(RAW + (size_t)r0 * DXBC + ch);
#pragma unroll 4
        for (int r = 0; r < 16; ++r) {
            const int t = r0 + r;
            nxt = (u32x4){0, 0, 0, 0};
            if (((t + 1) % seg) != 0) nxt = *(const u32x4*)(RAW + (size_t)(t + 1) * DXBC + ch);
            u32x4 o;
#pragma unroll
            for (int e = 0; e < 4; ++e) {
                const float lo = bb[2 * e] + w0[2 * e] * bflo(prev[e]) + w1[2 * e] * bflo(cur[e]) + w2[2 * e] * bflo(nxt[e]);
                const float hi = bb[2 * e + 1] + w0[2 * e + 1] * bfhi(prev[e]) + w1[2 * e + 1] * bfhi(cur[e]) + w2[2 * e + 1] * bfhi(nxt[e]);
                o[e] = pk2(silu_f(lo), silu_f(hi));
            }
            *(u32x4*)(XBC + (size_t)t * DXBC + ch) = o;
            prev = cur; cur = nxt;
        }
    }
}

constexpr int SC_XS = 0, SC_XW = 8192, SC_BS = 16384, SC_CS = 32768, SC_HT = 49152, SC_SM = 65536;
__device__ __forceinline__ int off128(int row, int col) { return row * 128 + ((((col >> 3) ^ (row & 7))) << 4) + (col & 7) * 2; }
__device__ __forceinline__ int off256(int row, int col) { return row * 256 + ((((col >> 3) ^ (row & 15))) << 4) + (col & 7) * 2; }
template <int W256>
__device__ __forceinline__ bf16x8 tr_frag(const char* tile, int r0, int r1, int col0, int lane) {
    const int i = lane & 15, q = i >> 2, cc = col0 + (i & 3) * 4;
    const int o0 = W256 ? off256(r0 + q, cc) : off128(r0 + q, cc);
    const int o1 = W256 ? off256(r1 + q, cc) : off128(r1 + q, cc);
    const bf16x4 lo = __builtin_amdgcn_ds_read_tr16_b64_v4i16((LAS bf16x4*)(tile + o0));
    const bf16x4 hi = __builtin_amdgcn_ds_read_tr16_b64_v4i16((LAS bf16x4*)(tile + o1));
    return __builtin_shufflevector(lo, hi, 0, 1, 2, 3, 4, 5, 6, 7);
}

__device__ __forceinline__ void scan_unit(const Ctx& c, int j, int seq, int h) {
    const Args __attribute__((address_space(4)))& a = *c.a;
    const bf16_t* XBC = (const bf16_t*)(a.ws + S_XBC);
    const bf16_t* Z = (const bf16_t*)(a.ws + S_Z);
    const float* DT = (const float*)(a.ws + S_DT);
    bf16_t* YTMP = (bf16_t*)(a.ws + S_RAW);
    bf16_t* YG = (bf16_t*)(a.ws + S_YG);
    float* SSQ = (float*)(a.ws + S_SSQ);
    const bool is_lat = seq >= 32;
    const int tok0 = is_lat ? NCTX + (seq - 32) * 1024 : seq * 256;
    const int nch = is_lat ? 16 : 4;
    const int g = h >> 3;
    const int w = c.wid;
    char* lds = c.lds;
    float* sm_dt = (float*)(lds + SC_SM);
    float* sm_cs = sm_dt + 64;
    float* sm_tot = sm_dt + 128;
    const float Dh = a.in[14][j * NH + h];
    const float* normw = a.in[15] + (size_t)j * DI + h * 64;

#pragma unroll 1
    for (int dir = 0; dir < 2; ++dir) {
        const float Aneg = -__expf(a.in[13][(j * 2 + dir) * NH + h]);
        const float dtb = a.in[12][(j * 2 + dir) * NH + h];
        f32x4 S[4][2];
        bool has_h = is_lat;
        __syncthreads();
        if (is_lat) {
            const int lane = c.lane, fr = lane & 15, fq = lane >> 4;
            const float* sp = a.in[2] + ((size_t)(((seq - 32) * 2 + j) * 2 + dir) * NH + h) * 8192;
#pragma unroll
            for (int pb = 0; pb < 4; ++pb)
#pragma unroll
                for (int nbi = 0; nbi < 2; ++nbi) {
                    const int n = (2 * w + nbi) * 16 + fr, p0 = pb * 16 + fq * 4;
#pragma unroll
                    for (int r = 0; r < 4; ++r) S[pb][nbi][r] = sp[(p0 + r) * 128 + n];
                    u32x2 v; v.x = pk2(S[pb][nbi][0], S[pb][nbi][1]); v.y = pk2(S[pb][nbi][2], S[pb][nbi][3]);
                    *(u32x2*)(lds + SC_HT + off128(n, p0)) = v;
                }
        } else {
#pragma unroll
            for (int pb = 0; pb < 4; ++pb)
#pragma unroll
                for (int nbi = 0; nbi < 2; ++nbi) S[pb][nbi] = (f32x4){0.f, 0.f, 0.f, 0.f};
        }
#pragma unroll 1
        for (int ci = 0; ci < nch; ++ci) {
            int lane = c.lane; asm volatile("" : "+v"(lane));
            const int fr = lane & 15, fq = lane >> 4;
            const int ch = dir == 0 ? ci : nch - 1 - ci;
            const int t0 = tok0 + ch * 64;
            __syncthreads();
            {
#pragma unroll
                for (int i = 0; i < 2; ++i) {
                    const int q = w + 4 * i, row = q * 8 + (lane >> 3), lch = (lane & 7) ^ (row & 7);
                    __builtin_amdgcn_global_load_lds((const unsigned*)(XBC + (size_t)(t0 + row) * DXBC + h * 64 + lch * 8), (LAS unsigned*)(lds + SC_XS + q * 1024 + lane * 16), 16, 0, 0);
                }
#pragma unroll
                for (int i = 0; i < 4; ++i) {
                    const int q = w + 4 * i, row = q * 4 + (lane >> 4), lch = (lane & 15) ^ (row & 15);
                    __builtin_amdgcn_global_load_lds((const unsigned*)(XBC + (size_t)(t0 + row) * DXBC + DI + g * 128 + lch * 8), (LAS unsigned*)(lds + SC_BS + q * 1024 + lane * 16), 16, 0, 0);
                    __builtin_amdgcn_global_load_lds((const unsigned*)(XBC + (size_t)(t0 + row) * DXBC + DI + 512 + g * 128 + lch * 8), (LAS unsigned*)(lds + SC_CS + q * 1024 + lane * 16), 16, 0, 0);
                }
            }
            if (w == 0) {
                const int l = dir == 0 ? lane : 63 - lane;
                const float raw = DT[(size_t)(t0 + l) * 64 + dir * NH + h] + dtb;
                const float dt = raw > 20.f ? raw : log1pf(__expf(raw));
                float cs = dt * Aneg;
#pragma unroll
                for (int o = 1; o < 64; o <<= 1) { const float u = __shfl_up(cs, o); if (lane >= o) cs += u; }
                sm_dt[l] = dt; sm_cs[l] = cs;
                if (lane == 63) sm_tot[0] = cs;
            }
            asm volatile("s_waitcnt vmcnt(0)" ::: "memory");
            __syncthreads();
            const float tot = sm_tot[0];
            {
                const int l = c.tid >> 2, c0 = (c.tid & 3) * 16;
                const float sc = __expf(tot - sm_cs[l]) * sm_dt[l];
#pragma unroll
                for (int q = 0; q < 2; ++q) {
                    const int o = off128(l, c0 + q * 8);
                    const u32x4 v = *(const u32x4*)(lds + SC_XS + o);
                    u32x4 r;
#pragma unroll
                    for (int e = 0; e < 4; ++e) r[e] = pk2(bflo(v[e]) * sc, bfhi(v[e]) * sc);
                    *(u32x4*)(lds + SC_XW + o) = r;
                }
            }
            bf16x8 cf[4];
#pragma unroll
            for (int kk = 0; kk < 4; ++kk) cf[kk] = *(const bf16x8*)(lds + SC_CS + off256(w * 16 + fr, kk * 32 + fq * 8));
            const float csl = sm_cs[w * 16 + fr];
            f32x4 yacc[4];
#pragma unroll
            for (int pb = 0; pb < 4; ++pb) yacc[pb] = (f32x4){0.f, 0.f, 0.f, 0.f};
            if (has_h) {
#pragma unroll
                for (int pb = 0; pb < 4; ++pb)
#pragma unroll
                    for (int kk = 0; kk < 4; ++kk) {
                        const bf16x8 af = tr_frag<0>(lds + SC_HT, kk * 32 + fq * 8, kk * 32 + fq * 8 + 4, pb * 16, lane);
                        yacc[pb] = __builtin_amdgcn_mfma_f32_16x16x32_bf16(af, cf[kk], yacc[pb], 0, 0, 0);
                    }
                const float e = __expf(csl);
#pragma unroll
                for (int pb = 0; pb < 4; ++pb) yacc[pb] = yacc[pb] * e;
            }
#pragma unroll
            for (int kk2 = 0; kk2 < 2; ++kk2) {
                const bool need = dir == 0 ? (2 * kk2 <= w) : (2 * kk2 + 1 >= w);
                if (need) {
                    unsigned m[4];
#pragma unroll
                    for (int half = 0; half < 2; ++half) {
                        const int sb = 2 * kk2 + half;
                        f32x4 gacc = (f32x4){0.f, 0.f, 0.f, 0.f};
#pragma unroll
                        for (int kk = 0; kk < 4; ++kk) {
                            const bf16x8 bfrag = *(const bf16x8*)(lds + SC_BS + off256(sb * 16 + fr, kk * 32 + fq * 8));
                            gacc = __builtin_amdgcn_mfma_f32_16x16x32_bf16(bfrag, cf[kk], gacc, 0, 0, 0);
                        }
                        const f32x4 css = *(const f32x4*)(sm_cs + sb * 16 + fq * 4);
                        const f32x4 dts = *(const f32x4*)(sm_dt + sb * 16 + fq * 4);
                        float v[4];
#pragma unroll
                        for (int r = 0; r < 4; ++r) {
                            const int s = sb * 16 + fq * 4 + r, l = w * 16 + fr;
                            const bool valid = dir == 0 ? (s <= l) : (s >= l);
                            v[r] = valid ? gacc[r] * __expf(csl - css[r]) * dts[r] : 0.f;
                        }
                        m[half * 2 + 0] = pk2(v[0], v[1]); m[half * 2 + 1] = pk2(v[2], v[3]);
                    }
                    union { unsigned u[4]; bf16x8 v; } mf; mf.u[0] = m[0]; mf.u[1] = m[1]; mf.u[2] = m[2]; mf.u[3] = m[3];
#pragma unroll
                    for (int pb = 0; pb < 4; ++pb) {
                        const bf16x8 af = tr_frag<0>(lds + SC_XS, 32 * kk2 + 4 * fq, 32 * kk2 + 16 + 4 * fq, pb * 16, lane);
                        yacc[pb] = __builtin_amdgcn_mfma_f32_16x16x32_bf16(af, mf.v, yacc[pb], 0, 0, 0);
                    }
                }
            }
            __syncthreads();
            {
                const float et = __expf(tot);
#pragma unroll
                for (int pb = 0; pb < 4; ++pb)
#pragma unroll
                    for (int nbi = 0; nbi < 2; ++nbi) S[pb][nbi] = S[pb][nbi] * et;
#pragma unroll
                for (int kk = 0; kk < 2; ++kk) {
                    bf16x8 bq[2];
#pragma unroll
                    for (int nbi = 0; nbi < 2; ++nbi) bq[nbi] = tr_frag<1>(lds + SC_BS, kk * 32 + fq * 8, kk * 32 + fq * 8 + 4, (2 * w + nbi) * 16, lane);
#pragma unroll
                    for (int pb = 0; pb < 4; ++pb) {
                        const bf16x8 af = tr_frag<0>(lds + SC_XW, kk * 32 + fq * 8, kk * 32 + fq * 8 + 4, pb * 16, lane);
#pragma unroll
                        for (int nbi = 0; nbi < 2; ++nbi) S[pb][nbi] = __builtin_amdgcn_mfma_f32_16x16x32_bf16(af, bq[nbi], S[pb][nbi], 0, 0, 0);
                    }
                }
#pragma unroll
                for (int pb = 0; pb < 4; ++pb)
#pragma unroll
                    for (int nbi = 0; nbi < 2; ++nbi) {
                        const int n = (2 * w + nbi) * 16 + fr, p0 = pb * 16 + fq * 4;
                        u32x2 v; v.x = pk2(S[pb][nbi][0], S[pb][nbi][1]); v.y = pk2(S[pb][nbi][2], S[pb][nbi][3]);
                        *(u32x2*)(lds + SC_HT + off128(n, p0)) = v;
                    }
                has_h = true;
            }
            {
                const int l = w * 16 + fr, tok = t0 + l;
                if (dir == 0) {
#pragma unroll
                    for (int pb = 0; pb < 4; ++pb) {
                        const int p0 = pb * 16 + fq * 4;
                        u32x2 v; v.x = pk2(yacc[pb][0], yacc[pb][1]); v.y = pk2(yacc[pb][2], yacc[pb][3]);
                        *(u32x2*)(YTMP + (size_t)tok * DI + h * 64 + p0) = v;
                    }
                } else {
                    float ss = 0.f;
#pragma unroll
                    for (int pb = 0; pb < 4; ++pb) {
                        const int p0 = pb * 16 + fq * 4;
                        const u32x2 yt = *(const u32x2*)(YTMP + (size_t)tok * DI + h * 64 + p0);
                        const u32x2 zz = *(const u32x2*)(Z + (size_t)tok * DI + h * 64 + p0);
                        const u32x2 xx = *(const u32x2*)(lds + SC_XS + off128(l, p0));
                        const f32x4 nw = *(const f32x4*)(normw + p0);
                        float y[4];
                        y[0] = yacc[pb][0] + bflo(yt.x) + Dh * bflo(xx.x); y[1] = yacc[pb][1] + bfhi(yt.x) + Dh * bfhi(xx.x);
                        y[2] = yacc[pb][2] + bflo(yt.y) + Dh * bflo(xx.y); y[3] = yacc[pb][3] + bfhi(yt.y) + Dh * bfhi(xx.y);
                        y[0] *= silu_f(bflo(zz.x)); y[1] *= silu_f(bfhi(zz.x)); y[2] *= silu_f(bflo(zz.y)); y[3] *= silu_f(bfhi(zz.y));
                        ss += y[0] * y[0] + y[1] * y[1] + y[2] * y[2] + y[3] * y[3];
                        u32x2 v; v.x = pk2(y[0] * nw[0], y[1] * nw[1]); v.y = pk2(y[2] * nw[2], y[3] * nw[3]);
                        *(u32x2*)(YG + (size_t)tok * DI + h * 64 + p0) = v;
                    }
                    ss += __shfl_xor(ss, 16); ss += __shfl_xor(ss, 32);
                    if (fq == 0) SSQ[(size_t)tok * NH + h] = ss;
                }
            }
        }
        if (!is_lat) {
            const int lane = c.lane, fr = lane & 15, fq = lane >> 4;
            float* op = a.out + (size_t)NTOK * D + ((size_t)((seq * 2 + j) * 2 + dir) * NH + h) * 8192;
#pragma unroll
            for (int pb = 0; pb < 4; ++pb)
#pragma unroll
                for (int nbi = 0; nbi < 2; ++nbi) {
                    const int n = (2 * w + nbi) * 16 + fr, p0 = pb * 16 + fq * 4;
#pragma unroll
                    for (int r = 0; r < 4; ++r) op[(p0 + r) * 128 + n] = S[pb][nbi][r];
                }
        }
    }
}
#if NAIVE_SCAN
__device__ __forceinline__ void scan_unit_naive(const Ctx& c, int j, int seq, int h) {
    const Args __attribute__((address_space(4)))& a = *c.a;
    const bf16_t* XBC = (const bf16_t*)(a.ws + S_XBC);
    const bf16_t* Z = (const bf16_t*)(a.ws + S_Z);
    const float* DT = (const float*)(a.ws + S_DT);
    bf16_t* YTMP = (bf16_t*)(a.ws + S_RAW);
    bf16_t* YG = (bf16_t*)(a.ws + S_YG);
    float* SSQ = (float*)(a.ws + S_SSQ);
    const bool is_lat = seq >= 32;
    const int tok0 = is_lat ? NCTX + (seq - 32) * 1024 : seq * 256;
    const int L = is_lat ? 1024 : 256;
    const int g = h >> 3, p = c.tid >> 2, nq = (c.tid & 3) * 32;
    const float Dh = a.in[14][j * NH + h];
    const float nw = a.in[15][(size_t)j * DI + h * 64 + p];
    float* red = (float*)c.lds;
    for (int dir = 0; dir < 2; ++dir) {
        const float Aneg = -__expf(a.in[13][(j * 2 + dir) * NH + h]);
        const float dtb = a.in[12][(j * 2 + dir) * NH + h];
        float hs[32];
        if (is_lat) { const float* sp = a.in[2] + ((size_t)(((seq - 32) * 2 + j) * 2 + dir) * NH + h) * 8192 + p * 128 + nq;
#pragma unroll
            for (int e = 0; e < 32; ++e) hs[e] = sp[e]; }
        else {
#pragma unroll
            for (int e = 0; e < 32; ++e) hs[e] = 0.f; }
        asm volatile("s_waitcnt vmcnt(0)" ::: "memory"); __syncthreads();
        for (int ti = 0; ti < L; ++ti) {
            const int tok = tok0 + (dir == 0 ? ti : L - 1 - ti);
            const float raw = DT[(size_t)tok * 64 + dir * NH + h] + dtb;
            const float dt = raw > 20.f ? raw : log1pf(__expf(raw));
            const float dec = __expf(dt * Aneg);
            const float xv = bflo((unsigned)XBC[(size_t)tok * DXBC + h * 64 + p]);
            const bf16_t* Bp = XBC + (size_t)tok * DXBC + DI + g * 128 + nq;
            const bf16_t* Cp = XBC + (size_t)tok * DXBC + DI + 512 + g * 128 + nq;
            float y = 0.f;
#pragma unroll
            for (int e = 0; e < 32; ++e) { hs[e] = hs[e] * dec + dt * xv * bflo((unsigned)Bp[e]); y += bflo((unsigned)Cp[e]) * hs[e]; }
            y += __shfl_xor(y, 1); y += __shfl_xor(y, 2);
            if (dir == 0) { if ((c.tid & 3) == 0) YTMP[(size_t)tok * DI + h * 64 + p] = (bf16_t)(pk2(y, 0.f) & 0xffff); }
            else {
                const float yt = bflo((unsigned)YTMP[(size_t)tok * DI + h * 64 + p]);
                const float zz = bflo((unsigned)Z[(size_t)tok * DI + h * 64 + p]);
                float yy = (y + yt + Dh * xv) * silu_f(zz);
                __syncthreads();
                if ((c.tid & 3) == 0) { red[p] = yy * yy; YG[(size_t)tok * DI + h * 64 + p] = (bf16_t)(pk2(yy * nw, 0.f) & 0xffff); }
                __syncthreads();
                if (c.tid == 0) { float s = 0.f; for (int e = 0; e < 64; ++e) s += red[e]; SSQ[(size_t)tok * NH + h] = s; }
            }
        }
        if (!is_lat) { float* op = a.out + (size_t)NTOK * D + ((size_t)((seq * 2 + j) * 2 + dir) * NH + h) * 8192 + p * 128 + nq;
#pragma unroll
            for (int e = 0; e < 32; ++e) op[e] = hs[e]; }
    }
}
#endif
__device__ __forceinline__ void phase_scan(const Ctx& c, int j) {
#if NAIVE_SCAN
    for (int u = c.vb; u < 1088; u += c.G) { if (u < 64) scan_unit_naive(c, j, 32 + (u >> 5), u & 31); else scan_unit_naive(c, j, (u - 64) >> 5, (u - 64) & 31); }
    return;
#endif
    if (c.vb < 64) { scan_unit(c, j, 32 + (c.vb >> 5), c.vb & 31); return; }
    const int nb = c.G - 64;
    for (int u = c.vb - 64; u < 1024; u += nb) scan_unit(c, j, u >> 5, u & 31);
}

typedef const Args __attribute__((address_space(4)))* ArgsP;
#if 0
#define LB_WAVES 1
#else
#define LB_WAVES 2
#endif
__global__ void __launch_bounds__(256, LB_WAVES) fwd_kernel(Args args) {
    extern __shared__ __attribute__((aligned(16))) char lds[];
    volatile LAS unsigned* st = (volatile LAS unsigned*)(lds + LDS_BYTES - 16);
    if (threadIdx.x == 0) { st[0] = 0u; st[1] = 0u; }
    __syncthreads();
    const int ph_lo = args.ph_lo, ph_hi = args.ph_hi;
    const bool multi = (ph_hi - ph_lo) > 1;
    XcdBarrier bar; bar.bar = (unsigned*)(args.ws + WS_CTL); bar.x = 0; bar.st = st;
    if (multi) bar = xcd_barrier_post((unsigned*)(args.ws + WS_CTL), st);

#pragma unroll 1
    for (int ph = ph_lo; ph < ph_hi; ++ph) {
        ArgsP ap = (ArgsP)__builtin_amdgcn_kernarg_segment_ptr();
        asm volatile("" : "+s"(ap));
        int tid = threadIdx.x;
        asm volatile("" : "+v"(tid));
        Ctx c;
        c.lds = lds; c.tid = tid; c.lane = tid & 63; c.wid = __builtin_amdgcn_readfirstlane(tid >> 6);
        c.G = gridDim.x; c.vb = (c.G % 8 == 0) ? (int)(blockIdx.x % 8) * (c.G / 8) + (int)(blockIdx.x / 8) : (int)blockIdx.x;
        c.a = ap;
        unsigned char* ws = ap->ws;
        const float* MOD = (const float*)(ws + WS_MOD);

        if (ph == 0) { if (PH_ON(0)) phase_prep(c); }
        else {
            int layer, sub;
            if (ph <= 8) { layer = 0; sub = ph - 1; } else if (ph <= 15) { layer = 1; sub = ph - 9; } else if (ph <= 23) { layer = 2; sub = ph - 16; } else if (ph <= 30) { layer = 3; sub = ph - 24; } else { layer = 3; sub = 100; }
            const int j = layer >> 1;
            const float* mod = MOD + (size_t)layer * 3 * 6144;
            const bool ssd = (layer & 1) == 0;
            const int nsub_mix = ssd ? 5 : 4;
            int kind;
            if (sub == 100 || sub == 0 || sub == nsub_mix) kind = 1;
            else if (sub < nsub_mix) kind = ssd ? (sub == 1 ? 2 : sub == 2 ? 3 : sub == 3 ? 4 : 5) : (sub == 1 ? 6 : sub == 2 ? 7 : 5);
            else kind = (sub - nsub_mix == 1) ? 8 : 5;

            if (kind == 1) {
                if (PH_ON(1)) {
                    if (sub == 100) phase_norm(c, ap->in[21], nullptr, 0, 0, true);
                    else if (sub == 0) phase_norm(c, ap->in[7] + layer * D, mod, 0, 1024, false);
                    else phase_norm(c, ap->in[8] + layer * D, mod, 3072, 4096, false);
                }
            } else if (kind == 2) { if (PH_ON(2)) phase_inproj(c, j); }
            else if (kind == 3) { if (PH_ON(3)) phase_conv(c, j); }
            else if (kind == 4) { if (PH_ON(4)) phase_scan(c, j); }
            else if (kind == 6) { if (PH_ON(6)) phase_f1(c); }
            else if (kind == 7) { if (PH_ON(7)) phase_f2(c); }
            else if (kind == 8) { if (PH_ON(8)) phase_mlp_up(c, layer); }
            else {
                if (PH_ON(5)) {
                    const bf16_t* WT; const bf16_t* Act; int K; const float* gate; const float* bias = nullptr; const float* ssq = nullptr;
                    if (sub < nsub_mix) {
                        gate = mod + 2048;
                        if (ssd) { WT = (const bf16_t*)(ws + WS_WOUT) + (size_t)j * D * DI; Act = (const bf16_t*)(ws + S_YG); K = DI; ssq = (const float*)(ws + S_SSQ); }
                        else { WT = (const bf16_t*)(ws + WS_WFNO) + (size_t)j * D * D; Act = (const bf16_t*)(ws + S_F); K = D; bias = ap->in[18] + j * D; }
                    } else { gate = mod + 5120; WT = (const bf16_t*)(ws + WS_W2) + (size_t)layer * D * DFF; Act = (const bf16_t*)(ws + S_HID); K = DFF; }
                    phase_resid_gemm(c, WT, Act, K, gate, bias, ssq);
                }
            }
        }
        if (ph + 1 < ph_hi) xcd_barrier(bar);
    }
}

extern "C" void kernel_launch(void* const* d_in, const int* in_sizes, int n_in, void* d_out, int out_size, void* d_ws, size_t ws_size, hipStream_t stream) {
    static int grid = 0;
    if (grid == 0) {
        int dev = 0, cus = 0;
        if (hipGetDevice(&dev) != hipSuccess || hipDeviceGetAttribute(&cus, hipDeviceAttributeMultiprocessorCount, dev) != hipSuccess || cus <= 0) { fprintf(stderr, "kernel_launch: device query failed\n"); grid = -1; return; }
        if (hipFuncSetAttribute((const void*)fwd_kernel, hipFuncAttributeMaxDynamicSharedMemorySize, LDS_BYTES) != hipSuccess) { fprintf(stderr, "kernel_launch: hipFuncSetAttribute failed\n"); }
        (void)hipGetLastError();
        if (ws_size < WS_END) fprintf(stderr, "kernel_launch: workspace too small: %zu < %zu\n", ws_size, (size_t)WS_END);
        grid = 2 * cus;
    }
    if (grid < 0) return;
    (void)hipMemsetAsync((char*)d_ws + WS_CTL, 0, CTL_BYTES, stream);
    Args a{};
    for (int i = 0; i < 22; ++i) a.in[i] = (const float*)d_in[i];
    a.out = (float*)d_out; a.ws = (unsigned char*)d_ws;
#if N_LAUNCH_MODE == 1
    a.ph_lo = 0; a.ph_hi = NPHASE;
    hipLaunchKernelGGL(fwd_kernel, dim3(grid), dim3(256), LDS_BYTES, stream, a);
#else
    for (int ph = 0; ph < NPHASE; ++ph) {
        a.ph_lo = ph; a.ph_hi = ph + 1;
        hipLaunchKernelGGL(fwd_kernel, dim3(grid), dim3(256), LDS_BYTES, stream, a);
    }
#endif
}
```

```cpp
#include <hip/hip_runtime.h>
#include <stdint.h>
#include <stdio.h>

#ifndef PH_MASK
#define PH_MASK 0xFFFF
#endif
#define PH_ON(k) ((PH_MASK >> (k)) & 1)
#ifndef NAIVE_GEMM
#define NAIVE_GEMM 0
#endif
#define GN(k) ((NAIVE_GEMM >> (k)) & 1)
#ifndef NAIVE_SCAN
#define NAIVE_SCAN 0
#endif
#ifndef REP_KIND
#define REP_KIND -1
#endif
#ifndef REP_N
#define REP_N 0
#endif
#ifndef GEMM_SETPRIO
#define GEMM_SETPRIO 1
#endif
#ifndef N_LAUNCH_MODE
#define N_LAUNCH_MODE 1
#endif

typedef unsigned short bf16_t;
typedef short bf16x8 __attribute__((ext_vector_type(8)));
typedef short bf16x4 __attribute__((ext_vector_type(4)));
typedef float f32x4 __attribute__((ext_vector_type(4)));
typedef unsigned u32x4 __attribute__((ext_vector_type(4)));
typedef unsigned u32x2 __attribute__((ext_vector_type(2)));
#define LAS __attribute__((address_space(3)))

constexpr int D = 1024, NCTX = 8192, NLAT = 2048, NTOK = 10240;
constexpr int DI = 2048, DXBC = 3072, DPROJ = 5184, NZX = 5120, NH = 32, DFF = 4096;
constexpr float EPS = 1e-6f;
constexpr int NPHASE = 25;

constexpr size_t al256(size_t x) { return (x + 255) & ~(size_t)255; }
constexpr size_t WS_CTL  = 0;
constexpr size_t CTL_BYTES = 65536 + 81920;
constexpr size_t WS_ZERO = 65536;
constexpr size_t WS_MOD  = WS_CTL + CTL_BYTES;
constexpr size_t WS_SWIN = al256(WS_MOD + 4 * 3 * 6144 * 4);
constexpr size_t WS_SWUP = WS_SWIN + 2 * 3 * DPROJ * 4;
constexpr size_t WS_SWF1 = WS_SWUP + 4 * 3 * DFF * 4;
constexpr size_t WS_RSS  = al256(WS_SWF1 + 2 * 3 * 2048 * 4);
constexpr size_t WS_WIN  = al256(WS_RSS + (size_t)NTOK * 16 * 4);
constexpr size_t WS_WOUT = WS_WIN + (size_t)2 * DPROJ * D * 2;
constexpr size_t WS_WFNO = WS_WOUT + (size_t)2 * D * DI * 2;
constexpr size_t WS_W1   = WS_WFNO + (size_t)2 * D * D * 2;
constexpr size_t WS_W2   = WS_W1 + (size_t)4 * DFF * D * 2;
constexpr size_t WS_T1   = WS_W2 + (size_t)4 * DFF * D * 2;
constexpr size_t WS_T2C  = WS_T1 + (size_t)512 * 256 * 2;
constexpr size_t WS_T2L  = WS_T2C + (size_t)256 * 512 * 2;
constexpr size_t WS_H    = WS_T2L + (size_t)1024 * 2048 * 2;
constexpr size_t WS_S    = WS_H + (size_t)NTOK * D * 2;
constexpr size_t S_Z     = WS_S;
constexpr size_t S_XBC   = S_Z + (size_t)NTOK * DI * 2;
constexpr size_t S_DT    = S_XBC + (size_t)NTOK * DXBC * 2;
constexpr size_t S_SSQ   = S_DT + (size_t)NTOK * 64 * 4;
constexpr size_t S_YG    = S_SSQ + (size_t)NTOK * 32 * 4;
constexpr size_t S_RAW   = S_YG + (size_t)NTOK * DI * 2;
constexpr size_t WS_END  = S_RAW + (size_t)NTOK * DXBC * 2;
constexpr size_t S_HID   = WS_S;
constexpr size_t S_UVT   = WS_S;
constexpr size_t S_F     = WS_S + (size_t)NTOK * 2048 * 2;

constexpr int LDS_BYTES = 163840;
constexpr int NTHR = 512, NWAVE = 8;

typedef __bf16 bf16x2_t __attribute__((ext_vector_type(2)));
typedef float f32x2_t __attribute__((ext_vector_type(2)));
__device__ __forceinline__ unsigned pk2(float lo, float hi) { const f32x2_t f = {lo, hi}; return __builtin_bit_cast(unsigned, __builtin_convertvector(f, bf16x2_t)); }
__device__ __forceinline__ float bflo(unsigned u) { return __uint_as_float(u << 16); }
__device__ __forceinline__ float bfhi(unsigned u) { return __uint_as_float(u & 0xffff0000u); }
__device__ __forceinline__ float wave_sum(float v) {
#pragma unroll
    for (int o = 1; o < 64; o <<= 1) v += __shfl_xor(v, o);
    return v;
}
__device__ __forceinline__ float silu_f(float x) { return x * __builtin_amdgcn_rcpf(1.0f + __expf(-x)); }
__device__ __forceinline__ int cond_of(int tok) { return tok < NCTX ? 0 : (tok < NCTX + 1024 ? 1 : 2); }

#define XB_TMO      128
#define XB_XCNT(j)  (256  + 64 * (j))
#define XB_XSUB(j)  (1280 + 64 * (j))
#define XB_XGEN(j)  (2304 + 64 * (j))
#define XB_TOP      3328
#define XB_TOPGEN   3392
#define XCD_BAR_WORDS 3456
#define XB_SPIN_CAP (1u << 20)
__device__ __forceinline__ unsigned xb_ld(unsigned* p)              { return __hip_atomic_load(p, __ATOMIC_RELAXED, __HIP_MEMORY_SCOPE_AGENT); }
__device__ __forceinline__ unsigned xb_add(unsigned* p, unsigned v) { return __hip_atomic_fetch_add(p, v, __ATOMIC_RELAXED, __HIP_MEMORY_SCOPE_AGENT); }
__device__ __forceinline__ unsigned xb_xcc_id() { return (unsigned)__builtin_amdgcn_s_getreg((3 << 11) | 20) & 0xFu; }
#define XB_SPIN(cond, bar) do { unsigned _sp = 0; while (cond) { __builtin_amdgcn_s_sleep(1); \
    if ((++_sp & 255u) == 0u) { if (xb_ld(&(bar)[XB_TMO])) break; if (_sp > XB_SPIN_CAP) { atomicAdd(&(bar)[XB_TMO], 1u); break; } } } } while (0)
struct XcdBarrier { unsigned* bar; unsigned x; volatile LAS unsigned* st; };
__device__ __forceinline__ XcdBarrier xcd_barrier_post(unsigned* bar, volatile LAS unsigned* st) {
    XcdBarrier b; b.bar = bar; b.x = xb_xcc_id(); b.st = st;
    if (threadIdx.x == 0) (void)xb_add(&bar[XB_XCNT(b.x)], 1u);
    return b;
}
__device__ __forceinline__ void xcd_barrier_complete(unsigned* bar, unsigned x, unsigned& nloc, unsigned& nx) {
    const unsigned G = gridDim.x * gridDim.y * gridDim.z;
    unsigned sum, cnt, mine, sp = 0u;
    for (;;) {
        sum = 0u; cnt = 0u; mine = 0u;
#pragma unroll
        for (unsigned j = 0; j < 16; ++j) { const unsigned c = xb_ld(&bar[XB_XCNT(j)]); sum += c; cnt += (c > 0u) ? 1u : 0u; mine = (j == x) ? c : mine; }
        if (sum == G) break;
        __builtin_amdgcn_s_sleep(1);
        if ((++sp & 255u) == 0u) { if (xb_ld(&bar[XB_TMO])) break; if (sp > XB_SPIN_CAP) { atomicAdd(&bar[XB_TMO], 1u); break; } }
    }
    nloc = mine > 0u ? mine : 1u; nx = cnt > 0u ? cnt : 1u;
}
__device__ __forceinline__ void xcd_barrier(const XcdBarrier& b) {
    asm volatile("s_waitcnt vmcnt(0)" ::: "memory");
    __syncthreads();
    if (threadIdx.x == 0) {
        unsigned* bar = b.bar;
        __builtin_amdgcn_s_waitcnt(0);
        unsigned nloc = b.st[0], nx = b.st[1];
        if (nloc == 0u) { xcd_barrier_complete(bar, b.x, nloc, nx); b.st[0] = nloc; b.st[1] = nx; }
        const unsigned old = xb_add(&bar[XB_XSUB(b.x)], 1u);
        const unsigned gen = old / nloc;
        if (old + 1u == (gen + 1u) * nloc) {
            __builtin_amdgcn_fence(__ATOMIC_RELEASE, "agent");
            asm volatile("s_waitcnt vmcnt(0)" ::: "memory");
            const unsigned og = xb_add(&bar[XB_TOP], 1u);
            const unsigned tg = og / nx;
            if (og + 1u == (tg + 1u) * nx) xb_add(&bar[XB_TOPGEN], 1u);
            else XB_SPIN(xb_ld(&bar[XB_TOPGEN]) == tg, bar);
            __builtin_amdgcn_fence(__ATOMIC_ACQUIRE, "agent");
            xb_add(&bar[XB_XGEN(b.x)], 1u);
            asm volatile("s_waitcnt vmcnt(0)" ::: "memory");
        } else {
            XB_SPIN(xb_ld(&bar[XB_XGEN(b.x)]) == gen, bar);
            __builtin_amdgcn_fence(__ATOMIC_ACQUIRE, "agent");
            asm volatile("s_waitcnt vmcnt(0)" ::: "memory");
        }
    }
    __syncthreads();
}

struct Args {
    const float* in[22];
    float* out;
    unsigned char* ws;
    int ph_lo, ph_hi;
};

struct Ctx {
    char* lds;
    int tid, lane, wid;
    int vb, G;
    const Args __attribute__((address_space(4)))* a;
};

template <int TB> struct GT { static constexpr int ROWS = 256 + 32 * TB, STAGE = ROWS * 128, NI = ROWS / 8; };

template <int TB>
__device__ __forceinline__ void gemm_stage(char* st, const bf16_t* Ag, int lda, const bf16_t* Bg, int ldb, int k0, int wid, int lane) {
    constexpr int NI = GT<TB>::NI;
    const int rsub = lane >> 3, lch = (lane & 7) ^ rsub;
#pragma unroll
    for (int i = 0; i < (NI + 7) / 8; ++i) {
        const int q = wid + 8 * i;
        if (q < NI) {
            const int row = q * 8 + rsub;
            const bf16_t* src = (q < 32) ? (Ag + (size_t)row * lda + k0 + lch * 8) : (Bg + (size_t)(row - 256) * ldb + k0 + lch * 8);
            __builtin_amdgcn_global_load_lds((const unsigned*)src, (LAS unsigned*)(st + q * 1024 + lane * 16), 16, 0, 0);
        }
    }
}
__device__ __forceinline__ bf16x8 frag128(const char* tile, int row, int chunk) {
    return *(const bf16x8*)(tile + row * 128 + ((chunk ^ (row & 7)) << 4));
}

struct NoPre { __device__ __forceinline__ void operator()() const {} };
template <int TB, bool NAIVE, class Epi, class Pre = NoPre>
__device__ __forceinline__ void gemm_tile(const Ctx& c, const bf16_t* Ag, int lda, const bf16_t* Bg, int ldb, int K, int a0, int b0, const Epi& epi, const Pre& pre = Pre(),
                                          bool prefetched = false, const bf16_t* An = nullptr, const bf16_t* Bn = nullptr) {
    constexpr int STAGE = GT<TB>::STAGE;
    const int wr = c.wid >> 1, wc = c.wid & 1, fr = c.lane & 15, fq = c.lane >> 4;
    f32x4 acc[4][TB];
#pragma unroll
    for (int i = 0; i < 4; ++i)
#pragma unroll
        for (int j = 0; j < TB; ++j) acc[i][j] = (f32x4){0.f, 0.f, 0.f, 0.f};
    if (NAIVE) {
        __syncthreads(); pre(); __syncthreads();
        const bf16_t* ar = Ag + (size_t)(wr * 64 + fq * 4) * lda;
        const bf16_t* br = Bg + (size_t)(wc * 16 * TB + fr) * ldb;
#pragma unroll
        for (int j = 0; j < TB; ++j) {
#pragma unroll 1
            for (int k = 0; k < K; k += 8) {
                float bv[8];
                { const u32x4 v = *(const u32x4*)(br + (size_t)(j * 16) * ldb + k);
#pragma unroll
                  for (int e = 0; e < 4; ++e) { bv[2 * e] = bflo(v[e]); bv[2 * e + 1] = bfhi(v[e]); } }
#pragma unroll
                for (int i = 0; i < 4; ++i)
#pragma unroll
                    for (int r = 0; r < 4; ++r) {
                        const u32x4 v = *(const u32x4*)(ar + (size_t)(i * 16 + r) * lda + k);
#pragma unroll
                        for (int e = 0; e < 4; ++e) acc[i][j][r] += bflo(v[e]) * bv[2 * e] + bfhi(v[e]) * bv[2 * e + 1];
                    }
                asm volatile("" ::: "memory");
            }
        }
        epi(acc, a0 + wr * 64, b0 + wc * (16 * TB), fr, fq);
        return;
    }
    const int nt = K >> 6;
    __syncthreads();
    if (!prefetched) gemm_stage<TB>(c.lds, Ag, lda, Bg, ldb, 0, c.wid, c.lane);
    pre();
    for (int t = 0; t < nt; ++t) {
        asm volatile("s_waitcnt vmcnt(0)" ::: "memory");
        __syncthreads();
        const char* cur = c.lds + (t & 1) * STAGE;
        if (t + 1 < nt) gemm_stage<TB>(c.lds + ((t + 1) & 1) * STAGE, Ag, lda, Bg, ldb, (t + 1) << 6, c.wid, c.lane);
        else if (An) gemm_stage<TB>(c.lds, An, lda, Bn, ldb, 0, c.wid, c.lane);
#pragma unroll
        for (int kk = 0; kk < 2; ++kk) {
            bf16x8 af[4], bfr[TB];
#pragma unroll
            for (int i = 0; i < 4; ++i) af[i] = frag128(cur, wr * 64 + i * 16 + fr, kk * 4 + fq);
#pragma unroll
            for (int j = 0; j < TB; ++j) bfr[j] = frag128(cur, 256 + wc * (16 * TB) + j * 16 + fr, kk * 4 + fq);
#pragma unroll
            for (int i = 0; i < 4; ++i)
#pragma unroll
                for (int j = 0; j < TB; ++j) acc[i][j] = __builtin_amdgcn_mfma_f32_16x16x32_bf16(af[i], bfr[j], acc[i][j], 0, 0, 0);
        }
    }
    epi(acc, a0 + wr * 64, b0 + wc * (16 * TB), fr, fq);
}

template <int TB, class Prob, int BENCH = 0>
__device__ __forceinline__ void gemm_stream(const Ctx& c, const Prob& P) {
    constexpr int STAGE = GT<TB>::STAGE, NI = GT<TB>::NI;
    constexpr int NSLOT = (NI + 7) / 8;
    const int wr = c.wid >> 1, wc = c.wid & 1, fr = c.lane & 15, fq = c.lane >> 4;
    const int n = P.count();
    if (n <= 0) return;
    f32x4 acc[4][TB];
#pragma unroll
    for (int i = 0; i < 4; ++i)
#pragma unroll
        for (int j = 0; j < TB; ++j) acc[i][j] = (f32x4){0.f, 0.f, 0.f, 0.f};
    const int KT = P.K >> 6;
    const int total = n * KT;
    const int rsub = c.lane >> 3, lch = (c.lane & 7) ^ rsub;
    int voff[NSLOT];
#pragma unroll
    for (int s = 0; s < NSLOT; ++s) {
        const int q = c.wid + 8 * s;
        voff[s] = (s < 4) ? ((q * 8 + rsub) * P.lda + lch * 8) : ((q * 8 + rsub - 256) * P.ldb + lch * 8);
    }
    const bf16_t* Acur; const bf16_t* Bcur;
    int li = 0, lk = 0;
    P.tile(0, Acur, Bcur);
    auto issue = [&](int stage) {
        char* st = c.lds + stage * STAGE;
#pragma unroll
        for (int s = 0; s < NSLOT; ++s) {
            const int q = c.wid + 8 * s;
            if (q < NI) {
                const bf16_t* src = ((s < 4) ? Acur : Bcur) + voff[s] + lk * 64;
                __builtin_amdgcn_global_load_lds((const unsigned*)src, (LAS unsigned*)(st + q * 1024 + c.lane * 16), 16, 0, 0);
            }
        }
        if (++lk == KT) { lk = 0; if (li + 1 < n) { ++li; P.tile(li, Acur, Bcur); } }
    };
    asm volatile("s_waitcnt vmcnt(0)" ::: "memory");
    __builtin_amdgcn_s_barrier();
    asm volatile("" ::: "memory");
    issue(0); issue(1);
    P.pre_all();
    int ci = 0, ck = 0, stg = 0;
    const bool more = (NI % 8 != 0) && (c.wid < (NI % 8));
#define GEMM_WAIT_ONE_STAGE() do { if (BENCH == 1 || BENCH == 3 || BENCH == 4) { asm volatile("s_waitcnt vmcnt(0)" ::: "memory"); } \
        else if (NI % 8 == 0) { asm volatile("s_waitcnt vmcnt(%0)" :: "n"(NI / 8) : "memory"); } \
        else if (more) { asm volatile("s_waitcnt vmcnt(%0)" :: "n"(NSLOT) : "memory"); } \
        else { asm volatile("s_waitcnt vmcnt(%0)" :: "n"(NSLOT - 1) : "memory"); } } while (0)
#define GEMM_BAR() do { asm volatile("" ::: "memory"); __builtin_amdgcn_s_barrier(); asm volatile("" ::: "memory"); } while (0)
#define GEMM_LOADF(dst, stage_ptr, kk) do { \
        _Pragma("unroll") for (int i = 0; i < 4; ++i) dst.a[i] = frag128(stage_ptr, wr * 64 + i * 16 + fr, (kk) * 4 + fq); \
        _Pragma("unroll") for (int jj = 0; jj < TB; ++jj) dst.b[jj] = frag128(stage_ptr, 256 + wc * (16 * TB) + jj * 16 + fr, (kk) * 4 + fq); } while (0)
#define GEMM_MMA(src_) do { \
        _Pragma("unroll") for (int i = 0; i < 4; ++i) \
        _Pragma("unroll") for (int jj = 0; jj < TB; ++jj) acc[i][jj] = __builtin_amdgcn_mfma_f32_16x16x32_bf16(src_.a[i], src_.b[jj], acc[i][jj], 0, 0, 0); } while (0)
    struct Frags { bf16x8 a[4]; bf16x8 b[TB]; };
    Frags f0, f1;
    GEMM_WAIT_ONE_STAGE(); GEMM_BAR();
    GEMM_LOADF(f0, c.lds, 0);
#pragma unroll 1
    for (int gs = 0; gs < total; ++gs) {
        const char* cur = c.lds + stg * STAGE;
        const int nst1 = stg == 2 ? 0 : stg + 1;
        GEMM_LOADF(f1, cur, 1);
        if (BENCH != 1) { const int nst = stg == 0 ? 2 : stg - 1; issue(nst); }
#if GEMM_SETPRIO
        __builtin_amdgcn_s_setprio(1);
#endif
        GEMM_MMA(f0);
#if GEMM_SETPRIO
        __builtin_amdgcn_s_setprio(0);
#endif
        GEMM_WAIT_ONE_STAGE();
        asm volatile("s_waitcnt lgkmcnt(0)" ::: "memory");
        GEMM_BAR();
        GEMM_LOADF(f0, c.lds + nst1 * STAGE, 0);
#if GEMM_SETPRIO
        __builtin_amdgcn_s_setprio(1);
#endif
        GEMM_MMA(f1);
#if GEMM_SETPRIO
        __builtin_amdgcn_s_setprio(0);
#endif
        stg = nst1;
        if (++ck == KT) {
            P.epilogue(ci, acc, wr, wc, fr, fq);
#pragma unroll
            for (int i = 0; i < 4; ++i)
#pragma unroll
                for (int j = 0; j < TB; ++j) acc[i][j] = (f32x4){0.f, 0.f, 0.f, 0.f};
            ck = 0; ++ci;
        }
    }
    asm volatile("s_waitcnt vmcnt(0)" ::: "memory");
    GEMM_BAR();
#undef GEMM_WAIT_ONE_STAGE
#undef GEMM_BAR
#undef GEMM_LOADF
#undef GEMM_MMA
}

struct EpiInProj {
    bf16_t* Z; bf16_t* RAW; const float* rsx  ; int tok_base; const float* SW  ;
    __device__ __forceinline__ void operator()(f32x4 (&acc)[4][5], int ab, int bb, int fr, int fq) const {
#pragma unroll
        for (int j = 0; j < 5; ++j) {
            const int tok = bb + j * 16 + fr;
            const float rs = rsx[tok - tok_base];
            const float* sw = SW + cond_of(tok) * DPROJ;
#pragma unroll
            for (int i = 0; i < 4; ++i) {
                const int n = ab + i * 16 + fq * 4;
                const f32x4 o = acc[i][j] * rs + *(const f32x4*)(sw + n);
                u32x2 v; v.x = pk2(o[0], o[1]); v.y = pk2(o[2], o[3]);
                bf16_t* dst = (n < DI) ? (Z + (size_t)tok * DI + n) : (RAW + (size_t)tok * DXBC + (n - DI));
                *(u32x2*)dst = v;
            }
        }
    }
};
struct EpiResid {
    float* X; const float* gate  ; const float* bias; const float* rs_lds  ; int tok_base;
    bf16_t* XG  ; const float* nw_next; const float* scale_next  ; float* RSS;
    __device__ __forceinline__ void operator()(f32x4 (&acc)[4][5], int ab, int bb, int fr, int fq) const {
        const int slot = (ab >> 6);
#pragma unroll
        for (int j = 0; j < 5; ++j) {
            const int tok = bb + j * 16 + fr;
            const float rs = rs_lds ? rs_lds[tok - tok_base] : 1.0f;
            const int cd = cond_of(tok);
            const float* g = gate + cd * 6144;
            float ss = 0.f;
#pragma unroll
            for (int i = 0; i < 4; ++i) {
                const int n = ab + i * 16 + fq * 4;
                const f32x4 gv = *(const f32x4*)(g + n);
                f32x4 bv = (f32x4){0.f, 0.f, 0.f, 0.f};
                if (bias) bv = *(const f32x4*)(bias + n);
                f32x4* xp = (f32x4*)(X + (size_t)tok * D + n);
                f32x4 xv = *xp;
                xv = xv + gv * (acc[i][j] * rs + bv);
                *xp = xv;
                if (XG) {
                    ss += xv[0] * xv[0] + xv[1] * xv[1] + xv[2] * xv[2] + xv[3] * xv[3];
                    const f32x4 gn = *(const f32x4*)(nw_next + n) * (*(const f32x4*)(scale_next + cd * 6144 + n) + 1.0f);
                    const f32x4 o = xv * gn;
                    u32x2 v; v.x = pk2(o[0], o[1]); v.y = pk2(o[2], o[3]);
                    *(u32x2*)(XG + (size_t)tok * D + n) = v;
                }
            }
            if (XG) {
                ss += __shfl_xor(ss, 16); ss += __shfl_xor(ss, 32);
                if (fq == 0) RSS[(size_t)tok * 16 + slot] = ss;
            }
        }
    }
};
struct EpiMlpUp {
    bf16_t* HID; const float* rsx; int tok_base; const float* SW  ;
    __device__ __forceinline__ void operator()(f32x4 (&acc)[4][5], int ab, int bb, int fr, int fq) const {
#pragma unroll
        for (int j = 0; j < 5; ++j) {
            const int tok = bb + j * 16 + fr;
            const float rs = rsx[tok - tok_base];
            const float* sw = SW + cond_of(tok) * DFF;
#pragma unroll
            for (int i = 0; i < 4; ++i) {
                const int n = ab + i * 16 + fq * 4;
                f32x4 a = acc[i][j] * rs + *(const f32x4*)(sw + n);
                a[0] = fmaxf(a[0], 0.f); a[1] = fmaxf(a[1], 0.f); a[2] = fmaxf(a[2], 0.f); a[3] = fmaxf(a[3], 0.f);
                u32x2 v; v.x = pk2(a[0] * a[0], a[1] * a[1]); v.y = pk2(a[2] * a[2], a[3] * a[3]);
                *(u32x2*)(HID + (size_t)tok * DFF + n) = v;
            }
        }
    }
};
struct EpiDt {
    float* DT; const float* rsx; int tok_base; const float* SW  ; int ks;
    __device__ __forceinline__ void operator()(f32x4 (&acc)[4][2], int ab, int bb, int fr, int fq) const {
#pragma unroll
        for (int j = 0; j < 2; ++j) {
            const int col = bb + j * 16 + fr;
#pragma unroll
            for (int i = 0; i < 4; ++i) {
                const int tok = ab + i * 16 + fq * 4;
#pragma unroll
                for (int r = 0; r < 4; ++r) atomicAdd(DT + (size_t)(tok + r) * 64 + col, acc[i][j][r] * rsx[tok + r - tok_base] + (ks == 0 ? SW[cond_of(tok + r) * DPROJ + NZX + col] : 0.f));
            }
        }
    }
};
struct EpiF1 {
    bf16_t* UVT; int g; const float* rsx; int tok_base; const float* SW  ;
    __device__ __forceinline__ void operator()(f32x4 (&acc)[4][4], int ab, int bb, int fr, int fq) const {
#pragma unroll
        for (int j = 0; j < 4; ++j) {
            const int nn = bb + j * 16 + fr, part = nn >> 8, ch = g * 256 + (nn & 255);
#pragma unroll
            for (int i = 0; i < 4; ++i) {
                const int tok = ab + i * 16 + fq * 4;
                const float sw = SW[cond_of(tok) * 2048 + g * 512 + nn];
                bf16_t* dst;
                if (tok < NCTX) { const int s = tok >> 8, l = tok & 255; dst = UVT + ((size_t)(s * 1024 + ch) * 512 + part * 256 + l); }
                else { const int tt = tok - NCTX, s = tt >> 10, l = tt & 1023; dst = UVT + (size_t)NCTX * 2048 + ((size_t)(s * 1024 + ch) * 2048 + part * 1024 + l); }
                const f32x4 r4 = *(const f32x4*)(rsx + tok - tok_base);
                const f32x4 o = acc[i][j] * r4 + sw;
                u32x2 v; v.x = pk2(o[0], o[1]); v.y = pk2(o[2], o[3]);
                *(u32x2*)dst = v;
            }
        }
    }
};
template <int TB> struct EpiF2 {
    bf16_t* F; int tok0;
    __device__ __forceinline__ void operator()(f32x4 (&acc)[4][TB], int ab, int bb, int fr, int fq) const {
#pragma unroll
        for (int j = 0; j < TB; ++j) {
            const int tok = tok0 + bb + j * 16 + fr;
#pragma unroll
            for (int i = 0; i < 4; ++i) {
                const int n = ab + i * 16 + fq * 4;
                u32x2 v; v.x = pk2(acc[i][j][0], acc[i][j][1]); v.y = pk2(acc[i][j][2], acc[i][j][3]);
                *(u32x2*)(F + (size_t)tok * D + n) = v;
            }
        }
    }
};

__device__ __forceinline__ void transpose_item(const Ctx& c, const float* W, int K, int N, bf16_t* WT, int item) {
    float* tile = (float*)c.lds;
    const int nb = N >> 6, kb = item / nb, nbi = item - kb * nb, k0 = kb * 128, n0 = nbi * 64;
    __syncthreads();
    {
        const int cl = c.tid & 15, rl = c.tid >> 4;
#pragma unroll
        for (int p = 0; p < 4; ++p) {
            const int k = p * 32 + rl;
            const f32x4 v = *(const f32x4*)(W + (size_t)(k0 + k) * N + n0 + cl * 4);
            tile[k * 65 + cl * 4 + 0] = v[0]; tile[k * 65 + cl * 4 + 1] = v[1]; tile[k * 65 + cl * 4 + 2] = v[2]; tile[k * 65 + cl * 4 + 3] = v[3];
        }
    }
    __syncthreads();
#pragma unroll
    for (int p = 0; p < 2; ++p) {
        const int idx = c.tid + p * NTHR, n = idx >> 4, kc = idx & 15;
        const float* s = tile + (kc * 8) * 65 + n;
        u32x4 o; o.x = pk2(s[0], s[65]); o.y = pk2(s[2 * 65], s[3 * 65]); o.z = pk2(s[4 * 65], s[5 * 65]); o.w = pk2(s[6 * 65], s[7 * 65]);
        *(u32x4*)(WT + (size_t)(n0 + n) * K + k0 + kc * 8) = o;
    }
}

__device__ __forceinline__ void ada_item(const Ctx& c, int item) {
    const Args __attribute__((address_space(4)))& a = *c.a;
    const int layer = item / 96, cg = item - layer * 96, n0 = cg * 64;
    const float* W = a.in[5] + (size_t)layer * D * 6144;
    const float* sc = (const float*)(c.lds + 40960);
    float* red = (float*)c.lds;
    const int cl = c.tid & 15, kl = c.tid >> 4;
    f32x4 a0 = {0, 0, 0, 0}, a1 = {0, 0, 0, 0}, a2 = {0, 0, 0, 0};
#pragma unroll 8
    for (int it = 0; it < 32; ++it) {
        const int k = it * 32 + kl;
        const f32x4 w = *(const f32x4*)(W + (size_t)k * 6144 + n0 + cl * 4);
        a0 += w * sc[k]; a1 += w * sc[1024 + k]; a2 += w * sc[2048 + k];
    }
    __syncthreads();
    *(f32x4*)(red + (kl * 3 + 0) * 64 + cl * 4) = a0;
    *(f32x4*)(red + (kl * 3 + 1) * 64 + cl * 4) = a1;
    *(f32x4*)(red + (kl * 3 + 2) * 64 + cl * 4) = a2;
    __syncthreads();
    if (c.tid < 192) {
        const int cond = c.tid >> 6, col = c.tid & 63;
        float s = 0.f;
#pragma unroll
        for (int k = 0; k < 32; ++k) s += red[(k * 3 + cond) * 64 + col];
        s += a.in[6][layer * 6144 + n0 + col];
        ((float*)(a.ws + WS_MOD))[(layer * 3 + cond) * 6144 + n0 + col] = s;
    }
}

__device__ __forceinline__ void phase_prep(const Ctx& c) {
    const Args __attribute__((address_space(4)))& a = *c.a;
    {
        float* sc = (float*)(c.lds + 40960);
        for (int i = c.tid; i < 3072; i += NTHR) {
            const int cond = i >> 10, k = i & 1023;
            const float v = cond == 0 ? a.in[4][k] : a.in[3][(cond - 1) * 1024 + k];
            sc[i] = silu_f(v);
        }
        __syncthreads();
    }
    constexpr int I_ADA = 384;
    constexpr int I_WIN = 8 * 81, I_WOUT = 16 * 16, I_FNO = 8 * 16, I_W1 = 8 * 64, I_W2 = 32 * 16;
    constexpr int I_TR = 2 * I_WIN + 2 * I_WOUT + 2 * I_FNO + 4 * I_W1 + 4 * I_W2;
    constexpr int I_CP = NTOK / 32;
    constexpr int I_TB = 32 + 32 + 512;
    constexpr int I_ALL = I_ADA + I_TR + I_CP + I_TB;
    for (int it = c.vb; it < I_ALL; it += c.G) {
        int r = it;
        if (r < I_ADA) { ada_item(c, r); continue; }
        r -= I_ADA;
        if (r < I_TR) {
            if (r < 2 * I_WIN) { const int j = r / I_WIN; transpose_item(c, a.in[9] + (size_t)j * D * DPROJ, D, DPROJ, (bf16_t*)(a.ws + WS_WIN) + (size_t)j * DPROJ * D, r - j * I_WIN); continue; }
            r -= 2 * I_WIN;
            if (r < 2 * I_WOUT) { const int j = r / I_WOUT; transpose_item(c, a.in[16] + (size_t)j * DI * D, DI, D, (bf16_t*)(a.ws + WS_WOUT) + (size_t)j * D * DI, r - j * I_WOUT); continue; }
            r -= 2 * I_WOUT;
            if (r < 2 * I_FNO) { const int j = r / I_FNO; transpose_item(c, a.in[17] + (size_t)j * D * D, D, D, (bf16_t*)(a.ws + WS_WFNO) + (size_t)j * D * D, r - j * I_FNO); continue; }
            r -= 2 * I_FNO;
            if (r < 4 * I_W1) { const int j = r / I_W1; transpose_item(c, a.in[19] + (size_t)j * D * DFF, D, DFF, (bf16_t*)(a.ws + WS_W1) + (size_t)j * DFF * D, r - j * I_W1); continue; }
            r -= 4 * I_W1;
            { const int j = r / I_W2; transpose_item(c, a.in[20] + (size_t)j * DFF * D, DFF, D, (bf16_t*)(a.ws + WS_W2) + (size_t)j * D * DFF, r - j * I_W2); continue; }
        }
        r -= I_TR;
        if (r < I_CP) {
            const int row0 = r * 32 + (c.tid >> 8), cidx = (c.tid & 255) * 4;
#pragma unroll
            for (int p = 0; p < 16; ++p) {
                const int row = row0 + 2 * p;
                const float* src = row < NCTX ? a.in[0] + (size_t)row * D : a.in[1] + (size_t)(row - NCTX) * D;
                *(f32x4*)(a.out + (size_t)row * D + cidx) = *(const f32x4*)(src + cidx);
            }
            continue;
        }
        r -= I_CP;
        {
#pragma unroll 4
            for (int e = 0; e < 8; ++e) {
                int idx = r * 4096 + e * NTHR + c.tid;
                if (idx < 131072) {
                    const int nn = idx >> 8, cc = idx & 255, m = nn & 255, ph = (m * cc) & 255;
                    const float ang = (float)ph * (1.0f / 128.0f);
                    const float v = nn < 256 ? cospif(ang) : sinpif(ang);
                    ((bf16_t*)(a.ws + WS_T1))[idx] = (bf16_t)(pk2(v, 0.f) & 0xffff);
                } else if (idx < 262144) {
                    idx -= 131072;
                    const int k = idx >> 9, k2 = idx & 511, l = k2 & 255, ph = (k * l) & 255;
                    const float ang = (float)ph * (1.0f / 128.0f);
                    const float v = (k2 < 256 ? cospif(ang) : -sinpif(ang)) * (1.0f / 256.0f);
                    ((bf16_t*)(a.ws + WS_T2C))[idx] = (bf16_t)(pk2(v, 0.f) & 0xffff);
                } else {
                    idx -= 262144;
                    const int k = idx >> 11, k2 = idx & 2047, l = k2 & 1023, ph = (k * l) & 1023;
                    const float ang = (float)ph * (1.0f / 512.0f);
                    const float v = (k2 < 1024 ? cospif(ang) : -sinpif(ang)) * (1.0f / 512.0f);
                    ((bf16_t*)(a.ws + WS_T2L))[idx] = (bf16_t)(pk2(v, 0.f) & 0xffff);
                }
            }
        }
    }
}

__device__ __forceinline__ void phase_prep2(const Ctx& c) {
    const Args __attribute__((address_space(4)))& a = *c.a;
    const float* MOD = (const float*)(a.ws + WS_MOD);
    float* sh = (float*)c.lds;
    const int gw = c.vb * NWAVE + c.wid, NGW = c.G * NWAVE;
#pragma unroll 1
    for (int v = 0; v < 8; ++v) {
        const int layer = v >> 1, mlp = v & 1, jj = layer >> 1, fnet = (layer & 1) && !mlp;
        __syncthreads();
        for (int i = c.tid; i < 3072; i += NTHR) sh[i] = MOD[(size_t)(layer * 3 + (i >> 10)) * 6144 + (mlp ? 3072 : 0) + (i & 1023)];
        __syncthreads();
        const bf16_t* W; float* out; int N, ostride;
        if (mlp) { W = (const bf16_t*)(a.ws + WS_W1) + (size_t)layer * DFF * D; N = DFF; out = (float*)(a.ws + WS_SWUP) + (size_t)layer * 3 * DFF; ostride = DFF; }
        else if (fnet) { W = (const bf16_t*)(a.ws + WS_T1); N = 2048; out = (float*)(a.ws + WS_SWF1) + (size_t)jj * 3 * 2048; ostride = 2048; }
        else { W = (const bf16_t*)(a.ws + WS_WIN) + (size_t)jj * DPROJ * D; N = DPROJ; out = (float*)(a.ws + WS_SWIN) + (size_t)jj * 3 * DPROJ; ostride = DPROJ; }
        for (int n = gw; n < N; n += NGW) {
            float s0 = 0.f, s1 = 0.f, s2 = 0.f;
            if (fnet) {
                const int g = n >> 9, nn = n & 511;
                if (c.lane < 32) {
                    const u32x4 w = *(const u32x4*)(W + (size_t)nn * 256 + c.lane * 8);
                    const int k = g * 256 + c.lane * 8;
#pragma unroll
                    for (int e = 0; e < 4; ++e) {
                        const float wl = bflo(w[e]), wh = bfhi(w[e]);
                        s0 += wl * sh[k + 2 * e] + wh * sh[k + 2 * e + 1];
                        s1 += wl * sh[1024 + k + 2 * e] + wh * sh[1024 + k + 2 * e + 1];
                        s2 += wl * sh[2048 + k + 2 * e] + wh * sh[2048 + k + 2 * e + 1];
                    }
                }
            } else {
#pragma unroll
                for (int p = 0; p < 2; ++p) {
                    const int k = p * 512 + c.lane * 8;
                    const u32x4 w = *(const u32x4*)(W + (size_t)n * D + k);
#pragma unroll
                    for (int e = 0; e < 4; ++e) {
                        const float wl = bflo(w[e]), wh = bfhi(w[e]);
                        s0 += wl * sh[k + 2 * e] + wh * sh[k + 2 * e + 1];
                        s1 += wl * sh[1024 + k + 2 * e] + wh * sh[1024 + k + 2 * e + 1];
                        s2 += wl * sh[2048 + k + 2 * e] + wh * sh[2048 + k + 2 * e + 1];
                    }
                }
            }
            s0 = wave_sum(s0); s1 = wave_sum(s1); s2 = wave_sum(s2);
            if (c.lane == 0) { out[n] = s0; out[ostride + n] = s1; out[2 * ostride + n] = s2; }
        }
    }
    {
        bf16_t* XG = (bf16_t*)(a.ws + WS_H);
        float* RSS = (float*)(a.ws + WS_RSS);
        const float* nw = a.in[7];
        for (int row = gw; row < NTOK; row += NGW) {
            const float* xr = row < NCTX ? a.in[0] + (size_t)row * D : a.in[1] + (size_t)(row - NCTX) * D;
            const float* m = MOD + (size_t)cond_of(row) * 6144 + 1024;
            float ss = 0.f;
#pragma unroll
            for (int q = 0; q < 4; ++q) {
                const int col = q * 256 + c.lane * 4;
                const f32x4 v = *(const f32x4*)(xr + col);
                ss += v[0] * v[0] + v[1] * v[1] + v[2] * v[2] + v[3] * v[3];
                const f32x4 o = v * (*(const f32x4*)(nw + col)) * (*(const f32x4*)(m + col) + 1.0f);
                u32x2 w; w.x = pk2(o[0], o[1]); w.y = pk2(o[2], o[3]);
                *(u32x2*)(XG + (size_t)row * D + col) = w;
            }
            ss = wave_sum(ss);
            if (c.lane < 16) RSS[(size_t)row * 16 + c.lane] = c.lane == 0 ? ss : 0.f;
        }
    }
}

__device__ __forceinline__ void phase_norm(const Ctx& c, const float* nw, const float* mod  , int off_shift, int off_scale, bool final_norm) {
    const Args __attribute__((address_space(4)))& a = *c.a;
    const int gw = c.vb * NWAVE + c.wid, NGW = c.G * NWAVE;
    bf16_t* H = (bf16_t*)(a.ws + WS_H);
    for (int row = gw; row < NTOK; row += NGW) {
        float* xr = a.out + (size_t)row * D;
        f32x4 v[4]; float ss = 0.f;
#pragma unroll
        for (int j = 0; j < 4; ++j) { v[j] = *(const f32x4*)(xr + j * 256 + c.lane * 4); ss += v[j][0] * v[j][0] + v[j][1] * v[j][1] + v[j][2] * v[j][2] + v[j][3] * v[j][3]; }
        ss = wave_sum(ss);
        const float rstd = rsqrtf(ss * (1.0f / D) + EPS);
        if (final_norm) {
#pragma unroll
            for (int j = 0; j < 4; ++j) { const f32x4 w = *(const f32x4*)(nw + j * 256 + c.lane * 4); *(f32x4*)(xr + j * 256 + c.lane * 4) = v[j] * rstd * w; }
        } else {
            const float* m = mod + cond_of(row) * 6144;
#pragma unroll
            for (int j = 0; j < 4; ++j) {
                const int col = j * 256 + c.lane * 4;
                const f32x4 w = *(const f32x4*)(nw + col), sc = *(const f32x4*)(m + off_scale + col), sh = *(const f32x4*)(m + off_shift + col);
                const f32x4 h = v[j] * rstd * w * (sc + 1.0f) + sh;
                u32x2 o; o.x = pk2(h[0], h[1]); o.y = pk2(h[2], h[3]);
                *(u32x2*)(H + (size_t)row * D + col) = o;
            }
        }
    }
}

constexpr int RS_OFF = 3 * GT<5>::STAGE;
struct FillRstd { float* tab; const float* RSS; int tok0, ntok, tid;
    __device__ __forceinline__ void operator()() const {
        if (tid < ntok) {
            const float* p = RSS + (size_t)(tok0 + tid) * 16;
            float s = 0.f;
#pragma unroll
            for (int q = 0; q < 4; ++q) { const f32x4 v = *(const f32x4*)(p + q * 4); s += (v[0] + v[1]) + (v[2] + v[3]); }
            tab[tid] = rsqrtf(s * (1.0f / D) + EPS);
        }
    }
};
__device__ __forceinline__ FillRstd fill_rstd(const Ctx& c, int tok0, int ntok) { return FillRstd{(float*)(c.lds + RS_OFF), (const float*)(c.a->ws + WS_RSS), tok0, ntok, c.tid}; }
__device__ __forceinline__ void rstd_tables(const Ctx& c, int n, int ntok, int first, int stride, int toks_per_rt, int shift_rt  ) {
    float* tab = (float*)(c.lds + RS_OFF);
    const float* RSS = (const float*)(c.a->ws + WS_RSS);
    for (int i = 0; i < n; ++i) {
        const int t = first + i * stride, rt = shift_rt < 0 ? t / (-shift_rt) : (t >> shift_rt);
        if (c.tid < ntok) {
            const float* p = RSS + (size_t)(rt * toks_per_rt + c.tid) * 16;
            float s = 0.f;
#pragma unroll
            for (int q = 0; q < 4; ++q) { const f32x4 v = *(const f32x4*)(p + q * 4); s += (v[0] + v[1]) + (v[2] + v[3]); }
            tab[i * ntok + c.tid] = rsqrtf(s * (1.0f / D) + EPS);
        }
    }
}
struct ProbInProj {
    const Ctx* c; const bf16_t* W; const bf16_t* XG; int lda, ldb, K; int j;
    static constexpr int NC = NZX / 256, NT = (NTOK / 160) * NC;
    __device__ __forceinline__ int count() const { return (NT - c->vb + c->G - 1) / c->G; }
    __device__ __forceinline__ void tile(int i, const bf16_t*& A, const bf16_t*& B) const { const int t = c->vb + i * c->G, rt = t / NC, ct = t - rt * NC; A = W + (size_t)ct * 256 * D; B = XG + (size_t)rt * 160 * D; }
    __device__ __forceinline__ void pre_all() const { rstd_tables(*c, count(), 160, c->vb, c->G, 160, -NC); }
    __device__ __forceinline__ void epilogue(int i, f32x4 (&acc)[4][5], int wr, int wc, int fr, int fq) const {
        const int t = c->vb + i * c->G, rt = t / NC, ct = t - rt * NC; unsigned char* ws = c->a->ws;
        EpiInProj e{(bf16_t*)(ws + S_Z), (bf16_t*)(ws + S_RAW), (const float*)(c->lds + RS_OFF) + i * 160, rt * 160, (const float*)(ws + WS_SWIN) + (size_t)j * 3 * DPROJ};
        e(acc, ct * 256 + wr * 64, rt * 160 + wc * 80, fr, fq);
    }
};
__device__ __forceinline__ void phase_inproj(const Ctx& c, int j) {
    {
        f32x4* z = (f32x4*)(c.a->ws + S_DT);
        for (int i = c.vb * NTHR + c.tid; i < NTOK * 64 / 4; i += c.G * NTHR) z[i] = (f32x4){0.f, 0.f, 0.f, 0.f};
    }
    ProbInProj P{&c, (const bf16_t*)(c.a->ws + WS_WIN) + (size_t)j * DPROJ * D, (const bf16_t*)(c.a->ws + WS_H), D, D, D, j};
    gemm_stream<5>(c, P);
}
struct ProbMlpUp {
    const Ctx* c; const bf16_t* W; const bf16_t* XG; int lda, ldb, K; int layer;
    static constexpr int NC = DFF / 256, NT = (NTOK / 160) * NC;
    __device__ __forceinline__ int count() const { return (NT - c->vb + c->G - 1) / c->G; }
    __device__ __forceinline__ void tile(int i, const bf16_t*& A, const bf16_t*& B) const { const int t = c->vb + i * c->G, rt = t / NC, ct = t - rt * NC; A = W + (size_t)ct * 256 * D; B = XG + (size_t)rt * 160 * D; }
    __device__ __forceinline__ void pre_all() const { rstd_tables(*c, count(), 160, c->vb, c->G, 160, -NC); }
    __device__ __forceinline__ void epilogue(int i, f32x4 (&acc)[4][5], int wr, int wc, int fr, int fq) const {
        const int t = c->vb + i * c->G, rt = t / NC, ct = t - rt * NC; unsigned char* ws = c->a->ws;
        EpiMlpUp e{(bf16_t*)(ws + S_HID), (const float*)(c->lds + RS_OFF) + i * 160, rt * 160, (const float*)(ws + WS_SWUP) + (size_t)layer * 3 * DFF};
        e(acc, ct * 256 + wr * 64, rt * 160 + wc * 80, fr, fq);
    }
};
__device__ __forceinline__ void phase_mlp_up(const Ctx& c, int layer) {
    ProbMlpUp P{&c, (const bf16_t*)(c.a->ws + WS_W1) + (size_t)layer * DFF * D, (const bf16_t*)(c.a->ws + WS_H), D, D, D, layer};
    gemm_stream<5>(c, P);
}
#ifndef BENCH_MODE
#define BENCH_MODE 0
#endif
__device__ __forceinline__ void phase_bench(const Ctx& c) {
    ProbMlpUp P{&c, (const bf16_t*)(c.a->ws + WS_W1), (const bf16_t*)(c.a->ws + WS_H), D, D, D, 0};
    gemm_stream<5, ProbMlpUp, BENCH_MODE>(c, P);
}
struct ProbResid {
    const Ctx* c; const bf16_t* WT; const bf16_t* Act; int lda, ldb, K; const float* gate; const float* bias; const float* ssq; const float* nw_next; const float* scale_next;
    static constexpr int NC = D / 256, NT = (NTOK / 160) * NC;
    __device__ __forceinline__ int count() const { return (NT - c->vb + c->G - 1) / c->G; }
    __device__ __forceinline__ void tile(int i, const bf16_t*& A, const bf16_t*& B) const { const int t = c->vb + i * c->G, rt = t / NC, ct = t - rt * NC; A = WT + (size_t)ct * 256 * K; B = Act + (size_t)rt * 160 * K; }
    __device__ __forceinline__ void pre_all() const {
        if (!ssq) return;
        float* tab = (float*)(c->lds + RS_OFF);
        const int n = count();
        for (int i = 0; i < n; ++i) {
            const int t = c->vb + i * c->G, rt = t / NC;
            if (c->tid < 160) {
                const float* p = ssq + (size_t)(rt * 160 + c->tid) * 32;
                float s = 0.f;
#pragma unroll
                for (int q = 0; q < 8; ++q) { const f32x4 v = *(const f32x4*)(p + q * 4); s += v[0] + v[1] + v[2] + v[3]; }
                tab[i * 160 + c->tid] = rsqrtf(s * (1.0f / DI) + EPS);
            }
        }
    }
    __device__ __forceinline__ void epilogue(int i, f32x4 (&acc)[4][5], int wr, int wc, int fr, int fq) const {
        const int t = c->vb + i * c->G, rt = t / NC, ct = t - rt * NC; unsigned char* ws = c->a->ws;
        EpiResid e{c->a->out, gate, bias, ssq ? (const float*)(c->lds + RS_OFF) + i * 160 : nullptr, rt * 160, nw_next ? (bf16_t*)(ws + WS_H) : nullptr, nw_next, scale_next, (float*)(ws + WS_RSS)};
        e(acc, ct * 256 + wr * 64, rt * 160 + wc * 80, fr, fq);
    }
};
__device__ __forceinline__ void phase_resid_gemm(const Ctx& c, const bf16_t* WT, const bf16_t* Act, int K, const float* gate, const float* bias, const float* ssq, const float* nw_next, const float* scale_next) {
    ProbResid P{&c, WT, Act, K, K, K, gate, bias, ssq, nw_next, scale_next};
    gemm_stream<5>(c, P);
}
struct ProbF1 {
    const Ctx* c; const bf16_t* XG; const bf16_t* T1; int lda, ldb, K; int j;
    static constexpr int NT = (NTOK / 256) * 16;
    __device__ __forceinline__ int count() const { return (NT - c->vb + c->G - 1) / c->G; }
    __device__ __forceinline__ void tile(int i, const bf16_t*& A, const bf16_t*& B) const { const int t = c->vb + i * c->G, rt = t >> 4, g = (t >> 2) & 3, ct = t & 3; A = XG + (size_t)rt * 256 * D + g * 256; B = T1 + (size_t)ct * 128 * 256; }
    __device__ __forceinline__ void pre_all() const { rstd_tables(*c, count(), 256, c->vb, c->G, 256, 4); }
    __device__ __forceinline__ void epilogue(int i, f32x4 (&acc)[4][4], int wr, int wc, int fr, int fq) const {
        const int t = c->vb + i * c->G, rt = t >> 4, g = (t >> 2) & 3, ct = t & 3; unsigned char* ws = c->a->ws;
        EpiF1 e{(bf16_t*)(ws + S_UVT), g, (const float*)(c->lds + RS_OFF) + i * 256, rt * 256, (const float*)(ws + WS_SWF1) + (size_t)j * 3 * 2048};
        e(acc, rt * 256 + wr * 64, ct * 128 + wc * 64, fr, fq);
    }
};
__device__ __forceinline__ void phase_f1(const Ctx& c, int j) {
    ProbF1 P{&c, (const bf16_t*)(c.a->ws + WS_H), (const bf16_t*)(c.a->ws + WS_T1), D, 256, 256, j};
    gemm_stream<4>(c, P);
}
struct ProbF2L {
    const Ctx* c; const bf16_t* UVT; const bf16_t* T2; bf16_t* F; int lda, ldb, K;
    __device__ __forceinline__ int count() const { return c->vb < 128 ? 1 : 0; }
    __device__ __forceinline__ void tile(int i, const bf16_t*& A, const bf16_t*& B) const { const int t = c->vb, s = t >> 6, nt = (t >> 4) & 3, kt = t & 15; A = UVT + (size_t)NCTX * 2048 + ((size_t)s * 1024 + nt * 256) * 2048; B = T2 + (size_t)kt * 64 * 2048; }
    __device__ __forceinline__ void pre_all() const {}
    __device__ __forceinline__ void epilogue(int i, f32x4 (&acc)[4][2], int wr, int wc, int fr, int fq) const { const int t = c->vb, s = t >> 6, nt = (t >> 4) & 3, kt = t & 15; EpiF2<2> e{F, NCTX + s * 1024}; e(acc, nt * 256 + wr * 64, kt * 64 + wc * 32, fr, fq); }
};
struct ProbF2C {
    const Ctx* c; const bf16_t* UVT; const bf16_t* T2; bf16_t* F; int lda, ldb, K; int first, stride;
    __device__ __forceinline__ int count() const { return (256 - first + stride - 1) / stride; }
    __device__ __forceinline__ void tile(int i, const bf16_t*& A, const bf16_t*& B) const { const int u = first + i * stride, s = u >> 3, nt = (u >> 1) & 3, kt = u & 1; A = UVT + ((size_t)s * 1024 + nt * 256) * 512; B = T2 + (size_t)kt * 128 * 512; }
    __device__ __forceinline__ void pre_all() const {}
    __device__ __forceinline__ void epilogue(int i, f32x4 (&acc)[4][4], int wr, int wc, int fr, int fq) const { const int u = first + i * stride, s = u >> 3, nt = (u >> 1) & 3, kt = u & 1; EpiF2<4> e{F, s * 256}; e(acc, nt * 256 + wr * 64, kt * 128 + wc * 64, fr, fq); }
};
__device__ __forceinline__ void phase_f2(const Ctx& c) {
    unsigned char* ws = c.a->ws;
    const int half = c.G >> 1;
    if (c.vb < half) { ProbF2L P{&c, (const bf16_t*)(ws + S_UVT), (const bf16_t*)(ws + WS_T2L), (bf16_t*)(ws + S_F), 2048, 2048, 2048}; gemm_stream<2>(c, P); }
    else { ProbF2C P{&c, (const bf16_t*)(ws + S_UVT), (const bf16_t*)(ws + WS_T2C), (bf16_t*)(ws + S_F), 512, 512, 512, c.vb - half, c.G - half}; gemm_stream<4>(c, P); }
}

struct ProbDt {
    const Ctx* c; const bf16_t* XG; const bf16_t* W; int lda, ldb, K; int j;
    __device__ __forceinline__ int count() const { return (4 * (NTOK / 256) - c->vb + c->G - 1) / c->G; }
    __device__ __forceinline__ void tile(int i, const bf16_t*& A, const bf16_t*& B) const { const int t = c->vb + i * c->G, tt = t >> 2, ks = t & 3; A = XG + (size_t)tt * 256 * D + ks * 256; B = W + ks * 256; }
    __device__ __forceinline__ void pre_all() const { rstd_tables(*c, count(), 256, c->vb, c->G, 256, 2); }
    __device__ __forceinline__ void epilogue(int i, f32x4 (&acc)[4][2], int wr, int wc, int fr, int fq) const {
        const int t = c->vb + i * c->G, tt = t >> 2, ks = t & 3; unsigned char* ws = c->a->ws;
        EpiDt e{(float*)(ws + S_DT), (const float*)(c->lds + RS_OFF) + i * 256, tt * 256, (const float*)(ws + WS_SWIN) + (size_t)j * 3 * DPROJ, ks};
        e(acc, tt * 256 + wr * 64, wc * 32, fr, fq);
    }
};
__device__ __forceinline__ void phase_conv(const Ctx& c, int j) {
    const Args __attribute__((address_space(4)))& a = *c.a;
    {
        ProbDt P{&c, (const bf16_t*)(a.ws + WS_H), (const bf16_t*)(a.ws + WS_WIN) + (size_t)j * DPROJ * D + (size_t)NZX * D, D, D, 256, j};
        gemm_stream<2>(c, P);
    }
    const bf16_t* RAW = (const bf16_t*)(a.ws + S_RAW);
    bf16_t* XBC = (bf16_t*)(a.ws + S_XBC);
    const float* cw = a.in[10] + (size_t)j * 3 * DXBC;
    const float* cb = a.in[11] + (size_t)j * DXBC;
    constexpr int NIT = (NTOK / 64) * 3;
    for (int it = c.G - 1 - c.vb; it < NIT; it += c.G) {
        const int tg = it / 3, third = it - tg * 3;
        const int ch = third * 1024 + (c.tid & 127) * 8;
        const int r0 = tg * 64 + (c.tid >> 7) * 16;
        float w0[8], w1[8], w2[8], bb[8];
#pragma unroll
        for (int q = 0; q < 2; ++q) {
            const f32x4 t0 = *(const f32x4*)(cw + ch + q * 4), t1 = *(const f32x4*)(cw + DXBC + ch + q * 4), t2 = *(const f32x4*)(cw + 2 * DXBC + ch + q * 4), t3 = *(const f32x4*)(cb + ch + q * 4);
#pragma unroll
            for (int e = 0; e < 4; ++e) { w0[q * 4 + e] = t0[e]; w1[q * 4 + e] = t1[e]; w2[q * 4 + e] = t2[e]; bb[q * 4 + e] = t3[e]; }
        }
        const int seg = r0 < NCTX ? 256 : 64;
        u32x4 prev = {0, 0, 0, 0}, cur, nxt;
        if ((r0 % seg) != 0) prev = *(const u32x4*)(RAW + (size_t)(r0 - 1) * DXBC + ch);
        cur = *(const u32x4*)(RAW + (size_t)r0 * DXBC + ch);
#pragma unroll 4
        for (int r = 0; r < 16; ++r) {
            const int t = r0 + r;
            nxt = (u32x4){0, 0, 0, 0};
            if (((t + 1) % seg) != 0) nxt = *(const u32x4*)(RAW + (size_t)(t + 1) * DXBC + ch);
            u32x4 o;
#pragma unroll
            for (int e = 0; e < 4; ++e) {
                const float lo = bb[2 * e] + w0[2 * e] * bflo(prev[e]) + w1[2 * e] * bflo(cur[e]) + w2[2 * e] * bflo(nxt[e]);
                const float hi = bb[2 * e + 1] + w0[2 * e + 1] * bfhi(prev[e]) + w1[2 * e + 1] * bfhi(cur[e]) + w2[2 * e + 1] * bfhi(nxt[e]);
                o[e] = pk2(silu_f(lo), silu_f(hi));
            }
            *(u32x4*)(XBC + (size_t)t * DXBC + ch) = o;
            prev = cur; cur = nxt;
        }
    }
}

constexpr int SC_XS = 0, SC_XW = 16384, SC_BS = 32768, SC_CS = 49152, SC_HT = 65536, SC_SM = 98304;
__device__ __forceinline__ int off128(int row, int col) { return row * 128 + ((((col >> 3) ^ (row & 7))) << 4) + (col & 7) * 2; }
__device__ __forceinline__ int off256(int row, int col) { return row * 256 + ((((col >> 3) ^ (row & 15))) << 4) + (col & 7) * 2; }
template <int W256>
__device__ __forceinline__ bf16x8 tr_frag(const char* tile, int r0, int r1, int col0, int lane) {
    const int i = lane & 15, q = i >> 2, cc = col0 + (i & 3) * 4;
    const int o0 = W256 ? off256(r0 + q, cc) : off128(r0 + q, cc);
    const int o1 = W256 ? off256(r1 + q, cc) : off128(r1 + q, cc);
    const bf16x4 lo = __builtin_amdgcn_ds_read_tr16_b64_v4i16((LAS bf16x4*)(tile + o0));
    const bf16x4 hi = __builtin_amdgcn_ds_read_tr16_b64_v4i16((LAS bf16x4*)(tile + o1));
    return __builtin_shufflevector(lo, hi, 0, 1, 2, 3, 4, 5, 6, 7);
}

struct ScanStep { int seq, hp, dir, ci, nch, t0, valid; };
struct ScanIter {
    int vb, G, k, dir, ci;
    __device__ __forceinline__ void get(ScanStep& s) const {
        int seq, hp, ok;
        if (vb < 32) { seq = 32 + (vb >> 4); hp = vb & 15; ok = (k == 0); }
        else { const int u = (vb - 32) + k * (G - 32); seq = u >> 4; hp = u & 15; ok = (u < 512); }
        const bool lat = seq >= 32;
        s.seq = seq; s.hp = hp; s.dir = dir; s.ci = ci; s.nch = lat ? 16 : 4; s.valid = ok;
        const int tok0 = lat ? NCTX + (seq - 32) * 1024 : seq * 256;
        const int ch = dir == 0 ? ci : s.nch - 1 - ci;
        s.t0 = tok0 + ch * 64;
    }
    __device__ __forceinline__ void advance() {
        int seq; if (vb < 32) seq = 32; else seq = 0;
        const int nch = seq >= 32 ? 16 : 4;
        if (++ci == nch) { ci = 0; if (++dir == 2) { dir = 0; ++k; } }
    }
};
constexpr int SCB = 49152;
constexpr int SB_XS = 0, SB_BS = 16384, SB_CS = 32768;
constexpr int SCN_XW = 2 * SCB, SCN_HT = SCN_XW + 16384, SCN_SM = SCN_HT + 32768;

__device__ __forceinline__ void scan_issue_tiles(const Ctx& c, const ScanStep& s, int buf) {
    const bf16_t* XBC = (const bf16_t*)(c.a->ws + S_XBC);
    char* base = c.lds + buf * SCB;
    const int lane = c.lane, w8 = c.wid, g = (2 * s.hp) >> 3;
#pragma unroll
    for (int hh = 0; hh < 2; ++hh) {
        const int q = w8, row = q * 8 + (lane >> 3), lch = (lane & 7) ^ (row & 7);
        __builtin_amdgcn_global_load_lds((const unsigned*)(XBC + (size_t)(s.t0 + row) * DXBC + (2 * s.hp + hh) * 64 + lch * 8), (LAS unsigned*)(base + SB_XS + hh * 8192 + q * 1024 + lane * 16), 16, 0, 0);
    }
#pragma unroll
    for (int i = 0; i < 2; ++i) {
        const int q = w8 + 8 * i, row = q * 4 + (lane >> 4), lch = (lane & 15) ^ (row & 15);
        __builtin_amdgcn_global_load_lds((const unsigned*)(XBC + (size_t)(s.t0 + row) * DXBC + DI + g * 128 + lch * 8), (LAS unsigned*)(base + SB_BS + q * 1024 + lane * 16), 16, 0, 0);
        __builtin_amdgcn_global_load_lds((const unsigned*)(XBC + (size_t)(s.t0 + row) * DXBC + DI + 512 + g * 128 + lch * 8), (LAS unsigned*)(base + SB_CS + q * 1024 + lane * 16), 16, 0, 0);
    }
}
__device__ __forceinline__ float scan_load_dt(const Ctx& c, const ScanStep& s, int hw) {
    const float* DT = (const float*)(c.a->ws + S_DT);
    const int l = s.dir == 0 ? c.lane : 63 - c.lane, h = 2 * s.hp + hw;
    return DT[(size_t)(s.t0 + l) * 64 + s.dir * NH + h];
}
__device__ __forceinline__ void scan_dtcs(const Ctx& c, const ScanStep& s, int hw, int j, float raw, float* sm) {
    const int lane = c.lane, l = s.dir == 0 ? lane : 63 - lane, h = 2 * s.hp + hw;
    const float Aneg = -__expf(c.a->in[13][(j * 2 + s.dir) * NH + h]);
    raw += c.a->in[12][(j * 2 + s.dir) * NH + h];
    const float dt = raw > 20.f ? raw : log1pf(__expf(raw));
    float cs = dt * Aneg;
#pragma unroll
    for (int o = 1; o < 64; o <<= 1) { const float u = __shfl_up(cs, o); if (lane >= o) cs += u; }
    sm[l] = dt; sm[64 + l] = cs;
    if (lane == 63) sm[128] = cs;
}

__device__ __forceinline__ void phase_scan_pipe(const Ctx& c, int j) {
    const Args __attribute__((address_space(4)))& a = *c.a;
    const bf16_t* Z = (const bf16_t*)(a.ws + S_Z);
    bf16_t* YTMP = (bf16_t*)(a.ws + S_RAW);
    bf16_t* YG = (bf16_t*)(a.ws + S_YG);
    float* SSQ = (float*)(a.ws + S_SSQ);
    const int hw = c.wid >> 2, w = c.wid & 3;
    char* lds = c.lds;
    char* XWp = lds + SCN_XW + hw * 8192; char* HTp = lds + SCN_HT + hw * 16384;

    ScanIter it{c.vb, c.G, 0, 0, 0};
    ScanStep cur, nxt, nx2;
    it.get(cur); it.advance(); it.get(nxt); it.advance(); it.get(nx2);
    if (!cur.valid) return;
    scan_issue_tiles(c, cur, 0);
    float raw_n1 = 0.f;
    if (w == 0) {
        const float r0 = scan_load_dt(c, cur, hw);
        if (nxt.valid) raw_n1 = scan_load_dt(c, nxt, hw);
        scan_dtcs(c, cur, hw, j, r0, (float*)(lds + SCN_SM + (0 * 2 + hw) * 1024));
    }
    f32x4 S[4][2];
#pragma unroll
    for (int pb = 0; pb < 4; ++pb)
#pragma unroll
        for (int nbi = 0; nbi < 2; ++nbi) S[pb][nbi] = (f32x4){0.f, 0.f, 0.f, 0.f};

#pragma unroll 1
    for (int s = 0; cur.valid; ++s) {
        int lane = c.lane; asm volatile("" : "+v"(lane));
        const int fr = lane & 15, fq = lane >> 4;
        const int b = s & 1;
        char* TB_ = lds + b * SCB;
        char* XSp = TB_ + SB_XS + hw * 8192;
        const float* sm_dt = (const float*)(lds + SCN_SM + (b * 2 + hw) * 1024);
        const float* sm_cs = sm_dt + 64;
        const bool is_lat = cur.seq >= 32;
        const int dir = cur.dir, t0 = cur.t0, h = 2 * cur.hp + hw;
        asm volatile("s_waitcnt vmcnt(0)" ::: "memory");
        __syncthreads();
        if (nxt.valid) scan_issue_tiles(c, nxt, b ^ 1);
        float raw_n2 = 0.f;
        if (w == 0 && nx2.valid) raw_n2 = scan_load_dt(c, nx2, hw);
        u32x2 yt[4], zz[4]; f32x4 nwv[4]; float Dh = 0.f;
        const int tok = t0 + w * 16 + fr;
        if (dir == 1) {
            Dh = a.in[14][j * NH + h];
            const float* normw = a.in[15] + (size_t)j * DI + h * 64;
#pragma unroll
            for (int pb = 0; pb < 4; ++pb) {
                const int p0 = pb * 16 + fq * 4;
                yt[pb] = *(const u32x2*)(YTMP + (size_t)tok * DI + h * 64 + p0);
                zz[pb] = *(const u32x2*)(Z + (size_t)tok * DI + h * 64 + p0);
                nwv[pb] = *(const f32x4*)(normw + p0);
            }
        }
        bool has_h = is_lat || cur.ci > 0;
        if (cur.ci == 0) {
            if (is_lat) {
                const float* sp = a.in[2] + ((size_t)(((cur.seq - 32) * 2 + j) * 2 + dir) * NH + h) * 8192;
#pragma unroll
                for (int pb = 0; pb < 4; ++pb)
#pragma unroll
                    for (int nbi = 0; nbi < 2; ++nbi) {
                        const int n = (2 * w + nbi) * 16 + fr, p0 = pb * 16 + fq * 4;
#pragma unroll
                        for (int r = 0; r < 4; ++r) S[pb][nbi][r] = sp[(p0 + r) * 128 + n];
                        u32x2 v; v.x = pk2(S[pb][nbi][0], S[pb][nbi][1]); v.y = pk2(S[pb][nbi][2], S[pb][nbi][3]);
                        *(u32x2*)(HTp + off128(n, p0)) = v;
                    }
                __syncthreads();
            } else {
#pragma unroll
                for (int pb = 0; pb < 4; ++pb)
#pragma unroll
                    for (int nbi = 0; nbi < 2; ++nbi) S[pb][nbi] = (f32x4){0.f, 0.f, 0.f, 0.f};
            }
        }
        const float tot = sm_dt[128];
        {
            const int tl = c.tid & 255, l = tl >> 2, c0 = (tl & 3) * 16;
            const float sc = __expf(tot - sm_cs[l]) * sm_dt[l];
#pragma unroll
            for (int q = 0; q < 2; ++q) {
                const int o = off128(l, c0 + q * 8);
                const u32x4 v = *(const u32x4*)(XSp + o);
                u32x4 r;
#pragma unroll
                for (int e = 0; e < 4; ++e) r[e] = pk2(bflo(v[e]) * sc, bfhi(v[e]) * sc);
                *(u32x4*)(XWp + o) = r;
            }
        }
        bf16x8 cf[4];
#pragma unroll
        for (int kk = 0; kk < 4; ++kk) cf[kk] = *(const bf16x8*)(TB_ + SB_CS + off256(w * 16 + fr, kk * 32 + fq * 8));
        const float csl = sm_cs[w * 16 + fr];
        f32x4 yacc[4];
#pragma unroll
        for (int pb = 0; pb < 4; ++pb) yacc[pb] = (f32x4){0.f, 0.f, 0.f, 0.f};
        if (has_h) {
            bf16x8 hf[2][4];
#pragma unroll
            for (int pb = 0; pb < 4; ++pb) hf[0][pb] = tr_frag<0>(HTp, fq * 8, fq * 8 + 4, pb * 16, lane);
#pragma unroll
            for (int kk = 0; kk < 4; ++kk) {
                if (kk < 3) {
#pragma unroll
                    for (int pb = 0; pb < 4; ++pb) hf[(kk + 1) & 1][pb] = tr_frag<0>(HTp, (kk + 1) * 32 + fq * 8, (kk + 1) * 32 + fq * 8 + 4, pb * 16, lane);
                }
                __builtin_amdgcn_sched_barrier(0);
#pragma unroll
                for (int pb = 0; pb < 4; ++pb) yacc[pb] = __builtin_amdgcn_mfma_f32_16x16x32_bf16(hf[kk & 1][pb], cf[kk], yacc[pb], 0, 0, 0);
            }
            const float e = __expf(csl);
#pragma unroll
            for (int pb = 0; pb < 4; ++pb) yacc[pb] = yacc[pb] * e;
        }
#pragma unroll
        for (int kk2 = 0; kk2 < 2; ++kk2) {
            const bool need = dir == 0 ? (2 * kk2 <= w) : (2 * kk2 + 1 >= w);
            if (need) {
                unsigned m[4];
                bf16x8 bfg[2][4];
                f32x4 gg[2];
#pragma unroll
                for (int half = 0; half < 2; ++half)
#pragma unroll
                    for (int kk = 0; kk < 4; ++kk) bfg[half][kk] = *(const bf16x8*)(TB_ + SB_BS + off256((2 * kk2 + half) * 16 + fr, kk * 32 + fq * 8));
                bf16x8 xf[4];
#pragma unroll
                for (int pb = 0; pb < 4; ++pb) xf[pb] = tr_frag<0>(XSp, 32 * kk2 + 4 * fq, 32 * kk2 + 16 + 4 * fq, pb * 16, lane);
                __builtin_amdgcn_sched_barrier(0);
                gg[0] = (f32x4){0.f, 0.f, 0.f, 0.f}; gg[1] = (f32x4){0.f, 0.f, 0.f, 0.f};
#pragma unroll
                for (int kk = 0; kk < 4; ++kk)
#pragma unroll
                    for (int half = 0; half < 2; ++half) gg[half] = __builtin_amdgcn_mfma_f32_16x16x32_bf16(bfg[half][kk], cf[kk], gg[half], 0, 0, 0);
#pragma unroll
                for (int half = 0; half < 2; ++half) {
                    const int sb = 2 * kk2 + half;
                    const f32x4 gacc = gg[half];
                    const f32x4 css = *(const f32x4*)(sm_cs + sb * 16 + fq * 4);
                    const f32x4 dts = *(const f32x4*)(sm_dt + sb * 16 + fq * 4);
                    float v[4];
#pragma unroll
                    for (int r = 0; r < 4; ++r) {
                        const int si = sb * 16 + fq * 4 + r, l = w * 16 + fr;
                        const bool valid = dir == 0 ? (si <= l) : (si >= l);
                        v[r] = valid ? gacc[r] * __expf(csl - css[r]) * dts[r] : 0.f;
                    }
                    m[half * 2 + 0] = pk2(v[0], v[1]); m[half * 2 + 1] = pk2(v[2], v[3]);
                }
                union { unsigned u[4]; bf16x8 v; } mf; mf.u[0] = m[0]; mf.u[1] = m[1]; mf.u[2] = m[2]; mf.u[3] = m[3];
#pragma unroll
                for (int pb = 0; pb < 4; ++pb) yacc[pb] = __builtin_amdgcn_mfma_f32_16x16x32_bf16(xf[pb], mf.v, yacc[pb], 0, 0, 0);
            }
        }
        {
            const int l = w * 16 + fr;
            if (dir == 0) {
#pragma unroll
                for (int pb = 0; pb < 4; ++pb) {
                    const int p0 = pb * 16 + fq * 4;
                    u32x2 v; v.x = pk2(yacc[pb][0], yacc[pb][1]); v.y = pk2(yacc[pb][2], yacc[pb][3]);
                    *(u32x2*)(YTMP + (size_t)tok * DI + h * 64 + p0) = v;
                }
            } else {
                float ss = 0.f;
#pragma unroll
                for (int pb = 0; pb < 4; ++pb) {
                    const int p0 = pb * 16 + fq * 4;
                    const u32x2 xx = *(const u32x2*)(XSp + off128(l, p0));
                    const f32x4 nw = nwv[pb];
                    float y[4];
                    y[0] = yacc[pb][0] + bflo(yt[pb].x) + Dh * bflo(xx.x); y[1] = yacc[pb][1] + bfhi(yt[pb].x) + Dh * bfhi(xx.x);
                    y[2] = yacc[pb][2] + bflo(yt[pb].y) + Dh * bflo(xx.y); y[3] = yacc[pb][3] + bfhi(yt[pb].y) + Dh * bfhi(xx.y);
                    y[0] *= silu_f(bflo(zz[pb].x)); y[1] *= silu_f(bfhi(zz[pb].x)); y[2] *= silu_f(bflo(zz[pb].y)); y[3] *= silu_f(bfhi(zz[pb].y));
                    ss += y[0] * y[0] + y[1] * y[1] + y[2] * y[2] + y[3] * y[3];
                    u32x2 v; v.x = pk2(y[0] * nw[0], y[1] * nw[1]); v.y = pk2(y[2] * nw[2], y[3] * nw[3]);
                    *(u32x2*)(YG + (size_t)tok * DI + h * 64 + p0) = v;
                }
                ss += __shfl_xor(ss, 16); ss += __shfl_xor(ss, 32);
                if (fq == 0) SSQ[(size_t)tok * NH + h] = ss;
            }
        }
        __syncthreads();
        {
            const float et = __expf(tot);
#pragma unroll
            for (int pb = 0; pb < 4; ++pb)
#pragma unroll
                for (int nbi = 0; nbi < 2; ++nbi) S[pb][nbi] = S[pb][nbi] * et;
            bf16x8 bq[2][2], xa[2][4];
#pragma unroll
            for (int kk = 0; kk < 2; ++kk) {
#pragma unroll
                for (int nbi = 0; nbi < 2; ++nbi) bq[kk][nbi] = tr_frag<1>(TB_ + SB_BS, kk * 32 + fq * 8, kk * 32 + fq * 8 + 4, (2 * w + nbi) * 16, lane);
#pragma unroll
                for (int pb = 0; pb < 4; ++pb) xa[kk][pb] = tr_frag<0>(XWp, kk * 32 + fq * 8, kk * 32 + fq * 8 + 4, pb * 16, lane);
            }
            __builtin_amdgcn_sched_barrier(0);
#pragma unroll
            for (int kk = 0; kk < 2; ++kk)
#pragma unroll
                for (int pb = 0; pb < 4; ++pb)
#pragma unroll
                    for (int nbi = 0; nbi < 2; ++nbi) S[pb][nbi] = __builtin_amdgcn_mfma_f32_16x16x32_bf16(xa[kk][pb], bq[kk][nbi], S[pb][nbi], 0, 0, 0);
#pragma unroll
            for (int pb = 0; pb < 4; ++pb)
#pragma unroll
                for (int nbi = 0; nbi < 2; ++nbi) {
                    const int n = (2 * w + nbi) * 16 + fr, p0 = pb * 16 + fq * 4;
                    u32x2 v; v.x = pk2(S[pb][nbi][0], S[pb][nbi][1]); v.y = pk2(S[pb][nbi][2], S[pb][nbi][3]);
                    *(u32x2*)(HTp + off128(n, p0)) = v;
                }
        }
        if (!is_lat && cur.ci == cur.nch - 1) {
            float* op = a.out + (size_t)NTOK * D + ((size_t)((cur.seq * 2 + j) * 2 + dir) * NH + h) * 8192;
#pragma unroll
            for (int pb = 0; pb < 4; ++pb)
#pragma unroll
                for (int nbi = 0; nbi < 2; ++nbi) {
                    const int n = (2 * w + nbi) * 16 + fr, p0 = pb * 16 + fq * 4;
#pragma unroll
                    for (int r = 0; r < 4; ++r) op[(p0 + r) * 128 + n] = S[pb][nbi][r];
                }
        }
        if (w == 0 && nxt.valid) scan_dtcs(c, nxt, hw, j, raw_n1, (float*)(lds + SCN_SM + ((b ^ 1) * 2 + hw) * 1024));
        raw_n1 = raw_n2;
        cur = nxt; nxt = nx2; it.advance(); it.get(nx2);
    }
}

#if NAIVE_SCAN
__device__ __forceinline__ void scan_unit_naive(const Ctx& c, int j, int seq, int h) {
    const Args __attribute__((address_space(4)))& a = *c.a;
    const bf16_t* XBC = (const bf16_t*)(a.ws + S_XBC);
    const bf16_t* Z = (const bf16_t*)(a.ws + S_Z);
    const float* DT = (const float*)(a.ws + S_DT);
    bf16_t* YTMP = (bf16_t*)(a.ws + S_RAW);
    bf16_t* YG = (bf16_t*)(a.ws + S_YG);
    float* SSQ = (float*)(a.ws + S_SSQ);
    const bool is_lat = seq >= 32;
    const int tok0 = is_lat ? NCTX + (seq - 32) * 1024 : seq * 256;
    const int L = is_lat ? 1024 : 256;
    const int g = h >> 3, p = c.tid >> 2, nq = (c.tid & 3) * 32;
    const float Dh = a.in[14][j * NH + h];
    const float nw = a.in[15][(size_t)j * DI + h * 64 + p];
    float* red = (float*)c.lds;
    for (int dir = 0; dir < 2; ++dir) {
        const float Aneg = -__expf(a.in[13][(j * 2 + dir) * NH + h]);
        const float dtb = a.in[12][(j * 2 + dir) * NH + h];
        float hs[32];
        if (is_lat) { const float* sp = a.in[2] + ((size_t)(((seq - 32) * 2 + j) * 2 + dir) * NH + h) * 8192 + p * 128 + nq;
#pragma unroll
            for (int e = 0; e < 32; ++e) hs[e] = sp[e]; }
        else {
#pragma unroll
            for (int e = 0; e < 32; ++e) hs[e] = 0.f; }
        asm volatile("s_waitcnt vmcnt(0)" ::: "memory"); __syncthreads();
        for (int ti = 0; ti < L; ++ti) {
            const int tok = tok0 + (dir == 0 ? ti : L - 1 - ti);
            const float raw = DT[(size_t)tok * 64 + dir * NH + h] + dtb;
            const float dt = raw > 20.f ? raw : log1pf(__expf(raw));
            const float dec = __expf(dt * Aneg);
            const float xv = bflo((unsigned)XBC[(size_t)tok * DXBC + h * 64 + p]);
            const bf16_t* Bp = XBC + (size_t)tok * DXBC + DI + g * 128 + nq;
            const bf16_t* Cp = XBC + (size_t)tok * DXBC + DI + 512 + g * 128 + nq;
            float y = 0.f;
#pragma unroll
            for (int e = 0; e < 32; ++e) { hs[e] = hs[e] * dec + dt * xv * bflo((unsigned)Bp[e]); y += bflo((unsigned)Cp[e]) * hs[e]; }
            y += __shfl_xor(y, 1); y += __shfl_xor(y, 2);
            if (dir == 0) { if ((c.tid & 3) == 0) YTMP[(size_t)tok * DI + h * 64 + p] = (bf16_t)(pk2(y, 0.f) & 0xffff); }
            else {
                const float yt = bflo((unsigned)YTMP[(size_t)tok * DI + h * 64 + p]);
                const float zz = bflo((unsigned)Z[(size_t)tok * DI + h * 64 + p]);
                float yy = (y + yt + Dh * xv) * silu_f(zz);
                __syncthreads();
                if ((c.tid & 3) == 0) { red[p] = yy * yy; YG[(size_t)tok * DI + h * 64 + p] = (bf16_t)(pk2(yy * nw, 0.f) & 0xffff); }
                __syncthreads();
                if (c.tid == 0) { float s = 0.f; for (int e = 0; e < 64; ++e) s += red[e]; SSQ[(size_t)tok * NH + h] = s; }
            }
        }
        if (!is_lat) { float* op = a.out + (size_t)NTOK * D + ((size_t)((seq * 2 + j) * 2 + dir) * NH + h) * 8192 + p * 128 + nq;
#pragma unroll
            for (int e = 0; e < 32; ++e) op[e] = hs[e]; }
    }
}
#endif
__device__ __forceinline__ void phase_scan(const Ctx& c, int j) {
#if NAIVE_SCAN
    for (int u = c.vb; u < 1088; u += c.G) { if (u < 64) scan_unit_naive(c, j, 32 + (u >> 5), u & 31); else scan_unit_naive(c, j, (u - 64) >> 5, (u - 64) & 31); }
    return;
#endif
    phase_scan_pipe(c, j);
}

typedef const Args __attribute__((address_space(4)))* ArgsP;
#if 0
#define LB_WAVES 1
#else
#define LB_WAVES 2
#endif
__global__ void __launch_bounds__(NTHR, LB_WAVES) fwd_kernel(Args args) {
    extern __shared__ __attribute__((aligned(16))) char lds[];
    volatile LAS unsigned* st = (volatile LAS unsigned*)(lds + LDS_BYTES - 16);
    if (threadIdx.x == 0) { st[0] = 0u; st[1] = 0u; }
    __syncthreads();
    const int ph_lo = args.ph_lo, ph_hi = args.ph_hi;
    const bool multi = (ph_hi - ph_lo) > 1;
    XcdBarrier bar; bar.bar = (unsigned*)(args.ws + WS_CTL); bar.x = 0; bar.st = st;
    if (multi) bar = xcd_barrier_post((unsigned*)(args.ws + WS_CTL), st);

    int rep = 0;
#pragma unroll 1
    for (int ph = ph_lo; ph < ph_hi; ++ph) {
        ArgsP ap = (ArgsP)__builtin_amdgcn_kernarg_segment_ptr();
        asm volatile("" : "+s"(ap));
        int tid = threadIdx.x;
        asm volatile("" : "+v"(tid));
        Ctx c;
        c.lds = lds; c.tid = tid; c.lane = tid & 63; c.wid = __builtin_amdgcn_readfirstlane(tid >> 6);
        c.G = gridDim.x; c.vb = (c.G % 8 == 0) ? (int)(blockIdx.x % 8) * (c.G / 8) + (int)(blockIdx.x / 8) : (int)blockIdx.x;
        c.a = ap;
        unsigned char* ws = ap->ws;
        const float* MOD = (const float*)(ws + WS_MOD);

        int kind = 0;
        if (ph == 0) { if (PH_ON(0)) phase_prep(c); }
        else if (ph == 1) { kind = 12; phase_prep2(c); }
        else if (ph == NPHASE - 1) { kind = 10; if (PH_ON(1)) phase_norm(c, ap->in[21], nullptr, 0, 0, true); }
        else {
            int layer, sub;
            if (ph <= 7) { layer = 0; sub = ph - 2; } else if (ph <= 12) { layer = 1; sub = ph - 8; } else if (ph <= 18) { layer = 2; sub = ph - 13; } else { layer = 3; sub = ph - 19; }
            const int j = layer >> 1;
            const float* mod = MOD + (size_t)layer * 3 * 6144;
            const bool ssd = (layer & 1) == 0;
            const int nmix = ssd ? 4 : 3;
            if (sub < nmix - 1) kind = ssd ? (sub == 0 ? 2 : sub == 1 ? 3 : 4) : (sub == 0 ? 6 : 7);
            else if (sub == nmix) kind = 8;
            else kind = 5;

            if (kind == 2) { if (PH_ON(2)) phase_inproj(c, j); }
            else if (kind == 3) { if (PH_ON(3)) phase_conv(c, j); }
            else if (kind == 4) { if (PH_ON(4)) phase_scan(c, j); }
            else if (kind == 6) { if (PH_ON(6)) phase_f1(c, j); }
            else if (kind == 7) { if (PH_ON(7)) phase_f2(c); }
            else if (kind == 8) { if (PH_ON(8)) phase_mlp_up(c, layer); }
            else {
                if (PH_ON(5)) {
                    const bf16_t* WT; const bf16_t* Act; int K; const float* gate; const float* bias = nullptr; const float* ssq = nullptr;
                    const float* nw_next; const float* scale_next;
                    if (sub == nmix - 1) {
                        gate = mod + 2048; nw_next = ap->in[8] + layer * D; scale_next = mod + 4096;
                        if (ssd) { WT = (const bf16_t*)(ws + WS_WOUT) + (size_t)j * D * DI; Act = (const bf16_t*)(ws + S_YG); K = DI; ssq = (const float*)(ws + S_SSQ); }
                        else { WT = (const bf16_t*)(ws + WS_WFNO) + (size_t)j * D * D; Act = (const bf16_t*)(ws + S_F); K = D; bias = ap->in[18] + j * D; }
                    } else {
                        gate = mod + 5120; WT = (const bf16_t*)(ws + WS_W2) + (size_t)layer * D * DFF; Act = (const bf16_t*)(ws + S_HID); K = DFF;
                        if (layer < 3) { nw_next = ap->in[7] + (layer + 1) * D; scale_next = mod + 3 * 6144 + 1024; } else { nw_next = nullptr; scale_next = nullptr; }
                    }
                    if (rep > 0) { gate = (const float*)(ws + WS_ZERO); }
                    phase_resid_gemm(c, WT, Act, K, gate, bias, ssq, nw_next, scale_next);
                }
            }
        }
        if (REP_KIND == 9) { for (int r = 0; r < REP_N; ++r) if (multi) xcd_barrier(bar); }
        if (REP_N > 0 && kind == REP_KIND && rep < REP_N) { ++rep; --ph; if (multi) xcd_barrier(bar); continue; }
        rep = 0;
        if (REP_KIND == 11 && ph == NPHASE - 1) { for (int r = 0; r < REP_N; ++r) { if (multi) xcd_barrier(bar); phase_bench(c); } }
        if (ph + 1 < ph_hi) xcd_barrier(bar);
    }
}

extern "C" void kernel_launch(void* const* d_in, const int* in_sizes, int n_in, void* d_out, int out_size, void* d_ws, size_t ws_size, hipStream_t stream) {
    static int grid = 0;
    if (grid == 0) {
        int dev = 0, cus = 0;
        if (hipGetDevice(&dev) != hipSuccess || hipDeviceGetAttribute(&cus, hipDeviceAttributeMultiprocessorCount, dev) != hipSuccess || cus <= 0) { fprintf(stderr, "kernel_launch: device query failed\n"); grid = -1; return; }
        if (hipFuncSetAttribute((const void*)fwd_kernel, hipFuncAttributeMaxDynamicSharedMemorySize, LDS_BYTES) != hipSuccess) { fprintf(stderr, "kernel_launch: hipFuncSetAttribute failed\n"); }
        (void)hipGetLastError();
        if (ws_size < WS_END) fprintf(stderr, "kernel_launch: workspace too small: %zu < %zu\n", ws_size, (size_t)WS_END);
        grid = cus;
    }
    if (grid < 0) return;
    (void)hipMemsetAsync((char*)d_ws + WS_CTL, 0, CTL_BYTES, stream);
    Args a{};
    for (int i = 0; i < 22; ++i) a.in[i] = (const float*)d_in[i];
    a.out = (float*)d_out; a.ws = (unsigned char*)d_ws;
#if N_LAUNCH_MODE == 1
    a.ph_lo = 0; a.ph_hi = NPHASE;
    hipLaunchKernelGGL(fwd_kernel, dim3(grid), dim3(NTHR), LDS_BYTES, stream, a);
#else
    for (int ph = 0; ph < NPHASE; ++ph) {
        a.ph_lo = ph; a.ph_hi = ph + 1;
        hipLaunchKernelGGL(fwd_kernel, dim3(grid), dim3(NTHR), LDS_BYTES, stream, a);
    }
#endif
}
```

```cpp
#include <hip/hip_runtime.h>
#include <stdint.h>
#include <stdio.h>

#ifndef PH_MASK
#define PH_MASK 0xFFFF
#endif
#define PH_ON(k) ((PH_MASK >> (k)) & 1)
#ifndef NAIVE_GEMM
#define NAIVE_GEMM 0
#endif
#define GN(k) ((NAIVE_GEMM >> (k)) & 1)
#ifndef NAIVE_SCAN
#define NAIVE_SCAN 0
#endif
#ifndef REP_KIND
#define REP_KIND -1
#endif
#ifndef REP_N
#define REP_N 0
#endif
#ifndef GEMM_INTERLEAVE
#define GEMM_INTERLEAVE 0
#endif
#ifndef GEMM_SETPRIO
#define GEMM_SETPRIO 0
#endif
#ifndef N_LAUNCH_MODE
#define N_LAUNCH_MODE 1
#endif

typedef unsigned short bf16_t;
typedef short bf16x8 __attribute__((ext_vector_type(8)));
typedef short bf16x4 __attribute__((ext_vector_type(4)));
typedef float f32x4 __attribute__((ext_vector_type(4)));
typedef unsigned u32x4 __attribute__((ext_vector_type(4)));
typedef unsigned u32x2 __attribute__((ext_vector_type(2)));
#define LAS __attribute__((address_space(3)))

constexpr int D = 1024, NCTX = 8192, NLAT = 2048, NTOK = 10240;
constexpr int DI = 2048, DXBC = 3072, DPROJ = 5184, NZX = 5120, NH = 32, DFF = 4096;
constexpr float EPS = 1e-6f;
constexpr int NPHASE = 25;

constexpr size_t al256(size_t x) { return (x + 255) & ~(size_t)255; }
constexpr size_t WS_CTL  = 0;
constexpr size_t CTL_BYTES = 65536 + 81920;
constexpr size_t WS_ZERO = 65536;
constexpr size_t WS_MOD  = WS_CTL + CTL_BYTES;
constexpr size_t WS_SWIN = al256(WS_MOD + 4 * 3 * 6144 * 4);
constexpr size_t WS_SWUP = WS_SWIN + 2 * 3 * DPROJ * 4;
constexpr size_t WS_SWF1 = WS_SWUP + 4 * 3 * DFF * 4;
constexpr size_t WS_RSS  = al256(WS_SWF1 + 2 * 3 * 2048 * 4);
constexpr size_t WS_WIN  = al256(WS_RSS + (size_t)NTOK * 16 * 4);
constexpr size_t WS_WOUT = WS_WIN + (size_t)2 * DPROJ * D * 2;
constexpr size_t WS_WFNO = WS_WOUT + (size_t)2 * D * DI * 2;
constexpr size_t WS_W1   = WS_WFNO + (size_t)2 * D * D * 2;
constexpr size_t WS_W2   = WS_W1 + (size_t)4 * DFF * D * 2;
constexpr size_t WS_T1   = WS_W2 + (size_t)4 * DFF * D * 2;
constexpr size_t WS_T2C  = WS_T1 + (size_t)512 * 256 * 2;
constexpr size_t WS_T2L  = WS_T2C + (size_t)256 * 512 * 2;
constexpr size_t WS_H    = WS_T2L + (size_t)1024 * 2048 * 2;
constexpr size_t WS_S    = WS_H + (size_t)NTOK * D * 2;
constexpr size_t S_Z     = WS_S;
constexpr size_t S_XBC   = S_Z + (size_t)NTOK * DI * 2;
constexpr size_t S_DT    = S_XBC + (size_t)NTOK * DXBC * 2;
constexpr size_t S_SSQ   = S_DT + (size_t)NTOK * 64 * 4;
constexpr size_t S_YG    = S_SSQ + (size_t)NTOK * 32 * 4;
constexpr size_t S_RAW   = S_YG + (size_t)NTOK * DI * 2;
constexpr size_t WS_END  = S_RAW + (size_t)NTOK * DXBC * 2;
constexpr size_t S_HID   = WS_S;
constexpr size_t S_UVT   = WS_S;
constexpr size_t S_F     = WS_S + (size_t)NTOK * 2048 * 2;

constexpr int LDS_BYTES = 163840;
constexpr int NTHR = 512, NWAVE = 8;

typedef __bf16 bf16x2_t __attribute__((ext_vector_type(2)));
typedef float f32x2_t __attribute__((ext_vector_type(2)));
__device__ __forceinline__ unsigned pk2(float lo, float hi) { const f32x2_t f = {lo, hi}; return __builtin_bit_cast(unsigned, __builtin_convertvector(f, bf16x2_t)); }
__device__ __forceinline__ float bflo(unsigned u) { return __uint_as_float(u << 16); }
__device__ __forceinline__ float bfhi(unsigned u) { return __uint_as_float(u & 0xffff0000u); }
__device__ __forceinline__ float wave_sum(float v) {
#pragma unroll
    for (int o = 1; o < 64; o <<= 1) v += __shfl_xor(v, o);
    return v;
}
__device__ __forceinline__ float silu_f(float x) { return x * __builtin_amdgcn_rcpf(1.0f + __expf(-x)); }
__device__ __forceinline__ int cond_of(int tok) { return tok < NCTX ? 0 : (tok < NCTX + 1024 ? 1 : 2); }

#define XB_TMO      128
#define XB_XCNT(j)  (256  + 64 * (j))
#define XB_XSUB(j)  (1280 + 64 * (j))
#define XB_XGEN(j)  (2304 + 64 * (j))
#define XB_TOP      3328
#define XB_TOPGEN   3392
#define XCD_BAR_WORDS 3456
#define XB_SPIN_CAP (1u << 20)
__device__ __forceinline__ unsigned xb_ld(unsigned* p)              { return __hip_atomic_load(p, __ATOMIC_RELAXED, __HIP_MEMORY_SCOPE_AGENT); }
__device__ __forceinline__ unsigned xb_add(unsigned* p, unsigned v) { return __hip_atomic_fetch_add(p, v, __ATOMIC_RELAXED, __HIP_MEMORY_SCOPE_AGENT); }
__device__ __forceinline__ unsigned xb_xcc_id() { return (unsigned)__builtin_amdgcn_s_getreg((3 << 11) | 20) & 0xFu; }
#define XB_SPIN(cond, bar) do { unsigned _sp = 0; while (cond) { __builtin_amdgcn_s_sleep(1); \
    if ((++_sp & 255u) == 0u) { if (xb_ld(&(bar)[XB_TMO])) break; if (_sp > XB_SPIN_CAP) { atomicAdd(&(bar)[XB_TMO], 1u); break; } } } } while (0)
struct XcdBarrier { unsigned* bar; unsigned x; volatile LAS unsigned* st; };
__device__ __forceinline__ XcdBarrier xcd_barrier_post(unsigned* bar, volatile LAS unsigned* st) {
    XcdBarrier b; b.bar = bar; b.x = xb_xcc_id(); b.st = st;
    if (threadIdx.x == 0) (void)xb_add(&bar[XB_XCNT(b.x)], 1u);
    return b;
}
__device__ __forceinline__ void xcd_barrier_complete(unsigned* bar, unsigned x, unsigned& nloc, unsigned& nx) {
    const unsigned G = gridDim.x * gridDim.y * gridDim.z;
    unsigned sum, cnt, mine, sp = 0u;
    for (;;) {
        sum = 0u; cnt = 0u; mine = 0u;
#pragma unroll
        for (unsigned j = 0; j < 16; ++j) { const unsigned c = xb_ld(&bar[XB_XCNT(j)]); sum += c; cnt += (c > 0u) ? 1u : 0u; mine = (j == x) ? c : mine; }
        if (sum == G) break;
        __builtin_amdgcn_s_sleep(1);
        if ((++sp & 255u) == 0u) { if (xb_ld(&bar[XB_TMO])) break; if (sp > XB_SPIN_CAP) { atomicAdd(&bar[XB_TMO], 1u); break; } }
    }
    nloc = mine > 0u ? mine : 1u; nx = cnt > 0u ? cnt : 1u;
}
__device__ __forceinline__ void xcd_barrier(const XcdBarrier& b) {
    asm volatile("s_waitcnt vmcnt(0)" ::: "memory");
    __syncthreads();
    if (threadIdx.x == 0) {
        unsigned* bar = b.bar;
        __builtin_amdgcn_s_waitcnt(0);
        unsigned nloc = b.st[0], nx = b.st[1];
        if (nloc == 0u) { xcd_barrier_complete(bar, b.x, nloc, nx); b.st[0] = nloc; b.st[1] = nx; }
        const unsigned old = xb_add(&bar[XB_XSUB(b.x)], 1u);
        const unsigned gen = old / nloc;
        if (old + 1u == (gen + 1u) * nloc) {
            __builtin_amdgcn_fence(__ATOMIC_RELEASE, "agent");
            asm volatile("s_waitcnt vmcnt(0)" ::: "memory");
            const unsigned og = xb_add(&bar[XB_TOP], 1u);
            const unsigned tg = og / nx;
            if (og + 1u == (tg + 1u) * nx) xb_add(&bar[XB_TOPGEN], 1u);
            else XB_SPIN(xb_ld(&bar[XB_TOPGEN]) == tg, bar);
            __builtin_amdgcn_fence(__ATOMIC_ACQUIRE, "agent");
            xb_add(&bar[XB_XGEN(b.x)], 1u);
            asm volatile("s_waitcnt vmcnt(0)" ::: "memory");
        } else {
            XB_SPIN(xb_ld(&bar[XB_XGEN(b.x)]) == gen, bar);
            __builtin_amdgcn_fence(__ATOMIC_ACQUIRE, "agent");
            asm volatile("s_waitcnt vmcnt(0)" ::: "memory");
        }
    }
    __syncthreads();
}

struct Args {
    const float* in[22];
    float* out;
    unsigned char* ws;
    int ph_lo, ph_hi;
};

struct Ctx {
    char* lds;
    int tid, lane, wid;
    int vb, G;
    const Args __attribute__((address_space(4)))* a;
};

template <int TB> struct GT { static constexpr int ROWS = 256 + 32 * TB, STAGE = ROWS * 128, NI = ROWS / 8; };

template <int TB>
__device__ __forceinline__ void gemm_stage(char* st, const bf16_t* Ag, int lda, const bf16_t* Bg, int ldb, int k0, int wid, int lane) {
    constexpr int NI = GT<TB>::NI;
    const int rsub = lane >> 3, lch = (lane & 7) ^ rsub;
#pragma unroll
    for (int i = 0; i < (NI + 7) / 8; ++i) {
        const int q = wid + 8 * i;
        if (q < NI) {
            const int row = q * 8 + rsub;
            const bf16_t* src = (q < 32) ? (Ag + (size_t)row * lda + k0 + lch * 8) : (Bg + (size_t)(row - 256) * ldb + k0 + lch * 8);
            __builtin_amdgcn_global_load_lds((const unsigned*)src, (LAS unsigned*)(st + q * 1024 + lane * 16), 16, 0, 0);
        }
    }
}
__device__ __forceinline__ bf16x8 frag128(const char* tile, int row, int chunk) {
    return *(const bf16x8*)(tile + row * 128 + ((chunk ^ (row & 7)) << 4));
}

struct NoPre { __device__ __forceinline__ void operator()() const {} };
template <int TB, bool NAIVE, class Epi, class Pre = NoPre>
__device__ __forceinline__ void gemm_tile(const Ctx& c, const bf16_t* Ag, int lda, const bf16_t* Bg, int ldb, int K, int a0, int b0, const Epi& epi, const Pre& pre = Pre(),
                                          bool prefetched = false, const bf16_t* An = nullptr, const bf16_t* Bn = nullptr) {
    constexpr int STAGE = GT<TB>::STAGE;
    const int wr = c.wid >> 1, wc = c.wid & 1, fr = c.lane & 15, fq = c.lane >> 4;
    f32x4 acc[4][TB];
#pragma unroll
    for (int i = 0; i < 4; ++i)
#pragma unroll
        for (int j = 0; j < TB; ++j) acc[i][j] = (f32x4){0.f, 0.f, 0.f, 0.f};
    if (NAIVE) {
        __syncthreads(); pre(); __syncthreads();
        const bf16_t* ar = Ag + (size_t)(wr * 64 + fq * 4) * lda;
        const bf16_t* br = Bg + (size_t)(wc * 16 * TB + fr) * ldb;
#pragma unroll
        for (int j = 0; j < TB; ++j) {
#pragma unroll 1
            for (int k = 0; k < K; k += 8) {
                float bv[8];
                { const u32x4 v = *(const u32x4*)(br + (size_t)(j * 16) * ldb + k);
#pragma unroll
                  for (int e = 0; e < 4; ++e) { bv[2 * e] = bflo(v[e]); bv[2 * e + 1] = bfhi(v[e]); } }
#pragma unroll
                for (int i = 0; i < 4; ++i)
#pragma unroll
                    for (int r = 0; r < 4; ++r) {
                        const u32x4 v = *(const u32x4*)(ar + (size_t)(i * 16 + r) * lda + k);
#pragma unroll
                        for (int e = 0; e < 4; ++e) acc[i][j][r] += bflo(v[e]) * bv[2 * e] + bfhi(v[e]) * bv[2 * e + 1];
                    }
                asm volatile("" ::: "memory");
            }
        }
        epi(acc, a0 + wr * 64, b0 + wc * (16 * TB), fr, fq);
        return;
    }
    const int nt = K >> 6;
    __syncthreads();
    if (!prefetched) gemm_stage<TB>(c.lds, Ag, lda, Bg, ldb, 0, c.wid, c.lane);
    pre();
    for (int t = 0; t < nt; ++t) {
        asm volatile("s_waitcnt vmcnt(0)" ::: "memory");
        __syncthreads();
        const char* cur = c.lds + (t & 1) * STAGE;
        if (t + 1 < nt) gemm_stage<TB>(c.lds + ((t + 1) & 1) * STAGE, Ag, lda, Bg, ldb, (t + 1) << 6, c.wid, c.lane);
        else if (An) gemm_stage<TB>(c.lds, An, lda, Bn, ldb, 0, c.wid, c.lane);
#pragma unroll
        for (int kk = 0; kk < 2; ++kk) {
            bf16x8 af[4], bfr[TB];
#pragma unroll
            for (int i = 0; i < 4; ++i) af[i] = frag128(cur, wr * 64 + i * 16 + fr, kk * 4 + fq);
#pragma unroll
            for (int j = 0; j < TB; ++j) bfr[j] = frag128(cur, 256 + wc * (16 * TB) + j * 16 + fr, kk * 4 + fq);
#pragma unroll
            for (int i = 0; i < 4; ++i)
#pragma unroll
                for (int j = 0; j < TB; ++j) acc[i][j] = __builtin_amdgcn_mfma_f32_16x16x32_bf16(af[i], bfr[j], acc[i][j], 0, 0, 0);
        }
    }
    epi(acc, a0 + wr * 64, b0 + wc * (16 * TB), fr, fq);
}

template <int TB, class Prob, int BENCH = 0>
__device__ __forceinline__ void gemm_stream(const Ctx& c, const Prob& P) {
    constexpr int STAGE = GT<TB>::STAGE, NI = GT<TB>::NI;
    constexpr int NSLOT = (NI + 7) / 8;
    const int wr = c.wid >> 1, wc = c.wid & 1, fr = c.lane & 15, fq = c.lane >> 4;
    const int n = P.count();
    if (n <= 0) return;
    f32x4 acc[4][TB];
#pragma unroll
    for (int i = 0; i < 4; ++i)
#pragma unroll
        for (int j = 0; j < TB; ++j) acc[i][j] = (f32x4){0.f, 0.f, 0.f, 0.f};
    const int KT = P.K >> 6;
    const int total = n * KT;
    const int rsub = c.lane >> 3, lch = (c.lane & 7) ^ rsub;
    int voff[NSLOT], qs[NSLOT];
#pragma unroll
    for (int s = 0; s < NSLOT; ++s) {
        const int q = (c.wid + 8 * s < NI) ? c.wid + 8 * s : NI - 1;
        qs[s] = q;
        voff[s] = (s < 4) ? ((q * 8 + rsub) * P.lda + lch * 8) : ((q * 8 + rsub - 256) * P.ldb + lch * 8);
    }
    const bf16_t* Acur; const bf16_t* Bcur;
    int li = 0, lk = 0;
    P.tile(0, Acur, Bcur);
    constexpr int Q0 = (NSLOT + 3) / 4, Q1 = Q0 + (NSLOT + 2) / 4, Q2 = Q1 + (NSLOT + 1) / 4;
    constexpr int S1 = NSLOT;
    auto issue_part = [&](int stage, int s0, int s1) {
        char* st = c.lds + stage * STAGE;
#pragma unroll
        for (int s = 0; s < NSLOT; ++s) {
            if (s >= s0 && s < s1) {
                const bf16_t* src = ((s < 4) ? Acur : Bcur) + voff[s] + lk * 64;
                __builtin_amdgcn_global_load_lds((const unsigned*)src, (LAS unsigned*)(st + qs[s] * 1024 + c.lane * 16), 16, 0, 0);
            }
        }
    };
    auto issue = [&](int stage) { issue_part(stage, 0, NSLOT); };
    auto advance = [&]() { if (++lk == KT) { lk = 0; if (li + 1 < n) { ++li; P.tile(li, Acur, Bcur); } } };
    asm volatile("s_waitcnt vmcnt(0)" ::: "memory");
    __builtin_amdgcn_s_barrier();
    asm volatile("" ::: "memory");
    issue(0); advance(); issue(1); advance();
    if (BENCH != 1) issue_part(2, 0, Q1);
    P.pre_all();
    int ci = 0, ck = 0, stg = 0;
#define GEMM_WAIT_ONE_STAGE() do { if (BENCH == 1) { asm volatile("s_waitcnt vmcnt(0)" ::: "memory"); } \
        else if (after_epi) { asm volatile("s_waitcnt vmcnt(%0)" :: "n"(S1 + Prob::EPI_STORES) : "memory"); } \
        else { asm volatile("s_waitcnt vmcnt(%0)" :: "n"(S1) : "memory"); } } while (0)
    bool after_epi = false;
#define GEMM_BAR() do { asm volatile("" ::: "memory"); __builtin_amdgcn_s_barrier(); asm volatile("" ::: "memory"); } while (0)
#define GEMM_LOADF(dst, stage_ptr, kk) do { \
        _Pragma("unroll") for (int i = 0; i < 4; ++i) dst.a[i] = frag128(stage_ptr, wr * 64 + i * 16 + fr, (kk) * 4 + fq); \
        _Pragma("unroll") for (int jj = 0; jj < TB; ++jj) dst.b[jj] = frag128(stage_ptr, 256 + wc * (16 * TB) + jj * 16 + fr, (kk) * 4 + fq); } while (0)
#define GEMM_MMA(src_) do { \
        _Pragma("unroll") for (int i = 0; i < 4; ++i) \
        _Pragma("unroll") for (int jj = 0; jj < TB; ++jj) acc[i][jj] = __builtin_amdgcn_mfma_f32_16x16x32_bf16(src_.a[i], src_.b[jj], acc[i][jj], 0, 0, 0); } while (0)
    struct Frags { bf16x8 a[4]; bf16x8 b[TB]; };
    Frags f0, f1;
    if (BENCH == 1) { asm volatile("s_waitcnt vmcnt(0)" ::: "memory"); } else { asm volatile("s_waitcnt vmcnt(%0)" :: "n"(NSLOT + Q1) : "memory"); }
    GEMM_BAR();
    GEMM_LOADF(f0, c.lds, 0);
    f32x4 sw[4];
#pragma unroll
    for (int i = 0; i < 4; ++i) sw[i] = (f32x4){0.f, 0.f, 0.f, 0.f};
#pragma unroll 1
    for (int gs = 0; gs < total; ++gs) {
        const char* cur = c.lds + stg * STAGE;
        const int nst1 = stg == 2 ? 0 : stg + 1;
        if (ck == KT - 1) P.preload(ci, sw, wr, fq);
        if (BENCH != 2) GEMM_LOADF(f1, cur, 1);
        const int nst2 = stg == 0 ? 2 : stg - 1;
        if (BENCH != 1) issue_part(nst2, Q1, Q2);
        if (BENCH != 2) GEMM_MMA(f0);
#if GEMM_INTERLEAVE
        __builtin_amdgcn_sched_group_barrier(0x100, 4 + TB, 0);
#pragma unroll
        for (int s = 0; s < NSLOT; ++s) {
            __builtin_amdgcn_sched_group_barrier(0x008, 2, 0);
            __builtin_amdgcn_sched_group_barrier(0x006, 6, 0);
            __builtin_amdgcn_sched_group_barrier(0x010, 1, 0);
        }
        __builtin_amdgcn_sched_group_barrier(0x008, 4 * TB - 2 * NSLOT, 0);
#endif
        if (BENCH != 1) issue_part(nst2, Q2, NSLOT);
        advance();
        GEMM_WAIT_ONE_STAGE();
        after_epi = false;
        asm volatile("s_waitcnt lgkmcnt(0)" ::: "memory");
        GEMM_BAR();
        if (BENCH != 1) issue_part(stg, 0, Q0);
        if (BENCH != 2) GEMM_LOADF(f0, c.lds + nst1 * STAGE, 0);
#if GEMM_SETPRIO
        __builtin_amdgcn_s_setprio(1);
#endif
        if (BENCH != 2) GEMM_MMA(f1);
#if GEMM_SETPRIO
        __builtin_amdgcn_s_setprio(0);
#endif
        if (BENCH != 1) issue_part(stg, Q0, Q1);
        stg = nst1;
        if (++ck == KT) {
            P.epilogue(ci, acc, sw, wr, wc, fr, fq);
#pragma unroll
            for (int i = 0; i < 4; ++i)
#pragma unroll
                for (int j = 0; j < TB; ++j) acc[i][j] = (f32x4){0.f, 0.f, 0.f, 0.f};
            ck = 0; ++ci;
            after_epi = true;
        }
    }
    asm volatile("s_waitcnt vmcnt(0)" ::: "memory");
    GEMM_BAR();
#undef GEMM_WAIT_ONE_STAGE
#undef GEMM_BAR
#undef GEMM_LOADF
#undef GEMM_MMA
}

struct EpiInProj {
    bf16_t* Z; bf16_t* RAW; const float* rsx  ; int tok_base; const float* SW  ; bool uni  ;
    __device__ __forceinline__ void operator()(f32x4 (&acc)[4][5], const f32x4 (&swp)[4], int ab, int bb, int fr, int fq) const {
#pragma unroll
        for (int j = 0; j < 5; ++j) {
            const int tok = bb + j * 16 + fr;
            const float rs = rsx[tok - tok_base];
            const float* sw = SW + cond_of(tok) * DPROJ;
#pragma unroll
            for (int i = 0; i < 4; ++i) {
                const int n = ab + i * 16 + fq * 4;
                const f32x4 o = acc[i][j] * rs + (uni ? swp[i] : *(const f32x4*)(sw + n));
                u32x2 v; v.x = pk2(o[0], o[1]); v.y = pk2(o[2], o[3]);
                bf16_t* dst = (n < DI) ? (Z + (size_t)tok * DI + n) : (RAW + (size_t)tok * DXBC + (n - DI));
                *(u32x2*)dst = v;
            }
        }
    }
};
struct EpiResid {
    float* X; const float* gate  ; const float* bias; const float* rs_lds  ; int tok_base;
    const float* Xin0; const float* Xin1;
    bf16_t* XG  ; const float* nw_next; const float* scale_next  ; float* RSS;
    __device__ __forceinline__ void operator()(f32x4 (&acc)[4][5], int ab, int bb, int fr, int fq) const {
        const int slot = (ab >> 6);
#pragma unroll
        for (int j = 0; j < 5; ++j) {
            const int tok = bb + j * 16 + fr;
            const float rs = rs_lds ? rs_lds[tok - tok_base] : 1.0f;
            const int cd = cond_of(tok);
            const float* g = gate + cd * 6144;
            float ss = 0.f;
#pragma unroll
            for (int i = 0; i < 4; ++i) {
                const int n = ab + i * 16 + fq * 4;
                const f32x4 gv = *(const f32x4*)(g + n);
                f32x4 bv = (f32x4){0.f, 0.f, 0.f, 0.f};
                if (bias) bv = *(const f32x4*)(bias + n);
                f32x4* xp = (f32x4*)(X + (size_t)tok * D + n);
                f32x4 xv = Xin0 ? *(const f32x4*)((tok < NCTX ? Xin0 + (size_t)tok * D : Xin1 + (size_t)(tok - NCTX) * D) + n) : *xp;
                xv = xv + gv * (acc[i][j] * rs + bv);
                *xp = xv;
                if (XG) {
                    ss += xv[0] * xv[0] + xv[1] * xv[1] + xv[2] * xv[2] + xv[3] * xv[3];
                    const f32x4 gn = *(const f32x4*)(nw_next + n) * (*(const f32x4*)(scale_next + cd * 6144 + n) + 1.0f);
                    const f32x4 o = xv * gn;
                    u32x2 v; v.x = pk2(o[0], o[1]); v.y = pk2(o[2], o[3]);
                    *(u32x2*)(XG + (size_t)tok * D + n) = v;
                }
            }
            if (XG) {
                ss += __shfl_xor(ss, 16); ss += __shfl_xor(ss, 32);
                if (fq == 0) RSS[(size_t)tok * 16 + slot] = ss;
            }
        }
    }
};
struct EpiMlpUp {
    bf16_t* HID; const float* rsx; int tok_base; const float* SW  ; bool uni;
    __device__ __forceinline__ void operator()(f32x4 (&acc)[4][5], const f32x4 (&swp)[4], int ab, int bb, int fr, int fq) const {
#pragma unroll
        for (int j = 0; j < 5; ++j) {
            const int tok = bb + j * 16 + fr;
            const float rs = rsx[tok - tok_base];
            const float* sw = SW + cond_of(tok) * DFF;
#pragma unroll
            for (int i = 0; i < 4; ++i) {
                const int n = ab + i * 16 + fq * 4;
                f32x4 a = acc[i][j] * rs + (uni ? swp[i] : *(const f32x4*)(sw + n));
                a[0] = fmaxf(a[0], 0.f); a[1] = fmaxf(a[1], 0.f); a[2] = fmaxf(a[2], 0.f); a[3] = fmaxf(a[3], 0.f);
                u32x2 v; v.x = pk2(a[0] * a[0], a[1] * a[1]); v.y = pk2(a[2] * a[2], a[3] * a[3]);
                *(u32x2*)(HID + (size_t)tok * DFF + n) = v;
            }
        }
    }
};
struct EpiDt {
    float* DT; const float* rsx; int tok_base; const float* SW  ;
    __device__ __forceinline__ void operator()(f32x4 (&acc)[4][2], int ab, int bb, int fr, int fq) const {
#pragma unroll
        for (int j = 0; j < 2; ++j) {
            const int col = bb + j * 16 + fr;
#pragma unroll
            for (int i = 0; i < 4; ++i) {
                const int tok = ab + i * 16 + fq * 4;
#pragma unroll
                for (int r = 0; r < 4; ++r) DT[(size_t)(tok + r) * 64 + col] = acc[i][j][r] * rsx[tok + r - tok_base] + SW[cond_of(tok + r) * DPROJ + NZX + col];
            }
        }
    }
};
struct EpiF1 {
    bf16_t* UVT; int g; const float* rsx; int tok_base; const float* SW  ;
    __device__ __forceinline__ void operator()(f32x4 (&acc)[4][4], int ab, int bb, int fr, int fq) const {
#pragma unroll
        for (int j = 0; j < 4; ++j) {
            const int nn = bb + j * 16 + fr, part = nn >> 8, ch = g * 256 + (nn & 255);
#pragma unroll
            for (int i = 0; i < 4; ++i) {
                const int tok = ab + i * 16 + fq * 4;
                const float sw = SW[cond_of(tok) * 2048 + g * 512 + nn];
                bf16_t* dst;
                if (tok < NCTX) { const int s = tok >> 8, l = tok & 255; dst = UVT + ((size_t)(s * 1024 + ch) * 512 + part * 256 + l); }
                else { const int tt = tok - NCTX, s = tt >> 10, l = tt & 1023; dst = UVT + (size_t)NCTX * 2048 + ((size_t)(s * 1024 + ch) * 2048 + part * 1024 + l); }
                const f32x4 r4 = *(const f32x4*)(rsx + tok - tok_base);
                const f32x4 o = acc[i][j] * r4 + sw;
                u32x2 v; v.x = pk2(o[0], o[1]); v.y = pk2(o[2], o[3]);
                *(u32x2*)dst = v;
            }
        }
    }
};
template <int TB> struct EpiF2 {
    bf16_t* F; int tok0;
    __device__ __forceinline__ void operator()(f32x4 (&acc)[4][TB], int ab, int bb, int fr, int fq) const {
#pragma unroll
        for (int j = 0; j < TB; ++j) {
            const int tok = tok0 + bb + j * 16 + fr;
#pragma unroll
            for (int i = 0; i < 4; ++i) {
                const int n = ab + i * 16 + fq * 4;
                u32x2 v; v.x = pk2(acc[i][j][0], acc[i][j][1]); v.y = pk2(acc[i][j][2], acc[i][j][3]);
                *(u32x2*)(F + (size_t)tok * D + n) = v;
            }
        }
    }
};

struct TrItem { const float* W; bf16_t* WT; int K, N, k0, n0; };
__device__ __forceinline__ TrItem transpose_decode(const Ctx& c, int r) {
    const Args __attribute__((address_space(4)))& a = *c.a;
    constexpr int I_WIN = 8 * 81, I_WOUT = 16 * 16, I_FNO = 8 * 16, I_W1 = 8 * 64, I_W2 = 32 * 16;
    TrItem t; int item;
    if (r < 2 * I_WIN) { const int j = r / I_WIN; t.W = a.in[9] + (size_t)j * D * DPROJ; t.K = D; t.N = DPROJ; t.WT = (bf16_t*)(a.ws + WS_WIN) + (size_t)j * DPROJ * D; item = r - j * I_WIN; }
    else if ((r -= 2 * I_WIN) < 2 * I_WOUT) { const int j = r / I_WOUT; t.W = a.in[16] + (size_t)j * DI * D; t.K = DI; t.N = D; t.WT = (bf16_t*)(a.ws + WS_WOUT) + (size_t)j * D * DI; item = r - j * I_WOUT; }
    else if ((r -= 2 * I_WOUT) < 2 * I_FNO) { const int j = r / I_FNO; t.W = a.in[17] + (size_t)j * D * D; t.K = D; t.N = D; t.WT = (bf16_t*)(a.ws + WS_WFNO) + (size_t)j * D * D; item = r - j * I_FNO; }
    else if ((r -= 2 * I_FNO) < 4 * I_W1) { const int j = r / I_W1; t.W = a.in[19] + (size_t)j * D * DFF; t.K = D; t.N = DFF; t.WT = (bf16_t*)(a.ws + WS_W1) + (size_t)j * DFF * D; item = r - j * I_W1; }
    else { r -= 4 * I_W1; const int j = r / I_W2; t.W = a.in[20] + (size_t)j * DFF * D; t.K = DFF; t.N = D; t.WT = (bf16_t*)(a.ws + WS_W2) + (size_t)j * D * DFF; item = r - j * I_W2; }
    const int nb = t.N >> 6, kb = item / nb, nbi = item - kb * nb;
    t.k0 = kb * 128; t.n0 = nbi * 64;
    return t;
}
__device__ __forceinline__ void transpose_load(const Ctx& c, const TrItem& t, f32x4 (&v)[4]) {
    const int cl = c.tid & 15, rl = c.tid >> 4;
#pragma unroll
    for (int p = 0; p < 4; ++p) v[p] = *(const f32x4*)(t.W + (size_t)(t.k0 + p * 32 + rl) * t.N + t.n0 + cl * 4);
}
__device__ __forceinline__ void transpose_finish(const Ctx& c, const TrItem& t, const f32x4 (&v)[4]) {
    float* tile = (float*)c.lds;
    const int cl = c.tid & 15, rl = c.tid >> 4;
    __syncthreads();
#pragma unroll
    for (int p = 0; p < 4; ++p) { const int k = p * 32 + rl; tile[k * 65 + cl * 4 + 0] = v[p][0]; tile[k * 65 + cl * 4 + 1] = v[p][1]; tile[k * 65 + cl * 4 + 2] = v[p][2]; tile[k * 65 + cl * 4 + 3] = v[p][3]; }
    __syncthreads();
#pragma unroll
    for (int p = 0; p < 2; ++p) {
        const int idx = c.tid + p * NTHR, n = idx >> 4, kc = idx & 15;
        const float* s = tile + (kc * 8) * 65 + n;
        u32x4 o; o.x = pk2(s[0], s[65]); o.y = pk2(s[2 * 65], s[3 * 65]); o.z = pk2(s[4 * 65], s[5 * 65]); o.w = pk2(s[6 * 65], s[7 * 65]);
        *(u32x4*)(t.WT + (size_t)(t.n0 + n) * t.K + t.k0 + kc * 8) = o;
    }
}

__device__ __forceinline__ void ada_item(const Ctx& c, int item) {
    const Args __attribute__((address_space(4)))& a = *c.a;
    const int layer = item / 96, cg = item - layer * 96, n0 = cg * 64;
    const float* W = a.in[5] + (size_t)layer * D * 6144;
    const float* sc = (const float*)(c.lds + 40960);
    float* red = (float*)c.lds;
    const int cl = c.tid & 15, kl = c.tid >> 4;
    f32x4 a0 = {0, 0, 0, 0}, a1 = {0, 0, 0, 0}, a2 = {0, 0, 0, 0};
#pragma unroll 8
    for (int it = 0; it < 32; ++it) {
        const int k = it * 32 + kl;
        const f32x4 w = *(const f32x4*)(W + (size_t)k * 6144 + n0 + cl * 4);
        a0 += w * sc[k]; a1 += w * sc[1024 + k]; a2 += w * sc[2048 + k];
    }
    __syncthreads();
    *(f32x4*)(red + (kl * 3 + 0) * 64 + cl * 4) = a0;
    *(f32x4*)(red + (kl * 3 + 1) * 64 + cl * 4) = a1;
    *(f32x4*)(red + (kl * 3 + 2) * 64 + cl * 4) = a2;
    __syncthreads();
    if (c.tid < 192) {
        const int cond = c.tid >> 6, col = c.tid & 63;
        float s = 0.f;
#pragma unroll
        for (int k = 0; k < 32; ++k) s += red[(k * 3 + cond) * 64 + col];
        s += a.in[6][layer * 6144 + n0 + col];
        ((float*)(a.ws + WS_MOD))[(layer * 3 + cond) * 6144 + n0 + col] = s;
    }
}

__device__ __forceinline__ void phase_prep(const Ctx& c) {
    const Args __attribute__((address_space(4)))& a = *c.a;
    {
        float* sc = (float*)(c.lds + 40960);
        for (int i = c.tid; i < 3072; i += NTHR) {
            const int cond = i >> 10, k = i & 1023;
            const float v = cond == 0 ? a.in[4][k] : a.in[3][(cond - 1) * 1024 + k];
            sc[i] = silu_f(v);
        }
        __syncthreads();
    }
    constexpr int I_ADA = 384;
    constexpr int I_TR = 2 * 8 * 81 + 2 * 16 * 16 + 2 * 8 * 16 + 4 * 8 * 64 + 4 * 32 * 16;
    constexpr int I_TB = 32 + 32 + 512;
    for (int it = c.vb; it < I_ADA; it += c.G) ada_item(c, it);
    {
        int it = c.vb;
        if (it < I_TR) {
            TrItem cur = transpose_decode(c, it);
            f32x4 v[4]; transpose_load(c, cur, v);
            for (;;) {
                const int nit = it + c.G;
                TrItem nxt = cur; f32x4 vn[4];
                const bool has = nit < I_TR;
                if (has) { nxt = transpose_decode(c, nit); transpose_load(c, nxt, vn); }
                transpose_finish(c, cur, v);
                if (!has) break;
                cur = nxt; it = nit;
#pragma unroll
                for (int p = 0; p < 4; ++p) v[p] = vn[p];
            }
        }
    }
    for (int r = c.vb; r < I_TB; r += c.G) {
#pragma unroll 4
        for (int e = 0; e < 8; ++e) {
            int idx = r * 4096 + e * NTHR + c.tid;
            if (idx < 131072) {
                const int nn = idx >> 8, cc = idx & 255, m = nn & 255, ph = (m * cc) & 255;
                const float ang = (float)ph * (1.0f / 128.0f);
                const float v = nn < 256 ? cospif(ang) : sinpif(ang);
                ((bf16_t*)(a.ws + WS_T1))[idx] = (bf16_t)(pk2(v, 0.f) & 0xffff);
            } else if (idx < 262144) {
                idx -= 131072;
                const int k = idx >> 9, k2 = idx & 511, l = k2 & 255, ph = (k * l) & 255;
                const float ang = (float)ph * (1.0f / 128.0f);
                const float v = (k2 < 256 ? cospif(ang) : -sinpif(ang)) * (1.0f / 256.0f);
                ((bf16_t*)(a.ws + WS_T2C))[idx] = (bf16_t)(pk2(v, 0.f) & 0xffff);
            } else {
                idx -= 262144;
                const int k = idx >> 11, k2 = idx & 2047, l = k2 & 1023, ph = (k * l) & 1023;
                const float ang = (float)ph * (1.0f / 512.0f);
                const float v = (k2 < 1024 ? cospif(ang) : -sinpif(ang)) * (1.0f / 512.0f);
                ((bf16_t*)(a.ws + WS_T2L))[idx] = (bf16_t)(pk2(v, 0.f) & 0xffff);
            }
        }
    }
}

__device__ __forceinline__ void phase_prep2(const Ctx& c) {
    const Args __attribute__((address_space(4)))& a = *c.a;
    const float* MOD = (const float*)(a.ws + WS_MOD);
    float* sh = (float*)c.lds;
    const int gw = c.vb * NWAVE + c.wid, NGW = c.G * NWAVE;
#pragma unroll 1
    for (int v = 0; v < 8; ++v) {
        const int layer = v >> 1, mlp = v & 1, jj = layer >> 1, fnet = (layer & 1) && !mlp;
        __syncthreads();
        for (int i = c.tid; i < 3072; i += NTHR) sh[i] = MOD[(size_t)(layer * 3 + (i >> 10)) * 6144 + (mlp ? 3072 : 0) + (i & 1023)];
        __syncthreads();
        const bf16_t* W; float* out; int N, ostride;
        if (mlp) { W = (const bf16_t*)(a.ws + WS_W1) + (size_t)layer * DFF * D; N = DFF; out = (float*)(a.ws + WS_SWUP) + (size_t)layer * 3 * DFF; ostride = DFF; }
        else if (fnet) { W = (const bf16_t*)(a.ws + WS_T1); N = 2048; out = (float*)(a.ws + WS_SWF1) + (size_t)jj * 3 * 2048; ostride = 2048; }
        else { W = (const bf16_t*)(a.ws + WS_WIN) + (size_t)jj * DPROJ * D; N = DPROJ; out = (float*)(a.ws + WS_SWIN) + (size_t)jj * 3 * DPROJ; ostride = DPROJ; }
        for (int n = gw; n < N; n += NGW) {
            float s0 = 0.f, s1 = 0.f, s2 = 0.f;
            if (fnet) {
                const int g = n >> 9, nn = n & 511;
                if (c.lane < 32) {
                    const u32x4 w = *(const u32x4*)(W + (size_t)nn * 256 + c.lane * 8);
                    const int k = g * 256 + c.lane * 8;
#pragma unroll
                    for (int e = 0; e < 4; ++e) {
                        const float wl = bflo(w[e]), wh = bfhi(w[e]);
                        s0 += wl * sh[k + 2 * e] + wh * sh[k + 2 * e + 1];
                        s1 += wl * sh[1024 + k + 2 * e] + wh * sh[1024 + k + 2 * e + 1];
                        s2 += wl * sh[2048 + k + 2 * e] + wh * sh[2048 + k + 2 * e + 1];
                    }
                }
            } else {
#pragma unroll
                for (int p = 0; p < 2; ++p) {
                    const int k = p * 512 + c.lane * 8;
                    const u32x4 w = *(const u32x4*)(W + (size_t)n * D + k);
#pragma unroll
                    for (int e = 0; e < 4; ++e) {
                        const float wl = bflo(w[e]), wh = bfhi(w[e]);
                        s0 += wl * sh[k + 2 * e] + wh * sh[k + 2 * e + 1];
                        s1 += wl * sh[1024 + k + 2 * e] + wh * sh[1024 + k + 2 * e + 1];
                        s2 += wl * sh[2048 + k + 2 * e] + wh * sh[2048 + k + 2 * e + 1];
                    }
                }
            }
            s0 = wave_sum(s0); s1 = wave_sum(s1); s2 = wave_sum(s2);
            if (c.lane == 0) { out[n] = s0; out[ostride + n] = s1; out[2 * ostride + n] = s2; }
        }
    }
    {
        bf16_t* XG = (bf16_t*)(a.ws + WS_H);
        float* RSS = (float*)(a.ws + WS_RSS);
        const float* nw = a.in[7];
        for (int row = gw; row < NTOK; row += NGW) {
            const float* xr = row < NCTX ? a.in[0] + (size_t)row * D : a.in[1] + (size_t)(row - NCTX) * D;
            const float* m = MOD + (size_t)cond_of(row) * 6144 + 1024;
            float ss = 0.f;
#pragma unroll
            for (int q = 0; q < 4; ++q) {
                const int col = q * 256 + c.lane * 4;
                const f32x4 v = *(const f32x4*)(xr + col);
                ss += v[0] * v[0] + v[1] * v[1] + v[2] * v[2] + v[3] * v[3];
                const f32x4 o = v * (*(const f32x4*)(nw + col)) * (*(const f32x4*)(m + col) + 1.0f);
                u32x2 w; w.x = pk2(o[0], o[1]); w.y = pk2(o[2], o[3]);
                *(u32x2*)(XG + (size_t)row * D + col) = w;
            }
            ss = wave_sum(ss);
            if (c.lane < 16) RSS[(size_t)row * 16 + c.lane] = c.lane == 0 ? ss : 0.f;
        }
    }
}

__device__ __forceinline__ void phase_norm(const Ctx& c, const float* nw, const float* mod  , int off_shift, int off_scale, bool final_norm) {
    const Args __attribute__((address_space(4)))& a = *c.a;
    const int gw = c.vb * NWAVE + c.wid, NGW = c.G * NWAVE;
    bf16_t* H = (bf16_t*)(a.ws + WS_H);
    for (int row = gw; row < NTOK; row += NGW) {
        float* xr = a.out + (size_t)row * D;
        f32x4 v[4]; float ss = 0.f;
#pragma unroll
        for (int j = 0; j < 4; ++j) { v[j] = *(const f32x4*)(xr + j * 256 + c.lane * 4); ss += v[j][0] * v[j][0] + v[j][1] * v[j][1] + v[j][2] * v[j][2] + v[j][3] * v[j][3]; }
        ss = wave_sum(ss);
        const float rstd = rsqrtf(ss * (1.0f / D) + EPS);
        if (final_norm) {
#pragma unroll
            for (int j = 0; j < 4; ++j) { const f32x4 w = *(const f32x4*)(nw + j * 256 + c.lane * 4); *(f32x4*)(xr + j * 256 + c.lane * 4) = v[j] * rstd * w; }
        } else {
            const float* m = mod + cond_of(row) * 6144;
#pragma unroll
            for (int j = 0; j < 4; ++j) {
                const int col = j * 256 + c.lane * 4;
                const f32x4 w = *(const f32x4*)(nw + col), sc = *(const f32x4*)(m + off_scale + col), sh = *(const f32x4*)(m + off_shift + col);
                const f32x4 h = v[j] * rstd * w * (sc + 1.0f) + sh;
                u32x2 o; o.x = pk2(h[0], h[1]); o.y = pk2(h[2], h[3]);
                *(u32x2*)(H + (size_t)row * D + col) = o;
            }
        }
    }
}

constexpr int RS_OFF = 3 * GT<5>::STAGE;
struct FillRstd { float* tab; const float* RSS; int tok0, ntok, tid;
    __device__ __forceinline__ void operator()() const {
        if (tid < ntok) {
            const float* p = RSS + (size_t)(tok0 + tid) * 16;
            float s = 0.f;
#pragma unroll
            for (int q = 0; q < 4; ++q) { const f32x4 v = *(const f32x4*)(p + q * 4); s += (v[0] + v[1]) + (v[2] + v[3]); }
            tab[tid] = rsqrtf(s * (1.0f / D) + EPS);
        }
    }
};
__device__ __forceinline__ FillRstd fill_rstd(const Ctx& c, int tok0, int ntok) { return FillRstd{(float*)(c.lds + RS_OFF), (const float*)(c.a->ws + WS_RSS), tok0, ntok, c.tid}; }
__device__ __forceinline__ void rstd_table_one(const Ctx& c, int i, int ntok, int tok0) {
    float* tab = (float*)(c.lds + RS_OFF);
    const float* RSS = (const float*)(c.a->ws + WS_RSS);
    if (c.tid < ntok) {
        const float* p = RSS + (size_t)(tok0 + c.tid) * 16;
        float s = 0.f;
#pragma unroll
        for (int q = 0; q < 4; ++q) { const f32x4 v = *(const f32x4*)(p + q * 4); s += (v[0] + v[1]) + (v[2] + v[3]); }
        tab[i * ntok + c.tid] = rsqrtf(s * (1.0f / D) + EPS);
    }
}
__device__ __forceinline__ void rstd_tables(const Ctx& c, int n, int ntok, int first, int stride, int toks_per_rt, int shift_rt  ) {
    float* tab = (float*)(c.lds + RS_OFF);
    const float* RSS = (const float*)(c.a->ws + WS_RSS);
    for (int i = 0; i < n; ++i) {
        const int t = first + i * stride, rt = shift_rt < 0 ? t / (-shift_rt) : (t >> shift_rt);
        if (c.tid < ntok) {
            const float* p = RSS + (size_t)(rt * toks_per_rt + c.tid) * 16;
            float s = 0.f;
#pragma unroll
            for (int q = 0; q < 4; ++q) { const f32x4 v = *(const f32x4*)(p + q * 4); s += (v[0] + v[1]) + (v[2] + v[3]); }
            tab[i * ntok + c.tid] = rsqrtf(s * (1.0f / D) + EPS);
        }
    }
}
__device__ __forceinline__ void patch_tile(const Ctx& c, int i, int NC, int& rt, int& ct) {
    if (c.G == 256) { const int x = c.vb >> 5, l = c.vb & 31, p = i * 8 + x, PC = NC >> 2, pr = p / PC, pc = p - pr * PC; rt = pr * 8 + (l >> 2); ct = pc * 4 + (l & 3); }
    else { const int t = c.vb + i * c.G; rt = t / NC; ct = t - rt * NC; }
}
struct ProbInProj {
    static constexpr int EPI_STORES = 20;
    const Ctx* c; const bf16_t* W; const bf16_t* XG; int lda, ldb, K; int j;
    static constexpr int NC = NZX / 256, NT = (NTOK / 160) * NC;
    __device__ __forceinline__ int count() const { return (NT - c->vb + c->G - 1) / c->G; }
    __device__ __forceinline__ void tile(int i, const bf16_t*& A, const bf16_t*& B) const { int rt, ct; patch_tile(*c, i, NC, rt, ct); A = W + (size_t)ct * 256 * D; B = XG + (size_t)rt * 160 * D; }
    __device__ __forceinline__ void pre_all() const { const int n = count(); for (int i = 0; i < n; ++i) { int rt, ct; patch_tile(*c, i, NC, rt, ct); rstd_table_one(*c, i, 160, rt * 160); } }
    __device__ __forceinline__ void preload(int i, f32x4 (&sw)[4], int wr, int fq) const {
        int rt, ct; patch_tile(*c, i, NC, rt, ct);
        if (cond_of(rt * 160) == cond_of(rt * 160 + 159)) {
            const float* p = (const float*)(c->a->ws + WS_SWIN) + (size_t)j * 3 * DPROJ + cond_of(rt * 160) * DPROJ + ct * 256 + wr * 64 + fq * 4;
#pragma unroll
            for (int q = 0; q < 4; ++q) sw[q] = *(const f32x4*)(p + q * 16);
        }
    }
    __device__ __forceinline__ void epilogue(int i, f32x4 (&acc)[4][5], const f32x4 (&sw)[4], int wr, int wc, int fr, int fq) const {
        int rt, ct; patch_tile(*c, i, NC, rt, ct); unsigned char* ws = c->a->ws;
        EpiInProj e{(bf16_t*)(ws + S_Z), (bf16_t*)(ws + S_RAW), (const float*)(c->lds + RS_OFF) + i * 160, rt * 160, (const float*)(ws + WS_SWIN) + (size_t)j * 3 * DPROJ, cond_of(rt * 160) == cond_of(rt * 160 + 159)};
        e(acc, sw, ct * 256 + wr * 64, rt * 160 + wc * 80, fr, fq);
    }
};
__device__ __forceinline__ void phase_inproj(const Ctx& c, int j) {
    ProbInProj P{&c, (const bf16_t*)(c.a->ws + WS_WIN) + (size_t)j * DPROJ * D, (const bf16_t*)(c.a->ws + WS_H), D, D, D, j};
    gemm_stream<5>(c, P);
}
struct ProbMlpUp {
    static constexpr int EPI_STORES = 20;
    const Ctx* c; const bf16_t* W; const bf16_t* XG; int lda, ldb, K; int layer;
    static constexpr int NC = DFF / 256, NT = (NTOK / 160) * NC;
    __device__ __forceinline__ int count() const { return (NT - c->vb + c->G - 1) / c->G; }
    __device__ __forceinline__ void tile(int i, const bf16_t*& A, const bf16_t*& B) const { int rt, ct; patch_tile(*c, i, NC, rt, ct); A = W + (size_t)ct * 256 * D; B = XG + (size_t)rt * 160 * D; }
    __device__ __forceinline__ void pre_all() const { const int n = count(); for (int i = 0; i < n; ++i) { int rt, ct; patch_tile(*c, i, NC, rt, ct); rstd_table_one(*c, i, 160, rt * 160); } }
    __device__ __forceinline__ void preload(int i, f32x4 (&sw)[4], int wr, int fq) const {
        int rt, ct; patch_tile(*c, i, NC, rt, ct);
        if (cond_of(rt * 160) == cond_of(rt * 160 + 159)) {
            const float* p = (const float*)(c->a->ws + WS_SWUP) + (size_t)layer * 3 * DFF + cond_of(rt * 160) * DFF + ct * 256 + wr * 64 + fq * 4;
#pragma unroll
            for (int q = 0; q < 4; ++q) sw[q] = *(const f32x4*)(p + q * 16);
        }
    }
    __device__ __forceinline__ void epilogue(int i, f32x4 (&acc)[4][5], const f32x4 (&sw)[4], int wr, int wc, int fr, int fq) const {
        int rt, ct; patch_tile(*c, i, NC, rt, ct); unsigned char* ws = c->a->ws;
        EpiMlpUp e{(bf16_t*)(ws + S_HID), (const float*)(c->lds + RS_OFF) + i * 160, rt * 160, (const float*)(ws + WS_SWUP) + (size_t)layer * 3 * DFF, cond_of(rt * 160) == cond_of(rt * 160 + 159)};
        e(acc, sw, ct * 256 + wr * 64, rt * 160 + wc * 80, fr, fq);
    }
};
__device__ __forceinline__ void phase_mlp_up(const Ctx& c, int layer) {
    ProbMlpUp P{&c, (const bf16_t*)(c.a->ws + WS_W1) + (size_t)layer * DFF * D, (const bf16_t*)(c.a->ws + WS_H), D, D, D, layer};
    gemm_stream<5>(c, P);
}
#ifndef BENCH_MODE
#define BENCH_MODE 0
#endif
__device__ __forceinline__ void phase_bench(const Ctx& c) {
    ProbMlpUp P{&c, (const bf16_t*)(c.a->ws + WS_W1), (const bf16_t*)(c.a->ws + WS_H), D, D, D, 0};
    gemm_stream<5, ProbMlpUp, BENCH_MODE>(c, P);
}
struct ProbResid {
    static constexpr int EPI_STORES = 0;
    const Ctx* c; const bf16_t* WT; const bf16_t* Act; int lda, ldb, K; const float* gate; const float* bias; const float* ssq; const float* nw_next; const float* scale_next; bool first;
    static constexpr int NC = D / 256, NT = (NTOK / 160) * NC;
    __device__ __forceinline__ int count() const { return (NT - c->vb + c->G - 1) / c->G; }
    __device__ __forceinline__ void tile(int i, const bf16_t*& A, const bf16_t*& B) const { const int t = c->vb + i * c->G, rt = t / NC, ct = t - rt * NC; A = WT + (size_t)ct * 256 * K; B = Act + (size_t)rt * 160 * K; }
    __device__ __forceinline__ void pre_all() const {
        if (!ssq) return;
        float* tab = (float*)(c->lds + RS_OFF);
        const int n = count();
        for (int i = 0; i < n; ++i) {
            const int t = c->vb + i * c->G, rt = t / NC;
            if (c->tid < 160) {
                const float* p = ssq + (size_t)(rt * 160 + c->tid) * 32;
                float s = 0.f;
#pragma unroll
                for (int q = 0; q < 8; ++q) { const f32x4 v = *(const f32x4*)(p + q * 4); s += v[0] + v[1] + v[2] + v[3]; }
                tab[i * 160 + c->tid] = rsqrtf(s * (1.0f / DI) + EPS);
            }
        }
    }
    __device__ __forceinline__ void preload(int, f32x4 (&)[4], int, int) const {}
    __device__ __forceinline__ void epilogue(int i, f32x4 (&acc)[4][5], const f32x4 (&)[4], int wr, int wc, int fr, int fq) const {
        const int t = c->vb + i * c->G, rt = t / NC, ct = t - rt * NC; unsigned char* ws = c->a->ws;
        EpiResid e{c->a->out, gate, bias, ssq ? (const float*)(c->lds + RS_OFF) + i * 160 : nullptr, rt * 160, first ? c->a->in[0] : nullptr, first ? c->a->in[1] : nullptr, nw_next ? (bf16_t*)(ws + WS_H) : nullptr, nw_next, scale_next, (float*)(ws + WS_RSS)};
        e(acc, ct * 256 + wr * 64, rt * 160 + wc * 80, fr, fq);
    }
};
__device__ __forceinline__ void phase_resid_gemm(const Ctx& c, const bf16_t* WT, const bf16_t* Act, int K, const float* gate, const float* bias, const float* ssq, const float* nw_next, const float* scale_next, bool first) {
    ProbResid P{&c, WT, Act, K, K, K, gate, bias, ssq, nw_next, scale_next, first};
    gemm_stream<5>(c, P);
}
struct ProbF1 {
    static constexpr int EPI_STORES = 16;
    const Ctx* c; const bf16_t* XG; const bf16_t* T1; int lda, ldb, K; int j;
    static constexpr int NT = (NTOK / 256) * 16;
    __device__ __forceinline__ int count() const { return (NT - c->vb + c->G - 1) / c->G; }
    __device__ __forceinline__ void tile(int i, const bf16_t*& A, const bf16_t*& B) const { const int t = c->vb + i * c->G, rt = t >> 4, g = (t >> 2) & 3, ct = t & 3; A = XG + (size_t)rt * 256 * D + g * 256; B = T1 + (size_t)ct * 128 * 256; }
    __device__ __forceinline__ void pre_all() const { rstd_tables(*c, count(), 256, c->vb, c->G, 256, 4); }
    __device__ __forceinline__ void preload(int, f32x4 (&)[4], int, int) const {}
    __device__ __forceinline__ void epilogue(int i, f32x4 (&acc)[4][4], const f32x4 (&)[4], int wr, int wc, int fr, int fq) const {
        const int t = c->vb + i * c->G, rt = t >> 4, g = (t >> 2) & 3, ct = t & 3; unsigned char* ws = c->a->ws;
        EpiF1 e{(bf16_t*)(ws + S_UVT), g, (const float*)(c->lds + RS_OFF) + i * 256, rt * 256, (const float*)(ws + WS_SWF1) + (size_t)j * 3 * 2048};
        e(acc, rt * 256 + wr * 64, ct * 128 + wc * 64, fr, fq);
    }
};
__device__ __forceinline__ void phase_f1(const Ctx& c, int j) {
    ProbF1 P{&c, (const bf16_t*)(c.a->ws + WS_H), (const bf16_t*)(c.a->ws + WS_T1), D, 256, 256, j};
    gemm_stream<4>(c, P);
}
struct ProbF2L {
    static constexpr int EPI_STORES = 0;
    const Ctx* c; const bf16_t* UVT; const bf16_t* T2; bf16_t* F; int lda, ldb, K;
    __device__ __forceinline__ int count() const { return c->vb < 128 ? 1 : 0; }
    __device__ __forceinline__ void tile(int i, const bf16_t*& A, const bf16_t*& B) const { const int t = c->vb, s = t >> 6, nt = (t >> 4) & 3, kt = t & 15; A = UVT + (size_t)NCTX * 2048 + ((size_t)s * 1024 + nt * 256) * 2048; B = T2 + (size_t)kt * 64 * 2048; }
    __device__ __forceinline__ void pre_all() const {}
    __device__ __forceinline__ void preload(int, f32x4 (&)[4], int, int) const {}
    __device__ __forceinline__ void epilogue(int i, f32x4 (&acc)[4][2], const f32x4 (&)[4], int wr, int wc, int fr, int fq) const { const int t = c->vb, s = t >> 6, nt = (t >> 4) & 3, kt = t & 15; EpiF2<2> e{F, NCTX + s * 1024}; e(acc, nt * 256 + wr * 64, kt * 64 + wc * 32, fr, fq); }
};
struct ProbF2C {
    static constexpr int EPI_STORES = 16;
    const Ctx* c; const bf16_t* UVT; const bf16_t* T2; bf16_t* F; int lda, ldb, K; int first, stride;
    __device__ __forceinline__ int count() const { return (256 - first + stride - 1) / stride; }
    __device__ __forceinline__ void tile(int i, const bf16_t*& A, const bf16_t*& B) const { const int u = first + i * stride, s = u >> 3, nt = (u >> 1) & 3, kt = u & 1; A = UVT + ((size_t)s * 1024 + nt * 256) * 512; B = T2 + (size_t)kt * 128 * 512; }
    __device__ __forceinline__ void pre_all() const {}
    __device__ __forceinline__ void preload(int, f32x4 (&)[4], int, int) const {}
    __device__ __forceinline__ void epilogue(int i, f32x4 (&acc)[4][4], const f32x4 (&)[4], int wr, int wc, int fr, int fq) const { const int u = first + i * stride, s = u >> 3, nt = (u >> 1) & 3, kt = u & 1; EpiF2<4> e{F, s * 256}; e(acc, nt * 256 + wr * 64, kt * 128 + wc * 64, fr, fq); }
};
__device__ __forceinline__ void phase_f2(const Ctx& c) {
    unsigned char* ws = c.a->ws;
    const int half = c.G >> 1;
    if (c.vb < half) { ProbF2L P{&c, (const bf16_t*)(ws + S_UVT), (const bf16_t*)(ws + WS_T2L), (bf16_t*)(ws + S_F), 2048, 2048, 2048}; gemm_stream<2>(c, P); }
    else { ProbF2C P{&c, (const bf16_t*)(ws + S_UVT), (const bf16_t*)(ws + WS_T2C), (bf16_t*)(ws + S_F), 512, 512, 512, c.vb - half, c.G - half}; gemm_stream<4>(c, P); }
}

struct ProbDt {
    static constexpr int EPI_STORES = 0;
    const Ctx* c; const bf16_t* XG; const bf16_t* W; int lda, ldb, K; int j;
    __device__ __forceinline__ int count() const { return (NTOK / 256 - c->vb + c->G - 1) / c->G; }
    __device__ __forceinline__ void tile(int i, const bf16_t*& A, const bf16_t*& B) const { const int t = c->vb + i * c->G; A = XG + (size_t)t * 256 * D; B = W; }
    __device__ __forceinline__ void pre_all() const { rstd_tables(*c, count(), 256, c->vb, c->G, 256, 0); }
    __device__ __forceinline__ void preload(int, f32x4 (&)[4], int, int) const {}
    __device__ __forceinline__ void epilogue(int i, f32x4 (&acc)[4][2], const f32x4 (&)[4], int wr, int wc, int fr, int fq) const {
        const int t = c->vb + i * c->G; unsigned char* ws = c->a->ws;
        EpiDt e{(float*)(ws + S_DT), (const float*)(c->lds + RS_OFF) + i * 256, t * 256, (const float*)(ws + WS_SWIN) + (size_t)j * 3 * DPROJ};
        e(acc, t * 256 + wr * 64, wc * 32, fr, fq);
    }
};
__device__ __forceinline__ void phase_conv(const Ctx& c, int j) {
    const Args __attribute__((address_space(4)))& a = *c.a;
    {
        ProbDt P{&c, (const bf16_t*)(a.ws + WS_H), (const bf16_t*)(a.ws + WS_WIN) + (size_t)j * DPROJ * D + (size_t)NZX * D, D, D, D, j};
        gemm_stream<2>(c, P);
    }
    const bf16_t* RAW = (const bf16_t*)(a.ws + S_RAW);
    bf16_t* XBC = (bf16_t*)(a.ws + S_XBC);
    const float* cw = a.in[10] + (size_t)j * 3 * DXBC;
    const float* cb = a.in[11] + (size_t)j * DXBC;
    constexpr int NIT = (NTOK / 64) * 3;
    for (int it = c.G - 1 - c.vb; it < NIT; it += c.G) {
        const int tg = it / 3, third = it - tg * 3;
        const int ch = third * 1024 + (c.tid & 127) * 8;
        const int r0 = tg * 64 + (c.tid >> 7) * 16;
        float w0[8], w1[8], w2[8], bb[8];
#pragma unroll
        for (int q = 0; q < 2; ++q) {
            const f32x4 t0 = *(const f32x4*)(cw + ch + q * 4), t1 = *(const f32x4*)(cw + DXBC + ch + q * 4), t2 = *(const f32x4*)(cw + 2 * DXBC + ch + q * 4), t3 = *(const f32x4*)(cb + ch + q * 4);
#pragma unroll
            for (int e = 0; e < 4; ++e) { w0[q * 4 + e] = t0[e]; w1[q * 4 + e] = t1[e]; w2[q * 4 + e] = t2[e]; bb[q * 4 + e] = t3[e]; }
        }
        const int seg = r0 < NCTX ? 256 : 64;
        u32x4 prev = {0, 0, 0, 0}, cur, nxt;
        if ((r0 % seg) != 0) prev = *(const u32x4*)(RAW + (size_t)(r0 - 1) * DXBC + ch);
        cur = *(const u32x4*)(RAW + (size_t)r0 * DXBC + ch);
#pragma unroll 4
        for (int r = 0; r < 16; ++r) {
            const int t = r0 + r;
            nxt = (u32x4){0, 0, 0, 0};
            if (((t + 1) % seg) != 0) nxt = *(const u32x4*)(RAW + (size_t)(t + 1) * DXBC + ch);
            u32x4 o;
#pragma unroll
            for (int e = 0; e < 4; ++e) {
                const float lo = bb[2 * e] + w0[2 * e] * bflo(prev[e]) + w1[2 * e] * bflo(cur[e]) + w2[2 * e] * bflo(nxt[e]);
                const float hi = bb[2 * e + 1] + w0[2 * e + 1] * bfhi(prev[e]) + w1[2 * e + 1] * bfhi(cur[e]) + w2[2 * e + 1] * bfhi(nxt[e]);
                o[e] = pk2(silu_f(lo), silu_f(hi));
            }
            *(u32x4*)(XBC + (size_t)t * DXBC + ch) = o;
            prev = cur; cur = nxt;
        }
    }
}

constexpr int SC_XS = 0, SC_XW = 16384, SC_BS = 32768, SC_CS = 49152, SC_HT = 65536, SC_SM = 98304;
__device__ __forceinline__ int off128(int row, int col) { return row * 128 + ((((col >> 3) ^ (row & 7))) << 4) + (col & 7) * 2; }
__device__ __forceinline__ int off256(int row, int col) { return row * 256 + ((((col >> 3) ^ (row & 15))) << 4) + (col & 7) * 2; }
__device__ __forceinline__ int offX(int row, int col) { return row * 128 + col * 2; }
__device__ __forceinline__ int offP(int row, int col) { return row * 144 + col * 2; }
template <int LAY>
__device__ __forceinline__ bf16x8 tr_frag(const char* tile, int r0, int r1, int col0, int lane) {
    const int i = lane & 15, q = i >> 2, cc = col0 + (i & 3) * 4;
    const int o0 = LAY == 1 ? off256(r0 + q, cc) : LAY == 2 ? offP(r0 + q, cc) : offX(r0 + q, cc);
    const int o1 = LAY == 1 ? off256(r1 + q, cc) : LAY == 2 ? offP(r1 + q, cc) : offX(r1 + q, cc);
    const bf16x4 lo = __builtin_amdgcn_ds_read_tr16_b64_v4i16((LAS bf16x4*)(tile + o0));
    const bf16x4 hi = __builtin_amdgcn_ds_read_tr16_b64_v4i16((LAS bf16x4*)(tile + o1));
    return __builtin_shufflevector(lo, hi, 0, 1, 2, 3, 4, 5, 6, 7);
}

struct ScanStep { int seq, hp, dir, ci, nch, t0, valid, single, h0; };
struct ScanIter {
    int vb, G, k, dir, ci;
    __device__ __forceinline__ void get(ScanStep& s) const {
        int seq, hp, ok, single = 0, h0 = 0;
        if (vb < 64) { seq = 32 + (vb >> 5); h0 = vb & 31; hp = h0 >> 1; single = 1; ok = (k == 0); }
        else { const int u = (vb - 64) + k * (G - 64); seq = u >> 4; hp = u & 15; ok = (u < 512); }
        const bool lat = seq >= 32;
        s.seq = seq; s.hp = hp; s.dir = dir; s.ci = ci; s.nch = lat ? 16 : 4; s.valid = ok; s.single = single; s.h0 = h0;
        const int tok0 = lat ? NCTX + (seq - 32) * 1024 : seq * 256;
        const int ch = dir == 0 ? ci : s.nch - 1 - ci;
        s.t0 = tok0 + ch * 64;
    }
    __device__ __forceinline__ void advance() {
        int seq; if (vb < 64) seq = 32; else seq = 0;
        const int nch = seq >= 32 ? 16 : 4;
        if (++ci == nch) { ci = 0; if (++dir == 2) { dir = 0; ++k; } }
    }
};
constexpr int SCB = 49152;
constexpr int SB_XS = 0, SB_BS = 16384, SB_CS = 32768;
constexpr int XW_BYTES = 64 * 144, HT_BYTES = 128 * 144;
constexpr int SCN_XW = 2 * SCB, SCN_HT = SCN_XW + 2 * XW_BYTES, SCN_SM = SCN_HT + 2 * HT_BYTES;

__device__ __forceinline__ void scan_issue_tiles(const Ctx& c, const ScanStep& s, int buf) {
    const bf16_t* XBC = (const bf16_t*)(c.a->ws + S_XBC);
    char* base = c.lds + buf * SCB;
    const int lane = c.lane, w8 = c.wid, g = s.hp >> 2;
#pragma unroll
    for (int hh = 0; hh < 2; ++hh) {
        if (hh == 1 && s.single) break;
        const int q = w8, row = q * 8 + (lane >> 3), lch = lane & 7, hd = s.single ? s.h0 : 2 * s.hp + hh;
        __builtin_amdgcn_global_load_lds((const unsigned*)(XBC + (size_t)(s.t0 + row) * DXBC + hd * 64 + lch * 8), (LAS unsigned*)(base + SB_XS + hh * 8192 + q * 1024 + lane * 16), 16, 0, 0);
    }
#pragma unroll
    for (int i = 0; i < 2; ++i) {
        const int q = w8 + 8 * i, row = q * 4 + (lane >> 4), lch = (lane & 15) ^ (row & 15);
        __builtin_amdgcn_global_load_lds((const unsigned*)(XBC + (size_t)(s.t0 + row) * DXBC + DI + g * 128 + lch * 8), (LAS unsigned*)(base + SB_BS + q * 1024 + lane * 16), 16, 0, 0);
        __builtin_amdgcn_global_load_lds((const unsigned*)(XBC + (size_t)(s.t0 + row) * DXBC + DI + 512 + g * 128 + lch * 8), (LAS unsigned*)(base + SB_CS + q * 1024 + lane * 16), 16, 0, 0);
    }
}
__device__ __forceinline__ float scan_load_dt(const Ctx& c, const ScanStep& s, int hw) {
    const float* DT = (const float*)(c.a->ws + S_DT);
    const int l = s.dir == 0 ? c.lane : 63 - c.lane, h = s.single ? s.h0 : 2 * s.hp + hw;
    return DT[(size_t)(s.t0 + l) * 64 + s.dir * NH + h];
}
__device__ __forceinline__ void scan_dtcs(const Ctx& c, const ScanStep& s, int hw, int j, float raw, float* sm) {
    const int lane = c.lane, l = s.dir == 0 ? lane : 63 - lane, h = s.single ? s.h0 : 2 * s.hp + hw;
    const float Aneg = -__expf(c.a->in[13][(j * 2 + s.dir) * NH + h]);
    raw += c.a->in[12][(j * 2 + s.dir) * NH + h];
    const float dt = raw > 20.f ? raw : __logf(1.0f + __expf(raw));
    float cs = dt * Aneg;
#pragma unroll
    for (int o = 1; o < 64; o <<= 1) { const float u = __shfl_up(cs, o); if (lane >= o) cs += u; }
    sm[l] = dt; sm[64 + l] = cs;
    if (lane == 63) sm[128] = cs;
}

__device__ __forceinline__ void phase_scan_pipe(const Ctx& c, int j) {
    const Args __attribute__((address_space(4)))& a = *c.a;
    const bf16_t* Z = (const bf16_t*)(a.ws + S_Z);
    bf16_t* YTMP = (bf16_t*)(a.ws + S_RAW);
    bf16_t* YG = (bf16_t*)(a.ws + S_YG);
    float* SSQ = (float*)(a.ws + S_SSQ);
    const int hw = c.wid >> 2, w = c.wid & 3;
    char* lds = c.lds;
    char* XWp = lds + SCN_XW + hw * XW_BYTES; char* HTp = lds + SCN_HT + hw * HT_BYTES;

    ScanIter it{c.vb, c.G, 0, 0, 0};
    ScanStep cur, nxt, nx2;
    it.get(cur); it.advance(); it.get(nxt); it.advance(); it.get(nx2);
    if (!cur.valid) return;
    scan_issue_tiles(c, cur, 0);
    float raw_n1 = 0.f;
    if (w == 0 && !(cur.single && hw == 1)) {
        const float r0 = scan_load_dt(c, cur, hw);
        if (nxt.valid) raw_n1 = scan_load_dt(c, nxt, hw);
        scan_dtcs(c, cur, hw, j, r0, (float*)(lds + SCN_SM + (0 * 2 + hw) * 1024));
    }
    f32x4 S[4][2];
#pragma unroll
    for (int pb = 0; pb < 4; ++pb)
#pragma unroll
        for (int nbi = 0; nbi < 2; ++nbi) S[pb][nbi] = (f32x4){0.f, 0.f, 0.f, 0.f};

#pragma unroll 1
    for (int s = 0; cur.valid; ++s) {
        int lane = c.lane; asm volatile("" : "+v"(lane));
        const int fr = lane & 15, fq = lane >> 4;
        const int b = s & 1;
        char* TB_ = lds + b * SCB;
        char* XSp = TB_ + SB_XS + hw * 8192;
        const float* sm_dt = (const float*)(lds + SCN_SM + (b * 2 + hw) * 1024);
        const float* sm_cs = sm_dt + 64;
        const bool is_lat = cur.seq >= 32;
        const bool active = !(cur.single && hw == 1);
        const int dir = cur.dir, t0 = cur.t0, h = cur.single ? cur.h0 : 2 * cur.hp + hw;
        asm volatile("s_waitcnt vmcnt(0)" ::: "memory");
        __syncthreads();
        if (nxt.valid) scan_issue_tiles(c, nxt, b ^ 1);
        float raw_n2 = 0.f;
        if (w == 0 && nx2.valid && !(nx2.single && hw == 1)) raw_n2 = scan_load_dt(c, nx2, hw);
        u32x2 yt[4], zz[4]; f32x4 nwv[4]; float Dh = 0.f;
        const int tok = t0 + w * 16 + fr;
        if (dir == 1 && active) {
            Dh = a.in[14][j * NH + h];
            const float* normw = a.in[15] + (size_t)j * DI + h * 64;
#pragma unroll
            for (int pb = 0; pb < 4; ++pb) {
                const int p0 = pb * 16 + fq * 4;
                yt[pb] = *(const u32x2*)(YTMP + (size_t)tok * DI + h * 64 + p0);
                zz[pb] = *(const u32x2*)(Z + (size_t)tok * DI + h * 64 + p0);
                nwv[pb] = *(const f32x4*)(normw + p0);
            }
        }
        bool has_h = is_lat || cur.ci > 0;
        if (cur.ci == 0) {
            if (is_lat) {
                if (active) {
                const float* sp = a.in[2] + ((size_t)(((cur.seq - 32) * 2 + j) * 2 + dir) * NH + h) * 8192;
#pragma unroll
                for (int pb = 0; pb < 4; ++pb)
#pragma unroll
                    for (int nbi = 0; nbi < 2; ++nbi) {
                        const int n = (2 * w + nbi) * 16 + fr, p0 = pb * 16 + fq * 4;
#pragma unroll
                        for (int r = 0; r < 4; ++r) S[pb][nbi][r] = sp[(p0 + r) * 128 + n];
                        u32x2 v; v.x = pk2(S[pb][nbi][0], S[pb][nbi][1]); v.y = pk2(S[pb][nbi][2], S[pb][nbi][3]);
                        *(u32x2*)(HTp + offP(n, p0)) = v;
                    }
                }
                __syncthreads();
            } else {
#pragma unroll
                for (int pb = 0; pb < 4; ++pb)
#pragma unroll
                    for (int nbi = 0; nbi < 2; ++nbi) S[pb][nbi] = (f32x4){0.f, 0.f, 0.f, 0.f};
            }
        }
        float tot = 0.f;
        if (active) {
        tot = sm_dt[128];
        {
            const int tl = c.tid & 255, l = tl >> 2, c0 = (tl & 3) * 16;
            const float sc = __expf(tot - sm_cs[l]) * sm_dt[l];
#pragma unroll
            for (int q = 0; q < 2; ++q) {
                const u32x4 v = *(const u32x4*)(XSp + offX(l, c0 + q * 8));
                u32x4 r;
#pragma unroll
                for (int e = 0; e < 4; ++e) r[e] = pk2(bflo(v[e]) * sc, bfhi(v[e]) * sc);
                *(u32x4*)(XWp + offP(l, c0 + q * 8)) = r;
            }
        }
        bf16x8 cf[4];
#pragma unroll
        for (int kk = 0; kk < 4; ++kk) cf[kk] = *(const bf16x8*)(TB_ + SB_CS + off256(w * 16 + fr, kk * 32 + fq * 8));
        const float csl = sm_cs[w * 16 + fr];
        f32x4 yacc[4];
#pragma unroll
        for (int pb = 0; pb < 4; ++pb) yacc[pb] = (f32x4){0.f, 0.f, 0.f, 0.f};
        if (has_h) {
            bf16x8 hf[2][4];
#pragma unroll
            for (int pb = 0; pb < 4; ++pb) hf[0][pb] = tr_frag<2>(HTp, fq * 8, fq * 8 + 4, pb * 16, lane);
#pragma unroll
            for (int kk = 0; kk < 4; ++kk) {
                if (kk < 3) {
#pragma unroll
                    for (int pb = 0; pb < 4; ++pb) hf[(kk + 1) & 1][pb] = tr_frag<2>(HTp, (kk + 1) * 32 + fq * 8, (kk + 1) * 32 + fq * 8 + 4, pb * 16, lane);
                }
                __builtin_amdgcn_sched_barrier(0);
#pragma unroll
                for (int pb = 0; pb < 4; ++pb) yacc[pb] = __builtin_amdgcn_mfma_f32_16x16x32_bf16(hf[kk & 1][pb], cf[kk], yacc[pb], 0, 0, 0);
            }
            const float e = __expf(csl);
#pragma unroll
            for (int pb = 0; pb < 4; ++pb) yacc[pb] = yacc[pb] * e;
        }
#pragma unroll
        for (int kk2 = 0; kk2 < 2; ++kk2) {
            const bool need = dir == 0 ? (2 * kk2 <= w) : (2 * kk2 + 1 >= w);
            if (need) {
                unsigned m[4];
                bf16x8 bfg[2][4];
                f32x4 gg[2];
#pragma unroll
                for (int half = 0; half < 2; ++half)
#pragma unroll
                    for (int kk = 0; kk < 4; ++kk) bfg[half][kk] = *(const bf16x8*)(TB_ + SB_BS + off256((2 * kk2 + half) * 16 + fr, kk * 32 + fq * 8));
                bf16x8 xf[4];
#pragma unroll
                for (int pb = 0; pb < 4; ++pb) xf[pb] = tr_frag<0>(XSp, 32 * kk2 + 4 * fq, 32 * kk2 + 16 + 4 * fq, pb * 16, lane);
                __builtin_amdgcn_sched_barrier(0);
                gg[0] = (f32x4){0.f, 0.f, 0.f, 0.f}; gg[1] = (f32x4){0.f, 0.f, 0.f, 0.f};
#pragma unroll
                for (int kk = 0; kk < 4; ++kk)
#pragma unroll
                    for (int half = 0; half < 2; ++half) gg[half] = __builtin_amdgcn_mfma_f32_16x16x32_bf16(bfg[half][kk], cf[kk], gg[half], 0, 0, 0);
#pragma unroll
                for (int half = 0; half < 2; ++half) {
                    const int sb = 2 * kk2 + half;
                    const f32x4 gacc = gg[half];
                    const f32x4 css = *(const f32x4*)(sm_cs + sb * 16 + fq * 4);
                    const f32x4 dts = *(const f32x4*)(sm_dt + sb * 16 + fq * 4);
                    float v[4];
#pragma unroll
                    for (int r = 0; r < 4; ++r) {
                        const int si = sb * 16 + fq * 4 + r, l = w * 16 + fr;
                        const bool valid = dir == 0 ? (si <= l) : (si >= l);
                        v[r] = valid ? gacc[r] * __expf(csl - css[r]) * dts[r] : 0.f;
                    }
                    m[half * 2 + 0] = pk2(v[0], v[1]); m[half * 2 + 1] = pk2(v[2], v[3]);
                }
                union { unsigned u[4]; bf16x8 v; } mf; mf.u[0] = m[0]; mf.u[1] = m[1]; mf.u[2] = m[2]; mf.u[3] = m[3];
#pragma unroll
                for (int pb = 0; pb < 4; ++pb) yacc[pb] = __builtin_amdgcn_mfma_f32_16x16x32_bf16(xf[pb], mf.v, yacc[pb], 0, 0, 0);
            }
        }
        {
            const int l = w * 16 + fr;
            if (dir == 0) {
#pragma unroll
                for (int pb = 0; pb < 4; ++pb) {
                    const int p0 = pb * 16 + fq * 4;
                    u32x2 v; v.x = pk2(yacc[pb][0], yacc[pb][1]); v.y = pk2(yacc[pb][2], yacc[pb][3]);
                    *(u32x2*)(YTMP + (size_t)tok * DI + h * 64 + p0) = v;
                }
            } else {
                float ss = 0.f;
#pragma unroll
                for (int pb = 0; pb < 4; ++pb) {
                    const int p0 = pb * 16 + fq * 4;
                    const u32x2 xx = *(const u32x2*)(XSp + offX(l, p0));
                    const f32x4 nw = nwv[pb];
                    float y[4];
                    y[0] = yacc[pb][0] + bflo(yt[pb].x) + Dh * bflo(xx.x); y[1] = yacc[pb][1] + bfhi(yt[pb].x) + Dh * bfhi(xx.x);
                    y[2] = yacc[pb][2] + bflo(yt[pb].y) + Dh * bflo(xx.y); y[3] = yacc[pb][3] + bfhi(yt[pb].y) + Dh * bfhi(xx.y);
                    y[0] *= silu_f(bflo(zz[pb].x)); y[1] *= silu_f(bfhi(zz[pb].x)); y[2] *= silu_f(bflo(zz[pb].y)); y[3] *= silu_f(bfhi(zz[pb].y));
                    ss += y[0] * y[0] + y[1] * y[1] + y[2] * y[2] + y[3] * y[3];
                    u32x2 v; v.x = pk2(y[0] * nw[0], y[1] * nw[1]); v.y = pk2(y[2] * nw[2], y[3] * nw[3]);
                    *(u32x2*)(YG + (size_t)tok * DI + h * 64 + p0) = v;
                }
                ss += __shfl_xor(ss, 16); ss += __shfl_xor(ss, 32);
                if (fq == 0) SSQ[(size_t)tok * NH + h] = ss;
            }
        }
        }
        __syncthreads();
        if (active) {
            const float et = __expf(tot);
#pragma unroll
            for (int pb = 0; pb < 4; ++pb)
#pragma unroll
                for (int nbi = 0; nbi < 2; ++nbi) S[pb][nbi] = S[pb][nbi] * et;
            bf16x8 bq[2][2], xa[2][4];
#pragma unroll
            for (int kk = 0; kk < 2; ++kk) {
#pragma unroll
                for (int nbi = 0; nbi < 2; ++nbi) bq[kk][nbi] = tr_frag<1>(TB_ + SB_BS, kk * 32 + fq * 8, kk * 32 + fq * 8 + 4, (2 * w + nbi) * 16, lane);
#pragma unroll
                for (int pb = 0; pb < 4; ++pb) xa[kk][pb] = tr_frag<2>(XWp, kk * 32 + fq * 8, kk * 32 + fq * 8 + 4, pb * 16, lane);
            }
            __builtin_amdgcn_sched_barrier(0);
#pragma unroll
            for (int kk = 0; kk < 2; ++kk)
#pragma unroll
                for (int pb = 0; pb < 4; ++pb)
#pragma unroll
                    for (int nbi = 0; nbi < 2; ++nbi) S[pb][nbi] = __builtin_amdgcn_mfma_f32_16x16x32_bf16(xa[kk][pb], bq[kk][nbi], S[pb][nbi], 0, 0, 0);
#pragma unroll
            for (int pb = 0; pb < 4; ++pb)
#pragma unroll
                for (int nbi = 0; nbi < 2; ++nbi) {
                    const int n = (2 * w + nbi) * 16 + fr, p0 = pb * 16 + fq * 4;
                    u32x2 v; v.x = pk2(S[pb][nbi][0], S[pb][nbi][1]); v.y = pk2(S[pb][nbi][2], S[pb][nbi][3]);
                    *(u32x2*)(HTp + offP(n, p0)) = v;
                }
        }
        if (active && !is_lat && cur.ci == cur.nch - 1) {
            float* op = a.out + (size_t)NTOK * D + ((size_t)((cur.seq * 2 + j) * 2 + dir) * NH + h) * 8192;
#pragma unroll
            for (int pb = 0; pb < 4; ++pb)
#pragma unroll
                for (int nbi = 0; nbi < 2; ++nbi) {
                    const int n = (2 * w + nbi) * 16 + fr, p0 = pb * 16 + fq * 4;
#pragma unroll
                    for (int r = 0; r < 4; ++r) op[(p0 + r) * 128 + n] = S[pb][nbi][r];
                }
        }
        if (w == 0 && nxt.valid && !(nxt.single && hw == 1)) scan_dtcs(c, nxt, hw, j, raw_n1, (float*)(lds + SCN_SM + ((b ^ 1) * 2 + hw) * 1024));
        raw_n1 = raw_n2;
        cur = nxt; nxt = nx2; it.advance(); it.get(nx2);
    }
}

#if NAIVE_SCAN
__device__ __forceinline__ void scan_unit_naive(const Ctx& c, int j, int seq, int h) {
    const Args __attribute__((address_space(4)))& a = *c.a;
    const bf16_t* XBC = (const bf16_t*)(a.ws + S_XBC);
    const bf16_t* Z = (const bf16_t*)(a.ws + S_Z);
    const float* DT = (const float*)(a.ws + S_DT);
    bf16_t* YTMP = (bf16_t*)(a.ws + S_RAW);
    bf16_t* YG = (bf16_t*)(a.ws + S_YG);
    float* SSQ = (float*)(a.ws + S_SSQ);
    const bool is_lat = seq >= 32;
    const int tok0 = is_lat ? NCTX + (seq - 32) * 1024 : seq * 256;
    const int L = is_lat ? 1024 : 256;
    const int g = h >> 3, p = c.tid >> 2, nq = (c.tid & 3) * 32;
    const float Dh = a.in[14][j * NH + h];
    const float nw = a.in[15][(size_t)j * DI + h * 64 + p];
    float* red = (float*)c.lds;
    for (int dir = 0; dir < 2; ++dir) {
        const float Aneg = -__expf(a.in[13][(j * 2 + dir) * NH + h]);
        const float dtb = a.in[12][(j * 2 + dir) * NH + h];
        float hs[32];
        if (is_lat) { const float* sp = a.in[2] + ((size_t)(((seq - 32) * 2 + j) * 2 + dir) * NH + h) * 8192 + p * 128 + nq;
#pragma unroll
            for (int e = 0; e < 32; ++e) hs[e] = sp[e]; }
        else {
#pragma unroll
            for (int e = 0; e < 32; ++e) hs[e] = 0.f; }
        asm volatile("s_waitcnt vmcnt(0)" ::: "memory"); __syncthreads();
        for (int ti = 0; ti < L; ++ti) {
            const int tok = tok0 + (dir == 0 ? ti : L - 1 - ti);
            const float raw = DT[(size_t)tok * 64 + dir * NH + h] + dtb;
            const float dt = raw > 20.f ? raw : log1pf(__expf(raw));
            const float dec = __expf(dt * Aneg);
            const float xv = bflo((unsigned)XBC[(size_t)tok * DXBC + h * 64 + p]);
            const bf16_t* Bp = XBC + (size_t)tok * DXBC + DI + g * 128 + nq;
            const bf16_t* Cp = XBC + (size_t)tok * DXBC + DI + 512 + g * 128 + nq;
            float y = 0.f;
#pragma unroll
            for (int e = 0; e < 32; ++e) { hs[e] = hs[e] * dec + dt * xv * bflo((unsigned)Bp[e]); y += bflo((unsigned)Cp[e]) * hs[e]; }
            y += __shfl_xor(y, 1); y += __shfl_xor(y, 2);
            if (dir == 0) { if ((c.tid & 3) == 0) YTMP[(size_t)tok * DI + h * 64 + p] = (bf16_t)(pk2(y, 0.f) & 0xffff); }
            else {
                const float yt = bflo((unsigned)YTMP[(size_t)tok * DI + h * 64 + p]);
                const float zz = bflo((unsigned)Z[(size_t)tok * DI + h * 64 + p]);
                float yy = (y + yt + Dh * xv) * silu_f(zz);
                __syncthreads();
                if ((c.tid & 3) == 0) { red[p] = yy * yy; YG[(size_t)tok * DI + h * 64 + p] = (bf16_t)(pk2(yy * nw, 0.f) & 0xffff); }
                __syncthreads();
                if (c.tid == 0) { float s = 0.f; for (int e = 0; e < 64; ++e) s += red[e]; SSQ[(size_t)tok * NH + h] = s; }
            }
        }
        if (!is_lat) { float* op = a.out + (size_t)NTOK * D + ((size_t)((seq * 2 + j) * 2 + dir) * NH + h) * 8192 + p * 128 + nq;
#pragma unroll
            for (int e = 0; e < 32; ++e) op[e] = hs[e]; }
    }
}
#endif
__device__ __forceinline__ void phase_scan(const Ctx& c, int j) {
#if NAIVE_SCAN
    for (int u = c.vb; u < 1088; u += c.G) { if (u < 64) scan_unit_naive(c, j, 32 + (u >> 5), u & 31); else scan_unit_naive(c, j, (u - 64) >> 5, (u - 64) & 31); }
    return;
#endif
    phase_scan_pipe(c, j);
}

typedef const Args __attribute__((address_space(4)))* ArgsP;
#if 0
#define LB_WAVES 1
#else
#define LB_WAVES 2
#endif
__global__ void __launch_bounds__(NTHR, LB_WAVES) fwd_kernel(Args args) {
    extern __shared__ __attribute__((aligned(16))) char lds[];
    volatile LAS unsigned* st = (volatile LAS unsigned*)(lds + LDS_BYTES - 16);
    if (threadIdx.x == 0) { st[0] = 0u; st[1] = 0u; }
    __syncthreads();
    const int ph_lo = args.ph_lo, ph_hi = args.ph_hi;
    const bool multi = (ph_hi - ph_lo) > 1;
    XcdBarrier bar; bar.bar = (unsigned*)(args.ws + WS_CTL); bar.x = 0; bar.st = st;
    if (multi) bar = xcd_barrier_post((unsigned*)(args.ws + WS_CTL), st);

    int rep = 0;
#pragma unroll 1
    for (int ph = ph_lo; ph < ph_hi; ++ph) {
        ArgsP ap = (ArgsP)__builtin_amdgcn_kernarg_segment_ptr();
        asm volatile("" : "+s"(ap));
        int tid = threadIdx.x;
        asm volatile("" : "+v"(tid));
        Ctx c;
        c.lds = lds; c.tid = tid; c.lane = tid & 63; c.wid = __builtin_amdgcn_readfirstlane(tid >> 6);
        c.G = gridDim.x; c.vb = (c.G % 8 == 0) ? (int)(blockIdx.x % 8) * (c.G / 8) + (int)(blockIdx.x / 8) : (int)blockIdx.x;
        c.a = ap;
        unsigned char* ws = ap->ws;
        const float* MOD = (const float*)(ws + WS_MOD);

        int kind = 0;
        if (ph == 0) { if (PH_ON(0)) phase_prep(c); }
        else if (ph == 1) { kind = 12; phase_prep2(c); }
        else if (ph == NPHASE - 1) { kind = 10; if (PH_ON(1)) phase_norm(c, ap->in[21], nullptr, 0, 0, true); }
        else {
            int layer, sub;
            if (ph <= 7) { layer = 0; sub = ph - 2; } else if (ph <= 12) { layer = 1; sub = ph - 8; } else if (ph <= 18) { layer = 2; sub = ph - 13; } else { layer = 3; sub = ph - 19; }
            const int j = layer >> 1;
            const float* mod = MOD + (size_t)layer * 3 * 6144;
            const bool ssd = (layer & 1) == 0;
            const int nmix = ssd ? 4 : 3;
            if (sub < nmix - 1) kind = ssd ? (sub == 0 ? 2 : sub == 1 ? 3 : 4) : (sub == 0 ? 6 : 7);
            else if (sub == nmix) kind = 8;
            else kind = 5;

            if (kind == 2) { if (PH_ON(2)) phase_inproj(c, j); }
            else if (kind == 3) { if (PH_ON(3)) phase_conv(c, j); }
            else if (kind == 4) { if (PH_ON(4)) phase_scan(c, j); }
            else if (kind == 6) { if (PH_ON(6)) phase_f1(c, j); }
            else if (kind == 7) { if (PH_ON(7)) phase_f2(c); }
            else if (kind == 8) { if (PH_ON(8)) phase_mlp_up(c, layer); }
            else {
                if (PH_ON(5)) {
                    const bf16_t* WT; const bf16_t* Act; int K; const float* gate; const float* bias = nullptr; const float* ssq = nullptr;
                    const float* nw_next; const float* scale_next;
                    if (sub == nmix - 1) {
                        gate = mod + 2048; nw_next = ap->in[8] + layer * D; scale_next = mod + 4096;
                        if (ssd) { WT = (const bf16_t*)(ws + WS_WOUT) + (size_t)j * D * DI; Act = (const bf16_t*)(ws + S_YG); K = DI; ssq = (const float*)(ws + S_SSQ); }
                        else { WT = (const bf16_t*)(ws + WS_WFNO) + (size_t)j * D * D; Act = (const bf16_t*)(ws + S_F); K = D; bias = ap->in[18] + j * D; }
                    } else {
                        gate = mod + 5120; WT = (const bf16_t*)(ws + WS_W2) + (size_t)layer * D * DFF; Act = (const bf16_t*)(ws + S_HID); K = DFF;
                        if (layer < 3) { nw_next = ap->in[7] + (layer + 1) * D; scale_next = mod + 3 * 6144 + 1024; } else { nw_next = nullptr; scale_next = nullptr; }
                    }
                    if (rep > 0) { gate = (const float*)(ws + WS_ZERO); }
                    phase_resid_gemm(c, WT, Act, K, gate, bias, ssq, nw_next, scale_next, layer == 0 && sub == nmix - 1 && rep == 0);
                }
            }
        }
        if (REP_KIND == 9) { for (int r = 0; r < REP_N; ++r) if (multi) xcd_barrier(bar); }
        if (REP_N > 0 && kind == REP_KIND && rep < REP_N) { ++rep; --ph; if (multi) xcd_barrier(bar); continue; }
        rep = 0;
        if (REP_KIND == 11 && ph == NPHASE - 1) { for (int r = 0; r < REP_N; ++r) { if (multi) xcd_barrier(bar); phase_bench(c); } }
        if (ph + 1 < ph_hi) xcd_barrier(bar);
    }
}

extern "C" void kernel_launch(void* const* d_in, const int* in_sizes, int n_in, void* d_out, int out_size, void* d_ws, size_t ws_size, hipStream_t stream) {
    static int grid = 0;
    if (grid == 0) {
        int dev = 0, cus = 0;
        if (hipGetDevice(&dev) != hipSuccess || hipDeviceGetAttribute(&cus, hipDeviceAttributeMultiprocessorCount, dev) != hipSuccess || cus <= 0) { fprintf(stderr, "kernel_launch: device query failed\n"); grid = -1; return; }
        if (hipFuncSetAttribute((const void*)fwd_kernel, hipFuncAttributeMaxDynamicSharedMemorySize, LDS_BYTES) != hipSuccess) { fprintf(stderr, "kernel_launch: hipFuncSetAttribute failed\n"); }
        (void)hipGetLastError();
        if (ws_size < WS_END) fprintf(stderr, "kernel_launch: workspace too small: %zu < %zu\n", ws_size, (size_t)WS_END);
        grid = cus;
    }
    if (grid < 0) return;
    (void)hipMemsetAsync((char*)d_ws + WS_CTL, 0, CTL_BYTES, stream);
    Args a{};
    for (int i = 0; i < 22; ++i) a.in[i] = (const float*)d_in[i];
    a.out = (float*)d_out; a.ws = (unsigned char*)d_ws;
#if N_LAUNCH_MODE == 1
    a.ph_lo = 0; a.ph_hi = NPHASE;
    hipLaunchKernelGGL(fwd_kernel, dim3(grid), dim3(NTHR), LDS_BYTES, stream, a);
#else
    for (int ph = 0; ph < NPHASE; ++ph) {
        a.ph_lo = ph; a.ph_hi = ph + 1;
        hipLaunchKernelGGL(fwd_kernel, dim3(grid), dim3(NTHR), LDS_BYTES, stream, a);
    }
#endif
}
```

```cpp
#include <hip/hip_runtime.h>
#include <stdint.h>
#include <stdio.h>

#ifndef PH_MASK
#define PH_MASK 0xFFFF
#endif
#define PH_ON(k) ((PH_MASK >> (k)) & 1)
#ifndef NAIVE_GEMM
#define NAIVE_GEMM 0
#endif
#define GN(k) ((NAIVE_GEMM >> (k)) & 1)
#ifndef NAIVE_SCAN
#define NAIVE_SCAN 0
#endif
#ifndef REP_KIND
#define REP_KIND -1
#endif
#ifndef REP_N
#define REP_N 0
#endif
#ifndef GEMM_INTERLEAVE
#define GEMM_INTERLEAVE 0
#endif
#ifndef GEMM_SETPRIO
#define GEMM_SETPRIO 0
#endif
#ifndef N_LAUNCH_MODE
#define N_LAUNCH_MODE 1
#endif

typedef unsigned short bf16_t;
typedef short bf16x8 __attribute__((ext_vector_type(8)));
typedef short bf16x4 __attribute__((ext_vector_type(4)));
typedef float f32x4 __attribute__((ext_vector_type(4)));
typedef unsigned u32x4 __attribute__((ext_vector_type(4)));
typedef unsigned u32x2 __attribute__((ext_vector_type(2)));
#define LAS __attribute__((address_space(3)))

constexpr int D = 1024, NCTX = 8192, NLAT = 2048, NTOK = 10240;
constexpr int DI = 2048, DXBC = 3072, DPROJ = 5184, NZX = 5120, NH = 32, DFF = 4096;
constexpr float EPS = 1e-6f;
constexpr int NPHASE = 25;

constexpr size_t al256(size_t x) { return (x + 255) & ~(size_t)255; }
constexpr size_t WS_CTL  = 0;
constexpr size_t CTL_BYTES = 65536 + 81920;
constexpr size_t WS_ZERO = 65536;
constexpr size_t WS_MOD  = WS_CTL + CTL_BYTES;
constexpr size_t WS_SWIN = al256(WS_MOD + 4 * 3 * 6144 * 4);
constexpr size_t WS_SWUP = WS_SWIN + 2 * 3 * DPROJ * 4;
constexpr size_t WS_SWF1 = WS_SWUP + 4 * 3 * DFF * 4;
constexpr size_t WS_RSS  = al256(WS_SWF1 + 2 * 3 * 2048 * 4);
constexpr size_t WS_WIN  = al256(WS_RSS + (size_t)NTOK * 16 * 4);
constexpr size_t WS_WOUT = WS_WIN + (size_t)2 * DPROJ * D * 2;
constexpr size_t WS_WFNO = WS_WOUT + (size_t)2 * D * DI * 2;
constexpr size_t WS_W1   = WS_WFNO + (size_t)2 * D * D * 2;
constexpr size_t WS_W2   = WS_W1 + (size_t)4 * DFF * D * 2;
constexpr size_t WS_T1   = WS_W2 + (size_t)4 * DFF * D * 2;
constexpr size_t WS_T2C  = WS_T1 + (size_t)512 * 256 * 2;
constexpr size_t WS_T2L  = WS_T2C + (size_t)256 * 512 * 2;
constexpr size_t WS_H    = WS_T2L + (size_t)1024 * 2048 * 2;
constexpr size_t WS_S    = WS_H + (size_t)NTOK * D * 2;
constexpr size_t S_Z     = WS_S;
constexpr size_t S_XBC   = S_Z + (size_t)NTOK * DI * 2;
constexpr size_t S_DT    = S_XBC + (size_t)NTOK * DXBC * 2;
constexpr size_t S_SSQ   = S_DT + (size_t)NTOK * 64 * 4;
constexpr size_t S_YG    = S_SSQ + (size_t)NTOK * 32 * 4;
constexpr size_t S_RAW   = S_YG + (size_t)NTOK * DI * 2;
constexpr size_t WS_END  = S_RAW + (size_t)NTOK * DXBC * 2;
constexpr size_t S_HID   = WS_S;
constexpr size_t S_UVT   = WS_S;
constexpr size_t S_F     = WS_S + (size_t)NTOK * 2048 * 2;

constexpr int LDS_BYTES = 163840;
constexpr int NTHR = 512, NWAVE = 8;

typedef __bf16 bf16x2_t __attribute__((ext_vector_type(2)));
typedef float f32x2_t __attribute__((ext_vector_type(2)));
__device__ __forceinline__ unsigned pk2(float lo, float hi) { const f32x2_t f = {lo, hi}; return __builtin_bit_cast(unsigned, __builtin_convertvector(f, bf16x2_t)); }
__device__ __forceinline__ float bflo(unsigned u) { return __uint_as_float(u << 16); }
__device__ __forceinline__ float bfhi(unsigned u) { return __uint_as_float(u & 0xffff0000u); }
__device__ __forceinline__ float wave_sum(float v) {
#pragma unroll
    for (int o = 1; o < 64; o <<= 1) v += __shfl_xor(v, o);
    return v;
}
__device__ __forceinline__ float silu_f(float x) { return x * __builtin_amdgcn_rcpf(1.0f + __expf(-x)); }
__device__ __forceinline__ int cond_of(int tok) { return tok < NCTX ? 0 : (tok < NCTX + 1024 ? 1 : 2); }

#define XB_TMO      128
#define XB_XCNT(j)  (256  + 64 * (j))
#define XB_XSUB(j)  (1280 + 64 * (j))
#define XB_XGEN(j)  (2304 + 64 * (j))
#define XB_TOP      3328
#define XB_TOPGEN   3392
#define XCD_BAR_WORDS 3456
#define XB_SPIN_CAP (1u << 20)
__device__ __forceinline__ unsigned xb_ld(unsigned* p)              { return __hip_atomic_load(p, __ATOMIC_RELAXED, __HIP_MEMORY_SCOPE_AGENT); }
__device__ __forceinline__ unsigned xb_add(unsigned* p, unsigned v) { return __hip_atomic_fetch_add(p, v, __ATOMIC_RELAXED, __HIP_MEMORY_SCOPE_AGENT); }
__device__ __forceinline__ unsigned xb_xcc_id() { return (unsigned)__builtin_amdgcn_s_getreg((3 << 11) | 20) & 0xFu; }
#define XB_SPIN(cond, bar) do { unsigned _sp = 0; while (cond) { __builtin_amdgcn_s_sleep(1); \
    if ((++_sp & 255u) == 0u) { if (xb_ld(&(bar)[XB_TMO])) break; if (_sp > XB_SPIN_CAP) { atomicAdd(&(bar)[XB_TMO], 1u); break; } } } } while (0)
struct XcdBarrier { unsigned* bar; unsigned x; volatile LAS unsigned* st; };
__device__ __forceinline__ XcdBarrier xcd_barrier_post(unsigned* bar, volatile LAS unsigned* st) {
    XcdBarrier b; b.bar = bar; b.x = xb_xcc_id(); b.st = st;
    if (threadIdx.x == 0) (void)xb_add(&bar[XB_XCNT(b.x)], 1u);
    return b;
}
__device__ __forceinline__ void xcd_barrier_complete(unsigned* bar, unsigned x, unsigned& nloc, unsigned& nx) {
    const unsigned G = gridDim.x * gridDim.y * gridDim.z;
    unsigned sum, cnt, mine, sp = 0u;
    for (;;) {
        sum = 0u; cnt = 0u; mine = 0u;
#pragma unroll
        for (unsigned j = 0; j < 16; ++j) { const unsigned c = xb_ld(&bar[XB_XCNT(j)]); sum += c; cnt += (c > 0u) ? 1u : 0u; mine = (j == x) ? c : mine; }
        if (sum == G) break;
        __builtin_amdgcn_s_sleep(1);
        if ((++sp & 255u) == 0u) { if (xb_ld(&bar[XB_TMO])) break; if (sp > XB_SPIN_CAP) { atomicAdd(&bar[XB_TMO], 1u); break; } }
    }
    nloc = mine > 0u ? mine : 1u; nx = cnt > 0u ? cnt : 1u;
}
__device__ __forceinline__ void xcd_barrier(const XcdBarrier& b) {
    asm volatile("s_waitcnt vmcnt(0)" ::: "memory");
    __syncthreads();
    if (threadIdx.x == 0) {
        unsigned* bar = b.bar;
        __builtin_amdgcn_s_waitcnt(0);
        unsigned nloc = b.st[0], nx = b.st[1];
        if (nloc == 0u) { xcd_barrier_complete(bar, b.x, nloc, nx); b.st[0] = nloc; b.st[1] = nx; }
        const unsigned old = xb_add(&bar[XB_XSUB(b.x)], 1u);
        const unsigned gen = old / nloc;
        if (old + 1u == (gen + 1u) * nloc) {
            __builtin_amdgcn_fence(__ATOMIC_RELEASE, "agent");
            asm volatile("s_waitcnt vmcnt(0)" ::: "memory");
            const unsigned og = xb_add(&bar[XB_TOP], 1u);
            const unsigned tg = og / nx;
            if (og + 1u == (tg + 1u) * nx) xb_add(&bar[XB_TOPGEN], 1u);
            else XB_SPIN(xb_ld(&bar[XB_TOPGEN]) == tg, bar);
            __builtin_amdgcn_fence(__ATOMIC_ACQUIRE, "agent");
            xb_add(&bar[XB_XGEN(b.x)], 1u);
            asm volatile("s_waitcnt vmcnt(0)" ::: "memory");
        } else {
            XB_SPIN(xb_ld(&bar[XB_XGEN(b.x)]) == gen, bar);
            __builtin_amdgcn_fence(__ATOMIC_ACQUIRE, "agent");
            asm volatile("s_waitcnt vmcnt(0)" ::: "memory");
        }
    }
    __syncthreads();
}

struct Args {
    const float* in[22];
    float* out;
    unsigned char* ws;
    int ph_lo, ph_hi;
};

struct Ctx {
    char* lds;
    int tid, lane, wid;
    int vb, G;
    const Args __attribute__((address_space(4)))* a;
};

template <int TB> struct GT { static constexpr int ROWS = 256 + 32 * TB, STAGE = ROWS * 128, NI = ROWS / 8; };

template <int TB>
__device__ __forceinline__ void gemm_stage(char* st, const bf16_t* Ag, int lda, const bf16_t* Bg, int ldb, int k0, int wid, int lane) {
    constexpr int NI = GT<TB>::NI;
    const int rsub = lane >> 3, lch = (lane & 7) ^ rsub;
#pragma unroll
    for (int i = 0; i < (NI + 7) / 8; ++i) {
        const int q = wid + 8 * i;
        if (q < NI) {
            const int row = q * 8 + rsub;
            const bf16_t* src = (q < 32) ? (Ag + (size_t)row * lda + k0 + lch * 8) : (Bg + (size_t)(row - 256) * ldb + k0 + lch * 8);
            __builtin_amdgcn_global_load_lds((const unsigned*)src, (LAS unsigned*)(st + q * 1024 + lane * 16), 16, 0, 0);
        }
    }
}
__device__ __forceinline__ bf16x8 frag128(const char* tile, int row, int chunk) {
    return *(const bf16x8*)(tile + row * 128 + ((chunk ^ (row & 7)) << 4));
}

struct NoPre { __device__ __forceinline__ void operator()() const {} };
template <int TB, bool NAIVE, class Epi, class Pre = NoPre>
__device__ __forceinline__ void gemm_tile(const Ctx& c, const bf16_t* Ag, int lda, const bf16_t* Bg, int ldb, int K, int a0, int b0, const Epi& epi, const Pre& pre = Pre(),
                                          bool prefetched = false, const bf16_t* An = nullptr, const bf16_t* Bn = nullptr) {
    constexpr int STAGE = GT<TB>::STAGE;
    const int wr = c.wid >> 1, wc = c.wid & 1, fr = c.lane & 15, fq = c.lane >> 4;
    f32x4 acc[4][TB];
#pragma unroll
    for (int i = 0; i < 4; ++i)
#pragma unroll
        for (int j = 0; j < TB; ++j) acc[i][j] = (f32x4){0.f, 0.f, 0.f, 0.f};
    if (NAIVE) {
        __syncthreads(); pre(); __syncthreads();
        const bf16_t* ar = Ag + (size_t)(wr * 64 + fq * 4) * lda;
        const bf16_t* br = Bg + (size_t)(wc * 16 * TB + fr) * ldb;
#pragma unroll
        for (int j = 0; j < TB; ++j) {
#pragma unroll 1
            for (int k = 0; k < K; k += 8) {
                float bv[8];
                { const u32x4 v = *(const u32x4*)(br + (size_t)(j * 16) * ldb + k);
#pragma unroll
                  for (int e = 0; e < 4; ++e) { bv[2 * e] = bflo(v[e]); bv[2 * e + 1] = bfhi(v[e]); } }
#pragma unroll
                for (int i = 0; i < 4; ++i)
#pragma unroll
                    for (int r = 0; r < 4; ++r) {
                        const u32x4 v = *(const u32x4*)(ar + (size_t)(i * 16 + r) * lda + k);
#pragma unroll
                        for (int e = 0; e < 4; ++e) acc[i][j][r] += bflo(v[e]) * bv[2 * e] + bfhi(v[e]) * bv[2 * e + 1];
                    }
                asm volatile("" ::: "memory");
            }
        }
        epi(acc, a0 + wr * 64, b0 + wc * (16 * TB), fr, fq);
        return;
    }
    const int nt = K >> 6;
    __syncthreads();
    if (!prefetched) gemm_stage<TB>(c.lds, Ag, lda, Bg, ldb, 0, c.wid, c.lane);
    pre();
    for (int t = 0; t < nt; ++t) {
        asm volatile("s_waitcnt vmcnt(0)" ::: "memory");
        __syncthreads();
        const char* cur = c.lds + (t & 1) * STAGE;
        if (t + 1 < nt) gemm_stage<TB>(c.lds + ((t + 1) & 1) * STAGE, Ag, lda, Bg, ldb, (t + 1) << 6, c.wid, c.lane);
        else if (An) gemm_stage<TB>(c.lds, An, lda, Bn, ldb, 0, c.wid, c.lane);
#pragma unroll
        for (int kk = 0; kk < 2; ++kk) {
            bf16x8 af[4], bfr[TB];
#pragma unroll
            for (int i = 0; i < 4; ++i) af[i] = frag128(cur, wr * 64 + i * 16 + fr, kk * 4 + fq);
#pragma unroll
            for (int j = 0; j < TB; ++j) bfr[j] = frag128(cur, 256 + wc * (16 * TB) + j * 16 + fr, kk * 4 + fq);
#pragma unroll
            for (int i = 0; i < 4; ++i)
#pragma unroll
                for (int j = 0; j < TB; ++j) acc[i][j] = __builtin_amdgcn_mfma_f32_16x16x32_bf16(af[i], bfr[j], acc[i][j], 0, 0, 0);
        }
    }
    epi(acc, a0 + wr * 64, b0 + wc * (16 * TB), fr, fq);
}

template <int TB, class Prob, int BENCH = 0>
__device__ __forceinline__ void gemm_stream(const Ctx& c, const Prob& P) {
    constexpr int STAGE = GT<TB>::STAGE, NI = GT<TB>::NI;
    constexpr int NSLOT = (NI + 7) / 8;
    const int wr = c.wid >> 1, wc = c.wid & 1, fr = c.lane & 15, fq = c.lane >> 4;
    const int n = P.count();
    if (n <= 0) return;
    f32x4 acc[4][TB];
#pragma unroll
    for (int i = 0; i < 4; ++i)
#pragma unroll
        for (int j = 0; j < TB; ++j) acc[i][j] = (f32x4){0.f, 0.f, 0.f, 0.f};
    const int KT = P.K >> 6;
    const int total = n * KT;
    const int rsub = c.lane >> 3, lch = (c.lane & 7) ^ rsub;
    int voff[NSLOT], qs[NSLOT];
#pragma unroll
    for (int s = 0; s < NSLOT; ++s) {
        const int q = (c.wid + 8 * s < NI) ? c.wid + 8 * s : NI - 1;
        qs[s] = q;
        voff[s] = (s < 4) ? ((q * 8 + rsub) * P.lda + lch * 8) : ((q * 8 + rsub - 256) * P.ldb + lch * 8);
    }
    const bf16_t* Acur; const bf16_t* Bcur;
    int li = 0, lk = 0;
    P.tile(0, Acur, Bcur);
    constexpr int Q0 = (NSLOT + 3) / 4, Q1 = Q0 + (NSLOT + 2) / 4, Q2 = Q1 + (NSLOT + 1) / 4;
    constexpr int S1 = Q1;
    auto issue_part = [&](int stage, int s0, int s1) {
        char* st = c.lds + stage * STAGE;
#pragma unroll
        for (int s = 0; s < NSLOT; ++s) {
            if (s >= s0 && s < s1) {
                const bf16_t* src = ((s < 4) ? Acur : Bcur) + voff[s] + lk * 64;
                __builtin_amdgcn_global_load_lds((const unsigned*)src, (LAS unsigned*)(st + qs[s] * 1024 + c.lane * 16), 16, 0, 0);
            }
        }
    };
    auto issue = [&](int stage) { issue_part(stage, 0, NSLOT); };
    auto advance = [&]() { if (++lk == KT) { lk = 0; if (li + 1 < n) { ++li; P.tile(li, Acur, Bcur); } } };
    asm volatile("s_waitcnt vmcnt(0)" ::: "memory");
    __builtin_amdgcn_s_barrier();
    asm volatile("" ::: "memory");
    issue(0); advance(); issue(1); advance();
    P.pre_all();
    int ci = 0, ck = 0, stg = 0;
#define GEMM_WAIT_ONE_STAGE() do { if (BENCH == 1) { asm volatile("s_waitcnt vmcnt(0)" ::: "memory"); } \
        else if (after_epi) { asm volatile("s_waitcnt vmcnt(%0)" :: "n"(S1 + Prob::EPI_STORES) : "memory"); } \
        else { asm volatile("s_waitcnt vmcnt(%0)" :: "n"(S1) : "memory"); } } while (0)
    bool after_epi = false;
#define GEMM_BAR() do { asm volatile("" ::: "memory"); __builtin_amdgcn_s_barrier(); asm volatile("" ::: "memory"); } while (0)
#define GEMM_LOADF(dst, stage_ptr, kk) do { \
        _Pragma("unroll") for (int i = 0; i < 4; ++i) dst.a[i] = frag128(stage_ptr, wr * 64 + i * 16 + fr, (kk) * 4 + fq); \
        _Pragma("unroll") for (int jj = 0; jj < TB; ++jj) dst.b[jj] = frag128(stage_ptr, 256 + wc * (16 * TB) + jj * 16 + fr, (kk) * 4 + fq); } while (0)
#define GEMM_MMA(src_) do { \
        _Pragma("unroll") for (int i = 0; i < 4; ++i) \
        _Pragma("unroll") for (int jj = 0; jj < TB; ++jj) acc[i][jj] = __builtin_amdgcn_mfma_f32_16x16x32_bf16(src_.a[i], src_.b[jj], acc[i][jj], 0, 0, 0); } while (0)
    struct Frags { bf16x8 a[4]; bf16x8 b[TB]; };
    Frags f0, f1;
    if (BENCH == 1) { asm volatile("s_waitcnt vmcnt(0)" ::: "memory"); } else { asm volatile("s_waitcnt vmcnt(%0)" :: "n"(NSLOT) : "memory"); }
    GEMM_BAR();
    GEMM_LOADF(f0, c.lds, 0);
    f32x4 sw[4];
#pragma unroll
    for (int i = 0; i < 4; ++i) sw[i] = (f32x4){0.f, 0.f, 0.f, 0.f};
#pragma unroll 1
    for (int gs = 0; gs < total; ++gs) {
        const char* cur = c.lds + stg * STAGE;
        const int nst1 = stg == 2 ? 0 : stg + 1;
        if (ck == KT - 1) P.preload(ci, sw, wr, fq);
        if (BENCH != 2) GEMM_LOADF(f1, cur, 1);
        const int nst2 = stg == 0 ? 2 : stg - 1;
        if (BENCH != 1) issue_part(nst2, 0, Q0);
        if (BENCH != 2) GEMM_MMA(f0);
#if GEMM_INTERLEAVE
        __builtin_amdgcn_sched_group_barrier(0x100, 4 + TB, 0);
#pragma unroll
        for (int s = 0; s < NSLOT; ++s) {
            __builtin_amdgcn_sched_group_barrier(0x008, 2, 0);
            __builtin_amdgcn_sched_group_barrier(0x006, 6, 0);
            __builtin_amdgcn_sched_group_barrier(0x010, 1, 0);
        }
        __builtin_amdgcn_sched_group_barrier(0x008, 4 * TB - 2 * NSLOT, 0);
#endif
        if (BENCH != 1) issue_part(nst2, Q0, Q1);
        GEMM_WAIT_ONE_STAGE();
        after_epi = false;
        asm volatile("s_waitcnt lgkmcnt(0)" ::: "memory");
        GEMM_BAR();
        if (BENCH != 1) issue_part(nst2, Q1, Q2);
        if (BENCH != 2) GEMM_LOADF(f0, c.lds + nst1 * STAGE, 0);
#if GEMM_SETPRIO
        __builtin_amdgcn_s_setprio(1);
#endif
        if (BENCH != 2) GEMM_MMA(f1);
#if GEMM_SETPRIO
        __builtin_amdgcn_s_setprio(0);
#endif
        if (BENCH != 1) issue_part(nst2, Q2, NSLOT);
        stg = nst1;
        advance();
        if (++ck == KT) {
            P.epilogue(ci, acc, sw, wr, wc, fr, fq);
#pragma unroll
            for (int i = 0; i < 4; ++i)
#pragma unroll
                for (int j = 0; j < TB; ++j) acc[i][j] = (f32x4){0.f, 0.f, 0.f, 0.f};
            ck = 0; ++ci;
            after_epi = true;
        }
    }
    asm volatile("s_waitcnt vmcnt(0)" ::: "memory");
    GEMM_BAR();
#undef GEMM_WAIT_ONE_STAGE
#undef GEMM_BAR
#undef GEMM_LOADF
#undef GEMM_MMA
}

__device__ __forceinline__ u32x4 pair16(const u32x2& a, const u32x2& b) {
    const auto sx = __builtin_amdgcn_permlane16_swap(a.x, b.x, false, false);
    const auto sy = __builtin_amdgcn_permlane16_swap(a.y, b.y, false, false);
    return (u32x4){sx[0], sy[0], sx[1], sy[1]};
}
struct EpiInProj {
    bf16_t* Z; bf16_t* RAW; const float* rsx  ; int tok_base; const float* SW  ; bool uni  ;
    __device__ __forceinline__ void operator()(f32x4 (&acc)[4][5], const f32x4 (&swp)[4], int ab, int bb, int fr, int fq) const {
#pragma unroll
        for (int j = 0; j < 5; ++j) {
            const int tok = bb + j * 16 + fr;
            const float rs = rsx[tok - tok_base];
            const float* sw = SW + cond_of(tok) * DPROJ;
            u32x2 v[4];
#pragma unroll
            for (int i = 0; i < 4; ++i) {
                const int n = ab + i * 16 + fq * 4;
                const f32x4 o = acc[i][j] * rs + (uni ? swp[i] : *(const f32x4*)(sw + n));
                v[i].x = pk2(o[0], o[1]); v[i].y = pk2(o[2], o[3]);
            }
#pragma unroll
            for (int p = 0; p < 2; ++p) {
                const u32x4 o = pair16(v[2 * p], v[2 * p + 1]);
                const int n = ab + (2 * p + (fq & 1)) * 16 + (fq & 2) * 4;
                bf16_t* dst = (n < DI) ? (Z + (size_t)tok * DI + n) : (RAW + (size_t)tok * DXBC + (n - DI));
                *(u32x4*)dst = o;
            }
        }
    }
};
struct EpiResid {
    float* X; const float* gate  ; const float* bias; const float* rs_lds  ; int tok_base;
    const float* Xin0; const float* Xin1;
    bf16_t* XG  ; const float* nw_next; const float* scale_next  ; float* RSS;
    __device__ __forceinline__ void operator()(f32x4 (&acc)[4][5], int ab, int bb, int fr, int fq) const {
        const int slot = (ab >> 6);
#pragma unroll
        for (int j = 0; j < 5; ++j) {
            const int tok = bb + j * 16 + fr;
            const float rs = rs_lds ? rs_lds[tok - tok_base] : 1.0f;
            const int cd = cond_of(tok);
            const float* g = gate + cd * 6144;
            float ss = 0.f;
#pragma unroll
            for (int i = 0; i < 4; ++i) {
                const int n = ab + i * 16 + fq * 4;
                const f32x4 gv = *(const f32x4*)(g + n);
                f32x4 bv = (f32x4){0.f, 0.f, 0.f, 0.f};
                if (bias) bv = *(const f32x4*)(bias + n);
                f32x4* xp = (f32x4*)(X + (size_t)tok * D + n);
                f32x4 xv = Xin0 ? *(const f32x4*)((tok < NCTX ? Xin0 + (size_t)tok * D : Xin1 + (size_t)(tok - NCTX) * D) + n) : *xp;
                xv = xv + gv * (acc[i][j] * rs + bv);
                *xp = xv;
                if (XG) {
                    ss += xv[0] * xv[0] + xv[1] * xv[1] + xv[2] * xv[2] + xv[3] * xv[3];
                    const f32x4 gn = *(const f32x4*)(nw_next + n) * (*(const f32x4*)(scale_next + cd * 6144 + n) + 1.0f);
                    const f32x4 o = xv * gn;
                    u32x2 v; v.x = pk2(o[0], o[1]); v.y = pk2(o[2], o[3]);
                    *(u32x2*)(XG + (size_t)tok * D + n) = v;
                }
            }
            if (XG) {
                ss += __shfl_xor(ss, 16); ss += __shfl_xor(ss, 32);
                if (fq == 0) RSS[(size_t)tok * 16 + slot] = ss;
            }
        }
    }
};
struct EpiMlpUp {
    bf16_t* HID; const float* rsx; int tok_base; const float* SW  ; bool uni;
    __device__ __forceinline__ void operator()(f32x4 (&acc)[4][5], const f32x4 (&swp)[4], int ab, int bb, int fr, int fq) const {
#pragma unroll
        for (int j = 0; j < 5; ++j) {
            const int tok = bb + j * 16 + fr;
            const float rs = rsx[tok - tok_base];
            const float* sw = SW + cond_of(tok) * DFF;
            u32x2 v[4];
#pragma unroll
            for (int i = 0; i < 4; ++i) {
                const int n = ab + i * 16 + fq * 4;
                f32x4 a = acc[i][j] * rs + (uni ? swp[i] : *(const f32x4*)(sw + n));
                a[0] = fmaxf(a[0], 0.f); a[1] = fmaxf(a[1], 0.f); a[2] = fmaxf(a[2], 0.f); a[3] = fmaxf(a[3], 0.f);
                v[i].x = pk2(a[0] * a[0], a[1] * a[1]); v[i].y = pk2(a[2] * a[2], a[3] * a[3]);
            }
#pragma unroll
            for (int p = 0; p < 2; ++p) {
                const u32x4 o = pair16(v[2 * p], v[2 * p + 1]);
                *(u32x4*)(HID + (size_t)tok * DFF + ab + (2 * p + (fq & 1)) * 16 + (fq & 2) * 4) = o;
            }
        }
    }
};
struct EpiDt {
    float* DT; const float* rsx; int tok_base; const float* SW  ;
    __device__ __forceinline__ void operator()(f32x4 (&acc)[4][2], int ab, int bb, int fr, int fq) const {
#pragma unroll
        for (int j = 0; j < 2; ++j) {
            const int col = bb + j * 16 + fr;
#pragma unroll
            for (int i = 0; i < 4; ++i) {
                const int tok = ab + i * 16 + fq * 4;
#pragma unroll
                for (int r = 0; r < 4; ++r) DT[(size_t)(tok + r) * 64 + col] = acc[i][j][r] * rsx[tok + r - tok_base] + SW[cond_of(tok + r) * DPROJ + NZX + col];
            }
        }
    }
};
struct EpiF1 {
    bf16_t* UVT; int g; const float* rsx; int tok_base; const float* SW  ;
    __device__ __forceinline__ void operator()(f32x4 (&acc)[4][4], int ab, int bb, int fr, int fq) const {
#pragma unroll
        for (int j = 0; j < 4; ++j) {
            const int nn = bb + j * 16 + fr, part = nn >> 8, ch = g * 256 + (nn & 255);
#pragma unroll
            for (int i = 0; i < 4; ++i) {
                const int tok = ab + i * 16 + fq * 4;
                const float sw = SW[cond_of(tok) * 2048 + g * 512 + nn];
                bf16_t* dst;
                if (tok < NCTX) { const int s = tok >> 8, l = tok & 255; dst = UVT + ((size_t)(s * 1024 + ch) * 512 + part * 256 + l); }
                else { const int tt = tok - NCTX, s = tt >> 10, l = tt & 1023; dst = UVT + (size_t)NCTX * 2048 + ((size_t)(s * 1024 + ch) * 2048 + part * 1024 + l); }
                const f32x4 r4 = *(const f32x4*)(rsx + tok - tok_base);
                const f32x4 o = acc[i][j] * r4 + sw;
                u32x2 v; v.x = pk2(o[0], o[1]); v.y = pk2(o[2], o[3]);
                *(u32x2*)dst = v;
            }
        }
    }
};
template <int TB> struct EpiF2 {
    bf16_t* F; int tok0;
    __device__ __forceinline__ void operator()(f32x4 (&acc)[4][TB], int ab, int bb, int fr, int fq) const {
#pragma unroll
        for (int j = 0; j < TB; ++j) {
            const int tok = tok0 + bb + j * 16 + fr;
#pragma unroll
            for (int i = 0; i < 4; ++i) {
                const int n = ab + i * 16 + fq * 4;
                u32x2 v; v.x = pk2(acc[i][j][0], acc[i][j][1]); v.y = pk2(acc[i][j][2], acc[i][j][3]);
                *(u32x2*)(F + (size_t)tok * D + n) = v;
            }
        }
    }
};

struct TrItem { const float* W; bf16_t* WT; int K, N, k0, n0; };
__device__ __forceinline__ TrItem transpose_decode(const Ctx& c, int r) {
    const Args __attribute__((address_space(4)))& a = *c.a;
    constexpr int I_WIN = 8 * 81, I_WOUT = 16 * 16, I_FNO = 8 * 16, I_W1 = 8 * 64, I_W2 = 32 * 16;
    TrItem t; int item;
    if (r < 2 * I_WIN) { const int j = r / I_WIN; t.W = a.in[9] + (size_t)j * D * DPROJ; t.K = D; t.N = DPROJ; t.WT = (bf16_t*)(a.ws + WS_WIN) + (size_t)j * DPROJ * D; item = r - j * I_WIN; }
    else if ((r -= 2 * I_WIN) < 2 * I_WOUT) { const int j = r / I_WOUT; t.W = a.in[16] + (size_t)j * DI * D; t.K = DI; t.N = D; t.WT = (bf16_t*)(a.ws + WS_WOUT) + (size_t)j * D * DI; item = r - j * I_WOUT; }
    else if ((r -= 2 * I_WOUT) < 2 * I_FNO) { const int j = r / I_FNO; t.W = a.in[17] + (size_t)j * D * D; t.K = D; t.N = D; t.WT = (bf16_t*)(a.ws + WS_WFNO) + (size_t)j * D * D; item = r - j * I_FNO; }
    else if ((r -= 2 * I_FNO) < 4 * I_W1) { const int j = r / I_W1; t.W = a.in[19] + (size_t)j * D * DFF; t.K = D; t.N = DFF; t.WT = (bf16_t*)(a.ws + WS_W1) + (size_t)j * DFF * D; item = r - j * I_W1; }
    else { r -= 4 * I_W1; const int j = r / I_W2; t.W = a.in[20] + (size_t)j * DFF * D; t.K = DFF; t.N = D; t.WT = (bf16_t*)(a.ws + WS_W2) + (size_t)j * D * DFF; item = r - j * I_W2; }
    const int nb = t.N >> 6, kb = item / nb, nbi = item - kb * nb;
    t.k0 = kb * 128; t.n0 = nbi * 64;
    return t;
}
__device__ __forceinline__ void transpose_load(const Ctx& c, const TrItem& t, f32x4 (&v)[4]) {
    const int cl = c.tid & 15, rl = c.tid >> 4;
#pragma unroll
    for (int p = 0; p < 4; ++p) v[p] = *(const f32x4*)(t.W + (size_t)(t.k0 + p * 32 + rl) * t.N + t.n0 + cl * 4);
}
__device__ __forceinline__ void transpose_finish(const Ctx& c, const TrItem& t, const f32x4 (&v)[4]) {
    float* tile = (float*)c.lds;
    const int cl = c.tid & 15, rl = c.tid >> 4;
    __syncthreads();
#pragma unroll
    for (int p = 0; p < 4; ++p) { const int k = p * 32 + rl; tile[k * 65 + cl * 4 + 0] = v[p][0]; tile[k * 65 + cl * 4 + 1] = v[p][1]; tile[k * 65 + cl * 4 + 2] = v[p][2]; tile[k * 65 + cl * 4 + 3] = v[p][3]; }
    __syncthreads();
#pragma unroll
    for (int p = 0; p < 2; ++p) {
        const int idx = c.tid + p * NTHR, n = idx >> 4, kc = idx & 15;
        const float* s = tile + (kc * 8) * 65 + n;
        u32x4 o; o.x = pk2(s[0], s[65]); o.y = pk2(s[2 * 65], s[3 * 65]); o.z = pk2(s[4 * 65], s[5 * 65]); o.w = pk2(s[6 * 65], s[7 * 65]);
        *(u32x4*)(t.WT + (size_t)(t.n0 + n) * t.K + t.k0 + kc * 8) = o;
    }
}

__device__ __forceinline__ void ada_item(const Ctx& c, int item) {
    const Args __attribute__((address_space(4)))& a = *c.a;
    const int layer = item / 96, cg = item - layer * 96, n0 = cg * 64;
    const float* W = a.in[5] + (size_t)layer * D * 6144;
    const float* sc = (const float*)(c.lds + 40960);
    float* red = (float*)c.lds;
    const int cl = c.tid & 15, kl = c.tid >> 4;
    f32x4 a0 = {0, 0, 0, 0}, a1 = {0, 0, 0, 0}, a2 = {0, 0, 0, 0};
#pragma unroll 8
    for (int it = 0; it < 32; ++it) {
        const int k = it * 32 + kl;
        const f32x4 w = *(const f32x4*)(W + (size_t)k * 6144 + n0 + cl * 4);
        a0 += w * sc[k]; a1 += w * sc[1024 + k]; a2 += w * sc[2048 + k];
    }
    __syncthreads();
    *(f32x4*)(red + (kl * 3 + 0) * 64 + cl * 4) = a0;
    *(f32x4*)(red + (kl * 3 + 1) * 64 + cl * 4) = a1;
    *(f32x4*)(red + (kl * 3 + 2) * 64 + cl * 4) = a2;
    __syncthreads();
    if (c.tid < 192) {
        const int cond = c.tid >> 6, col = c.tid & 63;
        float s = 0.f;
#pragma unroll
        for (int k = 0; k < 32; ++k) s += red[(k * 3 + cond) * 64 + col];
        s += a.in[6][layer * 6144 + n0 + col];
        ((float*)(a.ws + WS_MOD))[(layer * 3 + cond) * 6144 + n0 + col] = s;
    }
}

__device__ __forceinline__ void phase_prep(const Ctx& c) {
    const Args __attribute__((address_space(4)))& a = *c.a;
    {
        float* sc = (float*)(c.lds + 40960);
        for (int i = c.tid; i < 3072; i += NTHR) {
            const int cond = i >> 10, k = i & 1023;
            const float v = cond == 0 ? a.in[4][k] : a.in[3][(cond - 1) * 1024 + k];
            sc[i] = silu_f(v);
        }
        __syncthreads();
    }
    constexpr int I_ADA = 384;
    constexpr int I_TR = 2 * 8 * 81 + 2 * 16 * 16 + 2 * 8 * 16 + 4 * 8 * 64 + 4 * 32 * 16;
    constexpr int I_TB = 32 + 32 + 512;
    for (int it = c.vb; it < I_ADA; it += c.G) ada_item(c, it);
    {
        int it = c.vb;
        if (it < I_TR) {
            TrItem cur = transpose_decode(c, it);
            f32x4 v[4]; transpose_load(c, cur, v);
            for (;;) {
                const int nit = it + c.G;
                TrItem nxt = cur; f32x4 vn[4];
                const bool has = nit < I_TR;
                if (has) { nxt = transpose_decode(c, nit); transpose_load(c, nxt, vn); }
                transpose_finish(c, cur, v);
                if (!has) break;
                cur = nxt; it = nit;
#pragma unroll
                for (int p = 0; p < 4; ++p) v[p] = vn[p];
            }
        }
    }
    for (int r = c.vb; r < I_TB; r += c.G) {
#pragma unroll 4
        for (int e = 0; e < 8; ++e) {
            int idx = r * 4096 + e * NTHR + c.tid;
            if (idx < 131072) {
                const int nn = idx >> 8, cc = idx & 255, m = nn & 255, ph = (m * cc) & 255;
                const float ang = (float)ph * (1.0f / 128.0f);
                const float v = nn < 256 ? cospif(ang) : sinpif(ang);
                ((bf16_t*)(a.ws + WS_T1))[idx] = (bf16_t)(pk2(v, 0.f) & 0xffff);
            } else if (idx < 262144) {
                idx -= 131072;
                const int k = idx >> 9, k2 = idx & 511, l = k2 & 255, ph = (k * l) & 255;
                const float ang = (float)ph * (1.0f / 128.0f);
                const float v = (k2 < 256 ? cospif(ang) : -sinpif(ang)) * (1.0f / 256.0f);
                ((bf16_t*)(a.ws + WS_T2C))[idx] = (bf16_t)(pk2(v, 0.f) & 0xffff);
            } else {
                idx -= 262144;
                const int k = idx >> 11, k2 = idx & 2047, l = k2 & 1023, ph = (k * l) & 1023;
                const float ang = (float)ph * (1.0f / 512.0f);
                const float v = (k2 < 1024 ? cospif(ang) : -sinpif(ang)) * (1.0f / 512.0f);
                ((bf16_t*)(a.ws + WS_T2L))[idx] = (bf16_t)(pk2(v, 0.f) & 0xffff);
            }
        }
    }
}

__device__ __forceinline__ void phase_prep2(const Ctx& c) {
    const Args __attribute__((address_space(4)))& a = *c.a;
    const float* MOD = (const float*)(a.ws + WS_MOD);
    float* sh = (float*)c.lds;
    const int gw = c.vb * NWAVE + c.wid, NGW = c.G * NWAVE;
#pragma unroll 1
    for (int v = 0; v < 8; ++v) {
        const int layer = v >> 1, mlp = v & 1, jj = layer >> 1, fnet = (layer & 1) && !mlp;
        __syncthreads();
        for (int i = c.tid; i < 3072; i += NTHR) sh[i] = MOD[(size_t)(layer * 3 + (i >> 10)) * 6144 + (mlp ? 3072 : 0) + (i & 1023)];
        __syncthreads();
        const bf16_t* W; float* out; int N, ostride;
        if (mlp) { W = (const bf16_t*)(a.ws + WS_W1) + (size_t)layer * DFF * D; N = DFF; out = (float*)(a.ws + WS_SWUP) + (size_t)layer * 3 * DFF; ostride = DFF; }
        else if (fnet) { W = (const bf16_t*)(a.ws + WS_T1); N = 2048; out = (float*)(a.ws + WS_SWF1) + (size_t)jj * 3 * 2048; ostride = 2048; }
        else { W = (const bf16_t*)(a.ws + WS_WIN) + (size_t)jj * DPROJ * D; N = DPROJ; out = (float*)(a.ws + WS_SWIN) + (size_t)jj * 3 * DPROJ; ostride = DPROJ; }
        for (int n = gw; n < N; n += NGW) {
            float s0 = 0.f, s1 = 0.f, s2 = 0.f;
            if (fnet) {
                const int g = n >> 9, nn = n & 511;
                if (c.lane < 32) {
                    const u32x4 w = *(const u32x4*)(W + (size_t)nn * 256 + c.lane * 8);
                    const int k = g * 256 + c.lane * 8;
#pragma unroll
                    for (int e = 0; e < 4; ++e) {
                        const float wl = bflo(w[e]), wh = bfhi(w[e]);
                        s0 += wl * sh[k + 2 * e] + wh * sh[k + 2 * e + 1];
                        s1 += wl * sh[1024 + k + 2 * e] + wh * sh[1024 + k + 2 * e + 1];
                        s2 += wl * sh[2048 + k + 2 * e] + wh * sh[2048 + k + 2 * e + 1];
                    }
                }
            } else {
#pragma unroll
                for (int p = 0; p < 2; ++p) {
                    const int k = p * 512 + c.lane * 8;
                    const u32x4 w = *(const u32x4*)(W + (size_t)n * D + k);
#pragma unroll
                    for (int e = 0; e < 4; ++e) {
                        const float wl = bflo(w[e]), wh = bfhi(w[e]);
                        s0 += wl * sh[k + 2 * e] + wh * sh[k + 2 * e + 1];
                        s1 += wl * sh[1024 + k + 2 * e] + wh * sh[1024 + k + 2 * e + 1];
                        s2 += wl * sh[2048 + k + 2 * e] + wh * sh[2048 + k + 2 * e + 1];
                    }
                }
            }
            s0 = wave_sum(s0); s1 = wave_sum(s1); s2 = wave_sum(s2);
            if (c.lane == 0) { out[n] = s0; out[ostride + n] = s1; out[2 * ostride + n] = s2; }
        }
    }
    {
        bf16_t* XG = (bf16_t*)(a.ws + WS_H);
        float* RSS = (float*)(a.ws + WS_RSS);
        const float* nw = a.in[7];
        for (int row = gw; row < NTOK; row += NGW) {
            const float* xr = row < NCTX ? a.in[0] + (size_t)row * D : a.in[1] + (size_t)(row - NCTX) * D;
            const float* m = MOD + (size_t)cond_of(row) * 6144 + 1024;
            float ss = 0.f;
#pragma unroll
            for (int q = 0; q < 4; ++q) {
                const int col = q * 256 + c.lane * 4;
                const f32x4 v = *(const f32x4*)(xr + col);
                ss += v[0] * v[0] + v[1] * v[1] + v[2] * v[2] + v[3] * v[3];
                const f32x4 o = v * (*(const f32x4*)(nw + col)) * (*(const f32x4*)(m + col) + 1.0f);
                u32x2 w; w.x = pk2(o[0], o[1]); w.y = pk2(o[2], o[3]);
                *(u32x2*)(XG + (size_t)row * D + col) = w;
            }
            ss = wave_sum(ss);
            if (c.lane < 16) RSS[(size_t)row * 16 + c.lane] = c.lane == 0 ? ss : 0.f;
        }
    }
}

__device__ __forceinline__ void phase_norm(const Ctx& c, const float* nw, const float* mod  , int off_shift, int off_scale, bool final_norm) {
    const Args __attribute__((address_space(4)))& a = *c.a;
    const int gw = c.vb * NWAVE + c.wid, NGW = c.G * NWAVE;
    bf16_t* H = (bf16_t*)(a.ws + WS_H);
    for (int row = gw; row < NTOK; row += NGW) {
        float* xr = a.out + (size_t)row * D;
        f32x4 v[4]; float ss = 0.f;
#pragma unroll
        for (int j = 0; j < 4; ++j) { v[j] = *(const f32x4*)(xr + j * 256 + c.lane * 4); ss += v[j][0] * v[j][0] + v[j][1] * v[j][1] + v[j][2] * v[j][2] + v[j][3] * v[j][3]; }
        ss = wave_sum(ss);
        const float rstd = rsqrtf(ss * (1.0f / D) + EPS);
        if (final_norm) {
#pragma unroll
            for (int j = 0; j < 4; ++j) { const f32x4 w = *(const f32x4*)(nw + j * 256 + c.lane * 4); *(f32x4*)(xr + j * 256 + c.lane * 4) = v[j] * rstd * w; }
        } else {
            const float* m = mod + cond_of(row) * 6144;
#pragma unroll
            for (int j = 0; j < 4; ++j) {
                const int col = j * 256 + c.lane * 4;
                const f32x4 w = *(const f32x4*)(nw + col), sc = *(const f32x4*)(m + off_scale + col), sh = *(const f32x4*)(m + off_shift + col);
                const f32x4 h = v[j] * rstd * w * (sc + 1.0f) + sh;
                u32x2 o; o.x = pk2(h[0], h[1]); o.y = pk2(h[2], h[3]);
                *(u32x2*)(H + (size_t)row * D + col) = o;
            }
        }
    }
}

constexpr int RS_OFF = 3 * GT<5>::STAGE;
struct FillRstd { float* tab; const float* RSS; int tok0, ntok, tid;
    __device__ __forceinline__ void operator()() const {
        if (tid < ntok) {
            const float* p = RSS + (size_t)(tok0 + tid) * 16;
            float s = 0.f;
#pragma unroll
            for (int q = 0; q < 4; ++q) { const f32x4 v = *(const f32x4*)(p + q * 4); s += (v[0] + v[1]) + (v[2] + v[3]); }
            tab[tid] = rsqrtf(s * (1.0f / D) + EPS);
        }
    }
};
__device__ __forceinline__ FillRstd fill_rstd(const Ctx& c, int tok0, int ntok) { return FillRstd{(float*)(c.lds + RS_OFF), (const float*)(c.a->ws + WS_RSS), tok0, ntok, c.tid}; }
__device__ __forceinline__ void rstd_table_one(const Ctx& c, int i, int ntok, int tok0) {
    float* tab = (float*)(c.lds + RS_OFF);
    const float* RSS = (const float*)(c.a->ws + WS_RSS);
    if (c.tid < ntok) {
        const float* p = RSS + (size_t)(tok0 + c.tid) * 16;
        float s = 0.f;
#pragma unroll
        for (int q = 0; q < 4; ++q) { const f32x4 v = *(const f32x4*)(p + q * 4); s += (v[0] + v[1]) + (v[2] + v[3]); }
        tab[i * ntok + c.tid] = rsqrtf(s * (1.0f / D) + EPS);
    }
}
__device__ __forceinline__ void rstd_tables(const Ctx& c, int n, int ntok, int first, int stride, int toks_per_rt, int shift_rt  ) {
    float* tab = (float*)(c.lds + RS_OFF);
    const float* RSS = (const float*)(c.a->ws + WS_RSS);
    for (int i = 0; i < n; ++i) {
        const int t = first + i * stride, rt = shift_rt < 0 ? t / (-shift_rt) : (t >> shift_rt);
        if (c.tid < ntok) {
            const float* p = RSS + (size_t)(rt * toks_per_rt + c.tid) * 16;
            float s = 0.f;
#pragma unroll
            for (int q = 0; q < 4; ++q) { const f32x4 v = *(const f32x4*)(p + q * 4); s += (v[0] + v[1]) + (v[2] + v[3]); }
            tab[i * ntok + c.tid] = rsqrtf(s * (1.0f / D) + EPS);
        }
    }
}
__device__ __forceinline__ void patch_tile(const Ctx& c, int i, int NC, int& rt, int& ct) {
    if (c.G == 256) { const int x = c.vb >> 5, l = c.vb & 31, p = i * 8 + x, PC = NC >> 2, pr = p / PC, pc = p - pr * PC; rt = pr * 8 + (l >> 2); ct = pc * 4 + (l & 3); }
    else { const int t = c.vb + i * c.G; rt = t / NC; ct = t - rt * NC; }
}
struct ProbInProj {
    static constexpr int EPI_STORES = 10;
    const Ctx* c; const bf16_t* W; const bf16_t* XG; int lda, ldb, K; int j;
    static constexpr int NC = NZX / 256, NT = (NTOK / 160) * NC;
    __device__ __forceinline__ int count() const { return (NT - c->vb + c->G - 1) / c->G; }
    __device__ __forceinline__ void tile(int i, const bf16_t*& A, const bf16_t*& B) const { int rt, ct; patch_tile(*c, i, NC, rt, ct); A = W + (size_t)ct * 256 * D; B = XG + (size_t)rt * 160 * D; }
    __device__ __forceinline__ void pre_all() const { const int n = count(); for (int i = 0; i < n; ++i) { int rt, ct; patch_tile(*c, i, NC, rt, ct); rstd_table_one(*c, i, 160, rt * 160); } }
    __device__ __forceinline__ void preload(int i, f32x4 (&sw)[4], int wr, int fq) const {
        int rt, ct; patch_tile(*c, i, NC, rt, ct);
        if (cond_of(rt * 160) == cond_of(rt * 160 + 159)) {
            const float* p = (const float*)(c->a->ws + WS_SWIN) + (size_t)j * 3 * DPROJ + cond_of(rt * 160) * DPROJ + ct * 256 + wr * 64 + fq * 4;
#pragma unroll
            for (int q = 0; q < 4; ++q) sw[q] = *(const f32x4*)(p + q * 16);
        }
    }
    __device__ __forceinline__ void epilogue(int i, f32x4 (&acc)[4][5], const f32x4 (&sw)[4], int wr, int wc, int fr, int fq) const {
        int rt, ct; patch_tile(*c, i, NC, rt, ct); unsigned char* ws = c->a->ws;
        EpiInProj e{(bf16_t*)(ws + S_Z), (bf16_t*)(ws + S_RAW), (const float*)(c->lds + RS_OFF) + i * 160, rt * 160, (const float*)(ws + WS_SWIN) + (size_t)j * 3 * DPROJ, cond_of(rt * 160) == cond_of(rt * 160 + 159)};
        e(acc, sw, ct * 256 + wr * 64, rt * 160 + wc * 80, fr, fq);
    }
};
__device__ __forceinline__ void phase_inproj(const Ctx& c, int j) {
    ProbInProj P{&c, (const bf16_t*)(c.a->ws + WS_WIN) + (size_t)j * DPROJ * D, (const bf16_t*)(c.a->ws + WS_H), D, D, D, j};
    gemm_stream<5>(c, P);
}
struct ProbMlpUp {
    static constexpr int EPI_STORES = 10;
    const Ctx* c; const bf16_t* W; const bf16_t* XG; int lda, ldb, K; int layer;
    static constexpr int NC = DFF / 256, NT = (NTOK / 160) * NC;
    __device__ __forceinline__ int count() const { return (NT - c->vb + c->G - 1) / c->G; }
    __device__ __forceinline__ void tile(int i, const bf16_t*& A, const bf16_t*& B) const { int rt, ct; patch_tile(*c, i, NC, rt, ct); A = W + (size_t)ct * 256 * D; B = XG + (size_t)rt * 160 * D; }
    __device__ __forceinline__ void pre_all() const { const int n = count(); for (int i = 0; i < n; ++i) { int rt, ct; patch_tile(*c, i, NC, rt, ct); rstd_table_one(*c, i, 160, rt * 160); } }
    __device__ __forceinline__ void preload(int i, f32x4 (&sw)[4], int wr, int fq) const {
        int rt, ct; patch_tile(*c, i, NC, rt, ct);
        if (cond_of(rt * 160) == cond_of(rt * 160 + 159)) {
            const float* p = (const float*)(c->a->ws + WS_SWUP) + (size_t)layer * 3 * DFF + cond_of(rt * 160) * DFF + ct * 256 + wr * 64 + fq * 4;
#pragma unroll
            for (int q = 0; q < 4; ++q) sw[q] = *(const f32x4*)(p + q * 16);
        }
    }
    __device__ __forceinline__ void epilogue(int i, f32x4 (&acc)[4][5], const f32x4 (&sw)[4], int wr, int wc, int fr, int fq) const {
        int rt, ct; patch_tile(*c, i, NC, rt, ct); unsigned char* ws = c->a->ws;
        EpiMlpUp e{(bf16_t*)(ws + S_HID), (const float*)(c->lds + RS_OFF) + i * 160, rt * 160, (const float*)(ws + WS_SWUP) + (size_t)layer * 3 * DFF, cond_of(rt * 160) == cond_of(rt * 160 + 159)};
        e(acc, sw, ct * 256 + wr * 64, rt * 160 + wc * 80, fr, fq);
    }
};
__device__ __forceinline__ void phase_mlp_up(const Ctx& c, int layer) {
    ProbMlpUp P{&c, (const bf16_t*)(c.a->ws + WS_W1) + (size_t)layer * DFF * D, (const bf16_t*)(c.a->ws + WS_H), D, D, D, layer};
    gemm_stream<5>(c, P);
}
#ifndef BENCH_MODE
#define BENCH_MODE 0
#endif
__device__ __forceinline__ void phase_bench(const Ctx& c) {
    ProbMlpUp P{&c, (const bf16_t*)(c.a->ws + WS_W1), (const bf16_t*)(c.a->ws + WS_H), D, D, D, 0};
    gemm_stream<5, ProbMlpUp, BENCH_MODE>(c, P);
}
struct ProbResid {
    static constexpr int EPI_STORES = 0;
    const Ctx* c; const bf16_t* WT; const bf16_t* Act; int lda, ldb, K; const float* gate; const float* bias; const float* ssq; const float* nw_next; const float* scale_next; bool first;
    static constexpr int NC = D / 256, NT = (NTOK / 160) * NC;
    __device__ __forceinline__ int count() const { return (NT - c->vb + c->G - 1) / c->G; }
    __device__ __forceinline__ void tile(int i, const bf16_t*& A, const bf16_t*& B) const { const int t = c->vb + i * c->G, rt = t / NC, ct = t - rt * NC; A = WT + (size_t)ct * 256 * K; B = Act + (size_t)rt * 160 * K; }
    __device__ __forceinline__ void pre_all() const {
        if (!ssq) return;
        float* tab = (float*)(c->lds + RS_OFF);
        const int n = count();
        for (int i = 0; i < n; ++i) {
            const int t = c->vb + i * c->G, rt = t / NC;
            if (c->tid < 160) {
                const float* p = ssq + (size_t)(rt * 160 + c->tid) * 32;
                float s = 0.f;
#pragma unroll
                for (int q = 0; q < 8; ++q) { const f32x4 v = *(const f32x4*)(p + q * 4); s += v[0] + v[1] + v[2] + v[3]; }
                tab[i * 160 + c->tid] = rsqrtf(s * (1.0f / DI) + EPS);
            }
        }
    }
    __device__ __forceinline__ void preload(int, f32x4 (&)[4], int, int) const {}
    __device__ __forceinline__ void epilogue(int i, f32x4 (&acc)[4][5], const f32x4 (&)[4], int wr, int wc, int fr, int fq) const {
        const int t = c->vb + i * c->G, rt = t / NC, ct = t - rt * NC; unsigned char* ws = c->a->ws;
        EpiResid e{c->a->out, gate, bias, ssq ? (const float*)(c->lds + RS_OFF) + i * 160 : nullptr, rt * 160, first ? c->a->in[0] : nullptr, first ? c->a->in[1] : nullptr, nw_next ? (bf16_t*)(ws + WS_H) : nullptr, nw_next, scale_next, (float*)(ws + WS_RSS)};
        e(acc, ct * 256 + wr * 64, rt * 160 + wc * 80, fr, fq);
    }
};
__device__ __forceinline__ void phase_resid_gemm(const Ctx& c, const bf16_t* WT, const bf16_t* Act, int K, const float* gate, const float* bias, const float* ssq, const float* nw_next, const float* scale_next, bool first) {
    ProbResid P{&c, WT, Act, K, K, K, gate, bias, ssq, nw_next, scale_next, first};
    gemm_stream<5>(c, P);
}
struct ProbF1 {
    static constexpr int EPI_STORES = 16;
    const Ctx* c; const bf16_t* XG; const bf16_t* T1; int lda, ldb, K; int j;
    static constexpr int NT = (NTOK / 256) * 16;
    __device__ __forceinline__ int count() const { return (NT - c->vb + c->G - 1) / c->G; }
    __device__ __forceinline__ void tile(int i, const bf16_t*& A, const bf16_t*& B) const { const int t = c->vb + i * c->G, rt = t >> 4, g = (t >> 2) & 3, ct = t & 3; A = XG + (size_t)rt * 256 * D + g * 256; B = T1 + (size_t)ct * 128 * 256; }
    __device__ __forceinline__ void pre_all() const { rstd_tables(*c, count(), 256, c->vb, c->G, 256, 4); }
    __device__ __forceinline__ void preload(int, f32x4 (&)[4], int, int) const {}
    __device__ __forceinline__ void epilogue(int i, f32x4 (&acc)[4][4], const f32x4 (&)[4], int wr, int wc, int fr, int fq) const {
        const int t = c->vb + i * c->G, rt = t >> 4, g = (t >> 2) & 3, ct = t & 3; unsigned char* ws = c->a->ws;
        EpiF1 e{(bf16_t*)(ws + S_UVT), g, (const float*)(c->lds + RS_OFF) + i * 256, rt * 256, (const float*)(ws + WS_SWF1) + (size_t)j * 3 * 2048};
        e(acc, rt * 256 + wr * 64, ct * 128 + wc * 64, fr, fq);
    }
};
__device__ __forceinline__ void phase_f1(const Ctx& c, int j) {
    ProbF1 P{&c, (const bf16_t*)(c.a->ws + WS_H), (const bf16_t*)(c.a->ws + WS_T1), D, 256, 256, j};
    gemm_stream<4>(c, P);
}
struct ProbF2L {
    static constexpr int EPI_STORES = 0;
    const Ctx* c; const bf16_t* UVT; const bf16_t* T2; bf16_t* F; int lda, ldb, K;
    __device__ __forceinline__ int count() const { return c->vb < 128 ? 1 : 0; }
    __device__ __forceinline__ void tile(int i, const bf16_t*& A, const bf16_t*& B) const { const int t = c->vb, s = t >> 6, nt = (t >> 4) & 3, kt = t & 15; A = UVT + (size_t)NCTX * 2048 + ((size_t)s * 1024 + nt * 256) * 2048; B = T2 + (size_t)kt * 64 * 2048; }
    __device__ __forceinline__ void pre_all() const {}
    __device__ __forceinline__ void preload(int, f32x4 (&)[4], int, int) const {}
    __device__ __forceinline__ void epilogue(int i, f32x4 (&acc)[4][2], const f32x4 (&)[4], int wr, int wc, int fr, int fq) const { const int t = c->vb, s = t >> 6, nt = (t >> 4) & 3, kt = t & 15; EpiF2<2> e{F, NCTX + s * 1024}; e(acc, nt * 256 + wr * 64, kt * 64 + wc * 32, fr, fq); }
};
struct ProbF2C {
    static constexpr int EPI_STORES = 16;
    const Ctx* c; const bf16_t* UVT; const bf16_t* T2; bf16_t* F; int lda, ldb, K; int first, stride;
    __device__ __forceinline__ int count() const { return (256 - first + stride - 1) / stride; }
    __device__ __forceinline__ void tile(int i, const bf16_t*& A, const bf16_t*& B) const { const int u = first + i * stride, s = u >> 3, nt = (u >> 1) & 3, kt = u & 1; A = UVT + ((size_t)s * 1024 + nt * 256) * 512; B = T2 + (size_t)kt * 128 * 512; }
    __device__ __forceinline__ void pre_all() const {}
    __device__ __forceinline__ void preload(int, f32x4 (&)[4], int, int) const {}
    __device__ __forceinline__ void epilogue(int i, f32x4 (&acc)[4][4], const f32x4 (&)[4], int wr, int wc, int fr, int fq) const { const int u = first + i * stride, s = u >> 3, nt = (u >> 1) & 3, kt = u & 1; EpiF2<4> e{F, s * 256}; e(acc, nt * 256 + wr * 64, kt * 128 + wc * 64, fr, fq); }
};
__device__ __forceinline__ void phase_f2(const Ctx& c) {
    unsigned char* ws = c.a->ws;
    const int half = c.G >> 1;
    if (c.vb < half) { ProbF2L P{&c, (const bf16_t*)(ws + S_UVT), (const bf16_t*)(ws + WS_T2L), (bf16_t*)(ws + S_F), 2048, 2048, 2048}; gemm_stream<2>(c, P); }
    else { ProbF2C P{&c, (const bf16_t*)(ws + S_UVT), (const bf16_t*)(ws + WS_T2C), (bf16_t*)(ws + S_F), 512, 512, 512, c.vb - half, c.G - half}; gemm_stream<4>(c, P); }
}

struct ProbDt {
    static constexpr int EPI_STORES = 0;
    const Ctx* c; const bf16_t* XG; const bf16_t* W; int lda, ldb, K; int j;
    __device__ __forceinline__ int count() const { return (NTOK / 256 - c->vb + c->G - 1) / c->G; }
    __device__ __forceinline__ void tile(int i, const bf16_t*& A, const bf16_t*& B) const { const int t = c->vb + i * c->G; A = XG + (size_t)t * 256 * D; B = W; }
    __device__ __forceinline__ void pre_all() const { rstd_tables(*c, count(), 256, c->vb, c->G, 256, 0); }
    __device__ __forceinline__ void preload(int, f32x4 (&)[4], int, int) const {}
    __device__ __forceinline__ void epilogue(int i, f32x4 (&acc)[4][2], const f32x4 (&)[4], int wr, int wc, int fr, int fq) const {
        const int t = c->vb + i * c->G; unsigned char* ws = c->a->ws;
        EpiDt e{(float*)(ws + S_DT), (const float*)(c->lds + RS_OFF) + i * 256, t * 256, (const float*)(ws + WS_SWIN) + (size_t)j * 3 * DPROJ};
        e(acc, t * 256 + wr * 64, wc * 32, fr, fq);
    }
};
__device__ __forceinline__ void phase_conv(const Ctx& c, int j) {
    const Args __attribute__((address_space(4)))& a = *c.a;
    {
        ProbDt P{&c, (const bf16_t*)(a.ws + WS_H), (const bf16_t*)(a.ws + WS_WIN) + (size_t)j * DPROJ * D + (size_t)NZX * D, D, D, D, j};
        gemm_stream<2>(c, P);
    }
    const bf16_t* RAW = (const bf16_t*)(a.ws + S_RAW);
    bf16_t* XBC = (bf16_t*)(a.ws + S_XBC);
    const float* cw = a.in[10] + (size_t)j * 3 * DXBC;
    const float* cb = a.in[11] + (size_t)j * DXBC;
    constexpr int NIT = (NTOK / 64) * 3;
    for (int it = c.G - 1 - c.vb; it < NIT; it += c.G) {
        const int tg = it / 3, third = it - tg * 3;
        const int ch = third * 1024 + (c.tid & 127) * 8;
        const int r0 = tg * 64 + (c.tid >> 7) * 16;
        float w0[8], w1[8], w2[8], bb[8];
#pragma unroll
        for (int q = 0; q < 2; ++q) {
            const f32x4 t0 = *(const f32x4*)(cw + ch + q * 4), t1 = *(const f32x4*)(cw + DXBC + ch + q * 4), t2 = *(const f32x4*)(cw + 2 * DXBC + ch + q * 4), t3 = *(const f32x4*)(cb + ch + q * 4);
#pragma unroll
            for (int e = 0; e < 4; ++e) { w0[q * 4 + e] = t0[e]; w1[q * 4 + e] = t1[e]; w2[q * 4 + e] = t2[e]; bb[q * 4 + e] = t3[e]; }
        }
        const int seg = r0 < NCTX ? 256 : 64;
        u32x4 prev = {0, 0, 0, 0}, cur, nxt;
        if ((r0 % seg) != 0) prev = *(const u32x4*)(RAW + (size_t)(r0 - 1) * DXBC + ch);
        cur = *(const u32x4*)(RAW + (size_t)r0 * DXBC + ch);
#pragma unroll 4
        for (int r = 0; r < 16; ++r) {
            const int t = r0 + r;
            nxt = (u32x4){0, 0, 0, 0};
            if (((t + 1) % seg) != 0) nxt = *(const u32x4*)(RAW + (size_t)(t + 1) * DXBC + ch);
            u32x4 o;
#pragma unroll
            for (int e = 0; e < 4; ++e) {
                const float lo = bb[2 * e] + w0[2 * e] * bflo(prev[e]) + w1[2 * e] * bflo(cur[e]) + w2[2 * e] * bflo(nxt[e]);
                const float hi = bb[2 * e + 1] + w0[2 * e + 1] * bfhi(prev[e]) + w1[2 * e + 1] * bfhi(cur[e]) + w2[2 * e + 1] * bfhi(nxt[e]);
                o[e] = pk2(silu_f(lo), silu_f(hi));
            }
            *(u32x4*)(XBC + (size_t)t * DXBC + ch) = o;
            prev = cur; cur = nxt;
        }
    }
}

constexpr int SC_XS = 0, SC_XW = 16384, SC_BS = 32768, SC_CS = 49152, SC_HT = 65536, SC_SM = 98304;
__device__ __forceinline__ int off128(int row, int col) { return row * 128 + ((((col >> 3) ^ (row & 7))) << 4) + (col & 7) * 2; }
__device__ __forceinline__ int off256(int row, int col) { return row * 256 + ((((col >> 3) ^ (row & 15))) << 4) + (col & 7) * 2; }
__device__ __forceinline__ int offX(int row, int col) { return row * 128 + col * 2; }
__device__ __forceinline__ int offP(int row, int col) { return row * 144 + col * 2; }
template <int LAY>
__device__ __forceinline__ bf16x8 tr_frag(const char* tile, int r0, int r1, int col0, int lane) {
    const int i = lane & 15, q = i >> 2, cc = col0 + (i & 3) * 4;
    const int o0 = LAY == 1 ? off256(r0 + q, cc) : LAY == 2 ? offP(r0 + q, cc) : offX(r0 + q, cc);
    const int o1 = LAY == 1 ? off256(r1 + q, cc) : LAY == 2 ? offP(r1 + q, cc) : offX(r1 + q, cc);
    const bf16x4 lo = __builtin_amdgcn_ds_read_tr16_b64_v4i16((LAS bf16x4*)(tile + o0));
    const bf16x4 hi = __builtin_amdgcn_ds_read_tr16_b64_v4i16((LAS bf16x4*)(tile + o1));
    return __builtin_shufflevector(lo, hi, 0, 1, 2, 3, 4, 5, 6, 7);
}

struct ScanStep { int seq, hp, dir, ci, nch, t0, valid, single, h0; };
struct ScanIter {
    int vb, G, k, dir, ci;
    __device__ __forceinline__ void get(ScanStep& s) const {
        int seq, hp, ok, single = 0, h0 = 0;
        if (vb < 64) { seq = 32 + (vb >> 5); h0 = vb & 31; hp = h0 >> 1; single = 1; ok = (k == 0); }
        else { const int u = (vb - 64) + k * (G - 64); seq = u >> 4; hp = u & 15; ok = (u < 512); }
        const bool lat = seq >= 32;
        s.seq = seq; s.hp = hp; s.dir = dir; s.ci = ci; s.nch = lat ? 16 : 4; s.valid = ok; s.single = single; s.h0 = h0;
        const int tok0 = lat ? NCTX + (seq - 32) * 1024 : seq * 256;
        const int ch = dir == 0 ? ci : s.nch - 1 - ci;
        s.t0 = tok0 + ch * 64;
    }
    __device__ __forceinline__ void advance() {
        int seq; if (vb < 64) seq = 32; else seq = 0;
        const int nch = seq >= 32 ? 16 : 4;
        if (++ci == nch) { ci = 0; if (++dir == 2) { dir = 0; ++k; } }
    }
};
constexpr int SCB = 49152;
constexpr int SB_XS = 0, SB_BS = 16384, SB_CS = 32768;
constexpr int XW_BYTES = 64 * 144, HT_BYTES = 128 * 144;
constexpr int SCN_XW = 2 * SCB, SCN_HT = SCN_XW + 2 * XW_BYTES, SCN_SM = SCN_HT + 2 * HT_BYTES;

__device__ __forceinline__ void scan_issue_tiles(const Ctx& c, const ScanStep& s, int buf) {
    const bf16_t* XBC = (const bf16_t*)(c.a->ws + S_XBC);
    char* base = c.lds + buf * SCB;
    const int lane = c.lane, w8 = c.wid, g = s.hp >> 2;
#pragma unroll
    for (int hh = 0; hh < 2; ++hh) {
        if (hh == 1 && s.single) break;
        const int q = w8, row = q * 8 + (lane >> 3), lch = lane & 7, hd = s.single ? s.h0 : 2 * s.hp + hh;
        __builtin_amdgcn_global_load_lds((const unsigned*)(XBC + (size_t)(s.t0 + row) * DXBC + hd * 64 + lch * 8), (LAS unsigned*)(base + SB_XS + hh * 8192 + q * 1024 + lane * 16), 16, 0, 0);
    }
#pragma unroll
    for (int i = 0; i < 2; ++i) {
        const int q = w8 + 8 * i, row = q * 4 + (lane >> 4), lch = (lane & 15) ^ (row & 15);
        __builtin_amdgcn_global_load_lds((const unsigned*)(XBC + (size_t)(s.t0 + row) * DXBC + DI + g * 128 + lch * 8), (LAS unsigned*)(base + SB_BS + q * 1024 + lane * 16), 16, 0, 0);
        __builtin_amdgcn_global_load_lds((const unsigned*)(XBC + (size_t)(s.t0 + row) * DXBC + DI + 512 + g * 128 + lch * 8), (LAS unsigned*)(base + SB_CS + q * 1024 + lane * 16), 16, 0, 0);
    }
}
__device__ __forceinline__ float scan_load_dt(const Ctx& c, const ScanStep& s, int hw) {
    const float* DT = (const float*)(c.a->ws + S_DT);
    const int l = s.dir == 0 ? c.lane : 63 - c.lane, h = s.single ? s.h0 : 2 * s.hp + hw;
    return DT[(size_t)(s.t0 + l) * 64 + s.dir * NH + h];
}
__device__ __forceinline__ void scan_dtcs(const Ctx& c, const ScanStep& s, int hw, int j, float raw, float* sm) {
    const int lane = c.lane, l = s.dir == 0 ? lane : 63 - lane, h = s.single ? s.h0 : 2 * s.hp + hw;
    const float Aneg = -__expf(c.a->in[13][(j * 2 + s.dir) * NH + h]);
    raw += c.a->in[12][(j * 2 + s.dir) * NH + h];
    const float dt = raw > 20.f ? raw : __logf(1.0f + __expf(raw));
    float cs = dt * Aneg;
#pragma unroll
    for (int o = 1; o < 64; o <<= 1) { const float u = __shfl_up(cs, o); if (lane >= o) cs += u; }
    sm[l] = dt; sm[64 + l] = cs;
    if (lane == 63) sm[128] = cs;
}

__device__ __forceinline__ void phase_scan_pipe(const Ctx& c, int j) {
    const Args __attribute__((address_space(4)))& a = *c.a;
    const bf16_t* Z = (const bf16_t*)(a.ws + S_Z);
    bf16_t* YTMP = (bf16_t*)(a.ws + S_RAW);
    bf16_t* YG = (bf16_t*)(a.ws + S_YG);
    float* SSQ = (float*)(a.ws + S_SSQ);
    const int hw = c.wid >> 2, w = c.wid & 3;
    char* lds = c.lds;
    char* XWp = lds + SCN_XW + hw * XW_BYTES; char* HTp = lds + SCN_HT + hw * HT_BYTES;

    ScanIter it{c.vb, c.G, 0, 0, 0};
    ScanStep cur, nxt, nx2;
    it.get(cur); it.advance(); it.get(nxt); it.advance(); it.get(nx2);
    if (!cur.valid) return;
    scan_issue_tiles(c, cur, 0);
    float raw_n1 = 0.f;
    if (w == 0 && !(cur.single && hw == 1)) {
        const float r0 = scan_load_dt(c, cur, hw);
        if (nxt.valid) raw_n1 = scan_load_dt(c, nxt, hw);
        scan_dtcs(c, cur, hw, j, r0, (float*)(lds + SCN_SM + (0 * 2 + hw) * 1024));
    }
    f32x4 S[4][2];
#pragma unroll
    for (int pb = 0; pb < 4; ++pb)
#pragma unroll
        for (int nbi = 0; nbi < 2; ++nbi) S[pb][nbi] = (f32x4){0.f, 0.f, 0.f, 0.f};

#pragma unroll 1
    for (int s = 0; cur.valid; ++s) {
        int lane = c.lane; asm volatile("" : "+v"(lane));
        const int fr = lane & 15, fq = lane >> 4;
        const int b = s & 1;
        char* TB_ = lds + b * SCB;
        char* XSp = TB_ + SB_XS + hw * 8192;
        const float* sm_dt = (const float*)(lds + SCN_SM + (b * 2 + hw) * 1024);
        const float* sm_cs = sm_dt + 64;
        const bool is_lat = cur.seq >= 32;
        const bool active = !(cur.single && hw == 1);
        const int dir = cur.dir, t0 = cur.t0, h = cur.single ? cur.h0 : 2 * cur.hp + hw;
        asm volatile("s_waitcnt vmcnt(0)" ::: "memory");
        __syncthreads();
        if (nxt.valid) scan_issue_tiles(c, nxt, b ^ 1);
        float raw_n2 = 0.f;
        if (w == 0 && nx2.valid && !(nx2.single && hw == 1)) raw_n2 = scan_load_dt(c, nx2, hw);
        u32x2 yt[4], zz[4]; f32x4 nwv[4]; float Dh = 0.f;
        const int tok = t0 + w * 16 + fr;
        if (dir == 1 && active) {
            Dh = a.in[14][j * NH + h];
            const float* normw = a.in[15] + (size_t)j * DI + h * 64;
#pragma unroll
            for (int pb = 0; pb < 4; ++pb) {
                const int p0 = pb * 16 + fq * 4;
                yt[pb] = *(const u32x2*)(YTMP + (size_t)tok * DI + h * 64 + p0);
                zz[pb] = *(const u32x2*)(Z + (size_t)tok * DI + h * 64 + p0);
                nwv[pb] = *(const f32x4*)(normw + p0);
            }
        }
        bool has_h = is_lat || cur.ci > 0;
        if (cur.ci == 0) {
            if (is_lat) {
                if (active) {
                const float* sp = a.in[2] + ((size_t)(((cur.seq - 32) * 2 + j) * 2 + dir) * NH + h) * 8192;
#pragma unroll
                for (int pb = 0; pb < 4; ++pb)
#pragma unroll
                    for (int nbi = 0; nbi < 2; ++nbi) {
                        const int n = (2 * w + nbi) * 16 + fr, p0 = pb * 16 + fq * 4;
#pragma unroll
                        for (int r = 0; r < 4; ++r) S[pb][nbi][r] = sp[(p0 + r) * 128 + n];
                        u32x2 v; v.x = pk2(S[pb][nbi][0], S[pb][nbi][1]); v.y = pk2(S[pb][nbi][2], S[pb][nbi][3]);
                        *(u32x2*)(HTp + offP(n, p0)) = v;
                    }
                }
                __syncthreads();
            } else {
#pragma unroll
                for (int pb = 0; pb < 4; ++pb)
#pragma unroll
                    for (int nbi = 0; nbi < 2; ++nbi) S[pb][nbi] = (f32x4){0.f, 0.f, 0.f, 0.f};
            }
        }
        float tot = 0.f;
        if (active) {
        tot = sm_dt[128];
        {
            const int tl = c.tid & 255, l = tl >> 2, c0 = (tl & 3) * 16;
            const float sc = __expf(tot - sm_cs[l]) * sm_dt[l];
#pragma unroll
            for (int q = 0; q < 2; ++q) {
                const u32x4 v = *(const u32x4*)(XSp + offX(l, c0 + q * 8));
                u32x4 r;
#pragma unroll
                for (int e = 0; e < 4; ++e) r[e] = pk2(bflo(v[e]) * sc, bfhi(v[e]) * sc);
                *(u32x4*)(XWp + offP(l, c0 + q * 8)) = r;
            }
        }
        bf16x8 cf[4];
#pragma unroll
        for (int kk = 0; kk < 4; ++kk) cf[kk] = *(const bf16x8*)(TB_ + SB_CS + off256(w * 16 + fr, kk * 32 + fq * 8));
        const float csl = sm_cs[w * 16 + fr];
        f32x4 yacc[4];
#pragma unroll
        for (int pb = 0; pb < 4; ++pb) yacc[pb] = (f32x4){0.f, 0.f, 0.f, 0.f};
        if (has_h) {
            bf16x8 hf[2][4];
#pragma unroll
            for (int pb = 0; pb < 4; ++pb) hf[0][pb] = tr_frag<2>(HTp, fq * 8, fq * 8 + 4, pb * 16, lane);
#pragma unroll
            for (int kk = 0; kk < 4; ++kk) {
                if (kk < 3) {
#pragma unroll
                    for (int pb = 0; pb < 4; ++pb) hf[(kk + 1) & 1][pb] = tr_frag<2>(HTp, (kk + 1) * 32 + fq * 8, (kk + 1) * 32 + fq * 8 + 4, pb * 16, lane);
                }
                __builtin_amdgcn_sched_barrier(0);
#pragma unroll
                for (int pb = 0; pb < 4; ++pb) yacc[pb] = __builtin_amdgcn_mfma_f32_16x16x32_bf16(hf[kk & 1][pb], cf[kk], yacc[pb], 0, 0, 0);
            }
            const float e = __expf(csl);
#pragma unroll
            for (int pb = 0; pb < 4; ++pb) yacc[pb] = yacc[pb] * e;
        }
#pragma unroll
        for (int kk2 = 0; kk2 < 2; ++kk2) {
            const bool need = dir == 0 ? (2 * kk2 <= w) : (2 * kk2 + 1 >= w);
            if (need) {
                unsigned m[4];
                bf16x8 bfg[2][4];
                f32x4 gg[2];
#pragma unroll
                for (int half = 0; half < 2; ++half)
#pragma unroll
                    for (int kk = 0; kk < 4; ++kk) bfg[half][kk] = *(const bf16x8*)(TB_ + SB_BS + off256((2 * kk2 + half) * 16 + fr, kk * 32 + fq * 8));
                bf16x8 xf[4];
#pragma unroll
                for (int pb = 0; pb < 4; ++pb) xf[pb] = tr_frag<0>(XSp, 32 * kk2 + 4 * fq, 32 * kk2 + 16 + 4 * fq, pb * 16, lane);
                __builtin_amdgcn_sched_barrier(0);
                gg[0] = (f32x4){0.f, 0.f, 0.f, 0.f}; gg[1] = (f32x4){0.f, 0.f, 0.f, 0.f};
#pragma unroll
                for (int kk = 0; kk < 4; ++kk)
#pragma unroll
                    for (int half = 0; half < 2; ++half) gg[half] = __builtin_amdgcn_mfma_f32_16x16x32_bf16(bfg[half][kk], cf[kk], gg[half], 0, 0, 0);
#pragma unroll
                for (int half = 0; half < 2; ++half) {
                    const int sb = 2 * kk2 + half;
                    const f32x4 gacc = gg[half];
                    const f32x4 css = *(const f32x4*)(sm_cs + sb * 16 + fq * 4);
                    const f32x4 dts = *(const f32x4*)(sm_dt + sb * 16 + fq * 4);
                    float v[4];
#pragma unroll
                    for (int r = 0; r < 4; ++r) {
                        const int si = sb * 16 + fq * 4 + r, l = w * 16 + fr;
                        const bool valid = dir == 0 ? (si <= l) : (si >= l);
                        v[r] = valid ? gacc[r] * __expf(csl - css[r]) * dts[r] : 0.f;
                    }
                    m[half * 2 + 0] = pk2(v[0], v[1]); m[half * 2 + 1] = pk2(v[2], v[3]);
                }
                union { unsigned u[4]; bf16x8 v; } mf; mf.u[0] = m[0]; mf.u[1] = m[1]; mf.u[2] = m[2]; mf.u[3] = m[3];
#pragma unroll
                for (int pb = 0; pb < 4; ++pb) yacc[pb] = __builtin_amdgcn_mfma_f32_16x16x32_bf16(xf[pb], mf.v, yacc[pb], 0, 0, 0);
            }
        }
        {
            const int l = w * 16 + fr;
            if (dir == 0) {
#pragma unroll
                for (int pb = 0; pb < 4; ++pb) {
                    const int p0 = pb * 16 + fq * 4;
                    u32x2 v; v.x = pk2(yacc[pb][0], yacc[pb][1]); v.y = pk2(yacc[pb][2], yacc[pb][3]);
                    *(u32x2*)(YTMP + (size_t)tok * DI + h * 64 + p0) = v;
                }
            } else {
                float ss = 0.f;
#pragma unroll
                for (int pb = 0; pb < 4; ++pb) {
                    const int p0 = pb * 16 + fq * 4;
                    const u32x2 xx = *(const u32x2*)(XSp + offX(l, p0));
                    const f32x4 nw = nwv[pb];
                    float y[4];
                    y[0] = yacc[pb][0] + bflo(yt[pb].x) + Dh * bflo(xx.x); y[1] = yacc[pb][1] + bfhi(yt[pb].x) + Dh * bfhi(xx.x);
                    y[2] = yacc[pb][2] + bflo(yt[pb].y) + Dh * bflo(xx.y); y[3] = yacc[pb][3] + bfhi(yt[pb].y) + Dh * bfhi(xx.y);
                    y[0] *= silu_f(bflo(zz[pb].x)); y[1] *= silu_f(bfhi(zz[pb].x)); y[2] *= silu_f(bflo(zz[pb].y)); y[3] *= silu_f(bfhi(zz[pb].y));
                    ss += y[0] * y[0] + y[1] * y[1] + y[2] * y[2] + y[3] * y[3];
                    u32x2 v; v.x = pk2(y[0] * nw[0], y[1] * nw[1]); v.y = pk2(y[2] * nw[2], y[3] * nw[3]);
                    *(u32x2*)(YG + (size_t)tok * DI + h * 64 + p0) = v;
                }
                ss += __shfl_xor(ss, 16); ss += __shfl_xor(ss, 32);
                if (fq == 0) SSQ[(size_t)tok * NH + h] = ss;
            }
        }
        }
        __syncthreads();
        if (active) {
            const float et = __expf(tot);
#pragma unroll
            for (int pb = 0; pb < 4; ++pb)
#pragma unroll
                for (int nbi = 0; nbi < 2; ++nbi) S[pb][nbi] = S[pb][nbi] * et;
            bf16x8 bq[2][2], xa[2][4];
#pragma unroll
            for (int kk = 0; kk < 2; ++kk) {
#pragma unroll
                for (int nbi = 0; nbi < 2; ++nbi) bq[kk][nbi] = tr_frag<1>(TB_ + SB_BS, kk * 32 + fq * 8, kk * 32 + fq * 8 + 4, (2 * w + nbi) * 16, lane);
#pragma unroll
                for (int pb = 0; pb < 4; ++pb) xa[kk][pb] = tr_frag<2>(XWp, kk * 32 + fq * 8, kk * 32 + fq * 8 + 4, pb * 16, lane);
            }
            __builtin_amdgcn_sched_barrier(0);
#pragma unroll
            for (int kk = 0; kk < 2; ++kk)
#pragma unroll
                for (int pb = 0; pb < 4; ++pb)
#pragma unroll
                    for (int nbi = 0; nbi < 2; ++nbi) S[pb][nbi] = __builtin_amdgcn_mfma_f32_16x16x32_bf16(xa[kk][pb], bq[kk][nbi], S[pb][nbi], 0, 0, 0);
#pragma unroll
            for (int pb = 0; pb < 4; ++pb)
#pragma unroll
                for (int nbi = 0; nbi < 2; ++nbi) {
                    const int n = (2 * w + nbi) * 16 + fr, p0 = pb * 16 + fq * 4;
                    u32x2 v; v.x = pk2(S[pb][nbi][0], S[pb][nbi][1]); v.y = pk2(S[pb][nbi][2], S[pb][nbi][3]);
                    *(u32x2*)(HTp + offP(n, p0)) = v;
                }
        }
        if (active && !is_lat && cur.ci == cur.nch - 1) {
            float* op = a.out + (size_t)NTOK * D + ((size_t)((cur.seq * 2 + j) * 2 + dir) * NH + h) * 8192;
#pragma unroll
            for (int pb = 0; pb < 4; ++pb)
#pragma unroll
                for (int nbi = 0; nbi < 2; ++nbi) {
                    const int n = (2 * w + nbi) * 16 + fr, p0 = pb * 16 + fq * 4;
#pragma unroll
                    for (int r = 0; r < 4; ++r) op[(p0 + r) * 128 + n] = S[pb][nbi][r];
                }
        }
        if (w == 0 && nxt.valid && !(nxt.single && hw == 1)) scan_dtcs(c, nxt, hw, j, raw_n1, (float*)(lds + SCN_SM + ((b ^ 1) * 2 + hw) * 1024));
        raw_n1 = raw_n2;
        cur = nxt; nxt = nx2; it.advance(); it.get(nx2);
    }
}

#if NAIVE_SCAN
__device__ __forceinline__ void scan_unit_naive(const Ctx& c, int j, int seq, int h) {
    const Args __attribute__((address_space(4)))& a = *c.a;
    const bf16_t* XBC = (const bf16_t*)(a.ws + S_XBC);
    const bf16_t* Z = (const bf16_t*)(a.ws + S_Z);
    const float* DT = (const float*)(a.ws + S_DT);
    bf16_t* YTMP = (bf16_t*)(a.ws + S_RAW);
    bf16_t* YG = (bf16_t*)(a.ws + S_YG);
    float* SSQ = (float*)(a.ws + S_SSQ);
    const bool is_lat = seq >= 32;
    const int tok0 = is_lat ? NCTX + (seq - 32) * 1024 : seq * 256;
    const int L = is_lat ? 1024 : 256;
    const int g = h >> 3, p = c.tid >> 2, nq = (c.tid & 3) * 32;
    const float Dh = a.in[14][j * NH + h];
    const float nw = a.in[15][(size_t)j * DI + h * 64 + p];
    float* red = (float*)c.lds;
    for (int dir = 0; dir < 2; ++dir) {
        const float Aneg = -__expf(a.in[13][(j * 2 + dir) * NH + h]);
        const float dtb = a.in[12][(j * 2 + dir) * NH + h];
        float hs[32];
        if (is_lat) { const float* sp = a.in[2] + ((size_t)(((seq - 32) * 2 + j) * 2 + dir) * NH + h) * 8192 + p * 128 + nq;
#pragma unroll
            for (int e = 0; e < 32; ++e) hs[e] = sp[e]; }
        else {
#pragma unroll
            for (int e = 0; e < 32; ++e) hs[e] = 0.f; }
        asm volatile("s_waitcnt vmcnt(0)" ::: "memory"); __syncthreads();
        for (int ti = 0; ti < L; ++ti) {
            const int tok = tok0 + (dir == 0 ? ti : L - 1 - ti);
            const float raw = DT[(size_t)tok * 64 + dir * NH + h] + dtb;
            const float dt = raw > 20.f ? raw : log1pf(__expf(raw));
            const float dec = __expf(dt * Aneg);
            const float xv = bflo((unsigned)XBC[(size_t)tok * DXBC + h * 64 + p]);
            const bf16_t* Bp = XBC + (size_t)tok * DXBC + DI + g * 128 + nq;
            const bf16_t* Cp = XBC + (size_t)tok * DXBC + DI + 512 + g * 128 + nq;
            float y = 0.f;
#pragma unroll
            for (int e = 0; e < 32; ++e) { hs[e] = hs[e] * dec + dt * xv * bflo((unsigned)Bp[e]); y += bflo((unsigned)Cp[e]) * hs[e]; }
            y += __shfl_xor(y, 1); y += __shfl_xor(y, 2);
            if (dir == 0) { if ((c.tid & 3) == 0) YTMP[(size_t)tok * DI + h * 64 + p] = (bf16_t)(pk2(y, 0.f) & 0xffff); }
            else {
                const float yt = bflo((unsigned)YTMP[(size_t)tok * DI + h * 64 + p]);
                const float zz = bflo((unsigned)Z[(size_t)tok * DI + h * 64 + p]);
                float yy = (y + yt + Dh * xv) * silu_f(zz);
                __syncthreads();
                if ((c.tid & 3) == 0) { red[p] = yy * yy; YG[(size_t)tok * DI + h * 64 + p] = (bf16_t)(pk2(yy * nw, 0.f) & 0xffff); }
                __syncthreads();
                if (c.tid == 0) { float s = 0.f; for (int e = 0; e < 64; ++e) s += red[e]; SSQ[(size_t)tok * NH + h] = s; }
            }
        }
        if (!is_lat) { float* op = a.out + (size_t)NTOK * D + ((size_t)((seq * 2 + j) * 2 + dir) * NH + h) * 8192 + p * 128 + nq;
#pragma unroll
            for (int e = 0; e < 32; ++e) op[e] = hs[e]; }
    }
}
#endif
__device__ __forceinline__ void phase_scan(const Ctx& c, int j) {
#if NAIVE_SCAN
    for (int u = c.vb; u < 1088; u += c.G) { if (u < 64) scan_unit_naive(c, j, 32 + (u >> 5), u & 31); else scan_unit_naive(c, j, (u - 64) >> 5, (u - 64) & 31); }
    return;
#endif
    phase_scan_pipe(c, j);
}

typedef const Args __attribute__((address_space(4)))* ArgsP;
#if 0
#define LB_WAVES 1
#else
#define LB_WAVES 2
#endif
__global__ void __launch_bounds__(NTHR, LB_WAVES) fwd_kernel(Args args) {
    extern __shared__ __attribute__((aligned(16))) char lds[];
    volatile LAS unsigned* st = (volatile LAS unsigned*)(lds + LDS_BYTES - 16);
    if (threadIdx.x == 0) { st[0] = 0u; st[1] = 0u; }
    __syncthreads();
    const int ph_lo = args.ph_lo, ph_hi = args.ph_hi;
    const bool multi = (ph_hi - ph_lo) > 1;
    XcdBarrier bar; bar.bar = (unsigned*)(args.ws + WS_CTL); bar.x = 0; bar.st = st;
    if (multi) bar = xcd_barrier_post((unsigned*)(args.ws + WS_CTL), st);

    int rep = 0;
#pragma unroll 1
    for (int ph = ph_lo; ph < ph_hi; ++ph) {
        ArgsP ap = (ArgsP)__builtin_amdgcn_kernarg_segment_ptr();
        asm volatile("" : "+s"(ap));
        int tid = threadIdx.x;
        asm volatile("" : "+v"(tid));
        Ctx c;
        c.lds = lds; c.tid = tid; c.lane = tid & 63; c.wid = __builtin_amdgcn_readfirstlane(tid >> 6);
        c.G = gridDim.x; c.vb = (c.G % 8 == 0) ? (int)(blockIdx.x % 8) * (c.G / 8) + (int)(blockIdx.x / 8) : (int)blockIdx.x;
        c.a = ap;
        unsigned char* ws = ap->ws;
        const float* MOD = (const float*)(ws + WS_MOD);

        int kind = 0;
        if (ph == 0) { if (PH_ON(0)) phase_prep(c); }
        else if (ph == 1) { kind = 12; phase_prep2(c); }
        else if (ph == NPHASE - 1) { kind = 10; if (PH_ON(1)) phase_norm(c, ap->in[21], nullptr, 0, 0, true); }
        else {
            int layer, sub;
            if (ph <= 7) { layer = 0; sub = ph - 2; } else if (ph <= 12) { layer = 1; sub = ph - 8; } else if (ph <= 18) { layer = 2; sub = ph - 13; } else { layer = 3; sub = ph - 19; }
            const int j = layer >> 1;
            const float* mod = MOD + (size_t)layer * 3 * 6144;
            const bool ssd = (layer & 1) == 0;
            const int nmix = ssd ? 4 : 3;
            if (sub < nmix - 1) kind = ssd ? (sub == 0 ? 2 : sub == 1 ? 3 : 4) : (sub == 0 ? 6 : 7);
            else if (sub == nmix) kind = 8;
            else kind = 5;

            if (kind == 2) { if (PH_ON(2)) phase_inproj(c, j); }
            else if (kind == 3) { if (PH_ON(3)) phase_conv(c, j); }
            else if (kind == 4) { if (PH_ON(4)) phase_scan(c, j); }
            else if (kind == 6) { if (PH_ON(6)) phase_f1(c, j); }
            else if (kind == 7) { if (PH_ON(7)) phase_f2(c); }
            else if (kind == 8) { if (PH_ON(8)) phase_mlp_up(c, layer); }
            else {
                if (PH_ON(5)) {
                    const bf16_t* WT; const bf16_t* Act; int K; const float* gate; const float* bias = nullptr; const float* ssq = nullptr;
                    const float* nw_next; const float* scale_next;
                    if (sub == nmix - 1) {
                        gate = mod + 2048; nw_next = ap->in[8] + layer * D; scale_next = mod + 4096;
                        if (ssd) { WT = (const bf16_t*)(ws + WS_WOUT) + (size_t)j * D * DI; Act = (const bf16_t*)(ws + S_YG); K = DI; ssq = (const float*)(ws + S_SSQ); }
                        else { WT = (const bf16_t*)(ws + WS_WFNO) + (size_t)j * D * D; Act = (const bf16_t*)(ws + S_F); K = D; bias = ap->in[18] + j * D; }
                    } else {
                        gate = mod + 5120; WT = (const bf16_t*)(ws + WS_W2) + (size_t)layer * D * DFF; Act = (const bf16_t*)(ws + S_HID); K = DFF;
                        if (layer < 3) { nw_next = ap->in[7] + (layer + 1) * D; scale_next = mod + 3 * 6144 + 1024; } else { nw_next = nullptr; scale_next = nullptr; }
                    }
                    if (rep > 0) { gate = (const float*)(ws + WS_ZERO); }
                    phase_resid_gemm(c, WT, Act, K, gate, bias, ssq, nw_next, scale_next, layer == 0 && sub == nmix - 1 && rep == 0);
                }
            }
        }
        if (REP_KIND == 9) { for (int r = 0; r < REP_N; ++r) if (multi) xcd_barrier(bar); }
        if (REP_N > 0 && kind == REP_KIND && rep < REP_N) { ++rep; --ph; if (multi) xcd_barrier(bar); continue; }
        rep = 0;
        if (REP_KIND == 11 && ph == NPHASE - 1) { for (int r = 0; r < REP_N; ++r) { if (multi) xcd_barrier(bar); phase_bench(c); } }
        if (ph + 1 < ph_hi) xcd_barrier(bar);
    }
}

extern "C" void kernel_launch(void* const* d_in, const int* in_sizes, int n_in, void* d_out, int out_size, void* d_ws, size_t ws_size, hipStream_t stream) {
    static int grid = 0;
    if (grid == 0) {
        int dev = 0, cus = 0;
        if (hipGetDevice(&dev) != hipSuccess || hipDeviceGetAttribute(&cus, hipDeviceAttributeMultiprocessorCount, dev) != hipSuccess || cus <= 0) { fprintf(stderr, "kernel_launch: device query failed\n"); grid = -1; return; }
        if (hipFuncSetAttribute((const void*)fwd_kernel, hipFuncAttributeMaxDynamicSharedMemorySize, LDS_BYTES) != hipSuccess) { fprintf(stderr, "kernel_launch: hipFuncSetAttribute failed\n"); }
        (void)hipGetLastError();
        if (ws_size < WS_END) fprintf(stderr, "kernel_launch: workspace too small: %zu < %zu\n", ws_size, (size_t)WS_END);
        grid = cus;
    }
    if (grid < 0) return;
    (void)hipMemsetAsync((char*)d_ws + WS_CTL, 0, CTL_BYTES, stream);
    Args a{};
    for (int i = 0; i < 22; ++i) a.in[i] = (const float*)d_in[i];
    a.out = (float*)d_out; a.ws = (unsigned char*)d_ws;
#if N_LAUNCH_MODE == 1
    a.ph_lo = 0; a.ph_hi = NPHASE;
    hipLaunchKernelGGL(fwd_kernel, dim3(grid), dim3(NTHR), LDS_BYTES, stream, a);
#else
    for (int ph = 0; ph < NPHASE; ++ph) {
        a.ph_lo = ph; a.ph_hi = ph + 1;
        hipLaunchKernelGGL(fwd_kernel, dim3(grid), dim3(NTHR), LDS_BYTES, stream, a);
    }
#endif
}
```

```cpp
#include <hip/hip_runtime.h>
#include <stdint.h>
#include <stdio.h>

#ifndef PH_MASK
#define PH_MASK 0xFFFF
#endif
#define PH_ON(k) ((PH_MASK >> (k)) & 1)
#ifndef NAIVE_GEMM
#define NAIVE_GEMM 0
#endif
#define GN(k) ((NAIVE_GEMM >> (k)) & 1)
#ifndef NAIVE_SCAN
#define NAIVE_SCAN 0
#endif
#ifndef REP_KIND
#define REP_KIND -1
#endif
#ifndef REP_N
#define REP_N 0
#endif
#ifndef GEMM_INTERLEAVE
#define GEMM_INTERLEAVE 0
#endif
#ifndef GEMM_SETPRIO
#define GEMM_SETPRIO 0
#endif
#ifndef N_LAUNCH_MODE
#define N_LAUNCH_MODE 1
#endif

typedef unsigned short bf16_t;
typedef short bf16x8 __attribute__((ext_vector_type(8)));
typedef short bf16x4 __attribute__((ext_vector_type(4)));
typedef float f32x4 __attribute__((ext_vector_type(4)));
typedef unsigned u32x4 __attribute__((ext_vector_type(4)));
typedef unsigned u32x2 __attribute__((ext_vector_type(2)));
#define LAS __attribute__((address_space(3)))

constexpr int D = 1024, NCTX = 8192, NLAT = 2048, NTOK = 10240;
constexpr int DI = 2048, DXBC = 3072, DPROJ = 5184, NZX = 5120, NH = 32, DFF = 4096;
constexpr float EPS = 1e-6f;
constexpr int NPHASE = 25;

constexpr size_t al256(size_t x) { return (x + 255) & ~(size_t)255; }
constexpr size_t WS_CTL  = 0;
constexpr size_t CTL_BYTES = 65536 + 81920;
constexpr size_t WS_ZERO = 65536;
constexpr size_t WS_MOD  = WS_CTL + CTL_BYTES;
constexpr size_t WS_SWIN = al256(WS_MOD + 4 * 3 * 6144 * 4);
constexpr size_t WS_SWUP = WS_SWIN + 2 * 3 * DPROJ * 4;
constexpr size_t WS_SWF1 = WS_SWUP + 4 * 3 * DFF * 4;
constexpr size_t WS_RSS  = al256(WS_SWF1 + 2 * 3 * 2048 * 4);
constexpr size_t WS_WIN  = al256(WS_RSS + (size_t)NTOK * 16 * 4);
constexpr size_t WS_WOUT = WS_WIN + (size_t)2 * DPROJ * D * 2;
constexpr size_t WS_WFNO = WS_WOUT + (size_t)2 * D * DI * 2;
constexpr size_t WS_W1   = WS_WFNO + (size_t)2 * D * D * 2;
constexpr size_t WS_W2   = WS_W1 + (size_t)4 * DFF * D * 2;
constexpr size_t WS_T1   = WS_W2 + (size_t)4 * DFF * D * 2;
constexpr size_t WS_T2C  = WS_T1 + (size_t)512 * 256 * 2;
constexpr size_t WS_T2L  = WS_T2C + (size_t)256 * 512 * 2;
constexpr size_t WS_H    = WS_T2L + (size_t)1024 * 2048 * 2;
constexpr size_t WS_S    = WS_H + (size_t)NTOK * D * 2;
constexpr size_t S_Z     = WS_S;
constexpr size_t S_XBC   = S_Z + (size_t)NTOK * DI * 2;
constexpr size_t S_DT    = S_XBC + (size_t)NTOK * DXBC * 2;
constexpr size_t S_SSQ   = S_DT + (size_t)NTOK * 64 * 4;
constexpr size_t S_YG    = S_SSQ + (size_t)NTOK * 32 * 4;
constexpr size_t S_RAW   = S_YG + (size_t)NTOK * DI * 2;
constexpr size_t WS_END  = S_RAW + (size_t)NTOK * DXBC * 2;
constexpr size_t S_HID   = WS_S;
constexpr size_t S_UVT   = WS_S;
constexpr size_t S_F     = WS_S + (size_t)NTOK * 2048 * 2;

constexpr int LDS_BYTES = 163840;
constexpr int NTHR = 512, NWAVE = 8;

typedef __bf16 bf16x2_t __attribute__((ext_vector_type(2)));
typedef float f32x2_t __attribute__((ext_vector_type(2)));
__device__ __forceinline__ unsigned pk2(float lo, float hi) { const f32x2_t f = {lo, hi}; return __builtin_bit_cast(unsigned, __builtin_convertvector(f, bf16x2_t)); }
__device__ __forceinline__ float bflo(unsigned u) { return __uint_as_float(u << 16); }
__device__ __forceinline__ float bfhi(unsigned u) { return __uint_as_float(u & 0xffff0000u); }
__device__ __forceinline__ float wave_sum(float v) {
#pragma unroll
    for (int o = 1; o < 64; o <<= 1) v += __shfl_xor(v, o);
    return v;
}
__device__ __forceinline__ float silu_f(float x) { return x * __builtin_amdgcn_rcpf(1.0f + __expf(-x)); }
__device__ __forceinline__ int cond_of(int tok) { return tok < NCTX ? 0 : (tok < NCTX + 1024 ? 1 : 2); }

#define XB_TMO      128
#define XB_XCNT(j)  (256  + 64 * (j))
#define XB_XSUB(j)  (1280 + 64 * (j))
#define XB_XGEN(j)  (2304 + 64 * (j))
#define XB_TOP      3328
#define XB_TOPGEN   3392
#define XCD_BAR_WORDS 3456
#define XB_SPIN_CAP (1u << 20)
__device__ __forceinline__ unsigned xb_ld(unsigned* p)              { return __hip_atomic_load(p, __ATOMIC_RELAXED, __HIP_MEMORY_SCOPE_AGENT); }
__device__ __forceinline__ unsigned xb_add(unsigned* p, unsigned v) { return __hip_atomic_fetch_add(p, v, __ATOMIC_RELAXED, __HIP_MEMORY_SCOPE_AGENT); }
__device__ __forceinline__ unsigned xb_xcc_id() { return (unsigned)__builtin_amdgcn_s_getreg((3 << 11) | 20) & 0xFu; }
#define XB_SPIN(cond, bar) do { unsigned _sp = 0; while (cond) { __builtin_amdgcn_s_sleep(1); \
    if ((++_sp & 255u) == 0u) { if (xb_ld(&(bar)[XB_TMO])) break; if (_sp > XB_SPIN_CAP) { atomicAdd(&(bar)[XB_TMO], 1u); break; } } } } while (0)
struct XcdBarrier { unsigned* bar; unsigned x; volatile LAS unsigned* st; };
__device__ __forceinline__ XcdBarrier xcd_barrier_post(unsigned* bar, volatile LAS unsigned* st) {
    XcdBarrier b; b.bar = bar; b.x = xb_xcc_id(); b.st = st;
    if (threadIdx.x == 0) (void)xb_add(&bar[XB_XCNT(b.x)], 1u);
    return b;
}
__device__ __forceinline__ void xcd_barrier_complete(unsigned* bar, unsigned x, unsigned& nloc, unsigned& nx) {
    const unsigned G = gridDim.x * gridDim.y * gridDim.z;
    unsigned sum, cnt, mine, sp = 0u;
    for (;;) {
        sum = 0u; cnt = 0u; mine = 0u;
#pragma unroll
        for (unsigned j = 0; j < 16; ++j) { const unsigned c = xb_ld(&bar[XB_XCNT(j)]); sum += c; cnt += (c > 0u) ? 1u : 0u; mine = (j == x) ? c : mine; }
        if (sum == G) break;
        __builtin_amdgcn_s_sleep(1);
        if ((++sp & 255u) == 0u) { if (xb_ld(&bar[XB_TMO])) break; if (sp > XB_SPIN_CAP) { atomicAdd(&bar[XB_TMO], 1u); break; } }
    }
    nloc = mine > 0u ? mine : 1u; nx = cnt > 0u ? cnt : 1u;
}
__device__ __forceinline__ void xcd_barrier(const XcdBarrier& b) {
    asm volatile("s_waitcnt vmcnt(0)" ::: "memory");
    __syncthreads();
    if (threadIdx.x == 0) {
        unsigned* bar = b.bar;
        __builtin_amdgcn_s_waitcnt(0);
        unsigned nloc = b.st[0], nx = b.st[1];
        if (nloc == 0u) { xcd_barrier_complete(bar, b.x, nloc, nx); b.st[0] = nloc; b.st[1] = nx; }
        const unsigned old = xb_add(&bar[XB_XSUB(b.x)], 1u);
        const unsigned gen = old / nloc;
        if (old + 1u == (gen + 1u) * nloc) {
            __builtin_amdgcn_fence(__ATOMIC_RELEASE, "agent");
            asm volatile("s_waitcnt vmcnt(0)" ::: "memory");
            const unsigned og = xb_add(&bar[XB_TOP], 1u);
            const unsigned tg = og / nx;
            if (og + 1u == (tg + 1u) * nx) xb_add(&bar[XB_TOPGEN], 1u);
            else XB_SPIN(xb_ld(&bar[XB_TOPGEN]) == tg, bar);
            __builtin_amdgcn_fence(__ATOMIC_ACQUIRE, "agent");
            xb_add(&bar[XB_XGEN(b.x)], 1u);
            asm volatile("s_waitcnt vmcnt(0)" ::: "memory");
        } else {
            XB_SPIN(xb_ld(&bar[XB_XGEN(b.x)]) == gen, bar);
            __builtin_amdgcn_fence(__ATOMIC_ACQUIRE, "agent");
            asm volatile("s_waitcnt vmcnt(0)" ::: "memory");
        }
    }
    __syncthreads();
}

struct Args {
    const float* in[22];
    float* out;
    unsigned char* ws;
    int ph_lo, ph_hi;
};

struct Ctx {
    char* lds;
    int tid, lane, wid;
    int vb, G;
    const Args __attribute__((address_space(4)))* a;
};

template <int TB> struct GT { static constexpr int ROWS = 256 + 32 * TB, STAGE = ROWS * 128, NI = ROWS / 8; };

template <int TB>
__device__ __forceinline__ void gemm_stage(char* st, const bf16_t* Ag, int lda, const bf16_t* Bg, int ldb, int k0, int wid, int lane) {
    constexpr int NI = GT<TB>::NI;
    const int rsub = lane >> 3, lch = (lane & 7) ^ rsub;
#pragma unroll
    for (int i = 0; i < (NI + 7) / 8; ++i) {
        const int q = wid + 8 * i;
        if (q < NI) {
            const int row = q * 8 + rsub;
            const bf16_t* src = (q < 32) ? (Ag + (size_t)row * lda + k0 + lch * 8) : (Bg + (size_t)(row - 256) * ldb + k0 + lch * 8);
            __builtin_amdgcn_global_load_lds((const unsigned*)src, (LAS unsigned*)(st + q * 1024 + lane * 16), 16, 0, 0);
        }
    }
}
__device__ __forceinline__ bf16x8 frag128(const char* tile, int row, int chunk) {
    return *(const bf16x8*)(tile + row * 128 + ((chunk ^ (row & 7)) << 4));
}

struct NoPre { __device__ __forceinline__ void operator()() const {} };
template <int TB, bool NAIVE, class Epi, class Pre = NoPre>
__device__ __forceinline__ void gemm_tile(const Ctx& c, const bf16_t* Ag, int lda, const bf16_t* Bg, int ldb, int K, int a0, int b0, const Epi& epi, const Pre& pre = Pre(),
                                          bool prefetched = false, const bf16_t* An = nullptr, const bf16_t* Bn = nullptr) {
    constexpr int STAGE = GT<TB>::STAGE;
    const int wr = c.wid >> 1, wc = c.wid & 1, fr = c.lane & 15, fq = c.lane >> 4;
    f32x4 acc[4][TB];
#pragma unroll
    for (int i = 0; i < 4; ++i)
#pragma unroll
        for (int j = 0; j < TB; ++j) acc[i][j] = (f32x4){0.f, 0.f, 0.f, 0.f};
    if (NAIVE) {
        __syncthreads(); pre(); __syncthreads();
        const bf16_t* ar = Ag + (size_t)(wr * 64 + fq * 4) * lda;
        const bf16_t* br = Bg + (size_t)(wc * 16 * TB + fr) * ldb;
#pragma unroll
        for (int j = 0; j < TB; ++j) {
#pragma unroll 1
            for (int k = 0; k < K; k += 8) {
                float bv[8];
                { const u32x4 v = *(const u32x4*)(br + (size_t)(j * 16) * ldb + k);
#pragma unroll
                  for (int e = 0; e < 4; ++e) { bv[2 * e] = bflo(v[e]); bv[2 * e + 1] = bfhi(v[e]); } }
#pragma unroll
                for (int i = 0; i < 4; ++i)
#pragma unroll
                    for (int r = 0; r < 4; ++r) {
                        const u32x4 v = *(const u32x4*)(ar + (size_t)(i * 16 + r) * lda + k);
#pragma unroll
                        for (int e = 0; e < 4; ++e) acc[i][j][r] += bflo(v[e]) * bv[2 * e] + bfhi(v[e]) * bv[2 * e + 1];
                    }
                asm volatile("" ::: "memory");
            }
        }
        epi(acc, a0 + wr * 64, b0 + wc * (16 * TB), fr, fq);
        return;
    }
    const int nt = K >> 6;
    __syncthreads();
    if (!prefetched) gemm_stage<TB>(c.lds, Ag, lda, Bg, ldb, 0, c.wid, c.lane);
    pre();
    for (int t = 0; t < nt; ++t) {
        asm volatile("s_waitcnt vmcnt(0)" ::: "memory");
        __syncthreads();
        const char* cur = c.lds + (t & 1) * STAGE;
        if (t + 1 < nt) gemm_stage<TB>(c.lds + ((t + 1) & 1) * STAGE, Ag, lda, Bg, ldb, (t + 1) << 6, c.wid, c.lane);
        else if (An) gemm_stage<TB>(c.lds, An, lda, Bn, ldb, 0, c.wid, c.lane);
#pragma unroll
        for (int kk = 0; kk < 2; ++kk) {
            bf16x8 af[4], bfr[TB];
#pragma unroll
            for (int i = 0; i < 4; ++i) af[i] = frag128(cur, wr * 64 + i * 16 + fr, kk * 4 + fq);
#pragma unroll
            for (int j = 0; j < TB; ++j) bfr[j] = frag128(cur, 256 + wc * (16 * TB) + j * 16 + fr, kk * 4 + fq);
#pragma unroll
            for (int i = 0; i < 4; ++i)
#pragma unroll
                for (int j = 0; j < TB; ++j) acc[i][j] = __builtin_amdgcn_mfma_f32_16x16x32_bf16(af[i], bfr[j], acc[i][j], 0, 0, 0);
        }
    }
    epi(acc, a0 + wr * 64, b0 + wc * (16 * TB), fr, fq);
}

template <int TB, class Prob, int BENCH = 0>
__device__ __forceinline__ void gemm_stream(const Ctx& c, const Prob& P) {
    constexpr int STAGE = GT<TB>::STAGE, NI = GT<TB>::NI;
    constexpr int NSLOT = (NI + 7) / 8;
    const int wr = c.wid >> 1, wc = c.wid & 1, fr = c.lane & 15, fq = c.lane >> 4;
    const int n = P.count();
    if (n <= 0) return;
    f32x4 acc[4][TB];
#pragma unroll
    for (int i = 0; i < 4; ++i)
#pragma unroll
        for (int j = 0; j < TB; ++j) acc[i][j] = (f32x4){0.f, 0.f, 0.f, 0.f};
    const int KT = P.K >> 6;
    const int total = n * KT;
    const int rsub = c.lane >> 3, lch = (c.lane & 7) ^ rsub;
    int voff[NSLOT], qs[NSLOT];
#pragma unroll
    for (int s = 0; s < NSLOT; ++s) {
        const int q = (c.wid + 8 * s < NI) ? c.wid + 8 * s : NI - 1;
        qs[s] = q;
        voff[s] = (s < 4) ? ((q * 8 + rsub) * P.lda + lch * 8) : ((q * 8 + rsub - 256) * P.ldb + lch * 8);
    }
    const bf16_t* Acur; const bf16_t* Bcur;
    int li = 0, lk = 0;
    P.tile(0, Acur, Bcur);
    constexpr int Q0 = (NSLOT + 3) / 4, Q1 = Q0 + (NSLOT + 2) / 4, Q2 = Q1 + (NSLOT + 1) / 4;
    constexpr int S1 = Q1;
    auto issue_part = [&](int stage, int s0, int s1) {
        char* st = c.lds + stage * STAGE;
#pragma unroll
        for (int s = 0; s < NSLOT; ++s) {
            if (s >= s0 && s < s1) {
                const bf16_t* src = ((s < 4) ? Acur : Bcur) + voff[s] + lk * 64;
                __builtin_amdgcn_global_load_lds((const unsigned*)src, (LAS unsigned*)(st + qs[s] * 1024 + c.lane * 16), 16, 0, 0);
            }
        }
    };
    auto issue = [&](int stage) { issue_part(stage, 0, NSLOT); };
    auto advance = [&]() { if (++lk == KT) { lk = 0; if (li + 1 < n) { ++li; P.tile(li, Acur, Bcur); } } };
    asm volatile("s_waitcnt vmcnt(0)" ::: "memory");
    __builtin_amdgcn_s_barrier();
    asm volatile("" ::: "memory");
    issue(0); advance(); issue(1); advance();
    P.pre_all();
    int ci = 0, ck = 0, stg = 0;
#define GEMM_WAIT_ONE_STAGE() do { if (BENCH == 1) { asm volatile("s_waitcnt vmcnt(0)" ::: "memory"); } \
        else if (after_epi) { asm volatile("s_waitcnt vmcnt(%0)" :: "n"(S1 + Prob::EPI_STORES) : "memory"); } \
        else { asm volatile("s_waitcnt vmcnt(%0)" :: "n"(S1) : "memory"); } } while (0)
    bool after_epi = false;
#define GEMM_BAR() do { asm volatile("" ::: "memory"); __builtin_amdgcn_s_barrier(); asm volatile("" ::: "memory"); } while (0)
#define GEMM_LOADF(dst, stage_ptr, kk) do { \
        _Pragma("unroll") for (int i = 0; i < 4; ++i) dst.a[i] = frag128(stage_ptr, wr * 64 + i * 16 + fr, (kk) * 4 + fq); \
        _Pragma("unroll") for (int jj = 0; jj < TB; ++jj) dst.b[jj] = frag128(stage_ptr, 256 + wc * (16 * TB) + jj * 16 + fr, (kk) * 4 + fq); } while (0)
#define GEMM_MMA(src_) do { \
        _Pragma("unroll") for (int i = 0; i < 4; ++i) \
        _Pragma("unroll") for (int jj = 0; jj < TB; ++jj) acc[i][jj] = __builtin_amdgcn_mfma_f32_16x16x32_bf16(src_.a[i], src_.b[jj], acc[i][jj], 0, 0, 0); } while (0)
    struct Frags { bf16x8 a[4]; bf16x8 b[TB]; };
    Frags f0, f1;
    if (BENCH == 1) { asm volatile("s_waitcnt vmcnt(0)" ::: "memory"); } else { asm volatile("s_waitcnt vmcnt(%0)" :: "n"(NSLOT) : "memory"); }
    GEMM_BAR();
    GEMM_LOADF(f0, c.lds, 0);
    f32x4 sw[4];
#pragma unroll
    for (int i = 0; i < 4; ++i) sw[i] = (f32x4){0.f, 0.f, 0.f, 0.f};
#pragma unroll 1
    for (int gs = 0; gs < total; ++gs) {
        const char* cur = c.lds + stg * STAGE;
        const int nst1 = stg == 2 ? 0 : stg + 1;
        if (ck == KT - 1) P.preload(ci, sw, wr, fq);
        if (BENCH != 2) GEMM_LOADF(f1, cur, 1);
        const int nst2 = stg == 0 ? 2 : stg - 1;
        if (BENCH != 1) issue_part(nst2, 0, Q0);
        if (BENCH != 2) GEMM_MMA(f0);
#if GEMM_INTERLEAVE
        __builtin_amdgcn_sched_group_barrier(0x100, 4 + TB, 0);
#pragma unroll
        for (int s = 0; s < NSLOT; ++s) {
            __builtin_amdgcn_sched_group_barrier(0x008, 2, 0);
            __builtin_amdgcn_sched_group_barrier(0x006, 6, 0);
            __builtin_amdgcn_sched_group_barrier(0x010, 1, 0);
        }
        __builtin_amdgcn_sched_group_barrier(0x008, 4 * TB - 2 * NSLOT, 0);
#endif
        if (BENCH != 1) issue_part(nst2, Q0, Q1);
        GEMM_WAIT_ONE_STAGE();
        after_epi = false;
        asm volatile("s_waitcnt lgkmcnt(0)" ::: "memory");
        GEMM_BAR();
        if (BENCH != 1) issue_part(nst2, Q1, Q2);
        if (BENCH != 2) GEMM_LOADF(f0, c.lds + nst1 * STAGE, 0);
#if GEMM_SETPRIO
        __builtin_amdgcn_s_setprio(1);
#endif
        if (BENCH != 2) GEMM_MMA(f1);
#if GEMM_SETPRIO
        __builtin_amdgcn_s_setprio(0);
#endif
        if (BENCH != 1) issue_part(nst2, Q2, NSLOT);
        stg = nst1;
        advance();
        if (++ck == KT) {
            P.epilogue(ci, acc, sw, wr, wc, fr, fq);
#pragma unroll
            for (int i = 0; i < 4; ++i)
#pragma unroll
                for (int j = 0; j < TB; ++j) acc[i][j] = (f32x4){0.f, 0.f, 0.f, 0.f};
            ck = 0; ++ci;
            after_epi = true;
        }
    }
    asm volatile("s_waitcnt vmcnt(0)" ::: "memory");
    GEMM_BAR();
#undef GEMM_WAIT_ONE_STAGE
#undef GEMM_BAR
#undef GEMM_LOADF
#undef GEMM_MMA
}

__device__ __forceinline__ u32x4 pair16(const u32x2& a, const u32x2& b) {
    const auto sx = __builtin_amdgcn_permlane16_swap(a.x, b.x, false, false);
    const auto sy = __builtin_amdgcn_permlane16_swap(a.y, b.y, false, false);
    return (u32x4){sx[0], sy[0], sx[1], sy[1]};
}
struct EpiInProj {
    bf16_t* Z; bf16_t* RAW; const float* rsx  ; int tok_base; const float* SW  ; bool uni  ;
    __device__ __forceinline__ void operator()(f32x4 (&acc)[4][5], const f32x4 (&swp)[4], int ab, int bb, int fr, int fq) const {
#pragma unroll
        for (int j = 0; j < 5; ++j) {
            const int tok = bb + j * 16 + fr;
            const float rs = rsx[tok - tok_base];
            const float* sw = SW + cond_of(tok) * DPROJ;
            u32x2 v[4];
#pragma unroll
            for (int i = 0; i < 4; ++i) {
                const int n = ab + i * 16 + fq * 4;
                const f32x4 o = acc[i][j] * rs + (uni ? swp[i] : *(const f32x4*)(sw + n));
                v[i].x = pk2(o[0], o[1]); v[i].y = pk2(o[2], o[3]);
            }
#pragma unroll
            for (int p = 0; p < 2; ++p) {
                const u32x4 o = pair16(v[2 * p], v[2 * p + 1]);
                const int n = ab + (2 * p + (fq & 1)) * 16 + (fq & 2) * 4;
                bf16_t* dst = (n < DI) ? (Z + (size_t)tok * DI + n) : (RAW + (size_t)tok * DXBC + (n - DI));
                *(u32x4*)dst = o;
            }
        }
    }
};
struct EpiResid {
    float* X; const float* gate  ; const float* bias; const float* rs_lds  ; int tok_base;
    const float* Xin0; const float* Xin1;
    bf16_t* XG  ; const float* nw_next; const float* scale_next  ; float* RSS; const float* zeros  ;
    __device__ __forceinline__ void operator()(f32x4 (&acc)[4][5], int ab, int bb, int fr, int fq) const {
        const int slot = (ab >> 6);
        const bool uni = cond_of(bb) == cond_of(bb + 79);
        const int nb = ab + fq * 4;
        f32x4 gvv[4], bvv[4], gnn[4];
        auto load_vecs = [&](int cd) {
            const float* gp = gate + cd * 6144 + nb;
            const float* bp = (bias ? bias : zeros) + nb;
            const float* np = (XG ? nw_next : zeros) + nb;
            const float* sp = (XG ? scale_next + cd * 6144 : zeros) + nb;
            f32x4 t0[4], t1[4];
#pragma unroll
            for (int i = 0; i < 4; ++i) { gvv[i] = *(const f32x4*)(gp + i * 16); bvv[i] = *(const f32x4*)(bp + i * 16); t0[i] = *(const f32x4*)(np + i * 16); t1[i] = *(const f32x4*)(sp + i * 16); }
#pragma unroll
            for (int i = 0; i < 4; ++i) gnn[i] = t0[i] * (t1[i] + 1.0f);
        };
        if (uni) load_vecs(cond_of(bb));
        auto xrow = [&](int tok) -> const float* { return (Xin0 ? (tok < NCTX ? Xin0 + (size_t)tok * D : Xin1 + (size_t)(tok - NCTX) * D) : X + (size_t)tok * D) + nb; };
        f32x4 xv[4];
#pragma unroll
        for (int j = 0; j < 5; ++j) {
            const int tok = bb + j * 16 + fr;
            { const float* p = xrow(tok);
#pragma unroll
              for (int i = 0; i < 4; ++i) xv[i] = *(const f32x4*)(p + i * 16); }
            const float rs = rs_lds ? rs_lds[tok - tok_base] : 1.0f;
            if (!uni) load_vecs(cond_of(tok));
            float ss = 0.f;
            u32x2 xgv[4];
            float* xo = X + (size_t)tok * D + nb;
#pragma unroll
            for (int i = 0; i < 4; ++i) {
                const f32x4 x2 = xv[i] + gvv[i] * (acc[i][j] * rs + bvv[i]);
                *(f32x4*)(xo + i * 16) = x2;
                ss += x2[0] * x2[0] + x2[1] * x2[1] + x2[2] * x2[2] + x2[3] * x2[3];
                const f32x4 o = x2 * gnn[i];
                xgv[i].x = pk2(o[0], o[1]); xgv[i].y = pk2(o[2], o[3]);
            }
            if (XG) {
#pragma unroll
                for (int p = 0; p < 2; ++p) {
                    const u32x4 o = pair16(xgv[2 * p], xgv[2 * p + 1]);
                    *(u32x4*)(XG + (size_t)tok * D + ab + (2 * p + (fq & 1)) * 16 + (fq & 2) * 4) = o;
                }
                ss += __shfl_xor(ss, 16); ss += __shfl_xor(ss, 32);
                if (fq == 0) RSS[(size_t)tok * 16 + slot] = ss;
            }
        }
    }
};
struct EpiMlpUp {
    bf16_t* HID; const float* rsx; int tok_base; const float* SW  ; bool uni;
    __device__ __forceinline__ void operator()(f32x4 (&acc)[4][5], const f32x4 (&swp)[4], int ab, int bb, int fr, int fq) const {
#pragma unroll
        for (int j = 0; j < 5; ++j) {
            const int tok = bb + j * 16 + fr;
            const float rs = rsx[tok - tok_base];
            const float* sw = SW + cond_of(tok) * DFF;
            u32x2 v[4];
#pragma unroll
            for (int i = 0; i < 4; ++i) {
                const int n = ab + i * 16 + fq * 4;
                f32x4 a = acc[i][j] * rs + (uni ? swp[i] : *(const f32x4*)(sw + n));
                a[0] = fmaxf(a[0], 0.f); a[1] = fmaxf(a[1], 0.f); a[2] = fmaxf(a[2], 0.f); a[3] = fmaxf(a[3], 0.f);
                v[i].x = pk2(a[0] * a[0], a[1] * a[1]); v[i].y = pk2(a[2] * a[2], a[3] * a[3]);
            }
#pragma unroll
            for (int p = 0; p < 2; ++p) {
                const u32x4 o = pair16(v[2 * p], v[2 * p + 1]);
                *(u32x4*)(HID + (size_t)tok * DFF + ab + (2 * p + (fq & 1)) * 16 + (fq & 2) * 4) = o;
            }
        }
    }
};
struct EpiDt {
    float* DT; const float* rsx; int tok_base; const float* SW  ;
    __device__ __forceinline__ void operator()(f32x4 (&acc)[4][2], int ab, int bb, int fr, int fq) const {
#pragma unroll
        for (int j = 0; j < 2; ++j) {
            const int col = bb + j * 16 + fr;
#pragma unroll
            for (int i = 0; i < 4; ++i) {
                const int tok = ab + i * 16 + fq * 4;
#pragma unroll
                for (int r = 0; r < 4; ++r) DT[(size_t)(tok + r) * 64 + col] = acc[i][j][r] * rsx[tok + r - tok_base] + SW[cond_of(tok + r) * DPROJ + NZX + col];
            }
        }
    }
};
struct EpiF1 {
    bf16_t* UVT; int g; const float* rsx; int tok_base; const float* SW  ;
    __device__ __forceinline__ void operator()(f32x4 (&acc)[4][4], int ab, int bb, int fr, int fq) const {
#pragma unroll
        for (int j = 0; j < 4; ++j) {
            const int nn = bb + j * 16 + fr, part = nn >> 8, ch = g * 256 + (nn & 255);
#pragma unroll
            for (int i = 0; i < 4; ++i) {
                const int tok = ab + i * 16 + fq * 4;
                const float sw = SW[cond_of(tok) * 2048 + g * 512 + nn];
                bf16_t* dst;
                if (tok < NCTX) { const int s = tok >> 8, l = tok & 255; dst = UVT + ((size_t)(s * 1024 + ch) * 512 + part * 256 + l); }
                else { const int tt = tok - NCTX, s = tt >> 10, l = tt & 1023; dst = UVT + (size_t)NCTX * 2048 + ((size_t)(s * 1024 + ch) * 2048 + part * 1024 + l); }
                const f32x4 r4 = *(const f32x4*)(rsx + tok - tok_base);
                const f32x4 o = acc[i][j] * r4 + sw;
                u32x2 v; v.x = pk2(o[0], o[1]); v.y = pk2(o[2], o[3]);
                *(u32x2*)dst = v;
            }
        }
    }
};
template <int TB> struct EpiF2 {
    bf16_t* F; int tok0;
    __device__ __forceinline__ void operator()(f32x4 (&acc)[4][TB], int ab, int bb, int fr, int fq) const {
#pragma unroll
        for (int j = 0; j < TB; ++j) {
            const int tok = tok0 + bb + j * 16 + fr;
#pragma unroll
            for (int i = 0; i < 4; ++i) {
                const int n = ab + i * 16 + fq * 4;
                u32x2 v; v.x = pk2(acc[i][j][0], acc[i][j][1]); v.y = pk2(acc[i][j][2], acc[i][j][3]);
                *(u32x2*)(F + (size_t)tok * D + n) = v;
            }
        }
    }
};

struct TrItem { const float* W; bf16_t* WT; int K, N, k0, n0; };
__device__ __forceinline__ TrItem transpose_decode(const Ctx& c, int r) {
    const Args __attribute__((address_space(4)))& a = *c.a;
    constexpr int I_WIN = 8 * 81, I_WOUT = 16 * 16, I_FNO = 8 * 16, I_W1 = 8 * 64, I_W2 = 32 * 16;
    TrItem t; int item;
    if (r < 2 * I_WIN) { const int j = r / I_WIN; t.W = a.in[9] + (size_t)j * D * DPROJ; t.K = D; t.N = DPROJ; t.WT = (bf16_t*)(a.ws + WS_WIN) + (size_t)j * DPROJ * D; item = r - j * I_WIN; }
    else if ((r -= 2 * I_WIN) < 2 * I_WOUT) { const int j = r / I_WOUT; t.W = a.in[16] + (size_t)j * DI * D; t.K = DI; t.N = D; t.WT = (bf16_t*)(a.ws + WS_WOUT) + (size_t)j * D * DI; item = r - j * I_WOUT; }
    else if ((r -= 2 * I_WOUT) < 2 * I_FNO) { const int j = r / I_FNO; t.W = a.in[17] + (size_t)j * D * D; t.K = D; t.N = D; t.WT = (bf16_t*)(a.ws + WS_WFNO) + (size_t)j * D * D; item = r - j * I_FNO; }
    else if ((r -= 2 * I_FNO) < 4 * I_W1) { const int j = r / I_W1; t.W = a.in[19] + (size_t)j * D * DFF; t.K = D; t.N = DFF; t.WT = (bf16_t*)(a.ws + WS_W1) + (size_t)j * DFF * D; item = r - j * I_W1; }
    else { r -= 4 * I_W1; const int j = r / I_W2; t.W = a.in[20] + (size_t)j * DFF * D; t.K = DFF; t.N = D; t.WT = (bf16_t*)(a.ws + WS_W2) + (size_t)j * D * DFF; item = r - j * I_W2; }
    const int nb = t.N >> 6, kb = item / nb, nbi = item - kb * nb;
    t.k0 = kb * 128; t.n0 = nbi * 64;
    return t;
}
__device__ __forceinline__ void transpose_load(const Ctx& c, const TrItem& t, f32x4 (&v)[4]) {
    const int cl = c.tid & 15, rl = c.tid >> 4;
#pragma unroll
    for (int p = 0; p < 4; ++p) v[p] = *(const f32x4*)(t.W + (size_t)(t.k0 + p * 32 + rl) * t.N + t.n0 + cl * 4);
}
__device__ __forceinline__ void transpose_finish(const Ctx& c, const TrItem& t, const f32x4 (&v)[4]) {
    float* tile = (float*)c.lds;
    const int cl = c.tid & 15, rl = c.tid >> 4;
    __syncthreads();
#pragma unroll
    for (int p = 0; p < 4; ++p) { const int k = p * 32 + rl; tile[k * 65 + cl * 4 + 0] = v[p][0]; tile[k * 65 + cl * 4 + 1] = v[p][1]; tile[k * 65 + cl * 4 + 2] = v[p][2]; tile[k * 65 + cl * 4 + 3] = v[p][3]; }
    __syncthreads();
#pragma unroll
    for (int p = 0; p < 2; ++p) {
        const int idx = c.tid + p * NTHR, n = idx >> 4, kc = idx & 15;
        const float* s = tile + (kc * 8) * 65 + n;
        u32x4 o; o.x = pk2(s[0], s[65]); o.y = pk2(s[2 * 65], s[3 * 65]); o.z = pk2(s[4 * 65], s[5 * 65]); o.w = pk2(s[6 * 65], s[7 * 65]);
        *(u32x4*)(t.WT + (size_t)(t.n0 + n) * t.K + t.k0 + kc * 8) = o;
    }
}

__device__ __forceinline__ void ada_item(const Ctx& c, int item) {
    const Args __attribute__((address_space(4)))& a = *c.a;
    const int layer = item / 96, cg = item - layer * 96, n0 = cg * 64;
    const float* W = a.in[5] + (size_t)layer * D * 6144;
    const float* sc = (const float*)(c.lds + 40960);
    float* red = (float*)c.lds;
    const int cl = c.tid & 15, kl = c.tid >> 4;
    f32x4 a0 = {0, 0, 0, 0}, a1 = {0, 0, 0, 0}, a2 = {0, 0, 0, 0};
#pragma unroll 8
    for (int it = 0; it < 32; ++it) {
        const int k = it * 32 + kl;
        const f32x4 w = *(const f32x4*)(W + (size_t)k * 6144 + n0 + cl * 4);
        a0 += w * sc[k]; a1 += w * sc[1024 + k]; a2 += w * sc[2048 + k];
    }
    __syncthreads();
    *(f32x4*)(red + (kl * 3 + 0) * 64 + cl * 4) = a0;
    *(f32x4*)(red + (kl * 3 + 1) * 64 + cl * 4) = a1;
    *(f32x4*)(red + (kl * 3 + 2) * 64 + cl * 4) = a2;
    __syncthreads();
    if (c.tid < 192) {
        const int cond = c.tid >> 6, col = c.tid & 63;
        float s = 0.f;
#pragma unroll
        for (int k = 0; k < 32; ++k) s += red[(k * 3 + cond) * 64 + col];
        s += a.in[6][layer * 6144 + n0 + col];
        ((float*)(a.ws + WS_MOD))[(layer * 3 + cond) * 6144 + n0 + col] = s;
    }
}

__device__ __forceinline__ void phase_prep(const Ctx& c) {
    const Args __attribute__((address_space(4)))& a = *c.a;
    {
        float* sc = (float*)(c.lds + 40960);
        for (int i = c.tid; i < 3072; i += NTHR) {
            const int cond = i >> 10, k = i & 1023;
            const float v = cond == 0 ? a.in[4][k] : a.in[3][(cond - 1) * 1024 + k];
            sc[i] = silu_f(v);
        }
        __syncthreads();
    }
    constexpr int I_ADA = 384;
    constexpr int I_TR = 2 * 8 * 81 + 2 * 16 * 16 + 2 * 8 * 16 + 4 * 8 * 64 + 4 * 32 * 16;
    constexpr int I_TB = 32 + 32 + 512;
    for (int it = c.vb; it < I_ADA; it += c.G) ada_item(c, it);
    {
        int it = c.vb;
        if (it < I_TR) {
            TrItem cur = transpose_decode(c, it);
            f32x4 v[4]; transpose_load(c, cur, v);
            for (;;) {
                const int nit = it + c.G;
                TrItem nxt = cur; f32x4 vn[4];
                const bool has = nit < I_TR;
                if (has) { nxt = transpose_decode(c, nit); transpose_load(c, nxt, vn); }
                transpose_finish(c, cur, v);
                if (!has) break;
                cur = nxt; it = nit;
#pragma unroll
                for (int p = 0; p < 4; ++p) v[p] = vn[p];
            }
        }
    }
    for (int r = c.vb; r < I_TB; r += c.G) {
#pragma unroll 4
        for (int e = 0; e < 8; ++e) {
            int idx = r * 4096 + e * NTHR + c.tid;
            if (idx < 131072) {
                const int nn = idx >> 8, cc = idx & 255, m = nn & 255, ph = (m * cc) & 255;
                const float ang = (float)ph * (1.0f / 128.0f);
                const float v = nn < 256 ? cospif(ang) : sinpif(ang);
                ((bf16_t*)(a.ws + WS_T1))[idx] = (bf16_t)(pk2(v, 0.f) & 0xffff);
            } else if (idx < 262144) {
                idx -= 131072;
                const int k = idx >> 9, k2 = idx & 511, l = k2 & 255, ph = (k * l) & 255;
                const float ang = (float)ph * (1.0f / 128.0f);
                const float v = (k2 < 256 ? cospif(ang) : -sinpif(ang)) * (1.0f / 256.0f);
                ((bf16_t*)(a.ws + WS_T2C))[idx] = (bf16_t)(pk2(v, 0.f) & 0xffff);
            } else {
                idx -= 262144;
                const int k = idx >> 11, k2 = idx & 2047, l = k2 & 1023, ph = (k * l) & 1023;
                const float ang = (float)ph * (1.0f / 512.0f);
                const float v = (k2 < 1024 ? cospif(ang) : -sinpif(ang)) * (1.0f / 512.0f);
                ((bf16_t*)(a.ws + WS_T2L))[idx] = (bf16_t)(pk2(v, 0.f) & 0xffff);
            }
        }
    }
}

__device__ __forceinline__ void phase_prep2(const Ctx& c) {
    const Args __attribute__((address_space(4)))& a = *c.a;
    const float* MOD = (const float*)(a.ws + WS_MOD);
    float* sh = (float*)c.lds;
    const int gw = c.vb * NWAVE + c.wid, NGW = c.G * NWAVE;
#pragma unroll 1
    for (int v = 0; v < 8; ++v) {
        const int layer = v >> 1, mlp = v & 1, jj = layer >> 1, fnet = (layer & 1) && !mlp;
        __syncthreads();
        for (int i = c.tid; i < 3072; i += NTHR) sh[i] = MOD[(size_t)(layer * 3 + (i >> 10)) * 6144 + (mlp ? 3072 : 0) + (i & 1023)];
        __syncthreads();
        const bf16_t* W; float* out; int N, ostride;
        if (mlp) { W = (const bf16_t*)(a.ws + WS_W1) + (size_t)layer * DFF * D; N = DFF; out = (float*)(a.ws + WS_SWUP) + (size_t)layer * 3 * DFF; ostride = DFF; }
        else if (fnet) { W = (const bf16_t*)(a.ws + WS_T1); N = 2048; out = (float*)(a.ws + WS_SWF1) + (size_t)jj * 3 * 2048; ostride = 2048; }
        else { W = (const bf16_t*)(a.ws + WS_WIN) + (size_t)jj * DPROJ * D; N = DPROJ; out = (float*)(a.ws + WS_SWIN) + (size_t)jj * 3 * DPROJ; ostride = DPROJ; }
        for (int n = gw; n < N; n += NGW) {
            float s0 = 0.f, s1 = 0.f, s2 = 0.f;
            if (fnet) {
                const int g = n >> 9, nn = n & 511;
                if (c.lane < 32) {
                    const u32x4 w = *(const u32x4*)(W + (size_t)nn * 256 + c.lane * 8);
                    const int k = g * 256 + c.lane * 8;
#pragma unroll
                    for (int e = 0; e < 4; ++e) {
                        const float wl = bflo(w[e]), wh = bfhi(w[e]);
                        s0 += wl * sh[k + 2 * e] + wh * sh[k + 2 * e + 1];
                        s1 += wl * sh[1024 + k + 2 * e] + wh * sh[1024 + k + 2 * e + 1];
                        s2 += wl * sh[2048 + k + 2 * e] + wh * sh[2048 + k + 2 * e + 1];
                    }
                }
            } else {
#pragma unroll
                for (int p = 0; p < 2; ++p) {
                    const int k = p * 512 + c.lane * 8;
                    const u32x4 w = *(const u32x4*)(W + (size_t)n * D + k);
#pragma unroll
                    for (int e = 0; e < 4; ++e) {
                        const float wl = bflo(w[e]), wh = bfhi(w[e]);
                        s0 += wl * sh[k + 2 * e] + wh * sh[k + 2 * e + 1];
                        s1 += wl * sh[1024 + k + 2 * e] + wh * sh[1024 + k + 2 * e + 1];
                        s2 += wl * sh[2048 + k + 2 * e] + wh * sh[2048 + k + 2 * e + 1];
                    }
                }
            }
            s0 = wave_sum(s0); s1 = wave_sum(s1); s2 = wave_sum(s2);
            if (c.lane == 0) { out[n] = s0; out[ostride + n] = s1; out[2 * ostride + n] = s2; }
        }
    }
    {
        bf16_t* XG = (bf16_t*)(a.ws + WS_H);
        float* RSS = (float*)(a.ws + WS_RSS);
        const float* nw = a.in[7];
        for (int row = gw; row < NTOK; row += NGW) {
            const float* xr = row < NCTX ? a.in[0] + (size_t)row * D : a.in[1] + (size_t)(row - NCTX) * D;
            const float* m = MOD + (size_t)cond_of(row) * 6144 + 1024;
            float ss = 0.f;
#pragma unroll
            for (int q = 0; q < 4; ++q) {
                const int col = q * 256 + c.lane * 4;
                const f32x4 v = *(const f32x4*)(xr + col);
                ss += v[0] * v[0] + v[1] * v[1] + v[2] * v[2] + v[3] * v[3];
                const f32x4 o = v * (*(const f32x4*)(nw + col)) * (*(const f32x4*)(m + col) + 1.0f);
                u32x2 w; w.x = pk2(o[0], o[1]); w.y = pk2(o[2], o[3]);
                *(u32x2*)(XG + (size_t)row * D + col) = w;
            }
            ss = wave_sum(ss);
            if (c.lane < 16) RSS[(size_t)row * 16 + c.lane] = c.lane == 0 ? ss : 0.f;
        }
    }
}

__device__ __forceinline__ void phase_norm(const Ctx& c, const float* nw, const float* mod  , int off_shift, int off_scale, bool final_norm) {
    const Args __attribute__((address_space(4)))& a = *c.a;
    const int gw = c.vb * NWAVE + c.wid, NGW = c.G * NWAVE;
    bf16_t* H = (bf16_t*)(a.ws + WS_H);
    for (int row = gw; row < NTOK; row += NGW) {
        float* xr = a.out + (size_t)row * D;
        f32x4 v[4]; float ss = 0.f;
#pragma unroll
        for (int j = 0; j < 4; ++j) { v[j] = *(const f32x4*)(xr + j * 256 + c.lane * 4); ss += v[j][0] * v[j][0] + v[j][1] * v[j][1] + v[j][2] * v[j][2] + v[j][3] * v[j][3]; }
        ss = wave_sum(ss);
        const float rstd = rsqrtf(ss * (1.0f / D) + EPS);
        if (final_norm) {
#pragma unroll
            for (int j = 0; j < 4; ++j) { const f32x4 w = *(const f32x4*)(nw + j * 256 + c.lane * 4); *(f32x4*)(xr + j * 256 + c.lane * 4) = v[j] * rstd * w; }
        } else {
            const float* m = mod + cond_of(row) * 6144;
#pragma unroll
            for (int j = 0; j < 4; ++j) {
                const int col = j * 256 + c.lane * 4;
                const f32x4 w = *(const f32x4*)(nw + col), sc = *(const f32x4*)(m + off_scale + col), sh = *(const f32x4*)(m + off_shift + col);
                const f32x4 h = v[j] * rstd * w * (sc + 1.0f) + sh;
                u32x2 o; o.x = pk2(h[0], h[1]); o.y = pk2(h[2], h[3]);
                *(u32x2*)(H + (size_t)row * D + col) = o;
            }
        }
    }
}

constexpr int RS_OFF = 3 * GT<5>::STAGE;
struct FillRstd { float* tab; const float* RSS; int tok0, ntok, tid;
    __device__ __forceinline__ void operator()() const {
        if (tid < ntok) {
            const float* p = RSS + (size_t)(tok0 + tid) * 16;
            float s = 0.f;
#pragma unroll
            for (int q = 0; q < 4; ++q) { const f32x4 v = *(const f32x4*)(p + q * 4); s += (v[0] + v[1]) + (v[2] + v[3]); }
            tab[tid] = rsqrtf(s * (1.0f / D) + EPS);
        }
    }
};
__device__ __forceinline__ FillRstd fill_rstd(const Ctx& c, int tok0, int ntok) { return FillRstd{(float*)(c.lds + RS_OFF), (const float*)(c.a->ws + WS_RSS), tok0, ntok, c.tid}; }
__device__ __forceinline__ void rstd_table_one(const Ctx& c, int i, int ntok, int tok0) {
    float* tab = (float*)(c.lds + RS_OFF);
    const float* RSS = (const float*)(c.a->ws + WS_RSS);
    if (c.tid < ntok) {
        const float* p = RSS + (size_t)(tok0 + c.tid) * 16;
        float s = 0.f;
#pragma unroll
        for (int q = 0; q < 4; ++q) { const f32x4 v = *(const f32x4*)(p + q * 4); s += (v[0] + v[1]) + (v[2] + v[3]); }
        tab[i * ntok + c.tid] = rsqrtf(s * (1.0f / D) + EPS);
    }
}
__device__ __forceinline__ void rstd_tables(const Ctx& c, int n, int ntok, int first, int stride, int toks_per_rt, int shift_rt  ) {
    float* tab = (float*)(c.lds + RS_OFF);
    const float* RSS = (const float*)(c.a->ws + WS_RSS);
    for (int i = 0; i < n; ++i) {
        const int t = first + i * stride, rt = shift_rt < 0 ? t / (-shift_rt) : (t >> shift_rt);
        if (c.tid < ntok) {
            const float* p = RSS + (size_t)(rt * toks_per_rt + c.tid) * 16;
            float s = 0.f;
#pragma unroll
            for (int q = 0; q < 4; ++q) { const f32x4 v = *(const f32x4*)(p + q * 4); s += (v[0] + v[1]) + (v[2] + v[3]); }
            tab[i * ntok + c.tid] = rsqrtf(s * (1.0f / D) + EPS);
        }
    }
}
__device__ __forceinline__ void patch_tile(const Ctx& c, int i, int NC, int& rt, int& ct) {
    if (c.G == 256) { const int x = c.vb >> 5, l = c.vb & 31, p = i * 8 + x, PC = NC >> 2, pr = p / PC, pc = p - pr * PC; rt = pr * 8 + (l >> 2); ct = pc * 4 + (l & 3); }
    else { const int t = c.vb + i * c.G; rt = t / NC; ct = t - rt * NC; }
}
struct ProbInProj {
    static constexpr int EPI_STORES = 10;
    const Ctx* c; const bf16_t* W; const bf16_t* XG; int lda, ldb, K; int j;
    static constexpr int NC = NZX / 256, NT = (NTOK / 160) * NC;
    __device__ __forceinline__ int count() const { return (NT - c->vb + c->G - 1) / c->G; }
    __device__ __forceinline__ void tile(int i, const bf16_t*& A, const bf16_t*& B) const { int rt, ct; patch_tile(*c, i, NC, rt, ct); A = W + (size_t)ct * 256 * D; B = XG + (size_t)rt * 160 * D; }
    __device__ __forceinline__ void pre_all() const { const int n = count(); for (int i = 0; i < n; ++i) { int rt, ct; patch_tile(*c, i, NC, rt, ct); rstd_table_one(*c, i, 160, rt * 160); } }
    __device__ __forceinline__ void preload(int i, f32x4 (&sw)[4], int wr, int fq) const {
        int rt, ct; patch_tile(*c, i, NC, rt, ct);
        if (cond_of(rt * 160) == cond_of(rt * 160 + 159)) {
            const float* p = (const float*)(c->a->ws + WS_SWIN) + (size_t)j * 3 * DPROJ + cond_of(rt * 160) * DPROJ + ct * 256 + wr * 64 + fq * 4;
#pragma unroll
            for (int q = 0; q < 4; ++q) sw[q] = *(const f32x4*)(p + q * 16);
        }
    }
    __device__ __forceinline__ void epilogue(int i, f32x4 (&acc)[4][5], const f32x4 (&sw)[4], int wr, int wc, int fr, int fq) const {
        int rt, ct; patch_tile(*c, i, NC, rt, ct); unsigned char* ws = c->a->ws;
        EpiInProj e{(bf16_t*)(ws + S_Z), (bf16_t*)(ws + S_RAW), (const float*)(c->lds + RS_OFF) + i * 160, rt * 160, (const float*)(ws + WS_SWIN) + (size_t)j * 3 * DPROJ, cond_of(rt * 160) == cond_of(rt * 160 + 159)};
        e(acc, sw, ct * 256 + wr * 64, rt * 160 + wc * 80, fr, fq);
    }
};
__device__ __forceinline__ void phase_inproj(const Ctx& c, int j) {
    ProbInProj P{&c, (const bf16_t*)(c.a->ws + WS_WIN) + (size_t)j * DPROJ * D, (const bf16_t*)(c.a->ws + WS_H), D, D, D, j};
    gemm_stream<5>(c, P);
}
struct ProbMlpUp {
    static constexpr int EPI_STORES = 10;
    const Ctx* c; const bf16_t* W; const bf16_t* XG; int lda, ldb, K; int layer;
    static constexpr int NC = DFF / 256, NT = (NTOK / 160) * NC;
    __device__ __forceinline__ int count() const { return (NT - c->vb + c->G - 1) / c->G; }
    __device__ __forceinline__ void tile(int i, const bf16_t*& A, const bf16_t*& B) const { int rt, ct; patch_tile(*c, i, NC, rt, ct); A = W + (size_t)ct * 256 * D; B = XG + (size_t)rt * 160 * D; }
    __device__ __forceinline__ void pre_all() const { const int n = count(); for (int i = 0; i < n; ++i) { int rt, ct; patch_tile(*c, i, NC, rt, ct); rstd_table_one(*c, i, 160, rt * 160); } }
    __device__ __forceinline__ void preload(int i, f32x4 (&sw)[4], int wr, int fq) const {
        int rt, ct; patch_tile(*c, i, NC, rt, ct);
        if (cond_of(rt * 160) == cond_of(rt * 160 + 159)) {
            const float* p = (const float*)(c->a->ws + WS_SWUP) + (size_t)layer * 3 * DFF + cond_of(rt * 160) * DFF + ct * 256 + wr * 64 + fq * 4;
#pragma unroll
            for (int q = 0; q < 4; ++q) sw[q] = *(const f32x4*)(p + q * 16);
        }
    }
    __device__ __forceinline__ void epilogue(int i, f32x4 (&acc)[4][5], const f32x4 (&sw)[4], int wr, int wc, int fr, int fq) const {
        int rt, ct; patch_tile(*c, i, NC, rt, ct); unsigned char* ws = c->a->ws;
        EpiMlpUp e{(bf16_t*)(ws + S_HID), (const float*)(c->lds + RS_OFF) + i * 160, rt * 160, (const float*)(ws + WS_SWUP) + (size_t)layer * 3 * DFF, cond_of(rt * 160) == cond_of(rt * 160 + 159)};
        e(acc, sw, ct * 256 + wr * 64, rt * 160 + wc * 80, fr, fq);
    }
};
__device__ __forceinline__ void phase_mlp_up(const Ctx& c, int layer) {
    ProbMlpUp P{&c, (const bf16_t*)(c.a->ws + WS_W1) + (size_t)layer * DFF * D, (const bf16_t*)(c.a->ws + WS_H), D, D, D, layer};
    gemm_stream<5>(c, P);
}
#ifndef BENCH_MODE
#define BENCH_MODE 0
#endif
__device__ __forceinline__ void phase_bench(const Ctx& c) {
    ProbMlpUp P{&c, (const bf16_t*)(c.a->ws + WS_W1), (const bf16_t*)(c.a->ws + WS_H), D, D, D, 0};
    gemm_stream<5, ProbMlpUp, BENCH_MODE>(c, P);
}
struct ProbResid {
    static constexpr int EPI_STORES = 0;
    const Ctx* c; const bf16_t* WT; const bf16_t* Act; int lda, ldb, K; const float* gate; const float* bias; const float* ssq; const float* nw_next; const float* scale_next; bool first;
    static constexpr int NC = D / 256, NT = (NTOK / 160) * NC;
    __device__ __forceinline__ int count() const { return (NT - c->vb + c->G - 1) / c->G; }
    __device__ __forceinline__ void tile(int i, const bf16_t*& A, const bf16_t*& B) const { const int t = c->vb + i * c->G, rt = t / NC, ct = t - rt * NC; A = WT + (size_t)ct * 256 * K; B = Act + (size_t)rt * 160 * K; }
    __device__ __forceinline__ void pre_all() const {
        if (!ssq) return;
        float* tab = (float*)(c->lds + RS_OFF);
        const int n = count();
        for (int i = 0; i < n; ++i) {
            const int t = c->vb + i * c->G, rt = t / NC;
            if (c->tid < 160) {
                const float* p = ssq + (size_t)(rt * 160 + c->tid) * 32;
                float s = 0.f;
#pragma unroll
                for (int q = 0; q < 8; ++q) { const f32x4 v = *(const f32x4*)(p + q * 4); s += v[0] + v[1] + v[2] + v[3]; }
                tab[i * 160 + c->tid] = rsqrtf(s * (1.0f / DI) + EPS);
            }
        }
    }
    __device__ __forceinline__ void preload(int, f32x4 (&)[4], int, int) const {}
    __device__ __forceinline__ void epilogue(int i, f32x4 (&acc)[4][5], const f32x4 (&)[4], int wr, int wc, int fr, int fq) const {
        const int t = c->vb + i * c->G, rt = t / NC, ct = t - rt * NC; unsigned char* ws = c->a->ws;
        EpiResid e{c->a->out, gate, bias, ssq ? (const float*)(c->lds + RS_OFF) + i * 160 : nullptr, rt * 160, first ? c->a->in[0] : nullptr, first ? c->a->in[1] : nullptr, nw_next ? (bf16_t*)(ws + WS_H) : nullptr, nw_next, scale_next, (float*)(ws + WS_RSS), (const float*)(ws + WS_ZERO)};
        e(acc, ct * 256 + wr * 64, rt * 160 + wc * 80, fr, fq);
    }
};
__device__ __forceinline__ void phase_resid_gemm(const Ctx& c, const bf16_t* WT, const bf16_t* Act, int K, const float* gate, const float* bias, const float* ssq, const float* nw_next, const float* scale_next, bool first) {
    ProbResid P{&c, WT, Act, K, K, K, gate, bias, ssq, nw_next, scale_next, first};
    gemm_stream<5>(c, P);
}
struct ProbF1 {
    static constexpr int EPI_STORES = 16;
    const Ctx* c; const bf16_t* XG; const bf16_t* T1; int lda, ldb, K; int j;
    static constexpr int NT = (NTOK / 256) * 16;
    __device__ __forceinline__ int count() const { return (NT - c->vb + c->G - 1) / c->G; }
    __device__ __forceinline__ void tile(int i, const bf16_t*& A, const bf16_t*& B) const { const int t = c->vb + i * c->G, rt = t >> 4, g = (t >> 2) & 3, ct = t & 3; A = XG + (size_t)rt * 256 * D + g * 256; B = T1 + (size_t)ct * 128 * 256; }
    __device__ __forceinline__ void pre_all() const { rstd_tables(*c, count(), 256, c->vb, c->G, 256, 4); }
    __device__ __forceinline__ void preload(int, f32x4 (&)[4], int, int) const {}
    __device__ __forceinline__ void epilogue(int i, f32x4 (&acc)[4][4], const f32x4 (&)[4], int wr, int wc, int fr, int fq) const {
        const int t = c->vb + i * c->G, rt = t >> 4, g = (t >> 2) & 3, ct = t & 3; unsigned char* ws = c->a->ws;
        EpiF1 e{(bf16_t*)(ws + S_UVT), g, (const float*)(c->lds + RS_OFF) + i * 256, rt * 256, (const float*)(ws + WS_SWF1) + (size_t)j * 3 * 2048};
        e(acc, rt * 256 + wr * 64, ct * 128 + wc * 64, fr, fq);
    }
};
__device__ __forceinline__ void phase_f1(const Ctx& c, int j) {
    ProbF1 P{&c, (const bf16_t*)(c.a->ws + WS_H), (const bf16_t*)(c.a->ws + WS_T1), D, 256, 256, j};
    gemm_stream<4>(c, P);
}
struct ProbF2L {
    static constexpr int EPI_STORES = 0;
    const Ctx* c; const bf16_t* UVT; const bf16_t* T2; bf16_t* F; int lda, ldb, K;
    __device__ __forceinline__ int count() const { return c->vb < 128 ? 1 : 0; }
    __device__ __forceinline__ void tile(int i, const bf16_t*& A, const bf16_t*& B) const { const int t = c->vb, s = t >> 6, nt = (t >> 4) & 3, kt = t & 15; A = UVT + (size_t)NCTX * 2048 + ((size_t)s * 1024 + nt * 256) * 2048; B = T2 + (size_t)kt * 64 * 2048; }
    __device__ __forceinline__ void pre_all() const {}
    __device__ __forceinline__ void preload(int, f32x4 (&)[4], int, int) const {}
    __device__ __forceinline__ void epilogue(int i, f32x4 (&acc)[4][2], const f32x4 (&)[4], int wr, int wc, int fr, int fq) const { const int t = c->vb, s = t >> 6, nt = (t >> 4) & 3, kt = t & 15; EpiF2<2> e{F, NCTX + s * 1024}; e(acc, nt * 256 + wr * 64, kt * 64 + wc * 32, fr, fq); }
};
struct ProbF2C {
    static constexpr int EPI_STORES = 16;
    const Ctx* c; const bf16_t* UVT; const bf16_t* T2; bf16_t* F; int lda, ldb, K; int first, stride;
    __device__ __forceinline__ int count() const { return (256 - first + stride - 1) / stride; }
    __device__ __forceinline__ void tile(int i, const bf16_t*& A, const bf16_t*& B) const { const int u = first + i * stride, s = u >> 3, nt = (u >> 1) & 3, kt = u & 1; A = UVT + ((size_t)s * 1024 + nt * 256) * 512; B = T2 + (size_t)kt * 128 * 512; }
    __device__ __forceinline__ void pre_all() const {}
    __device__ __forceinline__ void preload(int, f32x4 (&)[4], int, int) const {}
    __device__ __forceinline__ void epilogue(int i, f32x4 (&acc)[4][4], const f32x4 (&)[4], int wr, int wc, int fr, int fq) const { const int u = first + i * stride, s = u >> 3, nt = (u >> 1) & 3, kt = u & 1; EpiF2<4> e{F, s * 256}; e(acc, nt * 256 + wr * 64, kt * 128 + wc * 64, fr, fq); }
};
__device__ __forceinline__ void phase_f2(const Ctx& c) {
    unsigned char* ws = c.a->ws;
    const int half = c.G >> 1;
    if (c.vb < half) { ProbF2L P{&c, (const bf16_t*)(ws + S_UVT), (const bf16_t*)(ws + WS_T2L), (bf16_t*)(ws + S_F), 2048, 2048, 2048}; gemm_stream<2>(c, P); }
    else { ProbF2C P{&c, (const bf16_t*)(ws + S_UVT), (const bf16_t*)(ws + WS_T2C), (bf16_t*)(ws + S_F), 512, 512, 512, c.vb - half, c.G - half}; gemm_stream<4>(c, P); }
}

struct ProbDt {
    static constexpr int EPI_STORES = 0;
    const Ctx* c; const bf16_t* XG; const bf16_t* W; int lda, ldb, K; int j;
    __device__ __forceinline__ int count() const { return (NTOK / 256 - c->vb + c->G - 1) / c->G; }
    __device__ __forceinline__ void tile(int i, const bf16_t*& A, const bf16_t*& B) const { const int t = c->vb + i * c->G; A = XG + (size_t)t * 256 * D; B = W; }
    __device__ __forceinline__ void pre_all() const { rstd_tables(*c, count(), 256, c->vb, c->G, 256, 0); }
    __device__ __forceinline__ void preload(int, f32x4 (&)[4], int, int) const {}
    __device__ __forceinline__ void epilogue(int i, f32x4 (&acc)[4][2], const f32x4 (&)[4], int wr, int wc, int fr, int fq) const {
        const int t = c->vb + i * c->G; unsigned char* ws = c->a->ws;
        EpiDt e{(float*)(ws + S_DT), (const float*)(c->lds + RS_OFF) + i * 256, t * 256, (const float*)(ws + WS_SWIN) + (size_t)j * 3 * DPROJ};
        e(acc, t * 256 + wr * 64, wc * 32, fr, fq);
    }
};
__device__ __forceinline__ void phase_conv(const Ctx& c, int j) {
    const Args __attribute__((address_space(4)))& a = *c.a;
    {
        ProbDt P{&c, (const bf16_t*)(a.ws + WS_H), (const bf16_t*)(a.ws + WS_WIN) + (size_t)j * DPROJ * D + (size_t)NZX * D, D, D, D, j};
        gemm_stream<2>(c, P);
    }
    const bf16_t* RAW = (const bf16_t*)(a.ws + S_RAW);
    bf16_t* XBC = (bf16_t*)(a.ws + S_XBC);
    const float* cw = a.in[10] + (size_t)j * 3 * DXBC;
    const float* cb = a.in[11] + (size_t)j * DXBC;
    constexpr int NIT = (NTOK / 64) * 3;
    for (int it = c.G - 1 - c.vb; it < NIT; it += c.G) {
        const int tg = it / 3, third = it - tg * 3;
        const int ch = third * 1024 + (c.tid & 127) * 8;
        const int r0 = tg * 64 + (c.tid >> 7) * 16;
        float w0[8], w1[8], w2[8], bb[8];
#pragma unroll
        for (int q = 0; q < 2; ++q) {
            const f32x4 t0 = *(const f32x4*)(cw + ch + q * 4), t1 = *(const f32x4*)(cw + DXBC + ch + q * 4), t2 = *(const f32x4*)(cw + 2 * DXBC + ch + q * 4), t3 = *(const f32x4*)(cb + ch + q * 4);
#pragma unroll
            for (int e = 0; e < 4; ++e) { w0[q * 4 + e] = t0[e]; w1[q * 4 + e] = t1[e]; w2[q * 4 + e] = t2[e]; bb[q * 4 + e] = t3[e]; }
        }
        const int seg = r0 < NCTX ? 256 : 64;
        u32x4 prev = {0, 0, 0, 0}, cur, nxt;
        if ((r0 % seg) != 0) prev = *(const u32x4*)(RAW + (size_t)(r0 - 1) * DXBC + ch);
        cur = *(const u32x4*)(RAW + (size_t)r0 * DXBC + ch);
#pragma unroll 4
        for (int r = 0; r < 16; ++r) {
            const int t = r0 + r;
            nxt = (u32x4){0, 0, 0, 0};
            if (((t + 1) % seg) != 0) nxt = *(const u32x4*)(RAW + (size_t)(t + 1) * DXBC + ch);
            u32x4 o;
#pragma unroll
            for (int e = 0; e < 4; ++e) {
                const float lo = bb[2 * e] + w0[2 * e] * bflo(prev[e]) + w1[2 * e] * bflo(cur[e]) + w2[2 * e] * bflo(nxt[e]);
                const float hi = bb[2 * e + 1] + w0[2 * e + 1] * bfhi(prev[e]) + w1[2 * e + 1] * bfhi(cur[e]) + w2[2 * e + 1] * bfhi(nxt[e]);
                o[e] = pk2(silu_f(lo), silu_f(hi));
            }
            *(u32x4*)(XBC + (size_t)t * DXBC + ch) = o;
            prev = cur; cur = nxt;
        }
    }
}

constexpr int SC_XS = 0, SC_XW = 16384, SC_BS = 32768, SC_CS = 49152, SC_HT = 65536, SC_SM = 98304;
__device__ __forceinline__ int off128(int row, int col) { return row * 128 + ((((col >> 3) ^ (row & 7))) << 4) + (col & 7) * 2; }
__device__ __forceinline__ int off256(int row, int col) { return row * 256 + ((((col >> 3) ^ (row & 15))) << 4) + (col & 7) * 2; }
__device__ __forceinline__ int offX(int row, int col) { return row * 128 + col * 2; }
__device__ __forceinline__ int offP(int row, int col) { return row * 144 + col * 2; }
template <int LAY>
__device__ __forceinline__ bf16x8 tr_frag(const char* tile, int r0, int r1, int col0, int lane) {
    const int i = lane & 15, q = i >> 2, cc = col0 + (i & 3) * 4;
    const int o0 = LAY == 1 ? off256(r0 + q, cc) : LAY == 2 ? offP(r0 + q, cc) : offX(r0 + q, cc);
    const int o1 = LAY == 1 ? off256(r1 + q, cc) : LAY == 2 ? offP(r1 + q, cc) : offX(r1 + q, cc);
    const bf16x4 lo = __builtin_amdgcn_ds_read_tr16_b64_v4i16((LAS bf16x4*)(tile + o0));
    const bf16x4 hi = __builtin_amdgcn_ds_read_tr16_b64_v4i16((LAS bf16x4*)(tile + o1));
    return __builtin_shufflevector(lo, hi, 0, 1, 2, 3, 4, 5, 6, 7);
}

struct ScanStep { int seq, hp, dir, ci, nch, t0, valid, single, h0; };
struct ScanIter {
    int vb, G, k, dir, ci;
    __device__ __forceinline__ void get(ScanStep& s) const {
        int seq, hp, ok, single = 0, h0 = 0;
        if (vb < 64) { seq = 32 + (vb >> 5); h0 = vb & 31; hp = h0 >> 1; single = 1; ok = (k == 0); }
        else { const int u = (vb - 64) + k * (G - 64); seq = u >> 4; hp = u & 15; ok = (u < 512); }
        const bool lat = seq >= 32;
        s.seq = seq; s.hp = hp; s.dir = dir; s.ci = ci; s.nch = lat ? 16 : 4; s.valid = ok; s.single = single; s.h0 = h0;
        const int tok0 = lat ? NCTX + (seq - 32) * 1024 : seq * 256;
        const int ch = dir == 0 ? ci : s.nch - 1 - ci;
        s.t0 = tok0 + ch * 64;
    }
    __device__ __forceinline__ void advance() {
        int seq; if (vb < 64) seq = 32; else seq = 0;
        const int nch = seq >= 32 ? 16 : 4;
        if (++ci == nch) { ci = 0; if (++dir == 2) { dir = 0; ++k; } }
    }
};
constexpr int SCB = 49152;
constexpr int SB_XS = 0, SB_BS = 16384, SB_CS = 32768;
constexpr int XW_BYTES = 64 * 144, HT_BYTES = 128 * 144;
constexpr int SCN_XW = 2 * SCB, SCN_HT = SCN_XW + 2 * XW_BYTES, SCN_SM = SCN_HT + 2 * HT_BYTES;

__device__ __forceinline__ void scan_issue_tiles(const Ctx& c, const ScanStep& s, int buf) {
    const bf16_t* XBC = (const bf16_t*)(c.a->ws + S_XBC);
    char* base = c.lds + buf * SCB;
    const int lane = c.lane, w8 = c.wid, g = s.hp >> 2;
#pragma unroll
    for (int hh = 0; hh < 2; ++hh) {
        if (hh == 1 && s.single) break;
        const int q = w8, row = q * 8 + (lane >> 3), lch = lane & 7, hd = s.single ? s.h0 : 2 * s.hp + hh;
        __builtin_amdgcn_global_load_lds((const unsigned*)(XBC + (size_t)(s.t0 + row) * DXBC + hd * 64 + lch * 8), (LAS unsigned*)(base + SB_XS + hh * 8192 + q * 1024 + lane * 16), 16, 0, 0);
    }
#pragma unroll
    for (int i = 0; i < 2; ++i) {
        const int q = w8 + 8 * i, row = q * 4 + (lane >> 4), lch = (lane & 15) ^ (row & 15);
        __builtin_amdgcn_global_load_lds((const unsigned*)(XBC + (size_t)(s.t0 + row) * DXBC + DI + g * 128 + lch * 8), (LAS unsigned*)(base + SB_BS + q * 1024 + lane * 16), 16, 0, 0);
        __builtin_amdgcn_global_load_lds((const unsigned*)(XBC + (size_t)(s.t0 + row) * DXBC + DI + 512 + g * 128 + lch * 8), (LAS unsigned*)(base + SB_CS + q * 1024 + lane * 16), 16, 0, 0);
    }
}
__device__ __forceinline__ float scan_load_dt(const Ctx& c, const ScanStep& s, int hw) {
    const float* DT = (const float*)(c.a->ws + S_DT);
    const int l = s.dir == 0 ? c.lane : 63 - c.lane, h = s.single ? s.h0 : 2 * s.hp + hw;
    return DT[(size_t)(s.t0 + l) * 64 + s.dir * NH + h];
}
__device__ __forceinline__ void scan_dtcs(const Ctx& c, const ScanStep& s, int hw, int j, float raw, float* sm) {
    const int lane = c.lane, l = s.dir == 0 ? lane : 63 - lane, h = s.single ? s.h0 : 2 * s.hp + hw;
    const float Aneg = -__expf(c.a->in[13][(j * 2 + s.dir) * NH + h]);
    raw += c.a->in[12][(j * 2 + s.dir) * NH + h];
    const float dt = raw > 20.f ? raw : __logf(1.0f + __expf(raw));
    float cs = dt * Aneg;
#pragma unroll
    for (int o = 1; o < 64; o <<= 1) { const float u = __shfl_up(cs, o); if (lane >= o) cs += u; }
    sm[l] = dt; sm[64 + l] = cs;
    if (lane == 63) sm[128] = cs;
}

__device__ __forceinline__ void phase_scan_pipe(const Ctx& c, int j) {
    const Args __attribute__((address_space(4)))& a = *c.a;
    const bf16_t* Z = (const bf16_t*)(a.ws + S_Z);
    bf16_t* YTMP = (bf16_t*)(a.ws + S_RAW);
    bf16_t* YG = (bf16_t*)(a.ws + S_YG);
    float* SSQ = (float*)(a.ws + S_SSQ);
    const int hw = c.wid >> 2, w = c.wid & 3;
    char* lds = c.lds;
    char* XWp = lds + SCN_XW + hw * XW_BYTES; char* HTp = lds + SCN_HT + hw * HT_BYTES;

    ScanIter it{c.vb, c.G, 0, 0, 0};
    ScanStep cur, nxt, nx2;
    it.get(cur); it.advance(); it.get(nxt); it.advance(); it.get(nx2);
    if (!cur.valid) return;
    scan_issue_tiles(c, cur, 0);
    float raw_n1 = 0.f;
    if (w == 0 && !(cur.single && hw == 1)) {
        const float r0 = scan_load_dt(c, cur, hw);
        if (nxt.valid) raw_n1 = scan_load_dt(c, nxt, hw);
        scan_dtcs(c, cur, hw, j, r0, (float*)(lds + SCN_SM + (0 * 2 + hw) * 1024));
    }
    f32x4 S[4][2];
#pragma unroll
    for (int pb = 0; pb < 4; ++pb)
#pragma unroll
        for (int nbi = 0; nbi < 2; ++nbi) S[pb][nbi] = (f32x4){0.f, 0.f, 0.f, 0.f};

#pragma unroll 1
    for (int s = 0; cur.valid; ++s) {
        int lane = c.lane; asm volatile("" : "+v"(lane));
        const int fr = lane & 15, fq = lane >> 4;
        const int b = s & 1;
        char* TB_ = lds + b * SCB;
        char* XSp = TB_ + SB_XS + hw * 8192;
        const float* sm_dt = (const float*)(lds + SCN_SM + (b * 2 + hw) * 1024);
        const float* sm_cs = sm_dt + 64;
        const bool is_lat = cur.seq >= 32;
        const bool active = !(cur.single && hw == 1);
        const int dir = cur.dir, t0 = cur.t0, h = cur.single ? cur.h0 : 2 * cur.hp + hw;
        asm volatile("s_waitcnt vmcnt(0)" ::: "memory");
        __syncthreads();
        if (nxt.valid) scan_issue_tiles(c, nxt, b ^ 1);
        float raw_n2 = 0.f;
        if (w == 0 && nx2.valid && !(nx2.single && hw == 1)) raw_n2 = scan_load_dt(c, nx2, hw);
        u32x2 yt[4], zz[4]; f32x4 nwv[4]; float Dh = 0.f;
        const int tok = t0 + w * 16 + fr;
        if (dir == 1 && active) {
            Dh = a.in[14][j * NH + h];
            const float* normw = a.in[15] + (size_t)j * DI + h * 64;
#pragma unroll
            for (int pb = 0; pb < 4; ++pb) {
                const int p0 = pb * 16 + fq * 4;
                yt[pb] = *(const u32x2*)(YTMP + (size_t)tok * DI + h * 64 + p0);
                zz[pb] = *(const u32x2*)(Z + (size_t)tok * DI + h * 64 + p0);
                nwv[pb] = *(const f32x4*)(normw + p0);
            }
        }
        bool has_h = is_lat || cur.ci > 0;
        if (cur.ci == 0) {
            if (is_lat) {
                if (active) {
                const float* sp = a.in[2] + ((size_t)(((cur.seq - 32) * 2 + j) * 2 + dir) * NH + h) * 8192;
#pragma unroll
                for (int pb = 0; pb < 4; ++pb)
#pragma unroll
                    for (int nbi = 0; nbi < 2; ++nbi) {
                        const int n = (2 * w + nbi) * 16 + fr, p0 = pb * 16 + fq * 4;
#pragma unroll
                        for (int r = 0; r < 4; ++r) S[pb][nbi][r] = sp[(p0 + r) * 128 + n];
                        u32x2 v; v.x = pk2(S[pb][nbi][0], S[pb][nbi][1]); v.y = pk2(S[pb][nbi][2], S[pb][nbi][3]);
                        *(u32x2*)(HTp + offP(n, p0)) = v;
                    }
                }
                __syncthreads();
            } else {
#pragma unroll
                for (int pb = 0; pb < 4; ++pb)
#pragma unroll
                    for (int nbi = 0; nbi < 2; ++nbi) S[pb][nbi] = (f32x4){0.f, 0.f, 0.f, 0.f};
            }
        }
        float tot = 0.f;
        if (active) {
        tot = sm_dt[128];
        {
            const int tl = c.tid & 255, l = tl >> 2, c0 = (tl & 3) * 16;
            const float sc = __expf(tot - sm_cs[l]) * sm_dt[l];
#pragma unroll
            for (int q = 0; q < 2; ++q) {
                const u32x4 v = *(const u32x4*)(XSp + offX(l, c0 + q * 8));
                u32x4 r;
#pragma unroll
                for (int e = 0; e < 4; ++e) r[e] = pk2(bflo(v[e]) * sc, bfhi(v[e]) * sc);
                *(u32x4*)(XWp + offP(l, c0 + q * 8)) = r;
            }
        }
        bf16x8 cf[4];
#pragma unroll
        for (int kk = 0; kk < 4; ++kk) cf[kk] = *(const bf16x8*)(TB_ + SB_CS + off256(w * 16 + fr, kk * 32 + fq * 8));
        const float csl = sm_cs[w * 16 + fr];
        f32x4 yacc[4];
#pragma unroll
        for (int pb = 0; pb < 4; ++pb) yacc[pb] = (f32x4){0.f, 0.f, 0.f, 0.f};
        if (has_h) {
            bf16x8 hf[2][4];
#pragma unroll
            for (int pb = 0; pb < 4; ++pb) hf[0][pb] = tr_frag<2>(HTp, fq * 8, fq * 8 + 4, pb * 16, lane);
#pragma unroll
            for (int kk = 0; kk < 4; ++kk) {
                if (kk < 3) {
#pragma unroll
                    for (int pb = 0; pb < 4; ++pb) hf[(kk + 1) & 1][pb] = tr_frag<2>(HTp, (kk + 1) * 32 + fq * 8, (kk + 1) * 32 + fq * 8 + 4, pb * 16, lane);
                }
                __builtin_amdgcn_sched_barrier(0);
#pragma unroll
                for (int pb = 0; pb < 4; ++pb) yacc[pb] = __builtin_amdgcn_mfma_f32_16x16x32_bf16(hf[kk & 1][pb], cf[kk], yacc[pb], 0, 0, 0);
            }
            const float e = __expf(csl);
#pragma unroll
            for (int pb = 0; pb < 4; ++pb) yacc[pb] = yacc[pb] * e;
        }
#pragma unroll
        for (int kk2 = 0; kk2 < 2; ++kk2) {
            const bool need = dir == 0 ? (2 * kk2 <= w) : (2 * kk2 + 1 >= w);
            if (need) {
                unsigned m[4];
                bf16x8 bfg[2][4];
                f32x4 gg[2];
#pragma unroll
                for (int half = 0; half < 2; ++half)
#pragma unroll
                    for (int kk = 0; kk < 4; ++kk) bfg[half][kk] = *(const bf16x8*)(TB_ + SB_BS + off256((2 * kk2 + half) * 16 + fr, kk * 32 + fq * 8));
                bf16x8 xf[4];
#pragma unroll
                for (int pb = 0; pb < 4; ++pb) xf[pb] = tr_frag<0>(XSp, 32 * kk2 + 4 * fq, 32 * kk2 + 16 + 4 * fq, pb * 16, lane);
                __builtin_amdgcn_sched_barrier(0);
                gg[0] = (f32x4){0.f, 0.f, 0.f, 0.f}; gg[1] = (f32x4){0.f, 0.f, 0.f, 0.f};
#pragma unroll
                for (int kk = 0; kk < 4; ++kk)
#pragma unroll
                    for (int half = 0; half < 2; ++half) gg[half] = __builtin_amdgcn_mfma_f32_16x16x32_bf16(bfg[half][kk], cf[kk], gg[half], 0, 0, 0);
#pragma unroll
                for (int half = 0; half < 2; ++half) {
                    const int sb = 2 * kk2 + half;
                    const f32x4 gacc = gg[half];
                    const f32x4 css = *(const f32x4*)(sm_cs + sb * 16 + fq * 4);
                    const f32x4 dts = *(const f32x4*)(sm_dt + sb * 16 + fq * 4);
                    float v[4];
#pragma unroll
                    for (int r = 0; r < 4; ++r) {
                        const int si = sb * 16 + fq * 4 + r, l = w * 16 + fr;
                        const bool valid = dir == 0 ? (si <= l) : (si >= l);
                        v[r] = valid ? gacc[r] * __expf(csl - css[r]) * dts[r] : 0.f;
                    }
                    m[half * 2 + 0] = pk2(v[0], v[1]); m[half * 2 + 1] = pk2(v[2], v[3]);
                }
                union { unsigned u[4]; bf16x8 v; } mf; mf.u[0] = m[0]; mf.u[1] = m[1]; mf.u[2] = m[2]; mf.u[3] = m[3];
#pragma unroll
                for (int pb = 0; pb < 4; ++pb) yacc[pb] = __builtin_amdgcn_mfma_f32_16x16x32_bf16(xf[pb], mf.v, yacc[pb], 0, 0, 0);
            }
        }
        {
            const int l = w * 16 + fr;
            if (dir == 0) {
                u32x2 v[4];
#pragma unroll
                for (int pb = 0; pb < 4; ++pb) { v[pb].x = pk2(yacc[pb][0], yacc[pb][1]); v[pb].y = pk2(yacc[pb][2], yacc[pb][3]); }
#pragma unroll
                for (int p = 0; p < 2; ++p) {
                    const u32x4 o = pair16(v[2 * p], v[2 * p + 1]);
                    *(u32x4*)(YTMP + (size_t)tok * DI + h * 64 + (2 * p + (fq & 1)) * 16 + (fq & 2) * 4) = o;
                }
            } else {
                float ss = 0.f;
                u32x2 v[4];
#pragma unroll
                for (int pb = 0; pb < 4; ++pb) {
                    const int p0 = pb * 16 + fq * 4;
                    const u32x2 xx = *(const u32x2*)(XSp + offX(l, p0));
                    const f32x4 nw = nwv[pb];
                    float y[4];
                    y[0] = yacc[pb][0] + bflo(yt[pb].x) + Dh * bflo(xx.x); y[1] = yacc[pb][1] + bfhi(yt[pb].x) + Dh * bfhi(xx.x);
                    y[2] = yacc[pb][2] + bflo(yt[pb].y) + Dh * bflo(xx.y); y[3] = yacc[pb][3] + bfhi(yt[pb].y) + Dh * bfhi(xx.y);
                    y[0] *= silu_f(bflo(zz[pb].x)); y[1] *= silu_f(bfhi(zz[pb].x)); y[2] *= silu_f(bflo(zz[pb].y)); y[3] *= silu_f(bfhi(zz[pb].y));
                    ss += y[0] * y[0] + y[1] * y[1] + y[2] * y[2] + y[3] * y[3];
                    v[pb].x = pk2(y[0] * nw[0], y[1] * nw[1]); v[pb].y = pk2(y[2] * nw[2], y[3] * nw[3]);
                }
#pragma unroll
                for (int p = 0; p < 2; ++p) {
                    const u32x4 o = pair16(v[2 * p], v[2 * p + 1]);
                    *(u32x4*)(YG + (size_t)tok * DI + h * 64 + (2 * p + (fq & 1)) * 16 + (fq & 2) * 4) = o;
                }
                ss += __shfl_xor(ss, 16); ss += __shfl_xor(ss, 32);
                if (fq == 0) SSQ[(size_t)tok * NH + h] = ss;
            }
        }
        }
        __syncthreads();
        if (active) {
            const float et = __expf(tot);
#pragma unroll
            for (int pb = 0; pb < 4; ++pb)
#pragma unroll
                for (int nbi = 0; nbi < 2; ++nbi) S[pb][nbi] = S[pb][nbi] * et;
            bf16x8 bq[2][2], xa[2][4];
#pragma unroll
            for (int kk = 0; kk < 2; ++kk) {
#pragma unroll
                for (int nbi = 0; nbi < 2; ++nbi) bq[kk][nbi] = tr_frag<1>(TB_ + SB_BS, kk * 32 + fq * 8, kk * 32 + fq * 8 + 4, (2 * w + nbi) * 16, lane);
#pragma unroll
                for (int pb = 0; pb < 4; ++pb) xa[kk][pb] = tr_frag<2>(XWp, kk * 32 + fq * 8, kk * 32 + fq * 8 + 4, pb * 16, lane);
            }
            __builtin_amdgcn_sched_barrier(0);
#pragma unroll
            for (int kk = 0; kk < 2; ++kk)
#pragma unroll
                for (int pb = 0; pb < 4; ++pb)
#pragma unroll
                    for (int nbi = 0; nbi < 2; ++nbi) S[pb][nbi] = __builtin_amdgcn_mfma_f32_16x16x32_bf16(xa[kk][pb], bq[kk][nbi], S[pb][nbi], 0, 0, 0);
#pragma unroll
            for (int pb = 0; pb < 4; ++pb)
#pragma unroll
                for (int nbi = 0; nbi < 2; ++nbi) {
                    const int n = (2 * w + nbi) * 16 + fr, p0 = pb * 16 + fq * 4;
                    u32x2 v; v.x = pk2(S[pb][nbi][0], S[pb][nbi][1]); v.y = pk2(S[pb][nbi][2], S[pb][nbi][3]);
                    *(u32x2*)(HTp + offP(n, p0)) = v;
                }
        }
        if (active && !is_lat && cur.ci == cur.nch - 1) {
            float* op = a.out + (size_t)NTOK * D + ((size_t)((cur.seq * 2 + j) * 2 + dir) * NH + h) * 8192;
#pragma unroll
            for (int pb = 0; pb < 4; ++pb)
#pragma unroll
                for (int nbi = 0; nbi < 2; ++nbi) {
                    const int n = (2 * w + nbi) * 16 + fr, p0 = pb * 16 + fq * 4;
#pragma unroll
                    for (int r = 0; r < 4; ++r) op[(p0 + r) * 128 + n] = S[pb][nbi][r];
                }
        }
        if (w == 0 && nxt.valid && !(nxt.single && hw == 1)) scan_dtcs(c, nxt, hw, j, raw_n1, (float*)(lds + SCN_SM + ((b ^ 1) * 2 + hw) * 1024));
        raw_n1 = raw_n2;
        cur = nxt; nxt = nx2; it.advance(); it.get(nx2);
    }
}

#if NAIVE_SCAN
__device__ __forceinline__ void scan_unit_naive(const Ctx& c, int j, int seq, int h) {
    const Args __attribute__((address_space(4)))& a = *c.a;
    const bf16_t* XBC = (const bf16_t*)(a.ws + S_XBC);
    const bf16_t* Z = (const bf16_t*)(a.ws + S_Z);
    const float* DT = (const float*)(a.ws + S_DT);
    bf16_t* YTMP = (bf16_t*)(a.ws + S_RAW);
    bf16_t* YG = (bf16_t*)(a.ws + S_YG);
    float* SSQ = (float*)(a.ws + S_SSQ);
    const bool is_lat = seq >= 32;
    const int tok0 = is_lat ? NCTX + (seq - 32) * 1024 : seq * 256;
    const int L = is_lat ? 1024 : 256;
    const int g = h >> 3, p = c.tid >> 2, nq = (c.tid & 3) * 32;
    const float Dh = a.in[14][j * NH + h];
    const float nw = a.in[15][(size_t)j * DI + h * 64 + p];
    float* red = (float*)c.lds;
    for (int dir = 0; dir < 2; ++dir) {
        const float Aneg = -__expf(a.in[13][(j * 2 + dir) * NH + h]);
        const float dtb = a.in[12][(j * 2 + dir) * NH + h];
        float hs[32];
        if (is_lat) { const float* sp = a.in[2] + ((size_t)(((seq - 32) * 2 + j) * 2 + dir) * NH + h) * 8192 + p * 128 + nq;
#pragma unroll
            for (int e = 0; e < 32; ++e) hs[e] = sp[e]; }
        else {
#pragma unroll
            for (int e = 0; e < 32; ++e) hs[e] = 0.f; }
        asm volatile("s_waitcnt vmcnt(0)" ::: "memory"); __syncthreads();
        for (int ti = 0; ti < L; ++ti) {
            const int tok = tok0 + (dir == 0 ? ti : L - 1 - ti);
            const float raw = DT[(size_t)tok * 64 + dir * NH + h] + dtb;
            const float dt = raw > 20.f ? raw : log1pf(__expf(raw));
            const float dec = __expf(dt * Aneg);
            const float xv = bflo((unsigned)XBC[(size_t)tok * DXBC + h * 64 + p]);
            const bf16_t* Bp = XBC + (size_t)tok * DXBC + DI + g * 128 + nq;
            const bf16_t* Cp = XBC + (size_t)tok * DXBC + DI + 512 + g * 128 + nq;
            float y = 0.f;
#pragma unroll
            for (int e = 0; e < 32; ++e) { hs[e] = hs[e] * dec + dt * xv * bflo((unsigned)Bp[e]); y += bflo((unsigned)Cp[e]) * hs[e]; }
            y += __shfl_xor(y, 1); y += __shfl_xor(y, 2);
            if (dir == 0) { if ((c.tid & 3) == 0) YTMP[(size_t)tok * DI + h * 64 + p] = (bf16_t)(pk2(y, 0.f) & 0xffff); }
            else {
                const float yt = bflo((unsigned)YTMP[(size_t)tok * DI + h * 64 + p]);
                const float zz = bflo((unsigned)Z[(size_t)tok * DI + h * 64 + p]);
                float yy = (y + yt + Dh * xv) * silu_f(zz);
                __syncthreads();
                if ((c.tid & 3) == 0) { red[p] = yy * yy; YG[(size_t)tok * DI + h * 64 + p] = (bf16_t)(pk2(yy * nw, 0.f) & 0xffff); }
                __syncthreads();
                if (c.tid == 0) { float s = 0.f; for (int e = 0; e < 64; ++e) s += red[e]; SSQ[(size_t)tok * NH + h] = s; }
            }
        }
        if (!is_lat) { float* op = a.out + (size_t)NTOK * D + ((size_t)((seq * 2 + j) * 2 + dir) * NH + h) * 8192 + p * 128 + nq;
#pragma unroll
            for (int e = 0; e < 32; ++e) op[e] = hs[e]; }
    }
}
#endif
__device__ __forceinline__ void phase_scan(const Ctx& c, int j) {
#if NAIVE_SCAN
    for (int u = c.vb; u < 1088; u += c.G) { if (u < 64) scan_unit_naive(c, j, 32 + (u >> 5), u & 31); else scan_unit_naive(c, j, (u - 64) >> 5, (u - 64) & 31); }
    return;
#endif
    phase_scan_pipe(c, j);
}

typedef const Args __attribute__((address_space(4)))* ArgsP;
#if 0
#define LB_WAVES 1
#else
#define LB_WAVES 2
#endif
__global__ void __launch_bounds__(NTHR, LB_WAVES) fwd_kernel(Args args) {
    extern __shared__ __attribute__((aligned(16))) char lds[];
    volatile LAS unsigned* st = (volatile LAS unsigned*)(lds + LDS_BYTES - 16);
    if (threadIdx.x == 0) { st[0] = 0u; st[1] = 0u; }
    __syncthreads();
    const int ph_lo = args.ph_lo, ph_hi = args.ph_hi;
    const bool multi = (ph_hi - ph_lo) > 1;
    XcdBarrier bar; bar.bar = (unsigned*)(args.ws + WS_CTL); bar.x = 0; bar.st = st;
    if (multi) bar = xcd_barrier_post((unsigned*)(args.ws + WS_CTL), st);

    int rep = 0;
#pragma unroll 1
    for (int ph = ph_lo; ph < ph_hi; ++ph) {
        ArgsP ap = (ArgsP)__builtin_amdgcn_kernarg_segment_ptr();
        asm volatile("" : "+s"(ap));
        int tid = threadIdx.x;
        asm volatile("" : "+v"(tid));
        Ctx c;
        c.lds = lds; c.tid = tid; c.lane = tid & 63; c.wid = __builtin_amdgcn_readfirstlane(tid >> 6);
        c.G = gridDim.x; c.vb = (c.G % 8 == 0) ? (int)(blockIdx.x % 8) * (c.G / 8) + (int)(blockIdx.x / 8) : (int)blockIdx.x;
        c.a = ap;
        unsigned char* ws = ap->ws;
        const float* MOD = (const float*)(ws + WS_MOD);

        int kind = 0;
        if (ph == 0) { if (PH_ON(0)) phase_prep(c); }
        else if (ph == 1) { kind = 12; phase_prep2(c); }
        else if (ph == NPHASE - 1) { kind = 10; if (PH_ON(1)) phase_norm(c, ap->in[21], nullptr, 0, 0, true); }
        else {
            int layer, sub;
            if (ph <= 7) { layer = 0; sub = ph - 2; } else if (ph <= 12) { layer = 1; sub = ph - 8; } else if (ph <= 18) { layer = 2; sub = ph - 13; } else { layer = 3; sub = ph - 19; }
            const int j = layer >> 1;
            const float* mod = MOD + (size_t)layer * 3 * 6144;
            const bool ssd = (layer & 1) == 0;
            const int nmix = ssd ? 4 : 3;
            if (sub < nmix - 1) kind = ssd ? (sub == 0 ? 2 : sub == 1 ? 3 : 4) : (sub == 0 ? 6 : 7);
            else if (sub == nmix) kind = 8;
            else kind = 5;

            if (kind == 2) { if (PH_ON(2)) phase_inproj(c, j); }
            else if (kind == 3) { if (PH_ON(3)) phase_conv(c, j); }
            else if (kind == 4) { if (PH_ON(4)) phase_scan(c, j); }
            else if (kind == 6) { if (PH_ON(6)) phase_f1(c, j); }
            else if (kind == 7) { if (PH_ON(7)) phase_f2(c); }
            else if (kind == 8) { if (PH_ON(8)) phase_mlp_up(c, layer); }
            else {
                if (PH_ON(5)) {
                    const bf16_t* WT; const bf16_t* Act; int K; const float* gate; const float* bias = nullptr; const float* ssq = nullptr;
                    const float* nw_next; const float* scale_next;
                    if (sub == nmix - 1) {
                        gate = mod + 2048; nw_next = ap->in[8] + layer * D; scale_next = mod + 4096;
                        if (ssd) { WT = (const bf16_t*)(ws + WS_WOUT) + (size_t)j * D * DI; Act = (const bf16_t*)(ws + S_YG); K = DI; ssq = (const float*)(ws + S_SSQ); }
                        else { WT = (const bf16_t*)(ws + WS_WFNO) + (size_t)j * D * D; Act = (const bf16_t*)(ws + S_F); K = D; bias = ap->in[18] + j * D; }
                    } else {
                        gate = mod + 5120; WT = (const bf16_t*)(ws + WS_W2) + (size_t)layer * D * DFF; Act = (const bf16_t*)(ws + S_HID); K = DFF;
                        if (layer < 3) { nw_next = ap->in[7] + (layer + 1) * D; scale_next = mod + 3 * 6144 + 1024; } else { nw_next = nullptr; scale_next = nullptr; }
                    }
                    if (rep > 0) { gate = (const float*)(ws + WS_ZERO); }
                    phase_resid_gemm(c, WT, Act, K, gate, bias, ssq, nw_next, scale_next, layer == 0 && sub == nmix - 1 && rep == 0);
                }
            }
        }
        if (REP_KIND == 9) { for (int r = 0; r < REP_N; ++r) if (multi) xcd_barrier(bar); }
        if (REP_N > 0 && kind == REP_KIND && rep < REP_N) { ++rep; --ph; if (multi) xcd_barrier(bar); continue; }
        rep = 0;
        if (REP_KIND == 11 && ph == NPHASE - 1) { for (int r = 0; r < REP_N; ++r) { if (multi) xcd_barrier(bar); phase_bench(c); } }
        if (ph + 1 < ph_hi) xcd_barrier(bar);
    }
}

extern "C" void kernel_launch(void* const* d_in, const int* in_sizes, int n_in, void* d_out, int out_size, void* d_ws, size_t ws_size, hipStream_t stream) {
    static int grid = 0;
    if (grid == 0) {
        int dev = 0, cus = 0;
        if (hipGetDevice(&dev) != hipSuccess || hipDeviceGetAttribute(&cus, hipDeviceAttributeMultiprocessorCount, dev) != hipSuccess || cus <= 0) { fprintf(stderr, "kernel_launch: device query failed\n"); grid = -1; return; }
        if (hipFuncSetAttribute((const void*)fwd_kernel, hipFuncAttributeMaxDynamicSharedMemorySize, LDS_BYTES) != hipSuccess) { fprintf(stderr, "kernel_launch: hipFuncSetAttribute failed\n"); }
        (void)hipGetLastError();
        if (ws_size < WS_END) fprintf(stderr, "kernel_launch: workspace too small: %zu < %zu\n", ws_size, (size_t)WS_END);
        grid = cus;
    }
    if (grid < 0) return;
    (void)hipMemsetAsync((char*)d_ws + WS_CTL, 0, CTL_BYTES, stream);
    Args a{};
    for (int i = 0; i < 22; ++i) a.in[i] = (const float*)d_in[i];
    a.out = (float*)d_out; a.ws = (unsigned char*)d_ws;
#if N_LAUNCH_MODE == 1
    a.ph_lo = 0; a.ph_hi = NPHASE;
    hipLaunchKernelGGL(fwd_kernel, dim3(grid), dim3(NTHR), LDS_BYTES, stream, a);
#else
    for (int ph = 0; ph < NPHASE; ++ph) {
        a.ph_lo = ph; a.ph_hi = ph + 1;
        hipLaunchKernelGGL(fwd_kernel, dim3(grid), dim3(NTHR), LDS_BYTES, stream, a);
    }
#endif
}
```

```cpp
#include <hip/hip_runtime.h>
#include <stdint.h>
#include <stdio.h>

#ifndef PH_MASK
#define PH_MASK 0xFFFF
#endif
#define PH_ON(k) ((PH_MASK >> (k)) & 1)
#ifndef NAIVE_GEMM
#define NAIVE_GEMM 0
#endif
#define GN(k) ((NAIVE_GEMM >> (k)) & 1)
#ifndef NAIVE_SCAN
#define NAIVE_SCAN 0
#endif
#ifndef REP_KIND
#define REP_KIND -1
#endif
#ifndef REP_N
#define REP_N 0
#endif
#ifndef GEMM_INTERLEAVE
#define GEMM_INTERLEAVE 0
#endif
#ifndef GEMM_SETPRIO
#define GEMM_SETPRIO 0
#endif
#ifndef N_LAUNCH_MODE
#define N_LAUNCH_MODE 1
#endif

typedef unsigned short bf16_t;
typedef short bf16x8 __attribute__((ext_vector_type(8)));
typedef short bf16x4 __attribute__((ext_vector_type(4)));
typedef float f32x4 __attribute__((ext_vector_type(4)));
typedef unsigned u32x4 __attribute__((ext_vector_type(4)));
typedef unsigned u32x2 __attribute__((ext_vector_type(2)));
#define LAS __attribute__((address_space(3)))

constexpr int D = 1024, NCTX = 8192, NLAT = 2048, NTOK = 10240;
constexpr int DI = 2048, DXBC = 3072, DPROJ = 5184, NZX = 5120, NH = 32, DFF = 4096;
constexpr float EPS = 1e-6f;
constexpr int NPHASE = 25;

constexpr size_t al256(size_t x) { return (x + 255) & ~(size_t)255; }
constexpr size_t WS_CTL  = 0;
constexpr size_t CTL_BYTES = 65536 + 81920;
constexpr size_t WS_ZERO = 65536;
constexpr size_t WS_MOD  = WS_CTL + CTL_BYTES;
constexpr size_t WS_SWIN = al256(WS_MOD + 4 * 3 * 6144 * 4);
constexpr size_t WS_SWUP = WS_SWIN + 2 * 3 * DPROJ * 4;
constexpr size_t WS_SWF1 = WS_SWUP + 4 * 3 * DFF * 4;
constexpr size_t WS_RSS  = al256(WS_SWF1 + 2 * 3 * 2048 * 4);
constexpr size_t WS_WIN  = al256(WS_RSS + (size_t)NTOK * 16 * 4);
constexpr size_t WS_WOUT = WS_WIN + (size_t)2 * DPROJ * D * 2;
constexpr size_t WS_WFNO = WS_WOUT + (size_t)2 * D * DI * 2;
constexpr size_t WS_W1   = WS_WFNO + (size_t)2 * D * D * 2;
constexpr size_t WS_W2   = WS_W1 + (size_t)4 * DFF * D * 2;
constexpr size_t WS_T1   = WS_W2 + (size_t)4 * DFF * D * 2;
constexpr size_t WS_T2C  = WS_T1 + (size_t)512 * 256 * 2;
constexpr size_t WS_T2L  = WS_T2C + (size_t)256 * 512 * 2;
constexpr size_t WS_H    = WS_T2L + (size_t)1024 * 2048 * 2;
constexpr size_t WS_S    = WS_H + (size_t)NTOK * D * 2;
constexpr size_t S_Z     = WS_S;
constexpr size_t S_XBC   = S_Z + (size_t)NTOK * DI * 2;
constexpr size_t S_DT    = S_XBC + (size_t)NTOK * DXBC * 2;
constexpr size_t S_SSQ   = S_DT + (size_t)NTOK * 64 * 4;
constexpr size_t S_YG    = S_SSQ + (size_t)NTOK * 32 * 4;
constexpr size_t S_RAW   = S_YG + (size_t)NTOK * DI * 2;
constexpr size_t WS_END  = S_RAW + (size_t)NTOK * DXBC * 2;
constexpr size_t S_HID   = WS_S;
constexpr size_t S_UVT   = WS_S;
constexpr size_t S_F     = WS_S + (size_t)NTOK * 2048 * 2;

constexpr int LDS_BYTES = 163840;
constexpr int NTHR = 512, NWAVE = 8;

typedef __bf16 bf16x2_t __attribute__((ext_vector_type(2)));
typedef float f32x2_t __attribute__((ext_vector_type(2)));
__device__ __forceinline__ unsigned pk2(float lo, float hi) { const f32x2_t f = {lo, hi}; return __builtin_bit_cast(unsigned, __builtin_convertvector(f, bf16x2_t)); }
__device__ __forceinline__ float bflo(unsigned u) { return __uint_as_float(u << 16); }
__device__ __forceinline__ float bfhi(unsigned u) { return __uint_as_float(u & 0xffff0000u); }
__device__ __forceinline__ float wave_sum(float v) {
#pragma unroll
    for (int o = 1; o < 64; o <<= 1) v += __shfl_xor(v, o);
    return v;
}
__device__ __forceinline__ float silu_f(float x) { return x * __builtin_amdgcn_rcpf(1.0f + __expf(-x)); }
__device__ __forceinline__ int cond_of(int tok) { return tok < NCTX ? 0 : (tok < NCTX + 1024 ? 1 : 2); }

#define XB_TMO      128
#define XB_XCNT(j)  (256  + 64 * (j))
#define XB_XSUB(j)  (1280 + 64 * (j))
#define XB_XGEN(j)  (2304 + 64 * (j))
#define XB_TOP      3328
#define XB_TOPGEN   3392
#define XCD_BAR_WORDS 3456
#define XB_SPIN_CAP (1u << 20)
__device__ __forceinline__ unsigned xb_ld(unsigned* p)              { return __hip_atomic_load(p, __ATOMIC_RELAXED, __HIP_MEMORY_SCOPE_AGENT); }
__device__ __forceinline__ unsigned xb_add(unsigned* p, unsigned v) { return __hip_atomic_fetch_add(p, v, __ATOMIC_RELAXED, __HIP_MEMORY_SCOPE_AGENT); }
__device__ __forceinline__ unsigned xb_xcc_id() { return (unsigned)__builtin_amdgcn_s_getreg((3 << 11) | 20) & 0xFu; }
#define XB_SPIN(cond, bar) do { unsigned _sp = 0; while (cond) { __builtin_amdgcn_s_sleep(1); \
    if ((++_sp & 255u) == 0u) { if (xb_ld(&(bar)[XB_TMO])) break; if (_sp > XB_SPIN_CAP) { atomicAdd(&(bar)[XB_TMO], 1u); break; } } } } while (0)
struct XcdBarrier { unsigned* bar; unsigned x; volatile LAS unsigned* st; };
__device__ __forceinline__ XcdBarrier xcd_barrier_post(unsigned* bar, volatile LAS unsigned* st) {
    XcdBarrier b; b.bar = bar; b.x = xb_xcc_id(); b.st = st;
    if (threadIdx.x == 0) (void)xb_add(&bar[XB_XCNT(b.x)], 1u);
    return b;
}
__device__ __forceinline__ void xcd_barrier_complete(unsigned* bar, unsigned x, unsigned& nloc, unsigned& nx) {
    const unsigned G = gridDim.x * gridDim.y * gridDim.z;
    unsigned sum, cnt, mine, sp = 0u;
    for (;;) {
        sum = 0u; cnt = 0u; mine = 0u;
#pragma unroll
        for (unsigned j = 0; j < 16; ++j) { const unsigned c = xb_ld(&bar[XB_XCNT(j)]); sum += c; cnt += (c > 0u) ? 1u : 0u; mine = (j == x) ? c : mine; }
        if (sum == G) break;
        __builtin_amdgcn_s_sleep(1);
        if ((++sp & 255u) == 0u) { if (xb_ld(&bar[XB_TMO])) break; if (sp > XB_SPIN_CAP) { atomicAdd(&bar[XB_TMO], 1u); break; } }
    }
    nloc = mine > 0u ? mine : 1u; nx = cnt > 0u ? cnt : 1u;
}
__device__ __forceinline__ void xcd_barrier(const XcdBarrier& b) {
    asm volatile("s_waitcnt vmcnt(0)" ::: "memory");
    __syncthreads();
    if (threadIdx.x == 0) {
        unsigned* bar = b.bar;
        __builtin_amdgcn_s_waitcnt(0);
        unsigned nloc = b.st[0], nx = b.st[1];
        if (nloc == 0u) { xcd_barrier_complete(bar, b.x, nloc, nx); b.st[0] = nloc; b.st[1] = nx; }
        const unsigned old = xb_add(&bar[XB_XSUB(b.x)], 1u);
        const unsigned gen = old / nloc;
        if (old + 1u == (gen + 1u) * nloc) {
            __builtin_amdgcn_fence(__ATOMIC_RELEASE, "agent");
            asm volatile("s_waitcnt vmcnt(0)" ::: "memory");
            const unsigned og = xb_add(&bar[XB_TOP], 1u);
            const unsigned tg = og / nx;
            if (og + 1u == (tg + 1u) * nx) xb_add(&bar[XB_TOPGEN], 1u);
            else XB_SPIN(xb_ld(&bar[XB_TOPGEN]) == tg, bar);
            __builtin_amdgcn_fence(__ATOMIC_ACQUIRE, "agent");
            xb_add(&bar[XB_XGEN(b.x)], 1u);
            asm volatile("s_waitcnt vmcnt(0)" ::: "memory");
        } else {
            XB_SPIN(xb_ld(&bar[XB_XGEN(b.x)]) == gen, bar);
            __builtin_amdgcn_fence(__ATOMIC_ACQUIRE, "agent");
            asm volatile("s_waitcnt vmcnt(0)" ::: "memory");
        }
    }
    __syncthreads();
}

struct Args {
    const float* in[22];
    float* out;
    unsigned char* ws;
    int ph_lo, ph_hi;
};

struct Ctx {
    char* lds;
    int tid, lane, wid;
    int vb, G;
    const Args __attribute__((address_space(4)))* a;
};

template <int TB> struct GT { static constexpr int ROWS = 256 + 32 * TB, STAGE = ROWS * 128, NI = ROWS / 8; };

template <int TB>
__device__ __forceinline__ void gemm_stage(char* st, const bf16_t* Ag, int lda, const bf16_t* Bg, int ldb, int k0, int wid, int lane) {
    constexpr int NI = GT<TB>::NI;
    const int rsub = lane >> 3, lch = (lane & 7) ^ rsub;
#pragma unroll
    for (int i = 0; i < (NI + 7) / 8; ++i) {
        const int q = wid + 8 * i;
        if (q < NI) {
            const int row = q * 8 + rsub;
            const bf16_t* src = (q < 32) ? (Ag + (size_t)row * lda + k0 + lch * 8) : (Bg + (size_t)(row - 256) * ldb + k0 + lch * 8);
            __builtin_amdgcn_global_load_lds((const unsigned*)src, (LAS unsigned*)(st + q * 1024 + lane * 16), 16, 0, 0);
        }
    }
}
__device__ __forceinline__ bf16x8 frag128(const char* tile, int row, int chunk) {
    return *(const bf16x8*)(tile + row * 128 + ((chunk ^ (row & 7)) << 4));
}

struct NoPre { __device__ __forceinline__ void operator()() const {} };
template <int TB, bool NAIVE, class Epi, class Pre = NoPre>
__device__ __forceinline__ void gemm_tile(const Ctx& c, const bf16_t* Ag, int lda, const bf16_t* Bg, int ldb, int K, int a0, int b0, const Epi& epi, const Pre& pre = Pre(),
                                          bool prefetched = false, const bf16_t* An = nullptr, const bf16_t* Bn = nullptr) {
    constexpr int STAGE = GT<TB>::STAGE;
    const int wr = c.wid >> 1, wc = c.wid & 1, fr = c.lane & 15, fq = c.lane >> 4;
    f32x4 acc[4][TB];
#pragma unroll
    for (int i = 0; i < 4; ++i)
#pragma unroll
        for (int j = 0; j < TB; ++j) acc[i][j] = (f32x4){0.f, 0.f, 0.f, 0.f};
    if (NAIVE) {
        __syncthreads(); pre(); __syncthreads();
        const bf16_t* ar = Ag + (size_t)(wr * 64 + fq * 4) * lda;
        const bf16_t* br = Bg + (size_t)(wc * 16 * TB + fr) * ldb;
#pragma unroll
        for (int j = 0; j < TB; ++j) {
#pragma unroll 1
            for (int k = 0; k < K; k += 8) {
                float bv[8];
                { const u32x4 v = *(const u32x4*)(br + (size_t)(j * 16) * ldb + k);
#pragma unroll
                  for (int e = 0; e < 4; ++e) { bv[2 * e] = bflo(v[e]); bv[2 * e + 1] = bfhi(v[e]); } }
#pragma unroll
                for (int i = 0; i < 4; ++i)
#pragma unroll
                    for (int r = 0; r < 4; ++r) {
                        const u32x4 v = *(const u32x4*)(ar + (size_t)(i * 16 + r) * lda + k);
#pragma unroll
                        for (int e = 0; e < 4; ++e) acc[i][j][r] += bflo(v[e]) * bv[2 * e] + bfhi(v[e]) * bv[2 * e + 1];
                    }
                asm volatile("" ::: "memory");
            }
        }
        epi(acc, a0 + wr * 64, b0 + wc * (16 * TB), fr, fq);
        return;
    }
    const int nt = K >> 6;
    __syncthreads();
    if (!prefetched) gemm_stage<TB>(c.lds, Ag, lda, Bg, ldb, 0, c.wid, c.lane);
    pre();
    for (int t = 0; t < nt; ++t) {
        asm volatile("s_waitcnt vmcnt(0)" ::: "memory");
        __syncthreads();
        const char* cur = c.lds + (t & 1) * STAGE;
        if (t + 1 < nt) gemm_stage<TB>(c.lds + ((t + 1) & 1) * STAGE, Ag, lda, Bg, ldb, (t + 1) << 6, c.wid, c.lane);
        else if (An) gemm_stage<TB>(c.lds, An, lda, Bn, ldb, 0, c.wid, c.lane);
#pragma unroll
        for (int kk = 0; kk < 2; ++kk) {
            bf16x8 af[4], bfr[TB];
#pragma unroll
            for (int i = 0; i < 4; ++i) af[i] = frag128(cur, wr * 64 + i * 16 + fr, kk * 4 + fq);
#pragma unroll
            for (int j = 0; j < TB; ++j) bfr[j] = frag128(cur, 256 + wc * (16 * TB) + j * 16 + fr, kk * 4 + fq);
#pragma unroll
            for (int i = 0; i < 4; ++i)
#pragma unroll
                for (int j = 0; j < TB; ++j) acc[i][j] = __builtin_amdgcn_mfma_f32_16x16x32_bf16(af[i], bfr[j], acc[i][j], 0, 0, 0);
        }
    }
    epi(acc, a0 + wr * 64, b0 + wc * (16 * TB), fr, fq);
}

template <int TB, class Prob, int BENCH = 0>
__device__ __forceinline__ void gemm_stream(const Ctx& c, const Prob& P) {
    constexpr int STAGE = GT<TB>::STAGE, NI = GT<TB>::NI;
    constexpr int NSLOT = (NI + 7) / 8;
    const int wr = c.wid >> 1, wc = c.wid & 1, fr = c.lane & 15, fq = c.lane >> 4;
    const int n = P.count();
    if (n <= 0) return;
    f32x4 acc[4][TB];
#pragma unroll
    for (int i = 0; i < 4; ++i)
#pragma unroll
        for (int j = 0; j < TB; ++j) acc[i][j] = (f32x4){0.f, 0.f, 0.f, 0.f};
    const int KT = P.K >> 6;
    const int total = n * KT;
    const int rsub = c.lane >> 3, lch = (c.lane & 7) ^ rsub;
    int voff[NSLOT], qs[NSLOT];
#pragma unroll
    for (int s = 0; s < NSLOT; ++s) {
        const int q = (c.wid + 8 * s < NI) ? c.wid + 8 * s : NI - 1;
        qs[s] = q;
        voff[s] = (s < 4) ? ((q * 8 + rsub) * P.lda + lch * 8) : ((q * 8 + rsub - 256) * P.ldb + lch * 8);
    }
    const bf16_t* Acur; const bf16_t* Bcur;
    int li = 0, lk = 0;
    P.tile(0, Acur, Bcur);
    constexpr int Q0 = (NSLOT + 3) / 4, Q1 = Q0 + (NSLOT + 2) / 4, Q2 = Q1 + (NSLOT + 1) / 4;
    constexpr int S1 = Q1;
    auto issue_part = [&](int stage, int s0, int s1) {
        char* st = c.lds + stage * STAGE;
#pragma unroll
        for (int s = 0; s < NSLOT; ++s) {
            if (s >= s0 && s < s1) {
                const bf16_t* src = ((s < 4) ? Acur : Bcur) + voff[s] + lk * 64;
                __builtin_amdgcn_global_load_lds((const unsigned*)src, (LAS unsigned*)(st + qs[s] * 1024 + c.lane * 16), 16, 0, 0);
            }
        }
    };
    auto issue = [&](int stage) { issue_part(stage, 0, NSLOT); };
    auto advance = [&]() { if (++lk == KT) { lk = 0; if (li + 1 < n) { ++li; P.tile(li, Acur, Bcur); } } };
    asm volatile("s_waitcnt vmcnt(0)" ::: "memory");
    __builtin_amdgcn_s_barrier();
    asm volatile("" ::: "memory");
    issue(0); advance(); issue(1); advance();
    P.pre_all();
    int ci = 0, ck = 0, stg = 0;
#define GEMM_WAIT_ONE_STAGE() do { if (BENCH == 1) { asm volatile("s_waitcnt vmcnt(0)" ::: "memory"); } \
        else if (after_epi) { asm volatile("s_waitcnt vmcnt(%0)" :: "n"(S1 + Prob::EPI_STORES) : "memory"); } \
        else { asm volatile("s_waitcnt vmcnt(%0)" :: "n"(S1) : "memory"); } } while (0)
    bool after_epi = false;
#define GEMM_BAR() do { asm volatile("" ::: "memory"); __builtin_amdgcn_s_barrier(); asm volatile("" ::: "memory"); } while (0)
#define GEMM_LOADF(dst, stage_ptr, kk) do { \
        _Pragma("unroll") for (int i = 0; i < 4; ++i) dst.a[i] = frag128(stage_ptr, wr * 64 + i * 16 + fr, (kk) * 4 + fq); \
        _Pragma("unroll") for (int jj = 0; jj < TB; ++jj) dst.b[jj] = frag128(stage_ptr, 256 + wc * (16 * TB) + jj * 16 + fr, (kk) * 4 + fq); } while (0)
#define GEMM_MMA(src_) do { \
        _Pragma("unroll") for (int i = 0; i < 4; ++i) \
        _Pragma("unroll") for (int jj = 0; jj < TB; ++jj) acc[i][jj] = __builtin_amdgcn_mfma_f32_16x16x32_bf16(src_.a[i], src_.b[jj], acc[i][jj], 0, 0, 0); } while (0)
    struct Frags { bf16x8 a[4]; bf16x8 b[TB]; };
    Frags f0, f1;
    if (BENCH == 1) { asm volatile("s_waitcnt vmcnt(0)" ::: "memory"); } else { asm volatile("s_waitcnt vmcnt(%0)" :: "n"(NSLOT) : "memory"); }
    GEMM_BAR();
    GEMM_LOADF(f0, c.lds, 0);
    f32x4 sw[4];
#pragma unroll
    for (int i = 0; i < 4; ++i) sw[i] = (f32x4){0.f, 0.f, 0.f, 0.f};
#pragma unroll 1
    for (int gs = 0; gs < total; ++gs) {
        const char* cur = c.lds + stg * STAGE;
        const int nst1 = stg == 2 ? 0 : stg + 1;
        if (ck == KT - 1) P.preload(ci, sw, wr, fq);
        if (BENCH != 2) GEMM_LOADF(f1, cur, 1);
        const int nst2 = stg == 0 ? 2 : stg - 1;
        if (BENCH != 1) issue_part(nst2, 0, Q0);
        if (BENCH != 2) GEMM_MMA(f0);
#if GEMM_INTERLEAVE
        __builtin_amdgcn_sched_group_barrier(0x100, 4 + TB, 0);
#pragma unroll
        for (int s = 0; s < NSLOT; ++s) {
            __builtin_amdgcn_sched_group_barrier(0x008, 2, 0);
            __builtin_amdgcn_sched_group_barrier(0x006, 6, 0);
            __builtin_amdgcn_sched_group_barrier(0x010, 1, 0);
        }
        __builtin_amdgcn_sched_group_barrier(0x008, 4 * TB - 2 * NSLOT, 0);
#endif
        if (BENCH != 1) issue_part(nst2, Q0, Q1);
        GEMM_WAIT_ONE_STAGE();
        after_epi = false;
        asm volatile("s_waitcnt lgkmcnt(0)" ::: "memory");
        GEMM_BAR();
        if (BENCH != 1) issue_part(nst2, Q1, Q2);
        if (BENCH != 2) GEMM_LOADF(f0, c.lds + nst1 * STAGE, 0);
#if GEMM_SETPRIO
        __builtin_amdgcn_s_setprio(1);
#endif
        if (BENCH != 2) GEMM_MMA(f1);
#if GEMM_SETPRIO
        __builtin_amdgcn_s_setprio(0);
#endif
        if (BENCH != 1) issue_part(nst2, Q2, NSLOT);
        stg = nst1;
        advance();
        if (++ck == KT) {
            P.epilogue(ci, acc, sw, wr, wc, fr, fq);
#pragma unroll
            for (int i = 0; i < 4; ++i)
#pragma unroll
                for (int j = 0; j < TB; ++j) acc[i][j] = (f32x4){0.f, 0.f, 0.f, 0.f};
            ck = 0; ++ci;
            after_epi = true;
        }
    }
    asm volatile("s_waitcnt vmcnt(0)" ::: "memory");
    GEMM_BAR();
#undef GEMM_WAIT_ONE_STAGE
#undef GEMM_BAR
#undef GEMM_LOADF
#undef GEMM_MMA
}

__device__ __forceinline__ u32x4 pair16(const u32x2& a, const u32x2& b) {
    const auto sx = __builtin_amdgcn_permlane16_swap(a.x, b.x, false, false);
    const auto sy = __builtin_amdgcn_permlane16_swap(a.y, b.y, false, false);
    return (u32x4){sx[0], sy[0], sx[1], sy[1]};
}
struct EpiInProj {
    bf16_t* Z; bf16_t* RAW; const float* rsx  ; int tok_base; const float* SW  ; bool uni  ;
    __device__ __forceinline__ void operator()(f32x4 (&acc)[4][5], const f32x4 (&swp)[4], int ab, int bb, int fr, int fq) const {
#pragma unroll
        for (int j = 0; j < 5; ++j) {
            const int tok = bb + j * 16 + fr;
            const float rs = rsx[tok - tok_base];
            const float* sw = SW + cond_of(tok) * DPROJ;
            u32x2 v[4];
#pragma unroll
            for (int i = 0; i < 4; ++i) {
                const int n = ab + i * 16 + fq * 4;
                const f32x4 o = acc[i][j] * rs + (uni ? swp[i] : *(const f32x4*)(sw + n));
                v[i].x = pk2(o[0], o[1]); v[i].y = pk2(o[2], o[3]);
            }
#pragma unroll
            for (int p = 0; p < 2; ++p) {
                const u32x4 o = pair16(v[2 * p], v[2 * p + 1]);
                const int n = ab + (2 * p + (fq & 1)) * 16 + (fq & 2) * 4;
                bf16_t* dst = (n < DI) ? (Z + (size_t)tok * DI + n) : (RAW + (size_t)tok * DXBC + (n - DI));
                *(u32x4*)dst = o;
            }
        }
    }
};
struct EpiResid {
    float* X; const float* gate  ; const float* bias; const float* rs_lds  ; int tok_base;
    const float* Xin0; const float* Xin1;
    bf16_t* XG  ; const float* nw_next; const float* scale_next  ; float* RSS; const float* zeros  ;
    __device__ __forceinline__ void operator()(f32x4 (&acc)[4][5], int ab, int bb, int fr, int fq) const {
        const int slot = (ab >> 6);
        const bool uni = cond_of(bb) == cond_of(bb + 79);
        const int nb = ab + fq * 4;
        f32x4 gvv[4], bvv[4], gnn[4];
        auto load_vecs = [&](int cd) {
            const float* gp = gate + cd * 6144 + nb;
            const float* bp = (bias ? bias : zeros) + nb;
            const float* np = (XG ? nw_next : zeros) + nb;
            const float* sp = (XG ? scale_next + cd * 6144 : zeros) + nb;
            f32x4 t0[4], t1[4];
#pragma unroll
            for (int i = 0; i < 4; ++i) { gvv[i] = *(const f32x4*)(gp + i * 16); bvv[i] = *(const f32x4*)(bp + i * 16); t0[i] = *(const f32x4*)(np + i * 16); t1[i] = *(const f32x4*)(sp + i * 16); }
#pragma unroll
            for (int i = 0; i < 4; ++i) gnn[i] = t0[i] * (t1[i] + 1.0f);
        };
        if (uni) load_vecs(cond_of(bb));
        auto xrow = [&](int tok) -> const float* { return (Xin0 ? (tok < NCTX ? Xin0 + (size_t)tok * D : Xin1 + (size_t)(tok - NCTX) * D) : X + (size_t)tok * D) + nb; };
        f32x4 xv[4];
#pragma unroll
        for (int j = 0; j < 5; ++j) {
            const int tok = bb + j * 16 + fr;
            { const float* p = xrow(tok);
#pragma unroll
              for (int i = 0; i < 4; ++i) xv[i] = *(const f32x4*)(p + i * 16); }
            const float rs = rs_lds ? rs_lds[tok - tok_base] : 1.0f;
            if (!uni) load_vecs(cond_of(tok));
            float ss = 0.f;
            u32x2 xgv[4];
            float* xo = X + (size_t)tok * D + nb;
#pragma unroll
            for (int i = 0; i < 4; ++i) {
                const f32x4 x2 = xv[i] + gvv[i] * (acc[i][j] * rs + bvv[i]);
                *(f32x4*)(xo + i * 16) = x2;
                ss += x2[0] * x2[0] + x2[1] * x2[1] + x2[2] * x2[2] + x2[3] * x2[3];
                const f32x4 o = x2 * gnn[i];
                xgv[i].x = pk2(o[0], o[1]); xgv[i].y = pk2(o[2], o[3]);
            }
            if (XG) {
#pragma unroll
                for (int p = 0; p < 2; ++p) {
                    const u32x4 o = pair16(xgv[2 * p], xgv[2 * p + 1]);
                    *(u32x4*)(XG + (size_t)tok * D + ab + (2 * p + (fq & 1)) * 16 + (fq & 2) * 4) = o;
                }
                ss += __shfl_xor(ss, 16); ss += __shfl_xor(ss, 32);
                if (fq == 0) RSS[(size_t)tok * 16 + slot] = ss;
            }
        }
    }
};
struct EpiMlpUp {
    bf16_t* HID; const float* rsx; int tok_base; const float* SW  ; bool uni;
    __device__ __forceinline__ void operator()(f32x4 (&acc)[4][5], const f32x4 (&swp)[4], int ab, int bb, int fr, int fq) const {
#pragma unroll
        for (int j = 0; j < 5; ++j) {
            const int tok = bb + j * 16 + fr;
            const float rs = rsx[tok - tok_base];
            const float* sw = SW + cond_of(tok) * DFF;
            u32x2 v[4];
#pragma unroll
            for (int i = 0; i < 4; ++i) {
                const int n = ab + i * 16 + fq * 4;
                f32x4 a = acc[i][j] * rs + (uni ? swp[i] : *(const f32x4*)(sw + n));
                a[0] = fmaxf(a[0], 0.f); a[1] = fmaxf(a[1], 0.f); a[2] = fmaxf(a[2], 0.f); a[3] = fmaxf(a[3], 0.f);
                v[i].x = pk2(a[0] * a[0], a[1] * a[1]); v[i].y = pk2(a[2] * a[2], a[3] * a[3]);
            }
#pragma unroll
            for (int p = 0; p < 2; ++p) {
                const u32x4 o = pair16(v[2 * p], v[2 * p + 1]);
                *(u32x4*)(HID + (size_t)tok * DFF + ab + (2 * p + (fq & 1)) * 16 + (fq & 2) * 4) = o;
            }
        }
    }
};
struct EpiDt {
    float* DT; const float* rsx; int tok_base; const float* SW  ;
    __device__ __forceinline__ void operator()(f32x4 (&acc)[4][2], int ab, int bb, int fr, int fq) const {
        float swv[2][3];
#pragma unroll
        for (int j = 0; j < 2; ++j)
#pragma unroll
            for (int cd = 0; cd < 3; ++cd) swv[j][cd] = SW[cd * DPROJ + NZX + bb + j * 16 + fr];
#pragma unroll
        for (int j = 0; j < 2; ++j) {
            const int col = bb + j * 16 + fr;
#pragma unroll
            for (int i = 0; i < 4; ++i) {
                const int tok = ab + i * 16 + fq * 4;
#pragma unroll
                for (int r = 0; r < 4; ++r) {
                    const int cd = cond_of(tok + r);
                    const float sw = cd == 0 ? swv[j][0] : (cd == 1 ? swv[j][1] : swv[j][2]);
                    DT[(size_t)(tok + r) * 64 + col] = acc[i][j][r] * rsx[tok + r - tok_base] + sw;
                }
            }
        }
    }
};
struct EpiF1 {
    bf16_t* UVT; int g; const float* rsx; int tok_base; const float* SW  ;
    __device__ __forceinline__ void operator()(f32x4 (&acc)[4][4], int ab, int bb, int fr, int fq) const {
        float swv[4];
#pragma unroll
        for (int j = 0; j < 4; ++j) swv[j] = SW[cond_of(ab) * 2048 + g * 512 + bb + j * 16 + fr];
#pragma unroll
        for (int j = 0; j < 4; ++j) {
            const int nn = bb + j * 16 + fr, part = nn >> 8, ch = g * 256 + (nn & 255);
#pragma unroll
            for (int i = 0; i < 4; ++i) {
                const int tok = ab + i * 16 + fq * 4;
                const float sw = swv[j];
                bf16_t* dst;
                if (tok < NCTX) { const int s = tok >> 8, l = tok & 255; dst = UVT + ((size_t)(s * 1024 + ch) * 512 + part * 256 + l); }
                else { const int tt = tok - NCTX, s = tt >> 10, l = tt & 1023; dst = UVT + (size_t)NCTX * 2048 + ((size_t)(s * 1024 + ch) * 2048 + part * 1024 + l); }
                const f32x4 r4 = *(const f32x4*)(rsx + tok - tok_base);
                const f32x4 o = acc[i][j] * r4 + sw;
                u32x2 v; v.x = pk2(o[0], o[1]); v.y = pk2(o[2], o[3]);
                *(u32x2*)dst = v;
            }
        }
    }
};
template <int TB> struct EpiF2 {
    bf16_t* F; int tok0;
    __device__ __forceinline__ void operator()(f32x4 (&acc)[4][TB], int ab, int bb, int fr, int fq) const {
#pragma unroll
        for (int j = 0; j < TB; ++j) {
            const int tok = tok0 + bb + j * 16 + fr;
#pragma unroll
            for (int i = 0; i < 4; ++i) {
                const int n = ab + i * 16 + fq * 4;
                u32x2 v; v.x = pk2(acc[i][j][0], acc[i][j][1]); v.y = pk2(acc[i][j][2], acc[i][j][3]);
                *(u32x2*)(F + (size_t)tok * D + n) = v;
            }
        }
    }
};

struct TrItem { const float* W; bf16_t* WT; int K, N, k0, n0; };
__device__ __forceinline__ TrItem transpose_decode(const Ctx& c, int r) {
    const Args __attribute__((address_space(4)))& a = *c.a;
    constexpr int I_WIN = 8 * 81, I_WOUT = 16 * 16, I_FNO = 8 * 16, I_W1 = 8 * 64, I_W2 = 32 * 16;
    TrItem t; int item;
    if (r < 2 * I_WIN) { const int j = r / I_WIN; t.W = a.in[9] + (size_t)j * D * DPROJ; t.K = D; t.N = DPROJ; t.WT = (bf16_t*)(a.ws + WS_WIN) + (size_t)j * DPROJ * D; item = r - j * I_WIN; }
    else if ((r -= 2 * I_WIN) < 2 * I_WOUT) { const int j = r / I_WOUT; t.W = a.in[16] + (size_t)j * DI * D; t.K = DI; t.N = D; t.WT = (bf16_t*)(a.ws + WS_WOUT) + (size_t)j * D * DI; item = r - j * I_WOUT; }
    else if ((r -= 2 * I_WOUT) < 2 * I_FNO) { const int j = r / I_FNO; t.W = a.in[17] + (size_t)j * D * D; t.K = D; t.N = D; t.WT = (bf16_t*)(a.ws + WS_WFNO) + (size_t)j * D * D; item = r - j * I_FNO; }
    else if ((r -= 2 * I_FNO) < 4 * I_W1) { const int j = r / I_W1; t.W = a.in[19] + (size_t)j * D * DFF; t.K = D; t.N = DFF; t.WT = (bf16_t*)(a.ws + WS_W1) + (size_t)j * DFF * D; item = r - j * I_W1; }
    else { r -= 4 * I_W1; const int j = r / I_W2; t.W = a.in[20] + (size_t)j * DFF * D; t.K = DFF; t.N = D; t.WT = (bf16_t*)(a.ws + WS_W2) + (size_t)j * D * DFF; item = r - j * I_W2; }
    const int nb = t.N >> 6, kb = item / nb, nbi = item - kb * nb;
    t.k0 = kb * 128; t.n0 = nbi * 64;
    return t;
}
__device__ __forceinline__ void transpose_load(const Ctx& c, const TrItem& t, f32x4 (&v)[4]) {
    const int cl = c.tid & 15, rl = c.tid >> 4;
#pragma unroll
    for (int p = 0; p < 4; ++p) v[p] = *(const f32x4*)(t.W + (size_t)(t.k0 + p * 32 + rl) * t.N + t.n0 + cl * 4);
}
__device__ __forceinline__ void transpose_finish(const Ctx& c, const TrItem& t, const f32x4 (&v)[4]) {
    float* tile = (float*)c.lds;
    const int cl = c.tid & 15, rl = c.tid >> 4;
    __syncthreads();
#pragma unroll
    for (int p = 0; p < 4; ++p) { const int k = p * 32 + rl; tile[k * 65 + cl * 4 + 0] = v[p][0]; tile[k * 65 + cl * 4 + 1] = v[p][1]; tile[k * 65 + cl * 4 + 2] = v[p][2]; tile[k * 65 + cl * 4 + 3] = v[p][3]; }
    __syncthreads();
#pragma unroll
    for (int p = 0; p < 2; ++p) {
        const int idx = c.tid + p * NTHR, n = idx >> 4, kc = idx & 15;
        const float* s = tile + (kc * 8) * 65 + n;
        u32x4 o; o.x = pk2(s[0], s[65]); o.y = pk2(s[2 * 65], s[3 * 65]); o.z = pk2(s[4 * 65], s[5 * 65]); o.w = pk2(s[6 * 65], s[7 * 65]);
        *(u32x4*)(t.WT + (size_t)(t.n0 + n) * t.K + t.k0 + kc * 8) = o;
    }
}

__device__ __forceinline__ void ada_item(const Ctx& c, int item) {
    const Args __attribute__((address_space(4)))& a = *c.a;
    const int layer = item / 96, cg = item - layer * 96, n0 = cg * 64;
    const float* W = a.in[5] + (size_t)layer * D * 6144;
    const float* sc = (const float*)(c.lds + 40960);
    float* red = (float*)c.lds;
    const int cl = c.tid & 15, kl = c.tid >> 4;
    f32x4 a0 = {0, 0, 0, 0}, a1 = {0, 0, 0, 0}, a2 = {0, 0, 0, 0};
#pragma unroll 8
    for (int it = 0; it < 32; ++it) {
        const int k = it * 32 + kl;
        const f32x4 w = *(const f32x4*)(W + (size_t)k * 6144 + n0 + cl * 4);
        a0 += w * sc[k]; a1 += w * sc[1024 + k]; a2 += w * sc[2048 + k];
    }
    __syncthreads();
    *(f32x4*)(red + (kl * 3 + 0) * 64 + cl * 4) = a0;
    *(f32x4*)(red + (kl * 3 + 1) * 64 + cl * 4) = a1;
    *(f32x4*)(red + (kl * 3 + 2) * 64 + cl * 4) = a2;
    __syncthreads();
    if (c.tid < 192) {
        const int cond = c.tid >> 6, col = c.tid & 63;
        float s = 0.f;
#pragma unroll
        for (int k = 0; k < 32; ++k) s += red[(k * 3 + cond) * 64 + col];
        s += a.in[6][layer * 6144 + n0 + col];
        ((float*)(a.ws + WS_MOD))[(layer * 3 + cond) * 6144 + n0 + col] = s;
    }
}

__device__ __forceinline__ void phase_prep(const Ctx& c) {
    const Args __attribute__((address_space(4)))& a = *c.a;
    {
        float* sc = (float*)(c.lds + 40960);
        for (int i = c.tid; i < 3072; i += NTHR) {
            const int cond = i >> 10, k = i & 1023;
            const float v = cond == 0 ? a.in[4][k] : a.in[3][(cond - 1) * 1024 + k];
            sc[i] = silu_f(v);
        }
        __syncthreads();
    }
    constexpr int I_ADA = 384;
    constexpr int I_TR = 2 * 8 * 81 + 2 * 16 * 16 + 2 * 8 * 16 + 4 * 8 * 64 + 4 * 32 * 16;
    constexpr int I_TB = 32 + 32 + 512;
    for (int it = c.vb; it < I_ADA; it += c.G) ada_item(c, it);
    {
        int it = c.vb;
        if (it < I_TR) {
            TrItem cur = transpose_decode(c, it);
            f32x4 v[4]; transpose_load(c, cur, v);
            for (;;) {
                const int nit = it + c.G;
                TrItem nxt = cur; f32x4 vn[4];
                const bool has = nit < I_TR;
                if (has) { nxt = transpose_decode(c, nit); transpose_load(c, nxt, vn); }
                transpose_finish(c, cur, v);
                if (!has) break;
                cur = nxt; it = nit;
#pragma unroll
                for (int p = 0; p < 4; ++p) v[p] = vn[p];
            }
        }
    }
    for (int r = c.vb; r < I_TB; r += c.G) {
#pragma unroll 4
        for (int e = 0; e < 8; ++e) {
            int idx = r * 4096 + e * NTHR + c.tid;
            if (idx < 131072) {
                const int nn = idx >> 8, cc = idx & 255, m = nn & 255, ph = (m * cc) & 255;
                const float ang = (float)ph * (1.0f / 128.0f);
                const float v = nn < 256 ? cospif(ang) : sinpif(ang);
                ((bf16_t*)(a.ws + WS_T1))[idx] = (bf16_t)(pk2(v, 0.f) & 0xffff);
            } else if (idx < 262144) {
                idx -= 131072;
                const int k = idx >> 9, k2 = idx & 511, l = k2 & 255, ph = (k * l) & 255;
                const float ang = (float)ph * (1.0f / 128.0f);
                const float v = (k2 < 256 ? cospif(ang) : -sinpif(ang)) * (1.0f / 256.0f);
                ((bf16_t*)(a.ws + WS_T2C))[idx] = (bf16_t)(pk2(v, 0.f) & 0xffff);
            } else {
                idx -= 262144;
                const int k = idx >> 11, k2 = idx & 2047, l = k2 & 1023, ph = (k * l) & 1023;
                const float ang = (float)ph * (1.0f / 512.0f);
                const float v = (k2 < 1024 ? cospif(ang) : -sinpif(ang)) * (1.0f / 512.0f);
                ((bf16_t*)(a.ws + WS_T2L))[idx] = (bf16_t)(pk2(v, 0.f) & 0xffff);
            }
        }
    }
}

__device__ __forceinline__ void phase_prep2(const Ctx& c) {
    const Args __attribute__((address_space(4)))& a = *c.a;
    const float* MOD = (const float*)(a.ws + WS_MOD);
    float* sh = (float*)c.lds;
    const int gw = c.vb * NWAVE + c.wid, NGW = c.G * NWAVE;
#pragma unroll 1
    for (int v = 0; v < 8; ++v) {
        const int layer = v >> 1, mlp = v & 1, jj = layer >> 1, fnet = (layer & 1) && !mlp;
        __syncthreads();
        for (int i = c.tid; i < 3072; i += NTHR) sh[i] = MOD[(size_t)(layer * 3 + (i >> 10)) * 6144 + (mlp ? 3072 : 0) + (i & 1023)];
        __syncthreads();
        const bf16_t* W; float* out; int N, ostride;
        if (mlp) { W = (const bf16_t*)(a.ws + WS_W1) + (size_t)layer * DFF * D; N = DFF; out = (float*)(a.ws + WS_SWUP) + (size_t)layer * 3 * DFF; ostride = DFF; }
        else if (fnet) { W = (const bf16_t*)(a.ws + WS_T1); N = 2048; out = (float*)(a.ws + WS_SWF1) + (size_t)jj * 3 * 2048; ostride = 2048; }
        else { W = (const bf16_t*)(a.ws + WS_WIN) + (size_t)jj * DPROJ * D; N = DPROJ; out = (float*)(a.ws + WS_SWIN) + (size_t)jj * 3 * DPROJ; ostride = DPROJ; }
        for (int n = gw; n < N; n += NGW) {
            float s0 = 0.f, s1 = 0.f, s2 = 0.f;
            if (fnet) {
                const int g = n >> 9, nn = n & 511;
                if (c.lane < 32) {
                    const u32x4 w = *(const u32x4*)(W + (size_t)nn * 256 + c.lane * 8);
                    const int k = g * 256 + c.lane * 8;
#pragma unroll
                    for (int e = 0; e < 4; ++e) {
                        const float wl = bflo(w[e]), wh = bfhi(w[e]);
                        s0 += wl * sh[k + 2 * e] + wh * sh[k + 2 * e + 1];
                        s1 += wl * sh[1024 + k + 2 * e] + wh * sh[1024 + k + 2 * e + 1];
                        s2 += wl * sh[2048 + k + 2 * e] + wh * sh[2048 + k + 2 * e + 1];
                    }
                }
            } else {
#pragma unroll
                for (int p = 0; p < 2; ++p) {
                    const int k = p * 512 + c.lane * 8;
                    const u32x4 w = *(const u32x4*)(W + (size_t)n * D + k);
#pragma unroll
                    for (int e = 0; e < 4; ++e) {
                        const float wl = bflo(w[e]), wh = bfhi(w[e]);
                        s0 += wl * sh[k + 2 * e] + wh * sh[k + 2 * e + 1];
                        s1 += wl * sh[1024 + k + 2 * e] + wh * sh[1024 + k + 2 * e + 1];
                        s2 += wl * sh[2048 + k + 2 * e] + wh * sh[2048 + k + 2 * e + 1];
                    }
                }
            }
            s0 = wave_sum(s0); s1 = wave_sum(s1); s2 = wave_sum(s2);
            if (c.lane == 0) { out[n] = s0; out[ostride + n] = s1; out[2 * ostride + n] = s2; }
        }
    }
    {
        bf16_t* XG = (bf16_t*)(a.ws + WS_H);
        float* RSS = (float*)(a.ws + WS_RSS);
        const float* nw = a.in[7];
        for (int row = gw; row < NTOK; row += NGW) {
            const float* xr = row < NCTX ? a.in[0] + (size_t)row * D : a.in[1] + (size_t)(row - NCTX) * D;
            const float* m = MOD + (size_t)cond_of(row) * 6144 + 1024;
            float ss = 0.f;
#pragma unroll
            for (int q = 0; q < 4; ++q) {
                const int col = q * 256 + c.lane * 4;
                const f32x4 v = *(const f32x4*)(xr + col);
                ss += v[0] * v[0] + v[1] * v[1] + v[2] * v[2] + v[3] * v[3];
                const f32x4 o = v * (*(const f32x4*)(nw + col)) * (*(const f32x4*)(m + col) + 1.0f);
                u32x2 w; w.x = pk2(o[0], o[1]); w.y = pk2(o[2], o[3]);
                *(u32x2*)(XG + (size_t)row * D + col) = w;
            }
            ss = wave_sum(ss);
            if (c.lane < 16) RSS[(size_t)row * 16 + c.lane] = c.lane == 0 ? ss : 0.f;
        }
    }
}

__device__ __forceinline__ void phase_norm(const Ctx& c, const float* nw, const float* mod  , int off_shift, int off_scale, bool final_norm) {
    const Args __attribute__((address_space(4)))& a = *c.a;
    const int gw = c.vb * NWAVE + c.wid, NGW = c.G * NWAVE;
    bf16_t* H = (bf16_t*)(a.ws + WS_H);
    f32x4 wfin[4];
#pragma unroll
    for (int j = 0; j < 4; ++j) wfin[j] = *(const f32x4*)(nw + j * 256 + c.lane * 4);
    for (int row = gw; row < NTOK; row += NGW) {
        float* xr = a.out + (size_t)row * D;
        f32x4 v[4]; float ss = 0.f;
#pragma unroll
        for (int j = 0; j < 4; ++j) { v[j] = *(const f32x4*)(xr + j * 256 + c.lane * 4); ss += v[j][0] * v[j][0] + v[j][1] * v[j][1] + v[j][2] * v[j][2] + v[j][3] * v[j][3]; }
        ss = wave_sum(ss);
        const float rstd = rsqrtf(ss * (1.0f / D) + EPS);
        if (final_norm) {
#pragma unroll
            for (int j = 0; j < 4; ++j) *(f32x4*)(xr + j * 256 + c.lane * 4) = v[j] * rstd * wfin[j];
        } else {
            const float* m = mod + cond_of(row) * 6144;
#pragma unroll
            for (int j = 0; j < 4; ++j) {
                const int col = j * 256 + c.lane * 4;
                const f32x4 w = *(const f32x4*)(nw + col), sc = *(const f32x4*)(m + off_scale + col), sh = *(const f32x4*)(m + off_shift + col);
                const f32x4 h = v[j] * rstd * w * (sc + 1.0f) + sh;
                u32x2 o; o.x = pk2(h[0], h[1]); o.y = pk2(h[2], h[3]);
                *(u32x2*)(H + (size_t)row * D + col) = o;
            }
        }
    }
}

constexpr int RS_OFF = 3 * GT<5>::STAGE;
struct FillRstd { float* tab; const float* RSS; int tok0, ntok, tid;
    __device__ __forceinline__ void operator()() const {
        if (tid < ntok) {
            const float* p = RSS + (size_t)(tok0 + tid) * 16;
            float s = 0.f;
#pragma unroll
            for (int q = 0; q < 4; ++q) { const f32x4 v = *(const f32x4*)(p + q * 4); s += (v[0] + v[1]) + (v[2] + v[3]); }
            tab[tid] = rsqrtf(s * (1.0f / D) + EPS);
        }
    }
};
__device__ __forceinline__ FillRstd fill_rstd(const Ctx& c, int tok0, int ntok) { return FillRstd{(float*)(c.lds + RS_OFF), (const float*)(c.a->ws + WS_RSS), tok0, ntok, c.tid}; }
__device__ __forceinline__ void rstd_table_one(const Ctx& c, int i, int ntok, int tok0) {
    float* tab = (float*)(c.lds + RS_OFF);
    const float* RSS = (const float*)(c.a->ws + WS_RSS);
    if (c.tid < ntok) {
        const float* p = RSS + (size_t)(tok0 + c.tid) * 16;
        float s = 0.f;
#pragma unroll
        for (int q = 0; q < 4; ++q) { const f32x4 v = *(const f32x4*)(p + q * 4); s += (v[0] + v[1]) + (v[2] + v[3]); }
        tab[i * ntok + c.tid] = rsqrtf(s * (1.0f / D) + EPS);
    }
}
__device__ __forceinline__ void rstd_tables(const Ctx& c, int n, int ntok, int first, int stride, int toks_per_rt, int shift_rt  ) {
    float* tab = (float*)(c.lds + RS_OFF);
    const float* RSS = (const float*)(c.a->ws + WS_RSS);
    for (int i = 0; i < n; ++i) {
        const int t = first + i * stride, rt = shift_rt < 0 ? t / (-shift_rt) : (t >> shift_rt);
        if (c.tid < ntok) {
            const float* p = RSS + (size_t)(rt * toks_per_rt + c.tid) * 16;
            float s = 0.f;
#pragma unroll
            for (int q = 0; q < 4; ++q) { const f32x4 v = *(const f32x4*)(p + q * 4); s += (v[0] + v[1]) + (v[2] + v[3]); }
            tab[i * ntok + c.tid] = rsqrtf(s * (1.0f / D) + EPS);
        }
    }
}
__device__ __forceinline__ void patch_tile(const Ctx& c, int i, int NC, int& rt, int& ct) {
    if (c.G == 256) { const int x = c.vb >> 5, l = c.vb & 31, p = i * 8 + x, PC = NC >> 2, pr = p / PC, pc = p - pr * PC; rt = pr * 8 + (l >> 2); ct = pc * 4 + (l & 3); }
    else { const int t = c.vb + i * c.G; rt = t / NC; ct = t - rt * NC; }
}
struct ProbInProj {
    static constexpr int EPI_STORES = 10;
    const Ctx* c; const bf16_t* W; const bf16_t* XG; int lda, ldb, K; int j;
    static constexpr int NC = NZX / 256, NT = (NTOK / 160) * NC;
    __device__ __forceinline__ int count() const { return (NT - c->vb + c->G - 1) / c->G; }
    __device__ __forceinline__ void tile(int i, const bf16_t*& A, const bf16_t*& B) const { int rt, ct; patch_tile(*c, i, NC, rt, ct); A = W + (size_t)ct * 256 * D; B = XG + (size_t)rt * 160 * D; }
    __device__ __forceinline__ void pre_all() const { const int n = count(); for (int i = 0; i < n; ++i) { int rt, ct; patch_tile(*c, i, NC, rt, ct); rstd_table_one(*c, i, 160, rt * 160); } }
    __device__ __forceinline__ void preload(int i, f32x4 (&sw)[4], int wr, int fq) const {
        int rt, ct; patch_tile(*c, i, NC, rt, ct);
        if (cond_of(rt * 160) == cond_of(rt * 160 + 159)) {
            const float* p = (const float*)(c->a->ws + WS_SWIN) + (size_t)j * 3 * DPROJ + cond_of(rt * 160) * DPROJ + ct * 256 + wr * 64 + fq * 4;
#pragma unroll
            for (int q = 0; q < 4; ++q) sw[q] = *(const f32x4*)(p + q * 16);
        }
    }
    __device__ __forceinline__ void epilogue(int i, f32x4 (&acc)[4][5], const f32x4 (&sw)[4], int wr, int wc, int fr, int fq) const {
        int rt, ct; patch_tile(*c, i, NC, rt, ct); unsigned char* ws = c->a->ws;
        EpiInProj e{(bf16_t*)(ws + S_Z), (bf16_t*)(ws + S_RAW), (const float*)(c->lds + RS_OFF) + i * 160, rt * 160, (const float*)(ws + WS_SWIN) + (size_t)j * 3 * DPROJ, cond_of(rt * 160) == cond_of(rt * 160 + 159)};
        e(acc, sw, ct * 256 + wr * 64, rt * 160 + wc * 80, fr, fq);
    }
};
__device__ __forceinline__ void phase_inproj(const Ctx& c, int j) {
    ProbInProj P{&c, (const bf16_t*)(c.a->ws + WS_WIN) + (size_t)j * DPROJ * D, (const bf16_t*)(c.a->ws + WS_H), D, D, D, j};
    gemm_stream<5>(c, P);
}
struct ProbMlpUp {
    static constexpr int EPI_STORES = 10;
    const Ctx* c; const bf16_t* W; const bf16_t* XG; int lda, ldb, K; int layer;
    static constexpr int NC = DFF / 256, NT = (NTOK / 160) * NC;
    __device__ __forceinline__ int count() const { return (NT - c->vb + c->G - 1) / c->G; }
    __device__ __forceinline__ void tile(int i, const bf16_t*& A, const bf16_t*& B) const { int rt, ct; patch_tile(*c, i, NC, rt, ct); A = W + (size_t)ct * 256 * D; B = XG + (size_t)rt * 160 * D; }
    __device__ __forceinline__ void pre_all() const { const int n = count(); for (int i = 0; i < n; ++i) { int rt, ct; patch_tile(*c, i, NC, rt, ct); rstd_table_one(*c, i, 160, rt * 160); } }
    __device__ __forceinline__ void preload(int i, f32x4 (&sw)[4], int wr, int fq) const {
        int rt, ct; patch_tile(*c, i, NC, rt, ct);
        if (cond_of(rt * 160) == cond_of(rt * 160 + 159)) {
            const float* p = (const float*)(c->a->ws + WS_SWUP) + (size_t)layer * 3 * DFF + cond_of(rt * 160) * DFF + ct * 256 + wr * 64 + fq * 4;
#pragma unroll
            for (int q = 0; q < 4; ++q) sw[q] = *(const f32x4*)(p + q * 16);
        }
    }
    __device__ __forceinline__ void epilogue(int i, f32x4 (&acc)[4][5], const f32x4 (&sw)[4], int wr, int wc, int fr, int fq) const {
        int rt, ct; patch_tile(*c, i, NC, rt, ct); unsigned char* ws = c->a->ws;
        EpiMlpUp e{(bf16_t*)(ws + S_HID), (const float*)(c->lds + RS_OFF) + i * 160, rt * 160, (const float*)(ws + WS_SWUP) + (size_t)layer * 3 * DFF, cond_of(rt * 160) == cond_of(rt * 160 + 159)};
        e(acc, sw, ct * 256 + wr * 64, rt * 160 + wc * 80, fr, fq);
    }
};
__device__ __forceinline__ void phase_mlp_up(const Ctx& c, int layer) {
    ProbMlpUp P{&c, (const bf16_t*)(c.a->ws + WS_W1) + (size_t)layer * DFF * D, (const bf16_t*)(c.a->ws + WS_H), D, D, D, layer};
    gemm_stream<5>(c, P);
}
#ifndef BENCH_MODE
#define BENCH_MODE 0
#endif
__device__ __forceinline__ void phase_bench(const Ctx& c) {
    ProbMlpUp P{&c, (const bf16_t*)(c.a->ws + WS_W1), (const bf16_t*)(c.a->ws + WS_H), D, D, D, 0};
    gemm_stream<5, ProbMlpUp, BENCH_MODE>(c, P);
}
struct ProbResid {
    static constexpr int EPI_STORES = 0;
    const Ctx* c; const bf16_t* WT; const bf16_t* Act; int lda, ldb, K; const float* gate; const float* bias; const float* ssq; const float* nw_next; const float* scale_next; bool first;
    static constexpr int NC = D / 256, NT = (NTOK / 160) * NC;
    __device__ __forceinline__ int count() const { return (NT - c->vb + c->G - 1) / c->G; }
    __device__ __forceinline__ void tile(int i, const bf16_t*& A, const bf16_t*& B) const { const int t = c->vb + i * c->G, rt = t / NC, ct = t - rt * NC; A = WT + (size_t)ct * 256 * K; B = Act + (size_t)rt * 160 * K; }
    __device__ __forceinline__ void pre_all() const {
        if (!ssq) return;
        float* tab = (float*)(c->lds + RS_OFF);
        const int n = count();
        for (int i = 0; i < n; ++i) {
            const int t = c->vb + i * c->G, rt = t / NC;
            if (c->tid < 160) {
                const float* p = ssq + (size_t)(rt * 160 + c->tid) * 32;
                float s = 0.f;
#pragma unroll
                for (int q = 0; q < 8; ++q) { const f32x4 v = *(const f32x4*)(p + q * 4); s += v[0] + v[1] + v[2] + v[3]; }
                tab[i * 160 + c->tid] = rsqrtf(s * (1.0f / DI) + EPS);
            }
        }
    }
    __device__ __forceinline__ void preload(int, f32x4 (&)[4], int, int) const {}
    __device__ __forceinline__ void epilogue(int i, f32x4 (&acc)[4][5], const f32x4 (&)[4], int wr, int wc, int fr, int fq) const {
        const int t = c->vb + i * c->G, rt = t / NC, ct = t - rt * NC; unsigned char* ws = c->a->ws;
        EpiResid e{c->a->out, gate, bias, ssq ? (const float*)(c->lds + RS_OFF) + i * 160 : nullptr, rt * 160, first ? c->a->in[0] : nullptr, first ? c->a->in[1] : nullptr, nw_next ? (bf16_t*)(ws + WS_H) : nullptr, nw_next, scale_next, (float*)(ws + WS_RSS), (const float*)(ws + WS_ZERO)};
        e(acc, ct * 256 + wr * 64, rt * 160 + wc * 80, fr, fq);
    }
};
__device__ __forceinline__ void phase_resid_gemm(const Ctx& c, const bf16_t* WT, const bf16_t* Act, int K, const float* gate, const float* bias, const float* ssq, const float* nw_next, const float* scale_next, bool first) {
    ProbResid P{&c, WT, Act, K, K, K, gate, bias, ssq, nw_next, scale_next, first};
    gemm_stream<5>(c, P);
}
struct ProbF1 {
    static constexpr int EPI_STORES = 16;
    const Ctx* c; const bf16_t* XG; const bf16_t* T1; int lda, ldb, K; int j;
    static constexpr int NT = (NTOK / 256) * 16;
    __device__ __forceinline__ int count() const { return (NT - c->vb + c->G - 1) / c->G; }
    __device__ __forceinline__ void tile(int i, const bf16_t*& A, const bf16_t*& B) const { const int t = c->vb + i * c->G, rt = t >> 4, g = (t >> 2) & 3, ct = t & 3; A = XG + (size_t)rt * 256 * D + g * 256; B = T1 + (size_t)ct * 128 * 256; }
    __device__ __forceinline__ void pre_all() const { rstd_tables(*c, count(), 256, c->vb, c->G, 256, 4); }
    __device__ __forceinline__ void preload(int, f32x4 (&)[4], int, int) const {}
    __device__ __forceinline__ void epilogue(int i, f32x4 (&acc)[4][4], const f32x4 (&)[4], int wr, int wc, int fr, int fq) const {
        const int t = c->vb + i * c->G, rt = t >> 4, g = (t >> 2) & 3, ct = t & 3; unsigned char* ws = c->a->ws;
        EpiF1 e{(bf16_t*)(ws + S_UVT), g, (const float*)(c->lds + RS_OFF) + i * 256, rt * 256, (const float*)(ws + WS_SWF1) + (size_t)j * 3 * 2048};
        e(acc, rt * 256 + wr * 64, ct * 128 + wc * 64, fr, fq);
    }
};
__device__ __forceinline__ void phase_f1(const Ctx& c, int j) {
    ProbF1 P{&c, (const bf16_t*)(c.a->ws + WS_H), (const bf16_t*)(c.a->ws + WS_T1), D, 256, 256, j};
    gemm_stream<4>(c, P);
}
struct ProbF2L {
    static constexpr int EPI_STORES = 0;
    const Ctx* c; const bf16_t* UVT; const bf16_t* T2; bf16_t* F; int lda, ldb, K;
    __device__ __forceinline__ int count() const { return c->vb < 128 ? 1 : 0; }
    __device__ __forceinline__ void tile(int i, const bf16_t*& A, const bf16_t*& B) const { const int t = c->vb, s = t >> 6, nt = (t >> 4) & 3, kt = t & 15; A = UVT + (size_t)NCTX * 2048 + ((size_t)s * 1024 + nt * 256) * 2048; B = T2 + (size_t)kt * 64 * 2048; }
    __device__ __forceinline__ void pre_all() const {}
    __device__ __forceinline__ void preload(int, f32x4 (&)[4], int, int) const {}
    __device__ __forceinline__ void epilogue(int i, f32x4 (&acc)[4][2], const f32x4 (&)[4], int wr, int wc, int fr, int fq) const { const int t = c->vb, s = t >> 6, nt = (t >> 4) & 3, kt = t & 15; EpiF2<2> e{F, NCTX + s * 1024}; e(acc, nt * 256 + wr * 64, kt * 64 + wc * 32, fr, fq); }
};
struct ProbF2C {
    static constexpr int EPI_STORES = 16;
    const Ctx* c; const bf16_t* UVT; const bf16_t* T2; bf16_t* F; int lda, ldb, K; int first, stride;
    __device__ __forceinline__ int count() const { return (256 - first + stride - 1) / stride; }
    __device__ __forceinline__ void tile(int i, const bf16_t*& A, const bf16_t*& B) const { const int u = first + i * stride, s = u >> 3, nt = (u >> 1) & 3, kt = u & 1; A = UVT + ((size_t)s * 1024 + nt * 256) * 512; B = T2 + (size_t)kt * 128 * 512; }
    __device__ __forceinline__ void pre_all() const {}
    __device__ __forceinline__ void preload(int, f32x4 (&)[4], int, int) const {}
    __device__ __forceinline__ void epilogue(int i, f32x4 (&acc)[4][4], const f32x4 (&)[4], int wr, int wc, int fr, int fq) const { const int u = first + i * stride, s = u >> 3, nt = (u >> 1) & 3, kt = u & 1; EpiF2<4> e{F, s * 256}; e(acc, nt * 256 + wr * 64, kt * 128 + wc * 64, fr, fq); }
};
__device__ __forceinline__ void phase_f2(const Ctx& c) {
    unsigned char* ws = c.a->ws;
    const int half = c.G >> 1;
    if (c.vb < half) { ProbF2L P{&c, (const bf16_t*)(ws + S_UVT), (const bf16_t*)(ws + WS_T2L), (bf16_t*)(ws + S_F), 2048, 2048, 2048}; gemm_stream<2>(c, P); }
    else { ProbF2C P{&c, (const bf16_t*)(ws + S_UVT), (const bf16_t*)(ws + WS_T2C), (bf16_t*)(ws + S_F), 512, 512, 512, c.vb - half, c.G - half}; gemm_stream<4>(c, P); }
}

struct ProbDt {
    static constexpr int EPI_STORES = 0;
    const Ctx* c; const bf16_t* XG; const bf16_t* W; int lda, ldb, K; int j;
    __device__ __forceinline__ int count() const { return (NTOK / 256 - c->vb + c->G - 1) / c->G; }
    __device__ __forceinline__ void tile(int i, const bf16_t*& A, const bf16_t*& B) const { const int t = c->vb + i * c->G; A = XG + (size_t)t * 256 * D; B = W; }
    __device__ __forceinline__ void pre_all() const { rstd_tables(*c, count(), 256, c->vb, c->G, 256, 0); }
    __device__ __forceinline__ void preload(int, f32x4 (&)[4], int, int) const {}
    __device__ __forceinline__ void epilogue(int i, f32x4 (&acc)[4][2], const f32x4 (&)[4], int wr, int wc, int fr, int fq) const {
        const int t = c->vb + i * c->G; unsigned char* ws = c->a->ws;
        EpiDt e{(float*)(ws + S_DT), (const float*)(c->lds + RS_OFF) + i * 256, t * 256, (const float*)(ws + WS_SWIN) + (size_t)j * 3 * DPROJ};
        e(acc, t * 256 + wr * 64, wc * 32, fr, fq);
    }
};
__device__ __forceinline__ void phase_conv(const Ctx& c, int j) {
    const Args __attribute__((address_space(4)))& a = *c.a;
    {
        ProbDt P{&c, (const bf16_t*)(a.ws + WS_H), (const bf16_t*)(a.ws + WS_WIN) + (size_t)j * DPROJ * D + (size_t)NZX * D, D, D, D, j};
        gemm_stream<2>(c, P);
    }
    const bf16_t* RAW = (const bf16_t*)(a.ws + S_RAW);
    bf16_t* XBC = (bf16_t*)(a.ws + S_XBC);
    const float* cw = a.in[10] + (size_t)j * 3 * DXBC;
    const float* cb = a.in[11] + (size_t)j * DXBC;
    constexpr int NIT = (NTOK / 64) * 3;
    for (int it = c.G - 1 - c.vb; it < NIT; it += c.G) {
        const int tg = it / 3, third = it - tg * 3;
        const int ch = third * 1024 + (c.tid & 127) * 8;
        const int r0 = tg * 64 + (c.tid >> 7) * 16;
        float w0[8], w1[8], w2[8], bb[8];
#pragma unroll
        for (int q = 0; q < 2; ++q) {
            const f32x4 t0 = *(const f32x4*)(cw + ch + q * 4), t1 = *(const f32x4*)(cw + DXBC + ch + q * 4), t2 = *(const f32x4*)(cw + 2 * DXBC + ch + q * 4), t3 = *(const f32x4*)(cb + ch + q * 4);
#pragma unroll
            for (int e = 0; e < 4; ++e) { w0[q * 4 + e] = t0[e]; w1[q * 4 + e] = t1[e]; w2[q * 4 + e] = t2[e]; bb[q * 4 + e] = t3[e]; }
        }
        const int seg = r0 < NCTX ? 256 : 64;
        u32x4 rows[18];
        {
            const int tl = (r0 % seg) != 0 ? r0 - 1 : r0, th = ((r0 + 16) % seg) != 0 ? r0 + 16 : r0 + 15;
            rows[0] = *(const u32x4*)(RAW + (size_t)tl * DXBC + ch);
#pragma unroll
            for (int r = 0; r < 16; ++r) rows[r + 1] = *(const u32x4*)(RAW + (size_t)(r0 + r) * DXBC + ch);
            rows[17] = *(const u32x4*)(RAW + (size_t)th * DXBC + ch);
            if ((r0 % seg) == 0) rows[0] = (u32x4){0, 0, 0, 0};
            if (((r0 + 16) % seg) == 0) rows[17] = (u32x4){0, 0, 0, 0};
        }
#pragma unroll
        for (int r = 0; r < 16; ++r) {
            const int t = r0 + r;
            const u32x4 prev = rows[r], cur = rows[r + 1], nxt = rows[r + 2];
            u32x4 o;
#pragma unroll
            for (int e = 0; e < 4; ++e) {
                const float lo = bb[2 * e] + w0[2 * e] * bflo(prev[e]) + w1[2 * e] * bflo(cur[e]) + w2[2 * e] * bflo(nxt[e]);
                const float hi = bb[2 * e + 1] + w0[2 * e + 1] * bfhi(prev[e]) + w1[2 * e + 1] * bfhi(cur[e]) + w2[2 * e + 1] * bfhi(nxt[e]);
                o[e] = pk2(silu_f(lo), silu_f(hi));
            }
            *(u32x4*)(XBC + (size_t)t * DXBC + ch) = o;
        }
    }
}

constexpr int SC_XS = 0, SC_XW = 16384, SC_BS = 32768, SC_CS = 49152, SC_HT = 65536, SC_SM = 98304;
__device__ __forceinline__ int off128(int row, int col) { return row * 128 + ((((col >> 3) ^ (row & 7))) << 4) + (col & 7) * 2; }
__device__ __forceinline__ int off256(int row, int col) { return row * 256 + ((((col >> 3) ^ (row & 15))) << 4) + (col & 7) * 2; }
__device__ __forceinline__ int offX(int row, int col) { return row * 128 + col * 2; }
__device__ __forceinline__ int offP(int row, int col) { return row * 144 + col * 2; }
template <int LAY>
__device__ __forceinline__ bf16x8 tr_frag(const char* tile, int r0, int r1, int col0, int lane) {
    const int i = lane & 15, q = i >> 2, cc = col0 + (i & 3) * 4;
    const int o0 = LAY == 1 ? off256(r0 + q, cc) : LAY == 2 ? offP(r0 + q, cc) : offX(r0 + q, cc);
    const int o1 = LAY == 1 ? off256(r1 + q, cc) : LAY == 2 ? offP(r1 + q, cc) : offX(r1 + q, cc);
    const bf16x4 lo = __builtin_amdgcn_ds_read_tr16_b64_v4i16((LAS bf16x4*)(tile + o0));
    const bf16x4 hi = __builtin_amdgcn_ds_read_tr16_b64_v4i16((LAS bf16x4*)(tile + o1));
    return __builtin_shufflevector(lo, hi, 0, 1, 2, 3, 4, 5, 6, 7);
}

struct ScanStep { int seq, hp, dir, ci, nch, t0, valid, single, h0; };
struct ScanIter {
    int vb, G, k, dir, ci;
    __device__ __forceinline__ void get(ScanStep& s) const {
        int seq, hp, ok, single = 0, h0 = 0;
        if (vb < 64) { seq = 32 + (vb >> 5); h0 = vb & 31; hp = h0 >> 1; single = 1; ok = (k == 0); }
        else { const int u = (vb - 64) + k * (G - 64); seq = u >> 4; hp = u & 15; ok = (u < 512); }
        const bool lat = seq >= 32;
        s.seq = seq; s.hp = hp; s.dir = dir; s.ci = ci; s.nch = lat ? 16 : 4; s.valid = ok; s.single = single; s.h0 = h0;
        const int tok0 = lat ? NCTX + (seq - 32) * 1024 : seq * 256;
        const int ch = dir == 0 ? ci : s.nch - 1 - ci;
        s.t0 = tok0 + ch * 64;
    }
    __device__ __forceinline__ void advance() {
        int seq; if (vb < 64) seq = 32; else seq = 0;
        const int nch = seq >= 32 ? 16 : 4;
        if (++ci == nch) { ci = 0; if (++dir == 2) { dir = 0; ++k; } }
    }
};
constexpr int SCB = 49152;
constexpr int SB_XS = 0, SB_BS = 16384, SB_CS = 32768;
constexpr int XW_BYTES = 64 * 144, HT_BYTES = 128 * 144;
constexpr int SCN_XW = 2 * SCB, SCN_HT = SCN_XW + 2 * XW_BYTES, SCN_SM = SCN_HT + 2 * HT_BYTES;

__device__ __forceinline__ void scan_issue_tiles(const Ctx& c, const ScanStep& s, int buf) {
    const bf16_t* XBC = (const bf16_t*)(c.a->ws + S_XBC);
    char* base = c.lds + buf * SCB;
    const int lane = c.lane, w8 = c.wid, g = s.hp >> 2;
#pragma unroll
    for (int hh = 0; hh < 2; ++hh) {
        if (hh == 1 && s.single) break;
        const int q = w8, row = q * 8 + (lane >> 3), lch = lane & 7, hd = s.single ? s.h0 : 2 * s.hp + hh;
        __builtin_amdgcn_global_load_lds((const unsigned*)(XBC + (size_t)(s.t0 + row) * DXBC + hd * 64 + lch * 8), (LAS unsigned*)(base + SB_XS + hh * 8192 + q * 1024 + lane * 16), 16, 0, 0);
    }
#pragma unroll
    for (int i = 0; i < 2; ++i) {
        const int q = w8 + 8 * i, row = q * 4 + (lane >> 4), lch = (lane & 15) ^ (row & 15);
        __builtin_amdgcn_global_load_lds((const unsigned*)(XBC + (size_t)(s.t0 + row) * DXBC + DI + g * 128 + lch * 8), (LAS unsigned*)(base + SB_BS + q * 1024 + lane * 16), 16, 0, 0);
        __builtin_amdgcn_global_load_lds((const unsigned*)(XBC + (size_t)(s.t0 + row) * DXBC + DI + 512 + g * 128 + lch * 8), (LAS unsigned*)(base + SB_CS + q * 1024 + lane * 16), 16, 0, 0);
    }
}
__device__ __forceinline__ float scan_load_dt(const Ctx& c, const ScanStep& s, int hw) {
    const float* DT = (const float*)(c.a->ws + S_DT);
    const int l = s.dir == 0 ? c.lane : 63 - c.lane, h = s.single ? s.h0 : 2 * s.hp + hw;
    return DT[(size_t)(s.t0 + l) * 64 + s.dir * NH + h];
}
__device__ __forceinline__ void scan_dtcs(const Ctx& c, const ScanStep& s, int hw, int j, float raw, float* sm) {
    const int lane = c.lane, l = s.dir == 0 ? lane : 63 - lane, h = s.single ? s.h0 : 2 * s.hp + hw;
    const float Aneg = -__expf(c.a->in[13][(j * 2 + s.dir) * NH + h]);
    raw += c.a->in[12][(j * 2 + s.dir) * NH + h];
    const float dt = raw > 20.f ? raw : __logf(1.0f + __expf(raw));
    float cs = dt * Aneg;
#pragma unroll
    for (int o = 1; o < 64; o <<= 1) { const float u = __shfl_up(cs, o); if (lane >= o) cs += u; }
    sm[l] = dt; sm[64 + l] = cs;
    if (lane == 63) sm[128] = cs;
}

__device__ __forceinline__ void phase_scan_pipe(const Ctx& c, int j) {
    const Args __attribute__((address_space(4)))& a = *c.a;
    const bf16_t* Z = (const bf16_t*)(a.ws + S_Z);
    bf16_t* YTMP = (bf16_t*)(a.ws + S_RAW);
    bf16_t* YG = (bf16_t*)(a.ws + S_YG);
    float* SSQ = (float*)(a.ws + S_SSQ);
    const int hw = c.wid >> 2, w = c.wid & 3;
    char* lds = c.lds;
    char* XWp = lds + SCN_XW + hw * XW_BYTES; char* HTp = lds + SCN_HT + hw * HT_BYTES;

    ScanIter it{c.vb, c.G, 0, 0, 0};
    ScanStep cur, nxt, nx2;
    it.get(cur); it.advance(); it.get(nxt); it.advance(); it.get(nx2);
    if (!cur.valid) return;
    scan_issue_tiles(c, cur, 0);
    float raw_n1 = 0.f;
    if (w == 0 && !(cur.single && hw == 1)) {
        const float r0 = scan_load_dt(c, cur, hw);
        if (nxt.valid) raw_n1 = scan_load_dt(c, nxt, hw);
        scan_dtcs(c, cur, hw, j, r0, (float*)(lds + SCN_SM + (0 * 2 + hw) * 1024));
    }
    f32x4 S[4][2];
#pragma unroll
    for (int pb = 0; pb < 4; ++pb)
#pragma unroll
        for (int nbi = 0; nbi < 2; ++nbi) S[pb][nbi] = (f32x4){0.f, 0.f, 0.f, 0.f};

#pragma unroll 1
    for (int s = 0; cur.valid; ++s) {
        int lane = c.lane; asm volatile("" : "+v"(lane));
        const int fr = lane & 15, fq = lane >> 4;
        const int b = s & 1;
        char* TB_ = lds + b * SCB;
        char* XSp = TB_ + SB_XS + hw * 8192;
        const float* sm_dt = (const float*)(lds + SCN_SM + (b * 2 + hw) * 1024);
        const float* sm_cs = sm_dt + 64;
        const bool is_lat = cur.seq >= 32;
        const bool active = !(cur.single && hw == 1);
        const int dir = cur.dir, t0 = cur.t0, h = cur.single ? cur.h0 : 2 * cur.hp + hw;
        asm volatile("s_waitcnt vmcnt(0)" ::: "memory");
        __syncthreads();
        if (nxt.valid) scan_issue_tiles(c, nxt, b ^ 1);
        float raw_n2 = 0.f;
        if (w == 0 && nx2.valid && !(nx2.single && hw == 1)) raw_n2 = scan_load_dt(c, nx2, hw);
        u32x2 yt[4], zz[4]; f32x4 nwv[4]; float Dh = 0.f;
        const int tok = t0 + w * 16 + fr;
        if (dir == 1 && active) {
            Dh = a.in[14][j * NH + h];
            const float* normw = a.in[15] + (size_t)j * DI + h * 64;
#pragma unroll
            for (int pb = 0; pb < 4; ++pb) {
                const int p0 = pb * 16 + fq * 4;
                yt[pb] = *(const u32x2*)(YTMP + (size_t)tok * DI + h * 64 + p0);
                zz[pb] = *(const u32x2*)(Z + (size_t)tok * DI + h * 64 + p0);
                nwv[pb] = *(const f32x4*)(normw + p0);
            }
        }
        bool has_h = is_lat || cur.ci > 0;
        if (cur.ci == 0) {
            if (is_lat) {
                if (active) {
                const float* sp = a.in[2] + ((size_t)(((cur.seq - 32) * 2 + j) * 2 + dir) * NH + h) * 8192;
#pragma unroll
                for (int pb = 0; pb < 4; ++pb)
#pragma unroll
                    for (int nbi = 0; nbi < 2; ++nbi) {
                        const int n = (2 * w + nbi) * 16 + fr, p0 = pb * 16 + fq * 4;
#pragma unroll
                        for (int r = 0; r < 4; ++r) S[pb][nbi][r] = sp[(p0 + r) * 128 + n];
                        u32x2 v; v.x = pk2(S[pb][nbi][0], S[pb][nbi][1]); v.y = pk2(S[pb][nbi][2], S[pb][nbi][3]);
                        *(u32x2*)(HTp + offP(n, p0)) = v;
                    }
                }
                __syncthreads();
            } else {
#pragma unroll
                for (int pb = 0; pb < 4; ++pb)
#pragma unroll
                    for (int nbi = 0; nbi < 2; ++nbi) S[pb][nbi] = (f32x4){0.f, 0.f, 0.f, 0.f};
            }
        }
        float tot = 0.f;
        if (active) {
        tot = sm_dt[128];
        {
            const int tl = c.tid & 255, l = tl >> 2, c0 = (tl & 3) * 16;
            const float sc = __expf(tot - sm_cs[l]) * sm_dt[l];
#pragma unroll
            for (int q = 0; q < 2; ++q) {
                const u32x4 v = *(const u32x4*)(XSp + offX(l, c0 + q * 8));
                u32x4 r;
#pragma unroll
                for (int e = 0; e < 4; ++e) r[e] = pk2(bflo(v[e]) * sc, bfhi(v[e]) * sc);
                *(u32x4*)(XWp + offP(l, c0 + q * 8)) = r;
            }
        }
        bf16x8 cf[4];
#pragma unroll
        for (int kk = 0; kk < 4; ++kk) cf[kk] = *(const bf16x8*)(TB_ + SB_CS + off256(w * 16 + fr, kk * 32 + fq * 8));
        const float csl = sm_cs[w * 16 + fr];
        f32x4 yacc[4];
#pragma unroll
        for (int pb = 0; pb < 4; ++pb) yacc[pb] = (f32x4){0.f, 0.f, 0.f, 0.f};
        if (has_h) {
            bf16x8 hf[2][4];
#pragma unroll
            for (int pb = 0; pb < 4; ++pb) hf[0][pb] = tr_frag<2>(HTp, fq * 8, fq * 8 + 4, pb * 16, lane);
#pragma unroll
            for (int kk = 0; kk < 4; ++kk) {
                if (kk < 3) {
#pragma unroll
                    for (int pb = 0; pb < 4; ++pb) hf[(kk + 1) & 1][pb] = tr_frag<2>(HTp, (kk + 1) * 32 + fq * 8, (kk + 1) * 32 + fq * 8 + 4, pb * 16, lane);
                }
                __builtin_amdgcn_sched_barrier(0);
#pragma unroll
                for (int pb = 0; pb < 4; ++pb) yacc[pb] = __builtin_amdgcn_mfma_f32_16x16x32_bf16(hf[kk & 1][pb], cf[kk], yacc[pb], 0, 0, 0);
            }
            const float e = __expf(csl);
#pragma unroll
            for (int pb = 0; pb < 4; ++pb) yacc[pb] = yacc[pb] * e;
        }
#pragma unroll
        for (int kk2 = 0; kk2 < 2; ++kk2) {
            const bool need = dir == 0 ? (2 * kk2 <= w) : (2 * kk2 + 1 >= w);
            if (need) {
                unsigned m[4];
                bf16x8 bfg[2][4];
                f32x4 gg[2];
#pragma unroll
                for (int half = 0; half < 2; ++half)
#pragma unroll
                    for (int kk = 0; kk < 4; ++kk) bfg[half][kk] = *(const bf16x8*)(TB_ + SB_BS + off256((2 * kk2 + half) * 16 + fr, kk * 32 + fq * 8));
                bf16x8 xf[4];
#pragma unroll
                for (int pb = 0; pb < 4; ++pb) xf[pb] = tr_frag<0>(XSp, 32 * kk2 + 4 * fq, 32 * kk2 + 16 + 4 * fq, pb * 16, lane);
                __builtin_amdgcn_sched_barrier(0);
                gg[0] = (f32x4){0.f, 0.f, 0.f, 0.f}; gg[1] = (f32x4){0.f, 0.f, 0.f, 0.f};
#pragma unroll
                for (int kk = 0; kk < 4; ++kk)
#pragma unroll
                    for (int half = 0; half < 2; ++half) gg[half] = __builtin_amdgcn_mfma_f32_16x16x32_bf16(bfg[half][kk], cf[kk], gg[half], 0, 0, 0);
#pragma unroll
                for (int half = 0; half < 2; ++half) {
                    const int sb = 2 * kk2 + half;
                    const f32x4 gacc = gg[half];
                    const f32x4 css = *(const f32x4*)(sm_cs + sb * 16 + fq * 4);
                    const f32x4 dts = *(const f32x4*)(sm_dt + sb * 16 + fq * 4);
                    float v[4];
#pragma unroll
                    for (int r = 0; r < 4; ++r) {
                        const int si = sb * 16 + fq * 4 + r, l = w * 16 + fr;
                        const bool valid = dir == 0 ? (si <= l) : (si >= l);
                        v[r] = valid ? gacc[r] * __expf(csl - css[r]) * dts[r] : 0.f;
                    }
                    m[half * 2 + 0] = pk2(v[0], v[1]); m[half * 2 + 1] = pk2(v[2], v[3]);
                }
                union { unsigned u[4]; bf16x8 v; } mf; mf.u[0] = m[0]; mf.u[1] = m[1]; mf.u[2] = m[2]; mf.u[3] = m[3];
#pragma unroll
                for (int pb = 0; pb < 4; ++pb) yacc[pb] = __builtin_amdgcn_mfma_f32_16x16x32_bf16(xf[pb], mf.v, yacc[pb], 0, 0, 0);
            }
        }
        {
            const int l = w * 16 + fr;
            if (dir == 0) {
                u32x2 v[4];
#pragma unroll
                for (int pb = 0; pb < 4; ++pb) { v[pb].x = pk2(yacc[pb][0], yacc[pb][1]); v[pb].y = pk2(yacc[pb][2], yacc[pb][3]); }
#pragma unroll
                for (int p = 0; p < 2; ++p) {
                    const u32x4 o = pair16(v[2 * p], v[2 * p + 1]);
                    *(u32x4*)(YTMP + (size_t)tok * DI + h * 64 + (2 * p + (fq & 1)) * 16 + (fq & 2) * 4) = o;
                }
            } else {
                float ss = 0.f;
                u32x2 v[4];
#pragma unroll
                for (int pb = 0; pb < 4; ++pb) {
                    const int p0 = pb * 16 + fq * 4;
                    const u32x2 xx = *(const u32x2*)(XSp + offX(l, p0));
                    const f32x4 nw = nwv[pb];
                    float y[4];
                    y[0] = yacc[pb][0] + bflo(yt[pb].x) + Dh * bflo(xx.x); y[1] = yacc[pb][1] + bfhi(yt[pb].x) + Dh * bfhi(xx.x);
                    y[2] = yacc[pb][2] + bflo(yt[pb].y) + Dh * bflo(xx.y); y[3] = yacc[pb][3] + bfhi(yt[pb].y) + Dh * bfhi(xx.y);
                    y[0] *= silu_f(bflo(zz[pb].x)); y[1] *= silu_f(bfhi(zz[pb].x)); y[2] *= silu_f(bflo(zz[pb].y)); y[3] *= silu_f(bfhi(zz[pb].y));
                    ss += y[0] * y[0] + y[1] * y[1] + y[2] * y[2] + y[3] * y[3];
                    v[pb].x = pk2(y[0] * nw[0], y[1] * nw[1]); v[pb].y = pk2(y[2] * nw[2], y[3] * nw[3]);
                }
#pragma unroll
                for (int p = 0; p < 2; ++p) {
                    const u32x4 o = pair16(v[2 * p], v[2 * p + 1]);
                    *(u32x4*)(YG + (size_t)tok * DI + h * 64 + (2 * p + (fq & 1)) * 16 + (fq & 2) * 4) = o;
                }
                ss += __shfl_xor(ss, 16); ss += __shfl_xor(ss, 32);
                if (fq == 0) SSQ[(size_t)tok * NH + h] = ss;
            }
        }
        }
        __syncthreads();
        if (active) {
            const float et = __expf(tot);
#pragma unroll
            for (int pb = 0; pb < 4; ++pb)
#pragma unroll
                for (int nbi = 0; nbi < 2; ++nbi) S[pb][nbi] = S[pb][nbi] * et;
            bf16x8 bq[2][2], xa[2][4];
#pragma unroll
            for (int kk = 0; kk < 2; ++kk) {
#pragma unroll
                for (int nbi = 0; nbi < 2; ++nbi) bq[kk][nbi] = tr_frag<1>(TB_ + SB_BS, kk * 32 + fq * 8, kk * 32 + fq * 8 + 4, (2 * w + nbi) * 16, lane);
#pragma unroll
                for (int pb = 0; pb < 4; ++pb) xa[kk][pb] = tr_frag<2>(XWp, kk * 32 + fq * 8, kk * 32 + fq * 8 + 4, pb * 16, lane);
            }
            __builtin_amdgcn_sched_barrier(0);
#pragma unroll
            for (int kk = 0; kk < 2; ++kk)
#pragma unroll
                for (int pb = 0; pb < 4; ++pb)
#pragma unroll
                    for (int nbi = 0; nbi < 2; ++nbi) S[pb][nbi] = __builtin_amdgcn_mfma_f32_16x16x32_bf16(xa[kk][pb], bq[kk][nbi], S[pb][nbi], 0, 0, 0);
#pragma unroll
            for (int pb = 0; pb < 4; ++pb)
#pragma unroll
                for (int nbi = 0; nbi < 2; ++nbi) {
                    const int n = (2 * w + nbi) * 16 + fr, p0 = pb * 16 + fq * 4;
                    u32x2 v; v.x = pk2(S[pb][nbi][0], S[pb][nbi][1]); v.y = pk2(S[pb][nbi][2], S[pb][nbi][3]);
                    *(u32x2*)(HTp + offP(n, p0)) = v;
                }
        }
        if (active && !is_lat && cur.ci == cur.nch - 1) {
            float* op = a.out + (size_t)NTOK * D + ((size_t)((cur.seq * 2 + j) * 2 + dir) * NH + h) * 8192;
#pragma unroll
            for (int pb = 0; pb < 4; ++pb)
#pragma unroll
                for (int nbi = 0; nbi < 2; ++nbi) {
                    const int n = (2 * w + nbi) * 16 + fr, p0 = pb * 16 + fq * 4;
#pragma unroll
                    for (int r = 0; r < 4; ++r) op[(p0 + r) * 128 + n] = S[pb][nbi][r];
                }
        }
        if (w == 0 && nxt.valid && !(nxt.single && hw == 1)) scan_dtcs(c, nxt, hw, j, raw_n1, (float*)(lds + SCN_SM + ((b ^ 1) * 2 + hw) * 1024));
        raw_n1 = raw_n2;
        cur = nxt; nxt = nx2; it.advance(); it.get(nx2);
    }
}

#if NAIVE_SCAN
__device__ __forceinline__ void scan_unit_naive(const Ctx& c, int j, int seq, int h) {
    const Args __attribute__((address_space(4)))& a = *c.a;
    const bf16_t* XBC = (const bf16_t*)(a.ws + S_XBC);
    const bf16_t* Z = (const bf16_t*)(a.ws + S_Z);
    const float* DT = (const float*)(a.ws + S_DT);
    bf16_t* YTMP = (bf16_t*)(a.ws + S_RAW);
    bf16_t* YG = (bf16_t*)(a.ws + S_YG);
    float* SSQ = (float*)(a.ws + S_SSQ);
    const bool is_lat = seq >= 32;
    const int tok0 = is_lat ? NCTX + (seq - 32) * 1024 : seq * 256;
    const int L = is_lat ? 1024 : 256;
    const int g = h >> 3, p = c.tid >> 2, nq = (c.tid & 3) * 32;
    const float Dh = a.in[14][j * NH + h];
    const float nw = a.in[15][(size_t)j * DI + h * 64 + p];
    float* red = (float*)c.lds;
    for (int dir = 0; dir < 2; ++dir) {
        const float Aneg = -__expf(a.in[13][(j * 2 + dir) * NH + h]);
        const float dtb = a.in[12][(j * 2 + dir) * NH + h];
        float hs[32];
        if (is_lat) { const float* sp = a.in[2] + ((size_t)(((seq - 32) * 2 + j) * 2 + dir) * NH + h) * 8192 + p * 128 + nq;
#pragma unroll
            for (int e = 0; e < 32; ++e) hs[e] = sp[e]; }
        else {
#pragma unroll
            for (int e = 0; e < 32; ++e) hs[e] = 0.f; }
        asm volatile("s_waitcnt vmcnt(0)" ::: "memory"); __syncthreads();
        for (int ti = 0; ti < L; ++ti) {
            const int tok = tok0 + (dir == 0 ? ti : L - 1 - ti);
            const float raw = DT[(size_t)tok * 64 + dir * NH + h] + dtb;
            const float dt = raw > 20.f ? raw : log1pf(__expf(raw));
            const float dec = __expf(dt * Aneg);
            const float xv = bflo((unsigned)XBC[(size_t)tok * DXBC + h * 64 + p]);
            const bf16_t* Bp = XBC + (size_t)tok * DXBC + DI + g * 128 + nq;
            const bf16_t* Cp = XBC + (size_t)tok * DXBC + DI + 512 + g * 128 + nq;
            float y = 0.f;
#pragma unroll
            for (int e = 0; e < 32; ++e) { hs[e] = hs[e] * dec + dt * xv * bflo((unsigned)Bp[e]); y += bflo((unsigned)Cp[e]) * hs[e]; }
            y += __shfl_xor(y, 1); y += __shfl_xor(y, 2);
            if (dir == 0) { if ((c.tid & 3) == 0) YTMP[(size_t)tok * DI + h * 64 + p] = (bf16_t)(pk2(y, 0.f) & 0xffff); }
            else {
                const float yt = bflo((unsigned)YTMP[(size_t)tok * DI + h * 64 + p]);
                const float zz = bflo((unsigned)Z[(size_t)tok * DI + h * 64 + p]);
                float yy = (y + yt + Dh * xv) * silu_f(zz);
                __syncthreads();
                if ((c.tid & 3) == 0) { red[p] = yy * yy; YG[(size_t)tok * DI + h * 64 + p] = (bf16_t)(pk2(yy * nw, 0.f) & 0xffff); }
                __syncthreads();
                if (c.tid == 0) { float s = 0.f; for (int e = 0; e < 64; ++e) s += red[e]; SSQ[(size_t)tok * NH + h] = s; }
            }
        }
        if (!is_lat) { float* op = a.out + (size_t)NTOK * D + ((size_t)((seq * 2 + j) * 2 + dir) * NH + h) * 8192 + p * 128 + nq;
#pragma unroll
            for (int e = 0; e < 32; ++e) op[e] = hs[e]; }
    }
}
#endif
__device__ __forceinline__ void phase_scan(const Ctx& c, int j) {
#if NAIVE_SCAN
    for (int u = c.vb; u < 1088; u += c.G) { if (u < 64) scan_unit_naive(c, j, 32 + (u >> 5), u & 31); else scan_unit_naive(c, j, (u - 64) >> 5, (u - 64) & 31); }
    return;
#endif
    phase_scan_pipe(c, j);
}

typedef const Args __attribute__((address_space(4)))* ArgsP;
#if 0
#define LB_WAVES 1
#else
#define LB_WAVES 2
#endif
__global__ void __launch_bounds__(NTHR, LB_WAVES) fwd_kernel(Args args) {
    extern __shared__ __attribute__((aligned(16))) char lds[];
    volatile LAS unsigned* st = (volatile LAS unsigned*)(lds + LDS_BYTES - 16);
    if (threadIdx.x == 0) { st[0] = 0u; st[1] = 0u; }
    __syncthreads();
    const int ph_lo = args.ph_lo, ph_hi = args.ph_hi;
    const bool multi = (ph_hi - ph_lo) > 1;
    XcdBarrier bar; bar.bar = (unsigned*)(args.ws + WS_CTL); bar.x = 0; bar.st = st;
    if (multi) bar = xcd_barrier_post((unsigned*)(args.ws + WS_CTL), st);

    int rep = 0;
#pragma unroll 1
    for (int ph = ph_lo; ph < ph_hi; ++ph) {
        ArgsP ap = (ArgsP)__builtin_amdgcn_kernarg_segment_ptr();
        asm volatile("" : "+s"(ap));
        int tid = threadIdx.x;
        asm volatile("" : "+v"(tid));
        Ctx c;
        c.lds = lds; c.tid = tid; c.lane = tid & 63; c.wid = __builtin_amdgcn_readfirstlane(tid >> 6);
        c.G = gridDim.x; c.vb = (c.G % 8 == 0) ? (int)(blockIdx.x % 8) * (c.G / 8) + (int)(blockIdx.x / 8) : (int)blockIdx.x;
        c.a = ap;
        unsigned char* ws = ap->ws;
        const float* MOD = (const float*)(ws + WS_MOD);

        int kind = 0;
        if (ph == 0) { if (PH_ON(0)) phase_prep(c); }
        else if (ph == 1) { kind = 12; phase_prep2(c); }
        else if (ph == NPHASE - 1) { kind = 10; if (PH_ON(1)) phase_norm(c, ap->in[21], nullptr, 0, 0, true); }
        else {
            int layer, sub;
            if (ph <= 7) { layer = 0; sub = ph - 2; } else if (ph <= 12) { layer = 1; sub = ph - 8; } else if (ph <= 18) { layer = 2; sub = ph - 13; } else { layer = 3; sub = ph - 19; }
            const int j = layer >> 1;
            const float* mod = MOD + (size_t)layer * 3 * 6144;
            const bool ssd = (layer & 1) == 0;
            const int nmix = ssd ? 4 : 3;
            if (sub < nmix - 1) kind = ssd ? (sub == 0 ? 2 : sub == 1 ? 3 : 4) : (sub == 0 ? 6 : 7);
            else if (sub == nmix) kind = 8;
            else kind = 5;

            if (kind == 2) { if (PH_ON(2)) phase_inproj(c, j); }
            else if (kind == 3) { if (PH_ON(3)) phase_conv(c, j); }
            else if (kind == 4) { if (PH_ON(4)) phase_scan(c, j); }
            else if (kind == 6) { if (PH_ON(6)) phase_f1(c, j); }
            else if (kind == 7) { if (PH_ON(7)) phase_f2(c); }
            else if (kind == 8) { if (PH_ON(8)) phase_mlp_up(c, layer); }
            else {
                if (PH_ON(5)) {
                    const bf16_t* WT; const bf16_t* Act; int K; const float* gate; const float* bias = nullptr; const float* ssq = nullptr;
                    const float* nw_next; const float* scale_next;
                    if (sub == nmix - 1) {
                        gate = mod + 2048; nw_next = ap->in[8] + layer * D; scale_next = mod + 4096;
                        if (ssd) { WT = (const bf16_t*)(ws + WS_WOUT) + (size_t)j * D * DI; Act = (const bf16_t*)(ws + S_YG); K = DI; ssq = (const float*)(ws + S_SSQ); }
                        else { WT = (const bf16_t*)(ws + WS_WFNO) + (size_t)j * D * D; Act = (const bf16_t*)(ws + S_F); K = D; bias = ap->in[18] + j * D; }
                    } else {
                        gate = mod + 5120; WT = (const bf16_t*)(ws + WS_W2) + (size_t)layer * D * DFF; Act = (const bf16_t*)(ws + S_HID); K = DFF;
                        if (layer < 3) { nw_next = ap->in[7] + (layer + 1) * D; scale_next = mod + 3 * 6144 + 1024; } else { nw_next = nullptr; scale_next = nullptr; }
                    }
                    if (rep > 0) { gate = (const float*)(ws + WS_ZERO); }
                    phase_resid_gemm(c, WT, Act, K, gate, bias, ssq, nw_next, scale_next, layer == 0 && sub == nmix - 1 && rep == 0);
                }
            }
        }
        if (REP_KIND == 9) { for (int r = 0; r < REP_N; ++r) if (multi) xcd_barrier(bar); }
        if (REP_N > 0 && kind == REP_KIND && rep < REP_N) { ++rep; --ph; if (multi) xcd_barrier(bar); continue; }
        rep = 0;
        if (REP_KIND == 11 && ph == NPHASE - 1) { for (int r = 0; r < REP_N; ++r) { if (multi) xcd_barrier(bar); phase_bench(c); } }
        if (ph + 1 < ph_hi) xcd_barrier(bar);
    }
}

extern "C" void kernel_launch(void* const* d_in, const int* in_sizes, int n_in, void* d_out, int out_size, void* d_ws, size_t ws_size, hipStream_t stream) {
    static int grid = 0;
    if (grid == 0) {
        int dev = 0, cus = 0;
        if (hipGetDevice(&dev) != hipSuccess || hipDeviceGetAttribute(&cus, hipDeviceAttributeMultiprocessorCount, dev) != hipSuccess || cus <= 0) { fprintf(stderr, "kernel_launch: device query failed\n"); grid = -1; return; }
        if (hipFuncSetAttribute((const void*)fwd_kernel, hipFuncAttributeMaxDynamicSharedMemorySize, LDS_BYTES) != hipSuccess) { fprintf(stderr, "kernel_launch: hipFuncSetAttribute failed\n"); }
        (void)hipGetLastError();
        if (ws_size < WS_END) fprintf(stderr, "kernel_launch: workspace too small: %zu < %zu\n", ws_size, (size_t)WS_END);
        grid = cus;
    }
    if (grid < 0) return;
    (void)hipMemsetAsync((char*)d_ws + WS_CTL, 0, CTL_BYTES, stream);
    Args a{};
    for (int i = 0; i < 22; ++i) a.in[i] = (const float*)d_in[i];
    a.out = (float*)d_out; a.ws = (unsigned char*)d_ws;
#if N_LAUNCH_MODE == 1
    a.ph_lo = 0; a.ph_hi = NPHASE;
    hipLaunchKernelGGL(fwd_kernel, dim3(grid), dim3(NTHR), LDS_BYTES, stream, a);
#else
    for (int ph = 0; ph < NPHASE; ++ph) {
        a.ph_lo = ph; a.ph_hi = ph + 1;
        hipLaunchKernelGGL(fwd_kernel, dim3(grid), dim3(NTHR), LDS_BYTES, stream, a);
    }
#endif
}
```

```cpp
#include <hip/hip_runtime.h>
#include <stdint.h>
#include <stdio.h>

#ifndef PH_MASK
#define PH_MASK 0xFFFF
#endif
#define PH_ON(k) ((PH_MASK >> (k)) & 1)
#ifndef NAIVE_GEMM
#define NAIVE_GEMM 0
#endif
#define GN(k) ((NAIVE_GEMM >> (k)) & 1)
#ifndef NAIVE_SCAN
#define NAIVE_SCAN 0
#endif
#ifndef REP_KIND
#define REP_KIND -1
#endif
#ifndef REP_N
#define REP_N 0
#endif
#ifndef GEMM_INTERLEAVE
#define GEMM_INTERLEAVE 0
#endif
#ifndef GEMM_SETPRIO
#define GEMM_SETPRIO 0
#endif
#ifndef N_LAUNCH_MODE
#define N_LAUNCH_MODE 1
#endif

typedef unsigned short bf16_t;
typedef short bf16x8 __attribute__((ext_vector_type(8)));
typedef short bf16x4 __attribute__((ext_vector_type(4)));
typedef float f32x4 __attribute__((ext_vector_type(4)));
typedef unsigned u32x4 __attribute__((ext_vector_type(4)));
typedef unsigned u32x2 __attribute__((ext_vector_type(2)));
#define LAS __attribute__((address_space(3)))

constexpr int D = 1024, NCTX = 8192, NLAT = 2048, NTOK = 10240;
constexpr int DI = 2048, DXBC = 3072, DPROJ = 5184, NZX = 5120, NH = 32, DFF = 4096;
constexpr float EPS = 1e-6f;
constexpr int NPHASE = 25;

constexpr size_t al256(size_t x) { return (x + 255) & ~(size_t)255; }
constexpr size_t WS_CTL  = 0;
constexpr size_t CTL_BYTES = 65536 + 81920;
constexpr size_t WS_ZERO = 65536;
constexpr size_t WS_MOD  = WS_CTL + CTL_BYTES;
constexpr size_t WS_SWIN = al256(WS_MOD + 4 * 3 * 6144 * 4);
constexpr size_t WS_SWUP = WS_SWIN + 2 * 3 * DPROJ * 4;
constexpr size_t WS_SWF1 = WS_SWUP + 4 * 3 * DFF * 4;
constexpr size_t WS_RSS  = al256(WS_SWF1 + 2 * 3 * 2048 * 4);
constexpr size_t WS_WIN  = al256(WS_RSS + (size_t)NTOK * 16 * 4);
constexpr size_t WS_WOUT = WS_WIN + (size_t)2 * DPROJ * D * 2;
constexpr size_t WS_WFNO = WS_WOUT + (size_t)2 * D * DI * 2;
constexpr size_t WS_W1   = WS_WFNO + (size_t)2 * D * D * 2;
constexpr size_t WS_W2   = WS_W1 + (size_t)4 * DFF * D * 2;
constexpr size_t WS_T1   = WS_W2 + (size_t)4 * DFF * D * 2;
constexpr size_t WS_T2C  = WS_T1 + (size_t)512 * 256 * 2;
constexpr size_t WS_T2L  = WS_T2C + (size_t)256 * 512 * 2;
constexpr size_t WS_H    = WS_T2L + (size_t)1024 * 2048 * 2;
constexpr size_t WS_S    = WS_H + (size_t)NTOK * D * 2;
constexpr size_t S_Z     = WS_S;
constexpr size_t S_XBC   = S_Z + (size_t)NTOK * DI * 2;
constexpr size_t S_DT    = S_XBC + (size_t)NTOK * DXBC * 2;
constexpr size_t S_SSQ   = S_DT + (size_t)NTOK * 64 * 4;
constexpr size_t S_YG    = S_SSQ + (size_t)NTOK * 32 * 4;
constexpr size_t S_RAW   = S_YG + (size_t)NTOK * DI * 2;
constexpr size_t WS_END  = S_RAW + (size_t)NTOK * DXBC * 2;
constexpr size_t S_HID   = WS_S;
constexpr size_t S_UVT   = WS_S;
constexpr size_t S_F     = WS_S + (size_t)NTOK * 2048 * 2;

constexpr int LDS_BYTES = 163840;
constexpr int NTHR = 512, NWAVE = 8;

typedef __bf16 bf16x2_t __attribute__((ext_vector_type(2)));
typedef float f32x2_t __attribute__((ext_vector_type(2)));
__device__ __forceinline__ unsigned pk2(float lo, float hi) { const f32x2_t f = {lo, hi}; return __builtin_bit_cast(unsigned, __builtin_convertvector(f, bf16x2_t)); }
__device__ __forceinline__ float bflo(unsigned u) { return __uint_as_float(u << 16); }
__device__ __forceinline__ float bfhi(unsigned u) { return __uint_as_float(u & 0xffff0000u); }
__device__ __forceinline__ float wave_sum(float v) {
#pragma unroll
    for (int o = 1; o < 64; o <<= 1) v += __shfl_xor(v, o);
    return v;
}
__device__ __forceinline__ float silu_f(float x) { return x * __builtin_amdgcn_rcpf(1.0f + __expf(-x)); }
__device__ __forceinline__ int cond_of(int tok) { return tok < NCTX ? 0 : (tok < NCTX + 1024 ? 1 : 2); }

#define XB_TMO      128
#define XB_XCNT(j)  (256  + 64 * (j))
#define XB_XSUB(j)  (1280 + 64 * (j))
#define XB_XGEN(j)  (2304 + 64 * (j))
#define XB_TOP      3328
#define XB_TOPGEN   3392
#define XCD_BAR_WORDS 3456
#define XB_SPIN_CAP (1u << 20)
__device__ __forceinline__ unsigned xb_ld(unsigned* p)              { return __hip_atomic_load(p, __ATOMIC_RELAXED, __HIP_MEMORY_SCOPE_AGENT); }
__device__ __forceinline__ unsigned xb_add(unsigned* p, unsigned v) { return __hip_atomic_fetch_add(p, v, __ATOMIC_RELAXED, __HIP_MEMORY_SCOPE_AGENT); }
__device__ __forceinline__ unsigned xb_xcc_id() { return (unsigned)__builtin_amdgcn_s_getreg((3 << 11) | 20) & 0xFu; }
#define XB_SPIN(cond, bar) do { unsigned _sp = 0; while (cond) { __builtin_amdgcn_s_sleep(1); \
    if ((++_sp & 255u) == 0u) { if (xb_ld(&(bar)[XB_TMO])) break; if (_sp > XB_SPIN_CAP) { atomicAdd(&(bar)[XB_TMO], 1u); break; } } } } while (0)
struct XcdBarrier { unsigned* bar; unsigned x; volatile LAS unsigned* st; };
__device__ __forceinline__ XcdBarrier xcd_barrier_post(unsigned* bar, volatile LAS unsigned* st) {
    XcdBarrier b; b.bar = bar; b.x = xb_xcc_id(); b.st = st;
    if (threadIdx.x == 0) (void)xb_add(&bar[XB_XCNT(b.x)], 1u);
    return b;
}
__device__ __forceinline__ void xcd_barrier_complete(unsigned* bar, unsigned x, unsigned& nloc, unsigned& nx) {
    const unsigned G = gridDim.x * gridDim.y * gridDim.z;
    unsigned sum, cnt, mine, sp = 0u;
    for (;;) {
        sum = 0u; cnt = 0u; mine = 0u;
#pragma unroll
        for (unsigned j = 0; j < 16; ++j) { const unsigned c = xb_ld(&bar[XB_XCNT(j)]); sum += c; cnt += (c > 0u) ? 1u : 0u; mine = (j == x) ? c : mine; }
        if (sum == G) break;
        __builtin_amdgcn_s_sleep(1);
        if ((++sp & 255u) == 0u) { if (xb_ld(&bar[XB_TMO])) break; if (sp > XB_SPIN_CAP) { atomicAdd(&bar[XB_TMO], 1u); break; } }
    }
    nloc = mine > 0u ? mine : 1u; nx = cnt > 0u ? cnt : 1u;
}
__device__ __forceinline__ void xcd_barrier(const XcdBarrier& b) {
    asm volatile("s_waitcnt vmcnt(0)" ::: "memory");
    __syncthreads();
    if (threadIdx.x == 0) {
        unsigned* bar = b.bar;
        __builtin_amdgcn_s_waitcnt(0);
        unsigned nloc = b.st[0], nx = b.st[1];
        if (nloc == 0u) { xcd_barrier_complete(bar, b.x, nloc, nx); b.st[0] = nloc; b.st[1] = nx; }
        const unsigned old = xb_add(&bar[XB_XSUB(b.x)], 1u);
        const unsigned gen = old / nloc;
        if (old + 1u == (gen + 1u) * nloc) {
            __builtin_amdgcn_fence(__ATOMIC_RELEASE, "agent");
            asm volatile("s_waitcnt vmcnt(0)" ::: "memory");
            const unsigned og = xb_add(&bar[XB_TOP], 1u);
            const unsigned tg = og / nx;
            if (og + 1u == (tg + 1u) * nx) xb_add(&bar[XB_TOPGEN], 1u);
            else XB_SPIN(xb_ld(&bar[XB_TOPGEN]) == tg, bar);
            __builtin_amdgcn_fence(__ATOMIC_ACQUIRE, "agent");
            xb_add(&bar[XB_XGEN(b.x)], 1u);
            asm volatile("s_waitcnt vmcnt(0)" ::: "memory");
        } else {
            XB_SPIN(xb_ld(&bar[XB_XGEN(b.x)]) == gen, bar);
            __builtin_amdgcn_fence(__ATOMIC_ACQUIRE, "agent");
            asm volatile("s_waitcnt vmcnt(0)" ::: "memory");
        }
    }
    __syncthreads();
}

struct Args {
    const float* in[22];
    float* out;
    unsigned char* ws;
    int ph_lo, ph_hi;
};

struct Ctx {
    char* lds;
    int tid, lane, wid;
    int vb, G;
    const Args __attribute__((address_space(4)))* a;
};

template <int TB> struct GT { static constexpr int ROWS = 256 + 32 * TB, STAGE = ROWS * 128, NI = ROWS / 8; };

template <int TB>
__device__ __forceinline__ void gemm_stage(char* st, const bf16_t* Ag, int lda, const bf16_t* Bg, int ldb, int k0, int wid, int lane) {
    constexpr int NI = GT<TB>::NI;
    const int rsub = lane >> 3, lch = (lane & 7) ^ rsub;
#pragma unroll
    for (int i = 0; i < (NI + 7) / 8; ++i) {
        const int q = wid + 8 * i;
        if (q < NI) {
            const int row = q * 8 + rsub;
            const bf16_t* src = (q < 32) ? (Ag + (size_t)row * lda + k0 + lch * 8) : (Bg + (size_t)(row - 256) * ldb + k0 + lch * 8);
            __builtin_amdgcn_global_load_lds((const unsigned*)src, (LAS unsigned*)(st + q * 1024 + lane * 16), 16, 0, 0);
        }
    }
}
__device__ __forceinline__ bf16x8 frag128(const char* tile, int row, int chunk) {
    return *(const bf16x8*)(tile + row * 128 + ((chunk ^ (row & 7)) << 4));
}

struct NoPre { __device__ __forceinline__ void operator()() const {} };
template <int TB, bool NAIVE, class Epi, class Pre = NoPre>
__device__ __forceinline__ void gemm_tile(const Ctx& c, const bf16_t* Ag, int lda, const bf16_t* Bg, int ldb, int K, int a0, int b0, const Epi& epi, const Pre& pre = Pre(),
                                          bool prefetched = false, const bf16_t* An = nullptr, const bf16_t* Bn = nullptr) {
    constexpr int STAGE = GT<TB>::STAGE;
    const int wr = c.wid >> 1, wc = c.wid & 1, fr = c.lane & 15, fq = c.lane >> 4;
    f32x4 acc[4][TB];
#pragma unroll
    for (int i = 0; i < 4; ++i)
#pragma unroll
        for (int j = 0; j < TB; ++j) acc[i][j] = (f32x4){0.f, 0.f, 0.f, 0.f};
    if (NAIVE) {
        __syncthreads(); pre(); __syncthreads();
        const bf16_t* ar = Ag + (size_t)(wr * 64 + fq * 4) * lda;
        const bf16_t* br = Bg + (size_t)(wc * 16 * TB + fr) * ldb;
#pragma unroll
        for (int j = 0; j < TB; ++j) {
#pragma unroll 1
            for (int k = 0; k < K; k += 8) {
                float bv[8];
                { const u32x4 v = *(const u32x4*)(br + (size_t)(j * 16) * ldb + k);
#pragma unroll
                  for (int e = 0; e < 4; ++e) { bv[2 * e] = bflo(v[e]); bv[2 * e + 1] = bfhi(v[e]); } }
#pragma unroll
                for (int i = 0; i < 4; ++i)
#pragma unroll
                    for (int r = 0; r < 4; ++r) {
                        const u32x4 v = *(const u32x4*)(ar + (size_t)(i * 16 + r) * lda + k);
#pragma unroll
                        for (int e = 0; e < 4; ++e) acc[i][j][r] += bflo(v[e]) * bv[2 * e] + bfhi(v[e]) * bv[2 * e + 1];
                    }
                asm volatile("" ::: "memory");
            }
        }
        epi(acc, a0 + wr * 64, b0 + wc * (16 * TB), fr, fq);
        return;
    }
    const int nt = K >> 6;
    __syncthreads();
    if (!prefetched) gemm_stage<TB>(c.lds, Ag, lda, Bg, ldb, 0, c.wid, c.lane);
    pre();
    for (int t = 0; t < nt; ++t) {
        asm volatile("s_waitcnt vmcnt(0)" ::: "memory");
        __syncthreads();
        const char* cur = c.lds + (t & 1) * STAGE;
        if (t + 1 < nt) gemm_stage<TB>(c.lds + ((t + 1) & 1) * STAGE, Ag, lda, Bg, ldb, (t + 1) << 6, c.wid, c.lane);
        else if (An) gemm_stage<TB>(c.lds, An, lda, Bn, ldb, 0, c.wid, c.lane);
#pragma unroll
        for (int kk = 0; kk < 2; ++kk) {
            bf16x8 af[4], bfr[TB];
#pragma unroll
            for (int i = 0; i < 4; ++i) af[i] = frag128(cur, wr * 64 + i * 16 + fr, kk * 4 + fq);
#pragma unroll
            for (int j = 0; j < TB; ++j) bfr[j] = frag128(cur, 256 + wc * (16 * TB) + j * 16 + fr, kk * 4 + fq);
#pragma unroll
            for (int i = 0; i < 4; ++i)
#pragma unroll
                for (int j = 0; j < TB; ++j) acc[i][j] = __builtin_amdgcn_mfma_f32_16x16x32_bf16(af[i], bfr[j], acc[i][j], 0, 0, 0);
        }
    }
    epi(acc, a0 + wr * 64, b0 + wc * (16 * TB), fr, fq);
}

template <int TB, class Prob, int BENCH = 0>
__device__ __forceinline__ void gemm_stream(const Ctx& c, const Prob& P) {
    constexpr int STAGE = GT<TB>::STAGE, NI = GT<TB>::NI;
    constexpr int NSLOT = (NI + 7) / 8;
    const int wr = c.wid >> 1, wc = c.wid & 1, fr = c.lane & 15, fq = c.lane >> 4;
    const int n = P.count();
    if (n <= 0) return;
    f32x4 acc[4][TB];
#pragma unroll
    for (int i = 0; i < 4; ++i)
#pragma unroll
        for (int j = 0; j < TB; ++j) acc[i][j] = (f32x4){0.f, 0.f, 0.f, 0.f};
    const int KT = P.K >> 6;
    const int total = n * KT;
    const int rsub = c.lane >> 3, lch = (c.lane & 7) ^ rsub;
    int voff[NSLOT], qs[NSLOT];
#pragma unroll
    for (int s = 0; s < NSLOT; ++s) {
        const int q = (c.wid + 8 * s < NI) ? c.wid + 8 * s : NI - 1;
        qs[s] = q;
        voff[s] = (s < 4) ? ((q * 8 + rsub) * P.lda + lch * 8) : ((q * 8 + rsub - 256) * P.ldb + lch * 8);
    }
    const bf16_t* Acur; const bf16_t* Bcur;
    int li = 0, lk = 0;
    P.tile(0, Acur, Bcur);
    constexpr int Q0 = (NSLOT + 3) / 4, Q1 = Q0 + (NSLOT + 2) / 4, Q2 = Q1 + (NSLOT + 1) / 4;
    constexpr int S1 = Q1;
    auto issue_part = [&](int stage, int s0, int s1) {
        char* st = c.lds + stage * STAGE;
#pragma unroll
        for (int s = 0; s < NSLOT; ++s) {
            if (s >= s0 && s < s1) {
                const bf16_t* src = ((s < 4) ? Acur : Bcur) + voff[s] + lk * 64;
                __builtin_amdgcn_global_load_lds((const unsigned*)src, (LAS unsigned*)(st + qs[s] * 1024 + c.lane * 16), 16, 0, 0);
            }
        }
    };
    auto issue = [&](int stage) { issue_part(stage, 0, NSLOT); };
    auto advance = [&]() { if (++lk == KT) { lk = 0; if (li + 1 < n) { ++li; P.tile(li, Acur, Bcur); } } };
    asm volatile("s_waitcnt vmcnt(0)" ::: "memory");
    __builtin_amdgcn_s_barrier();
    asm volatile("" ::: "memory");
    issue(0); advance(); issue(1); advance();
    P.pre_all();
    int ci = 0, ck = 0, stg = 0;
#define GEMM_WAIT_ONE_STAGE() do { if (BENCH == 1) { asm volatile("s_waitcnt vmcnt(0)" ::: "memory"); } \
        else if (after_epi) { asm volatile("s_waitcnt vmcnt(%0)" :: "n"(S1 + Prob::EPI_STORES) : "memory"); } \
        else { asm volatile("s_waitcnt vmcnt(%0)" :: "n"(S1) : "memory"); } } while (0)
    bool after_epi = false;
#define GEMM_BAR() do { asm volatile("" ::: "memory"); __builtin_amdgcn_s_barrier(); asm volatile("" ::: "memory"); } while (0)
#define GEMM_LOADF(dst, stage_ptr, kk) do { \
        _Pragma("unroll") for (int i = 0; i < 4; ++i) dst.a[i] = frag128(stage_ptr, wr * 64 + i * 16 + fr, (kk) * 4 + fq); \
        _Pragma("unroll") for (int jj = 0; jj < TB; ++jj) dst.b[jj] = frag128(stage_ptr, 256 + wc * (16 * TB) + jj * 16 + fr, (kk) * 4 + fq); } while (0)
#define GEMM_MMA(src_) do { \
        _Pragma("unroll") for (int i = 0; i < 4; ++i) \
        _Pragma("unroll") for (int jj = 0; jj < TB; ++jj) acc[i][jj] = __builtin_amdgcn_mfma_f32_16x16x32_bf16(src_.a[i], src_.b[jj], acc[i][jj], 0, 0, 0); } while (0)
    struct Frags { bf16x8 a[4]; bf16x8 b[TB]; };
    Frags f0, f1;
    if (BENCH == 1) { asm volatile("s_waitcnt vmcnt(0)" ::: "memory"); } else { asm volatile("s_waitcnt vmcnt(%0)" :: "n"(NSLOT) : "memory"); }
    GEMM_BAR();
    GEMM_LOADF(f0, c.lds, 0);
    f32x4 sw[4];
#pragma unroll
    for (int i = 0; i < 4; ++i) sw[i] = (f32x4){0.f, 0.f, 0.f, 0.f};
#pragma unroll 1
    for (int gs = 0; gs < total; ++gs) {
        const char* cur = c.lds + stg * STAGE;
        const int nst1 = stg == 2 ? 0 : stg + 1;
        if (ck == KT - 1) P.preload(ci, sw, wr, fq);
        if (BENCH != 2) GEMM_LOADF(f1, cur, 1);
        const int nst2 = stg == 0 ? 2 : stg - 1;
        if (BENCH != 1) issue_part(nst2, 0, Q0);
        if (BENCH != 2) GEMM_MMA(f0);
#if GEMM_INTERLEAVE
        __builtin_amdgcn_sched_group_barrier(0x100, 4 + TB, 0);
#pragma unroll
        for (int s = 0; s < NSLOT; ++s) {
            __builtin_amdgcn_sched_group_barrier(0x008, 2, 0);
            __builtin_amdgcn_sched_group_barrier(0x006, 6, 0);
            __builtin_amdgcn_sched_group_barrier(0x010, 1, 0);
        }
        __builtin_amdgcn_sched_group_barrier(0x008, 4 * TB - 2 * NSLOT, 0);
#endif
        if (BENCH != 1) issue_part(nst2, Q0, Q1);
        GEMM_WAIT_ONE_STAGE();
        after_epi = false;
        asm volatile("s_waitcnt lgkmcnt(0)" ::: "memory");
        GEMM_BAR();
        if (BENCH != 1) issue_part(nst2, Q1, Q2);
        if (BENCH != 2) GEMM_LOADF(f0, c.lds + nst1 * STAGE, 0);
#if GEMM_SETPRIO
        __builtin_amdgcn_s_setprio(1);
#endif
        if (BENCH != 2) GEMM_MMA(f1);
#if GEMM_SETPRIO
        __builtin_amdgcn_s_setprio(0);
#endif
        if (BENCH != 1) issue_part(nst2, Q2, NSLOT);
        stg = nst1;
        advance();
        if (++ck == KT) {
            P.epilogue(ci, acc, sw, wr, wc, fr, fq);
#pragma unroll
            for (int i = 0; i < 4; ++i)
#pragma unroll
                for (int j = 0; j < TB; ++j) acc[i][j] = (f32x4){0.f, 0.f, 0.f, 0.f};
            ck = 0; ++ci;
            after_epi = true;
        }
    }
    asm volatile("s_waitcnt vmcnt(0)" ::: "memory");
    GEMM_BAR();
#undef GEMM_WAIT_ONE_STAGE
#undef GEMM_BAR
#undef GEMM_LOADF
#undef GEMM_MMA
}

__device__ __forceinline__ u32x4 pair16(const u32x2& a, const u32x2& b) {
    const auto sx = __builtin_amdgcn_permlane16_swap(a.x, b.x, false, false);
    const auto sy = __builtin_amdgcn_permlane16_swap(a.y, b.y, false, false);
    return (u32x4){sx[0], sy[0], sx[1], sy[1]};
}
struct EpiInProj {
    bf16_t* Z; bf16_t* RAW; const float* rsx  ; int tok_base; const float* SW  ; bool uni  ;
    __device__ __forceinline__ void operator()(f32x4 (&acc)[4][5], const f32x4 (&swp)[4], int ab, int bb, int fr, int fq) const {
#pragma unroll
        for (int j = 0; j < 5; ++j) {
            const int tok = bb + j * 16 + fr;
            const float rs = rsx[tok - tok_base];
            const float* sw = SW + cond_of(tok) * DPROJ;
            u32x2 v[4];
#pragma unroll
            for (int i = 0; i < 4; ++i) {
                const int n = ab + i * 16 + fq * 4;
                const f32x4 o = acc[i][j] * rs + (uni ? swp[i] : *(const f32x4*)(sw + n));
                v[i].x = pk2(o[0], o[1]); v[i].y = pk2(o[2], o[3]);
            }
#pragma unroll
            for (int p = 0; p < 2; ++p) {
                const u32x4 o = pair16(v[2 * p], v[2 * p + 1]);
                const int n = ab + (2 * p + (fq & 1)) * 16 + (fq & 2) * 4;
                bf16_t* dst = (n < DI) ? (Z + (size_t)tok * DI + n) : (RAW + (size_t)tok * DXBC + (n - DI));
                *(u32x4*)dst = o;
            }
        }
    }
};
struct EpiResid {
    float* X; const float* gate  ; const float* bias; const float* rs_lds  ; int tok_base;
    const float* Xin0; const float* Xin1;
    bf16_t* XG  ; const float* nw_next; const float* scale_next  ; float* RSS; const float* zeros  ;
    __device__ __forceinline__ void operator()(f32x4 (&acc)[4][5], int ab, int bb, int fr, int fq) const {
        const int slot = (ab >> 6);
        const bool uni = cond_of(bb) == cond_of(bb + 79);
        const int nb = ab + fq * 4;
        f32x4 gvv[4], bvv[4], gnn[4];
        auto load_vecs = [&](int cd) {
            const float* gp = gate + cd * 6144 + nb;
            const float* bp = (bias ? bias : zeros) + nb;
            const float* np = (XG ? nw_next : zeros) + nb;
            const float* sp = (XG ? scale_next + cd * 6144 : zeros) + nb;
            f32x4 t0[4], t1[4];
#pragma unroll
            for (int i = 0; i < 4; ++i) { gvv[i] = *(const f32x4*)(gp + i * 16); bvv[i] = *(const f32x4*)(bp + i * 16); t0[i] = *(const f32x4*)(np + i * 16); t1[i] = *(const f32x4*)(sp + i * 16); }
#pragma unroll
            for (int i = 0; i < 4; ++i) gnn[i] = t0[i] * (t1[i] + 1.0f);
        };
        if (uni) load_vecs(cond_of(bb));
        auto xrow = [&](int tok) -> const float* { return (Xin0 ? (tok < NCTX ? Xin0 + (size_t)tok * D : Xin1 + (size_t)(tok - NCTX) * D) : X + (size_t)tok * D) + nb; };
        f32x4 xv[4];
#pragma unroll
        for (int j = 0; j < 5; ++j) {
            const int tok = bb + j * 16 + fr;
            { const float* p = xrow(tok);
#pragma unroll
              for (int i = 0; i < 4; ++i) xv[i] = *(const f32x4*)(p + i * 16); }
            const float rs = rs_lds ? rs_lds[tok - tok_base] : 1.0f;
            if (!uni) load_vecs(cond_of(tok));
            float ss = 0.f;
            u32x2 xgv[4];
            float* xo = X + (size_t)tok * D + nb;
#pragma unroll
            for (int i = 0; i < 4; ++i) {
                const f32x4 x2 = xv[i] + gvv[i] * (acc[i][j] * rs + bvv[i]);
                *(f32x4*)(xo + i * 16) = x2;
                ss += x2[0] * x2[0] + x2[1] * x2[1] + x2[2] * x2[2] + x2[3] * x2[3];
                const f32x4 o = x2 * gnn[i];
                xgv[i].x = pk2(o[0], o[1]); xgv[i].y = pk2(o[2], o[3]);
            }
            if (XG) {
#pragma unroll
                for (int p = 0; p < 2; ++p) {
                    const u32x4 o = pair16(xgv[2 * p], xgv[2 * p + 1]);
                    *(u32x4*)(XG + (size_t)tok * D + ab + (2 * p + (fq & 1)) * 16 + (fq & 2) * 4) = o;
                }
                ss += __shfl_xor(ss, 16); ss += __shfl_xor(ss, 32);
                if (fq == 0) RSS[(size_t)tok * 16 + slot] = ss;
            }
        }
    }
};
struct EpiMlpUp {
    bf16_t* HID; const float* rsx; int tok_base; const float* SW  ; bool uni;
    __device__ __forceinline__ void operator()(f32x4 (&acc)[4][5], const f32x4 (&swp)[4], int ab, int bb, int fr, int fq) const {
#pragma unroll
        for (int j = 0; j < 5; ++j) {
            const int tok = bb + j * 16 + fr;
            const float rs = rsx[tok - tok_base];
            const float* sw = SW + cond_of(tok) * DFF;
            u32x2 v[4];
#pragma unroll
            for (int i = 0; i < 4; ++i) {
                const int n = ab + i * 16 + fq * 4;
                f32x4 a = acc[i][j] * rs + (uni ? swp[i] : *(const f32x4*)(sw + n));
                a[0] = fmaxf(a[0], 0.f); a[1] = fmaxf(a[1], 0.f); a[2] = fmaxf(a[2], 0.f); a[3] = fmaxf(a[3], 0.f);
                v[i].x = pk2(a[0] * a[0], a[1] * a[1]); v[i].y = pk2(a[2] * a[2], a[3] * a[3]);
            }
#pragma unroll
            for (int p = 0; p < 2; ++p) {
                const u32x4 o = pair16(v[2 * p], v[2 * p + 1]);
                *(u32x4*)(HID + (size_t)tok * DFF + ab + (2 * p + (fq & 1)) * 16 + (fq & 2) * 4) = o;
            }
        }
    }
};
struct EpiDt {
    float* DT; const float* rsx; int tok_base; const float* SW  ;
    __device__ __forceinline__ void operator()(f32x4 (&acc)[4][2], int ab, int bb, int fr, int fq) const {
        float swv[2][3];
#pragma unroll
        for (int j = 0; j < 2; ++j)
#pragma unroll
            for (int cd = 0; cd < 3; ++cd) swv[j][cd] = SW[cd * DPROJ + NZX + bb + j * 16 + fr];
#pragma unroll
        for (int j = 0; j < 2; ++j) {
            const int col = bb + j * 16 + fr;
#pragma unroll
            for (int i = 0; i < 4; ++i) {
                const int tok = ab + i * 16 + fq * 4;
#pragma unroll
                for (int r = 0; r < 4; ++r) {
                    const int cd = cond_of(tok + r);
                    const float sw = cd == 0 ? swv[j][0] : (cd == 1 ? swv[j][1] : swv[j][2]);
                    DT[(size_t)(tok + r) * 64 + col] = acc[i][j][r] * rsx[tok + r - tok_base] + sw;
                }
            }
        }
    }
};
struct EpiF1 {
    bf16_t* UVT; int g; const float* rsx; int tok_base; const float* SW  ;
    __device__ __forceinline__ void operator()(f32x4 (&acc)[4][4], int ab, int bb, int fr, int fq) const {
        float swv[4];
#pragma unroll
        for (int j = 0; j < 4; ++j) swv[j] = SW[cond_of(ab) * 2048 + g * 512 + bb + j * 16 + fr];
#pragma unroll
        for (int j = 0; j < 4; ++j) {
            const int nn = bb + j * 16 + fr, part = nn >> 8, ch = g * 256 + (nn & 255);
#pragma unroll
            for (int i = 0; i < 4; ++i) {
                const int tok = ab + i * 16 + fq * 4;
                const float sw = swv[j];
                bf16_t* dst;
                if (tok < NCTX) { const int s = tok >> 8, l = tok & 255; dst = UVT + ((size_t)(s * 1024 + ch) * 512 + part * 256 + l); }
                else { const int tt = tok - NCTX, s = tt >> 10, l = tt & 1023; dst = UVT + (size_t)NCTX * 2048 + ((size_t)(s * 1024 + ch) * 2048 + part * 1024 + l); }
                const f32x4 r4 = *(const f32x4*)(rsx + tok - tok_base);
                const f32x4 o = acc[i][j] * r4 + sw;
                u32x2 v; v.x = pk2(o[0], o[1]); v.y = pk2(o[2], o[3]);
                *(u32x2*)dst = v;
            }
        }
    }
};
template <int TB> struct EpiF2 {
    bf16_t* F; int tok0;
    __device__ __forceinline__ void operator()(f32x4 (&acc)[4][TB], int ab, int bb, int fr, int fq) const {
#pragma unroll
        for (int j = 0; j < TB; ++j) {
            const int tok = tok0 + bb + j * 16 + fr;
#pragma unroll
            for (int i = 0; i < 4; ++i) {
                const int n = ab + i * 16 + fq * 4;
                u32x2 v; v.x = pk2(acc[i][j][0], acc[i][j][1]); v.y = pk2(acc[i][j][2], acc[i][j][3]);
                *(u32x2*)(F + (size_t)tok * D + n) = v;
            }
        }
    }
};

struct TrItem { const float* W; bf16_t* WT; int K, N, k0, n0; };
__device__ __forceinline__ TrItem transpose_decode(const Ctx& c, int r) {
    const Args __attribute__((address_space(4)))& a = *c.a;
    constexpr int I_WIN = 8 * 81, I_WOUT = 16 * 16, I_FNO = 8 * 16, I_W1 = 8 * 64, I_W2 = 32 * 16;
    TrItem t; int item;
    if (r < 2 * I_WIN) { const int j = r / I_WIN; t.W = a.in[9] + (size_t)j * D * DPROJ; t.K = D; t.N = DPROJ; t.WT = (bf16_t*)(a.ws + WS_WIN) + (size_t)j * DPROJ * D; item = r - j * I_WIN; }
    else if ((r -= 2 * I_WIN) < 2 * I_WOUT) { const int j = r / I_WOUT; t.W = a.in[16] + (size_t)j * DI * D; t.K = DI; t.N = D; t.WT = (bf16_t*)(a.ws + WS_WOUT) + (size_t)j * D * DI; item = r - j * I_WOUT; }
    else if ((r -= 2 * I_WOUT) < 2 * I_FNO) { const int j = r / I_FNO; t.W = a.in[17] + (size_t)j * D * D; t.K = D; t.N = D; t.WT = (bf16_t*)(a.ws + WS_WFNO) + (size_t)j * D * D; item = r - j * I_FNO; }
    else if ((r -= 2 * I_FNO) < 4 * I_W1) { const int j = r / I_W1; t.W = a.in[19] + (size_t)j * D * DFF; t.K = D; t.N = DFF; t.WT = (bf16_t*)(a.ws + WS_W1) + (size_t)j * DFF * D; item = r - j * I_W1; }
    else { r -= 4 * I_W1; const int j = r / I_W2; t.W = a.in[20] + (size_t)j * DFF * D; t.K = DFF; t.N = D; t.WT = (bf16_t*)(a.ws + WS_W2) + (size_t)j * D * DFF; item = r - j * I_W2; }
    const int nb = t.N >> 6, kb = item / nb, nbi = item - kb * nb;
    t.k0 = kb * 128; t.n0 = nbi * 64;
    return t;
}
__device__ __forceinline__ void transpose_load(const Ctx& c, const TrItem& t, f32x4 (&v)[4]) {
    const int cl = c.tid & 15, rl = c.tid >> 4;
#pragma unroll
    for (int p = 0; p < 4; ++p) v[p] = *(const f32x4*)(t.W + (size_t)(t.k0 + p * 32 + rl) * t.N + t.n0 + cl * 4);
}
__device__ __forceinline__ void transpose_finish(const Ctx& c, const TrItem& t, const f32x4 (&v)[4]) {
    float* tile = (float*)c.lds;
    const int cl = c.tid & 15, rl = c.tid >> 4;
    __syncthreads();
#pragma unroll
    for (int p = 0; p < 4; ++p) { const int k = p * 32 + rl; tile[k * 65 + cl * 4 + 0] = v[p][0]; tile[k * 65 + cl * 4 + 1] = v[p][1]; tile[k * 65 + cl * 4 + 2] = v[p][2]; tile[k * 65 + cl * 4 + 3] = v[p][3]; }
    __syncthreads();
#pragma unroll
    for (int p = 0; p < 2; ++p) {
        const int idx = c.tid + p * NTHR, n = idx >> 4, kc = idx & 15;
        const float* s = tile + (kc * 8) * 65 + n;
        u32x4 o; o.x = pk2(s[0], s[65]); o.y = pk2(s[2 * 65], s[3 * 65]); o.z = pk2(s[4 * 65], s[5 * 65]); o.w = pk2(s[6 * 65], s[7 * 65]);
        *(u32x4*)(t.WT + (size_t)(t.n0 + n) * t.K + t.k0 + kc * 8) = o;
    }
}

__device__ __forceinline__ void ada_item(const Ctx& c, int item) {
    const Args __attribute__((address_space(4)))& a = *c.a;
    const int layer = item / 96, cg = item - layer * 96, n0 = cg * 64;
    const float* W = a.in[5] + (size_t)layer * D * 6144;
    const float* sc = (const float*)(c.lds + 40960);
    float* red = (float*)c.lds;
    const int cl = c.tid & 15, kl = c.tid >> 4;
    f32x4 a0 = {0, 0, 0, 0}, a1 = {0, 0, 0, 0}, a2 = {0, 0, 0, 0};
#pragma unroll 8
    for (int it = 0; it < 32; ++it) {
        const int k = it * 32 + kl;
        const f32x4 w = *(const f32x4*)(W + (size_t)k * 6144 + n0 + cl * 4);
        a0 += w * sc[k]; a1 += w * sc[1024 + k]; a2 += w * sc[2048 + k];
    }
    __syncthreads();
    *(f32x4*)(red + (kl * 3 + 0) * 64 + cl * 4) = a0;
    *(f32x4*)(red + (kl * 3 + 1) * 64 + cl * 4) = a1;
    *(f32x4*)(red + (kl * 3 + 2) * 64 + cl * 4) = a2;
    __syncthreads();
    if (c.tid < 192) {
        const int cond = c.tid >> 6, col = c.tid & 63;
        float s = 0.f;
#pragma unroll
        for (int k = 0; k < 32; ++k) s += red[(k * 3 + cond) * 64 + col];
        s += a.in[6][layer * 6144 + n0 + col];
        ((float*)(a.ws + WS_MOD))[(layer * 3 + cond) * 6144 + n0 + col] = s;
    }
}

__device__ __forceinline__ void phase_prep(const Ctx& c) {
    const Args __attribute__((address_space(4)))& a = *c.a;
    {
        float* sc = (float*)(c.lds + 40960);
        for (int i = c.tid; i < 3072; i += NTHR) {
            const int cond = i >> 10, k = i & 1023;
            const float v = cond == 0 ? a.in[4][k] : a.in[3][(cond - 1) * 1024 + k];
            sc[i] = silu_f(v);
        }
        __syncthreads();
    }
    constexpr int I_ADA = 384;
    constexpr int I_TR = 2 * 8 * 81 + 2 * 16 * 16 + 2 * 8 * 16 + 4 * 8 * 64 + 4 * 32 * 16;
    constexpr int I_TB = 32 + 32 + 512;
    for (int it = c.vb; it < I_ADA; it += c.G) ada_item(c, it);
    {
        int it = c.vb;
        if (it < I_TR) {
            TrItem cur = transpose_decode(c, it);
            f32x4 v[4]; transpose_load(c, cur, v);
            for (;;) {
                const int nit = it + c.G;
                TrItem nxt = cur; f32x4 vn[4];
                const bool has = nit < I_TR;
                if (has) { nxt = transpose_decode(c, nit); transpose_load(c, nxt, vn); }
                transpose_finish(c, cur, v);
                if (!has) break;
                cur = nxt; it = nit;
#pragma unroll
                for (int p = 0; p < 4; ++p) v[p] = vn[p];
            }
        }
    }
    for (int r = c.vb; r < I_TB; r += c.G) {
#pragma unroll 4
        for (int e = 0; e < 8; ++e) {
            int idx = r * 4096 + e * NTHR + c.tid;
            if (idx < 131072) {
                const int nn = idx >> 8, cc = idx & 255, m = nn & 255, ph = (m * cc) & 255;
                const float ang = (float)ph * (1.0f / 128.0f);
                const float v = nn < 256 ? cospif(ang) : sinpif(ang);
                ((bf16_t*)(a.ws + WS_T1))[idx] = (bf16_t)(pk2(v, 0.f) & 0xffff);
            } else if (idx < 262144) {
                idx -= 131072;
                const int k = idx >> 9, k2 = idx & 511, l = k2 & 255, ph = (k * l) & 255;
                const float ang = (float)ph * (1.0f / 128.0f);
                const float v = (k2 < 256 ? cospif(ang) : -sinpif(ang)) * (1.0f / 256.0f);
                ((bf16_t*)(a.ws + WS_T2C))[idx] = (bf16_t)(pk2(v, 0.f) & 0xffff);
            } else {
                idx -= 262144;
                const int k = idx >> 11, k2 = idx & 2047, l = k2 & 1023, ph = (k * l) & 1023;
                const float ang = (float)ph * (1.0f / 512.0f);
                const float v = (k2 < 1024 ? cospif(ang) : -sinpif(ang)) * (1.0f / 512.0f);
                ((bf16_t*)(a.ws + WS_T2L))[idx] = (bf16_t)(pk2(v, 0.f) & 0xffff);
            }
        }
    }
}

__device__ __forceinline__ void phase_prep2(const Ctx& c) {
    const Args __attribute__((address_space(4)))& a = *c.a;
    const float* MOD = (const float*)(a.ws + WS_MOD);
    float* sh = (float*)c.lds;
    const int gw = c.vb * NWAVE + c.wid, NGW = c.G * NWAVE;
#pragma unroll 1
    for (int v = 0; v < 8; ++v) {
        const int layer = v >> 1, mlp = v & 1, jj = layer >> 1, fnet = (layer & 1) && !mlp;
        __syncthreads();
        { float tv[6];
#pragma unroll
          for (int u = 0; u < 6; ++u) { const int i = c.tid + u * NTHR; tv[u] = MOD[(size_t)(layer * 3 + (i >> 10)) * 6144 + (mlp ? 3072 : 0) + (i & 1023)]; }
#pragma unroll
          for (int u = 0; u < 6; ++u) sh[c.tid + u * NTHR] = tv[u]; }
        __syncthreads();
        const bf16_t* W; float* out; int N, ostride;
        if (mlp) { W = (const bf16_t*)(a.ws + WS_W1) + (size_t)layer * DFF * D; N = DFF; out = (float*)(a.ws + WS_SWUP) + (size_t)layer * 3 * DFF; ostride = DFF; }
        else if (fnet) { W = (const bf16_t*)(a.ws + WS_T1); N = 2048; out = (float*)(a.ws + WS_SWF1) + (size_t)jj * 3 * 2048; ostride = 2048; }
        else { W = (const bf16_t*)(a.ws + WS_WIN) + (size_t)jj * DPROJ * D; N = DPROJ; out = (float*)(a.ws + WS_SWIN) + (size_t)jj * 3 * DPROJ; ostride = DPROJ; }
        for (int n = gw; n < N; n += NGW) {
            float s0 = 0.f, s1 = 0.f, s2 = 0.f;
            if (fnet) {
                const int g = n >> 9, nn = n & 511;
                if (c.lane < 32) {
                    const u32x4 w = *(const u32x4*)(W + (size_t)nn * 256 + c.lane * 8);
                    const int k = g * 256 + c.lane * 8;
#pragma unroll
                    for (int e = 0; e < 4; ++e) {
                        const float wl = bflo(w[e]), wh = bfhi(w[e]);
                        s0 += wl * sh[k + 2 * e] + wh * sh[k + 2 * e + 1];
                        s1 += wl * sh[1024 + k + 2 * e] + wh * sh[1024 + k + 2 * e + 1];
                        s2 += wl * sh[2048 + k + 2 * e] + wh * sh[2048 + k + 2 * e + 1];
                    }
                }
            } else {
#pragma unroll
                for (int p = 0; p < 2; ++p) {
                    const int k = p * 512 + c.lane * 8;
                    const u32x4 w = *(const u32x4*)(W + (size_t)n * D + k);
#pragma unroll
                    for (int e = 0; e < 4; ++e) {
                        const float wl = bflo(w[e]), wh = bfhi(w[e]);
                        s0 += wl * sh[k + 2 * e] + wh * sh[k + 2 * e + 1];
                        s1 += wl * sh[1024 + k + 2 * e] + wh * sh[1024 + k + 2 * e + 1];
                        s2 += wl * sh[2048 + k + 2 * e] + wh * sh[2048 + k + 2 * e + 1];
                    }
                }
            }
            s0 = wave_sum(s0); s1 = wave_sum(s1); s2 = wave_sum(s2);
            if (c.lane == 0) { out[n] = s0; out[ostride + n] = s1; out[2 * ostride + n] = s2; }
        }
    }
    {
        bf16_t* XG = (bf16_t*)(a.ws + WS_H);
        float* RSS = (float*)(a.ws + WS_RSS);
        const float* nw = a.in[7];
        f32x4 nwv[4];
#pragma unroll
        for (int q = 0; q < 4; ++q) nwv[q] = *(const f32x4*)(nw + q * 256 + c.lane * 4);
#pragma unroll 1
        for (int row0 = gw; row0 < NTOK; row0 += 5 * NGW) {
        f32x4 xv[5][4];
#pragma unroll
        for (int k = 0; k < 5; ++k) {
            const int rowu = row0 + k * NGW, row = rowu < NTOK ? rowu : NTOK - 1;
            const float* xr = row < NCTX ? a.in[0] + (size_t)row * D : a.in[1] + (size_t)(row - NCTX) * D;
#pragma unroll
            for (int q = 0; q < 4; ++q) xv[k][q] = *(const f32x4*)(xr + q * 256 + c.lane * 4);
        }
#pragma unroll
        for (int k = 0; k < 5; ++k) {
            const int row = row0 + k * NGW;
            if (row >= NTOK) break;
            const float* m = MOD + (size_t)cond_of(row) * 6144 + 1024;
            float ss = 0.f;
            f32x4 mv[4];
#pragma unroll
            for (int q = 0; q < 4; ++q) mv[q] = *(const f32x4*)(m + q * 256 + c.lane * 4);
#pragma unroll
            for (int q = 0; q < 4; ++q) {
                const int col = q * 256 + c.lane * 4;
                const f32x4 v = xv[k][q];
                ss += v[0] * v[0] + v[1] * v[1] + v[2] * v[2] + v[3] * v[3];
                const f32x4 o = v * nwv[q] * (mv[q] + 1.0f);
                u32x2 w; w.x = pk2(o[0], o[1]); w.y = pk2(o[2], o[3]);
                *(u32x2*)(XG + (size_t)row * D + col) = w;
            }
            ss = wave_sum(ss);
            if (c.lane < 16) RSS[(size_t)row * 16 + c.lane] = c.lane == 0 ? ss : 0.f;
        }
        }
    }
}

__device__ __forceinline__ void phase_norm(const Ctx& c, const float* nw, const float* mod  , int off_shift, int off_scale, bool final_norm) {
    const Args __attribute__((address_space(4)))& a = *c.a;
    const int gw = c.vb * NWAVE + c.wid, NGW = c.G * NWAVE;
    bf16_t* H = (bf16_t*)(a.ws + WS_H);
    f32x4 wfin[4];
#pragma unroll
    for (int j = 0; j < 4; ++j) wfin[j] = *(const f32x4*)(nw + j * 256 + c.lane * 4);
    for (int row = gw; row < NTOK; row += NGW) {
        float* xr = a.out + (size_t)row * D;
        f32x4 v[4]; float ss = 0.f;
#pragma unroll
        for (int j = 0; j < 4; ++j) { v[j] = *(const f32x4*)(xr + j * 256 + c.lane * 4); ss += v[j][0] * v[j][0] + v[j][1] * v[j][1] + v[j][2] * v[j][2] + v[j][3] * v[j][3]; }
        ss = wave_sum(ss);
        const float rstd = rsqrtf(ss * (1.0f / D) + EPS);
        if (final_norm) {
#pragma unroll
            for (int j = 0; j < 4; ++j) *(f32x4*)(xr + j * 256 + c.lane * 4) = v[j] * rstd * wfin[j];
        } else {
            const float* m = mod + cond_of(row) * 6144;
#pragma unroll
            for (int j = 0; j < 4; ++j) {
                const int col = j * 256 + c.lane * 4;
                const f32x4 w = *(const f32x4*)(nw + col), sc = *(const f32x4*)(m + off_scale + col), sh = *(const f32x4*)(m + off_shift + col);
                const f32x4 h = v[j] * rstd * w * (sc + 1.0f) + sh;
                u32x2 o; o.x = pk2(h[0], h[1]); o.y = pk2(h[2], h[3]);
                *(u32x2*)(H + (size_t)row * D + col) = o;
            }
        }
    }
}

constexpr int RS_OFF = 3 * GT<5>::STAGE;
struct FillRstd { float* tab; const float* RSS; int tok0, ntok, tid;
    __device__ __forceinline__ void operator()() const {
        if (tid < ntok) {
            const float* p = RSS + (size_t)(tok0 + tid) * 16;
            float s = 0.f;
#pragma unroll
            for (int q = 0; q < 4; ++q) { const f32x4 v = *(const f32x4*)(p + q * 4); s += (v[0] + v[1]) + (v[2] + v[3]); }
            tab[tid] = rsqrtf(s * (1.0f / D) + EPS);
        }
    }
};
__device__ __forceinline__ FillRstd fill_rstd(const Ctx& c, int tok0, int ntok) { return FillRstd{(float*)(c.lds + RS_OFF), (const float*)(c.a->ws + WS_RSS), tok0, ntok, c.tid}; }
__device__ __forceinline__ void rstd_table_one(const Ctx& c, int i, int ntok, int tok0) {
    float* tab = (float*)(c.lds + RS_OFF);
    const float* RSS = (const float*)(c.a->ws + WS_RSS);
    if (c.tid < ntok) {
        const float* p = RSS + (size_t)(tok0 + c.tid) * 16;
        float s = 0.f;
#pragma unroll
        for (int q = 0; q < 4; ++q) { const f32x4 v = *(const f32x4*)(p + q * 4); s += (v[0] + v[1]) + (v[2] + v[3]); }
        tab[i * ntok + c.tid] = rsqrtf(s * (1.0f / D) + EPS);
    }
}
__device__ __forceinline__ void rstd_tables(const Ctx& c, int n, int ntok, int first, int stride, int toks_per_rt, int shift_rt  ) {
    float* tab = (float*)(c.lds + RS_OFF);
    const float* RSS = (const float*)(c.a->ws + WS_RSS);
    for (int i = 0; i < n; ++i) {
        const int t = first + i * stride, rt = shift_rt < 0 ? t / (-shift_rt) : (t >> shift_rt);
        if (c.tid < ntok) {
            const float* p = RSS + (size_t)(rt * toks_per_rt + c.tid) * 16;
            float s = 0.f;
#pragma unroll
            for (int q = 0; q < 4; ++q) { const f32x4 v = *(const f32x4*)(p + q * 4); s += (v[0] + v[1]) + (v[2] + v[3]); }
            tab[i * ntok + c.tid] = rsqrtf(s * (1.0f / D) + EPS);
        }
    }
}
__device__ __forceinline__ void patch_tile(const Ctx& c, int i, int NC, int& rt, int& ct) {
    if (c.G == 256) { const int x = c.vb >> 5, l = c.vb & 31, p = i * 8 + x, PC = NC >> 2, pr = p / PC, pc = p - pr * PC; rt = pr * 8 + (l >> 2); ct = pc * 4 + (l & 3); }
    else { const int t = c.vb + i * c.G; rt = t / NC; ct = t - rt * NC; }
}
struct ProbInProj {
    static constexpr int EPI_STORES = 10;
    const Ctx* c; const bf16_t* W; const bf16_t* XG; int lda, ldb, K; int j;
    static constexpr int NC = NZX / 256, NT = (NTOK / 160) * NC;
    __device__ __forceinline__ int count() const { return (NT - c->vb + c->G - 1) / c->G; }
    __device__ __forceinline__ void tile(int i, const bf16_t*& A, const bf16_t*& B) const { int rt, ct; patch_tile(*c, i, NC, rt, ct); A = W + (size_t)ct * 256 * D; B = XG + (size_t)rt * 160 * D; }
    __device__ __forceinline__ void pre_all() const { const int n = count(); for (int i = 0; i < n; ++i) { int rt, ct; patch_tile(*c, i, NC, rt, ct); rstd_table_one(*c, i, 160, rt * 160); } }
    __device__ __forceinline__ void preload(int i, f32x4 (&sw)[4], int wr, int fq) const {
        int rt, ct; patch_tile(*c, i, NC, rt, ct);
        if (cond_of(rt * 160) == cond_of(rt * 160 + 159)) {
            const float* p = (const float*)(c->a->ws + WS_SWIN) + (size_t)j * 3 * DPROJ + cond_of(rt * 160) * DPROJ + ct * 256 + wr * 64 + fq * 4;
#pragma unroll
            for (int q = 0; q < 4; ++q) sw[q] = *(const f32x4*)(p + q * 16);
        }
    }
    __device__ __forceinline__ void epilogue(int i, f32x4 (&acc)[4][5], const f32x4 (&sw)[4], int wr, int wc, int fr, int fq) const {
        int rt, ct; patch_tile(*c, i, NC, rt, ct); unsigned char* ws = c->a->ws;
        EpiInProj e{(bf16_t*)(ws + S_Z), (bf16_t*)(ws + S_RAW), (const float*)(c->lds + RS_OFF) + i * 160, rt * 160, (const float*)(ws + WS_SWIN) + (size_t)j * 3 * DPROJ, cond_of(rt * 160) == cond_of(rt * 160 + 159)};
        e(acc, sw, ct * 256 + wr * 64, rt * 160 + wc * 80, fr, fq);
    }
};
__device__ __forceinline__ void phase_inproj(const Ctx& c, int j) {
    ProbInProj P{&c, (const bf16_t*)(c.a->ws + WS_WIN) + (size_t)j * DPROJ * D, (const bf16_t*)(c.a->ws + WS_H), D, D, D, j};
    gemm_stream<5>(c, P);
}
struct ProbMlpUp {
    static constexpr int EPI_STORES = 10;
    const Ctx* c; const bf16_t* W; const bf16_t* XG; int lda, ldb, K; int layer;
    static constexpr int NC = DFF / 256, NT = (NTOK / 160) * NC;
    __device__ __forceinline__ int count() const { return (NT - c->vb + c->G - 1) / c->G; }
    __device__ __forceinline__ void tile(int i, const bf16_t*& A, const bf16_t*& B) const { int rt, ct; patch_tile(*c, i, NC, rt, ct); A = W + (size_t)ct * 256 * D; B = XG + (size_t)rt * 160 * D; }
    __device__ __forceinline__ void pre_all() const { const int n = count(); for (int i = 0; i < n; ++i) { int rt, ct; patch_tile(*c, i, NC, rt, ct); rstd_table_one(*c, i, 160, rt * 160); } }
    __device__ __forceinline__ void preload(int i, f32x4 (&sw)[4], int wr, int fq) const {
        int rt, ct; patch_tile(*c, i, NC, rt, ct);
        if (cond_of(rt * 160) == cond_of(rt * 160 + 159)) {
            const float* p = (const float*)(c->a->ws + WS_SWUP) + (size_t)layer * 3 * DFF + cond_of(rt * 160) * DFF + ct * 256 + wr * 64 + fq * 4;
#pragma unroll
            for (int q = 0; q < 4; ++q) sw[q] = *(const f32x4*)(p + q * 16);
        }
    }
    __device__ __forceinline__ void epilogue(int i, f32x4 (&acc)[4][5], const f32x4 (&sw)[4], int wr, int wc, int fr, int fq) const {
        int rt, ct; patch_tile(*c, i, NC, rt, ct); unsigned char* ws = c->a->ws;
        EpiMlpUp e{(bf16_t*)(ws + S_HID), (const float*)(c->lds + RS_OFF) + i * 160, rt * 160, (const float*)(ws + WS_SWUP) + (size_t)layer * 3 * DFF, cond_of(rt * 160) == cond_of(rt * 160 + 159)};
        e(acc, sw, ct * 256 + wr * 64, rt * 160 + wc * 80, fr, fq);
    }
};
__device__ __forceinline__ void phase_mlp_up(const Ctx& c, int layer) {
    ProbMlpUp P{&c, (const bf16_t*)(c.a->ws + WS_W1) + (size_t)layer * DFF * D, (const bf16_t*)(c.a->ws + WS_H), D, D, D, layer};
    gemm_stream<5>(c, P);
}
#ifndef BENCH_MODE
#define BENCH_MODE 0
#endif
__device__ __forceinline__ void phase_bench(const Ctx& c) {
    ProbMlpUp P{&c, (const bf16_t*)(c.a->ws + WS_W1), (const bf16_t*)(c.a->ws + WS_H), D, D, D, 0};
    gemm_stream<5, ProbMlpUp, BENCH_MODE>(c, P);
}
struct ProbResid {
    static constexpr int EPI_STORES = 0;
    const Ctx* c; const bf16_t* WT; const bf16_t* Act; int lda, ldb, K; const float* gate; const float* bias; const float* ssq; const float* nw_next; const float* scale_next; bool first;
    static constexpr int NC = D / 256, NT = (NTOK / 160) * NC;
    __device__ __forceinline__ int count() const { return (NT - c->vb + c->G - 1) / c->G; }
    __device__ __forceinline__ void tile(int i, const bf16_t*& A, const bf16_t*& B) const { const int t = c->vb + i * c->G, rt = t / NC, ct = t - rt * NC; A = WT + (size_t)ct * 256 * K; B = Act + (size_t)rt * 160 * K; }
    __device__ __forceinline__ void pre_all() const {
        if (!ssq) return;
        float* tab = (float*)(c->lds + RS_OFF);
        const int n = count();
        for (int i = 0; i < n; ++i) {
            const int t = c->vb + i * c->G, rt = t / NC;
            if (c->tid < 160) {
                const float* p = ssq + (size_t)(rt * 160 + c->tid) * 32;
                float s = 0.f;
#pragma unroll
                for (int q = 0; q < 8; ++q) { const f32x4 v = *(const f32x4*)(p + q * 4); s += v[0] + v[1] + v[2] + v[3]; }
                tab[i * 160 + c->tid] = rsqrtf(s * (1.0f / DI) + EPS);
            }
        }
    }
    __device__ __forceinline__ void preload(int, f32x4 (&)[4], int, int) const {}
    __device__ __forceinline__ void epilogue(int i, f32x4 (&acc)[4][5], const f32x4 (&)[4], int wr, int wc, int fr, int fq) const {
        const int t = c->vb + i * c->G, rt = t / NC, ct = t - rt * NC; unsigned char* ws = c->a->ws;
        EpiResid e{c->a->out, gate, bias, ssq ? (const float*)(c->lds + RS_OFF) + i * 160 : nullptr, rt * 160, first ? c->a->in[0] : nullptr, first ? c->a->in[1] : nullptr, nw_next ? (bf16_t*)(ws + WS_H) : nullptr, nw_next, scale_next, (float*)(ws + WS_RSS), (const float*)(ws + WS_ZERO)};
        e(acc, ct * 256 + wr * 64, rt * 160 + wc * 80, fr, fq);
    }
};
__device__ __forceinline__ void phase_resid_gemm(const Ctx& c, const bf16_t* WT, const bf16_t* Act, int K, const float* gate, const float* bias, const float* ssq, const float* nw_next, const float* scale_next, bool first) {
    ProbResid P{&c, WT, Act, K, K, K, gate, bias, ssq, nw_next, scale_next, first};
    gemm_stream<5>(c, P);
}
struct ProbF1 {
    static constexpr int EPI_STORES = 16;
    const Ctx* c; const bf16_t* XG; const bf16_t* T1; int lda, ldb, K; int j;
    static constexpr int NT = (NTOK / 256) * 16;
    __device__ __forceinline__ int count() const { return (NT - c->vb + c->G - 1) / c->G; }
    __device__ __forceinline__ void tile(int i, const bf16_t*& A, const bf16_t*& B) const { const int t = c->vb + i * c->G, rt = t >> 4, g = (t >> 2) & 3, ct = t & 3; A = XG + (size_t)rt * 256 * D + g * 256; B = T1 + (size_t)ct * 128 * 256; }
    __device__ __forceinline__ void pre_all() const { rstd_tables(*c, count(), 256, c->vb, c->G, 256, 4); }
    __device__ __forceinline__ void preload(int, f32x4 (&)[4], int, int) const {}
    __device__ __forceinline__ void epilogue(int i, f32x4 (&acc)[4][4], const f32x4 (&)[4], int wr, int wc, int fr, int fq) const {
        const int t = c->vb + i * c->G, rt = t >> 4, g = (t >> 2) & 3, ct = t & 3; unsigned char* ws = c->a->ws;
        EpiF1 e{(bf16_t*)(ws + S_UVT), g, (const float*)(c->lds + RS_OFF) + i * 256, rt * 256, (const float*)(ws + WS_SWF1) + (size_t)j * 3 * 2048};
        e(acc, rt * 256 + wr * 64, ct * 128 + wc * 64, fr, fq);
    }
};
__device__ __forceinline__ void phase_f1(const Ctx& c, int j) {
    ProbF1 P{&c, (const bf16_t*)(c.a->ws + WS_H), (const bf16_t*)(c.a->ws + WS_T1), D, 256, 256, j};
    gemm_stream<4>(c, P);
}
struct ProbF2L {
    static constexpr int EPI_STORES = 0;
    const Ctx* c; const bf16_t* UVT; const bf16_t* T2; bf16_t* F; int lda, ldb, K;
    __device__ __forceinline__ int count() const { return c->vb < 128 ? 1 : 0; }
    __device__ __forceinline__ void tile(int i, const bf16_t*& A, const bf16_t*& B) const { const int t = c->vb, s = t >> 6, nt = (t >> 4) & 3, kt = t & 15; A = UVT + (size_t)NCTX * 2048 + ((size_t)s * 1024 + nt * 256) * 2048; B = T2 + (size_t)kt * 64 * 2048; }
    __device__ __forceinline__ void pre_all() const {}
    __device__ __forceinline__ void preload(int, f32x4 (&)[4], int, int) const {}
    __device__ __forceinline__ void epilogue(int i, f32x4 (&acc)[4][2], const f32x4 (&)[4], int wr, int wc, int fr, int fq) const { const int t = c->vb, s = t >> 6, nt = (t >> 4) & 3, kt = t & 15; EpiF2<2> e{F, NCTX + s * 1024}; e(acc, nt * 256 + wr * 64, kt * 64 + wc * 32, fr, fq); }
};
struct ProbF2C {
    static constexpr int EPI_STORES = 16;
    const Ctx* c; const bf16_t* UVT; const bf16_t* T2; bf16_t* F; int lda, ldb, K; int first, stride;
    __device__ __forceinline__ int count() const { return (256 - first + stride - 1) / stride; }
    __device__ __forceinline__ void tile(int i, const bf16_t*& A, const bf16_t*& B) const { const int u = first + i * stride, s = u >> 3, nt = (u >> 1) & 3, kt = u & 1; A = UVT + ((size_t)s * 1024 + nt * 256) * 512; B = T2 + (size_t)kt * 128 * 512; }
    __device__ __forceinline__ void pre_all() const {}
    __device__ __forceinline__ void preload(int, f32x4 (&)[4], int, int) const {}
    __device__ __forceinline__ void epilogue(int i, f32x4 (&acc)[4][4], const f32x4 (&)[4], int wr, int wc, int fr, int fq) const { const int u = first + i * stride, s = u >> 3, nt = (u >> 1) & 3, kt = u & 1; EpiF2<4> e{F, s * 256}; e(acc, nt * 256 + wr * 64, kt * 128 + wc * 64, fr, fq); }
};
__device__ __forceinline__ void phase_f2(const Ctx& c) {
    unsigned char* ws = c.a->ws;
    const int half = c.G >> 1;
    if (c.vb < half) { ProbF2L P{&c, (const bf16_t*)(ws + S_UVT), (const bf16_t*)(ws + WS_T2L), (bf16_t*)(ws + S_F), 2048, 2048, 2048}; gemm_stream<2>(c, P); }
    else { ProbF2C P{&c, (const bf16_t*)(ws + S_UVT), (const bf16_t*)(ws + WS_T2C), (bf16_t*)(ws + S_F), 512, 512, 512, c.vb - half, c.G - half}; gemm_stream<4>(c, P); }
}

struct ProbDt {
    static constexpr int EPI_STORES = 0;
    const Ctx* c; const bf16_t* XG; const bf16_t* W; int lda, ldb, K; int j;
    __device__ __forceinline__ int count() const { return (NTOK / 256 - c->vb + c->G - 1) / c->G; }
    __device__ __forceinline__ void tile(int i, const bf16_t*& A, const bf16_t*& B) const { const int t = c->vb + i * c->G; A = XG + (size_t)t * 256 * D; B = W; }
    __device__ __forceinline__ void pre_all() const { rstd_tables(*c, count(), 256, c->vb, c->G, 256, 0); }
    __device__ __forceinline__ void preload(int, f32x4 (&)[4], int, int) const {}
    __device__ __forceinline__ void epilogue(int i, f32x4 (&acc)[4][2], const f32x4 (&)[4], int wr, int wc, int fr, int fq) const {
        const int t = c->vb + i * c->G; unsigned char* ws = c->a->ws;
        EpiDt e{(float*)(ws + S_DT), (const float*)(c->lds + RS_OFF) + i * 256, t * 256, (const float*)(ws + WS_SWIN) + (size_t)j * 3 * DPROJ};
        e(acc, t * 256 + wr * 64, wc * 32, fr, fq);
    }
};
__device__ __forceinline__ void phase_conv(const Ctx& c, int j) {
    const Args __attribute__((address_space(4)))& a = *c.a;
    {
        ProbDt P{&c, (const bf16_t*)(a.ws + WS_H), (const bf16_t*)(a.ws + WS_WIN) + (size_t)j * DPROJ * D + (size_t)NZX * D, D, D, D, j};
        gemm_stream<2>(c, P);
    }
    const bf16_t* RAW = (const bf16_t*)(a.ws + S_RAW);
    bf16_t* XBC = (bf16_t*)(a.ws + S_XBC);
    const float* cw = a.in[10] + (size_t)j * 3 * DXBC;
    const float* cb = a.in[11] + (size_t)j * DXBC;
    constexpr int NIT = (NTOK / 64) * 3;
    for (int it = c.G - 1 - c.vb; it < NIT; it += c.G) {
        const int tg = it / 3, third = it - tg * 3;
        const int ch = third * 1024 + (c.tid & 127) * 8;
        const int r0 = tg * 64 + (c.tid >> 7) * 16;
        float w0[8], w1[8], w2[8], bb[8];
#pragma unroll
        for (int q = 0; q < 2; ++q) {
            const f32x4 t0 = *(const f32x4*)(cw + ch + q * 4), t1 = *(const f32x4*)(cw + DXBC + ch + q * 4), t2 = *(const f32x4*)(cw + 2 * DXBC + ch + q * 4), t3 = *(const f32x4*)(cb + ch + q * 4);
#pragma unroll
            for (int e = 0; e < 4; ++e) { w0[q * 4 + e] = t0[e]; w1[q * 4 + e] = t1[e]; w2[q * 4 + e] = t2[e]; bb[q * 4 + e] = t3[e]; }
        }
        const int seg = r0 < NCTX ? 256 : 64;
        u32x4 rows[18];
        {
            const int tl = (r0 % seg) != 0 ? r0 - 1 : r0, th = ((r0 + 16) % seg) != 0 ? r0 + 16 : r0 + 15;
            rows[0] = *(const u32x4*)(RAW + (size_t)tl * DXBC + ch);
#pragma unroll
            for (int r = 0; r < 16; ++r) rows[r + 1] = *(const u32x4*)(RAW + (size_t)(r0 + r) * DXBC + ch);
            rows[17] = *(const u32x4*)(RAW + (size_t)th * DXBC + ch);
            if ((r0 % seg) == 0) rows[0] = (u32x4){0, 0, 0, 0};
            if (((r0 + 16) % seg) == 0) rows[17] = (u32x4){0, 0, 0, 0};
        }
#pragma unroll
        for (int r = 0; r < 16; ++r) {
            const int t = r0 + r;
            const u32x4 prev = rows[r], cur = rows[r + 1], nxt = rows[r + 2];
            u32x4 o;
#pragma unroll
            for (int e = 0; e < 4; ++e) {
                const float lo = bb[2 * e] + w0[2 * e] * bflo(prev[e]) + w1[2 * e] * bflo(cur[e]) + w2[2 * e] * bflo(nxt[e]);
                const float hi = bb[2 * e + 1] + w0[2 * e + 1] * bfhi(prev[e]) + w1[2 * e + 1] * bfhi(cur[e]) + w2[2 * e + 1] * bfhi(nxt[e]);
                o[e] = pk2(silu_f(lo), silu_f(hi));
            }
            *(u32x4*)(XBC + (size_t)t * DXBC + ch) = o;
        }
    }
}

constexpr int SC_XS = 0, SC_XW = 16384, SC_BS = 32768, SC_CS = 49152, SC_HT = 65536, SC_SM = 98304;
__device__ __forceinline__ int off128(int row, int col) { return row * 128 + ((((col >> 3) ^ (row & 7))) << 4) + (col & 7) * 2; }
__device__ __forceinline__ int off256(int row, int col) { return row * 256 + ((((col >> 3) ^ (row & 15))) << 4) + (col & 7) * 2; }
__device__ __forceinline__ int offX(int row, int col) { return row * 128 + col * 2; }
__device__ __forceinline__ int offP(int row, int col) { return row * 144 + col * 2; }
template <int LAY>
__device__ __forceinline__ bf16x8 tr_frag(const char* tile, int r0, int r1, int col0, int lane) {
    const int i = lane & 15, q = i >> 2, cc = col0 + (i & 3) * 4;
    const int o0 = LAY == 1 ? off256(r0 + q, cc) : LAY == 2 ? offP(r0 + q, cc) : offX(r0 + q, cc);
    const int o1 = LAY == 1 ? off256(r1 + q, cc) : LAY == 2 ? offP(r1 + q, cc) : offX(r1 + q, cc);
    const bf16x4 lo = __builtin_amdgcn_ds_read_tr16_b64_v4i16((LAS bf16x4*)(tile + o0));
    const bf16x4 hi = __builtin_amdgcn_ds_read_tr16_b64_v4i16((LAS bf16x4*)(tile + o1));
    return __builtin_shufflevector(lo, hi, 0, 1, 2, 3, 4, 5, 6, 7);
}

struct ScanStep { int seq, hp, dir, ci, nch, t0, valid, single, h0; };
struct ScanIter {
    int vb, G, k, dir, ci;
    __device__ __forceinline__ void get(ScanStep& s) const {
        int seq, hp, ok, single = 0, h0 = 0;
        if (vb < 64) { seq = 32 + (vb >> 5); h0 = vb & 31; hp = h0 >> 1; single = 1; ok = (k == 0); }
        else { const int u = (vb - 64) + k * (G - 64); seq = u >> 4; hp = u & 15; ok = (u < 512); }
        const bool lat = seq >= 32;
        s.seq = seq; s.hp = hp; s.dir = dir; s.ci = ci; s.nch = lat ? 16 : 4; s.valid = ok; s.single = single; s.h0 = h0;
        const int tok0 = lat ? NCTX + (seq - 32) * 1024 : seq * 256;
        const int ch = dir == 0 ? ci : s.nch - 1 - ci;
        s.t0 = tok0 + ch * 64;
    }
    __device__ __forceinline__ void advance() {
        int seq; if (vb < 64) seq = 32; else seq = 0;
        const int nch = seq >= 32 ? 16 : 4;
        if (++ci == nch) { ci = 0; if (++dir == 2) { dir = 0; ++k; } }
    }
};
constexpr int SCB = 49152;
constexpr int SB_XS = 0, SB_BS = 16384, SB_CS = 32768;
constexpr int XW_BYTES = 64 * 144, HT_BYTES = 128 * 144;
constexpr int SCN_XW = 2 * SCB, SCN_HT = SCN_XW + 2 * XW_BYTES, SCN_SM = SCN_HT + 2 * HT_BYTES;

__device__ __forceinline__ void scan_issue_tiles(const Ctx& c, const ScanStep& s, int buf) {
    const bf16_t* XBC = (const bf16_t*)(c.a->ws + S_XBC);
    char* base = c.lds + buf * SCB;
    const int lane = c.lane, w8 = c.wid, g = s.hp >> 2;
#pragma unroll
    for (int hh = 0; hh < 2; ++hh) {
        if (hh == 1 && s.single) break;
        const int q = w8, row = q * 8 + (lane >> 3), lch = lane & 7, hd = s.single ? s.h0 : 2 * s.hp + hh;
        __builtin_amdgcn_global_load_lds((const unsigned*)(XBC + (size_t)(s.t0 + row) * DXBC + hd * 64 + lch * 8), (LAS unsigned*)(base + SB_XS + hh * 8192 + q * 1024 + lane * 16), 16, 0, 0);
    }
#pragma unroll
    for (int i = 0; i < 2; ++i) {
        const int q = w8 + 8 * i, row = q * 4 + (lane >> 4), lch = (lane & 15) ^ (row & 15);
        __builtin_amdgcn_global_load_lds((const unsigned*)(XBC + (size_t)(s.t0 + row) * DXBC + DI + g * 128 + lch * 8), (LAS unsigned*)(base + SB_BS + q * 1024 + lane * 16), 16, 0, 0);
        __builtin_amdgcn_global_load_lds((const unsigned*)(XBC + (size_t)(s.t0 + row) * DXBC + DI + 512 + g * 128 + lch * 8), (LAS unsigned*)(base + SB_CS + q * 1024 + lane * 16), 16, 0, 0);
    }
}
__device__ __forceinline__ float scan_load_dt(const Ctx& c, const ScanStep& s, int hw) {
    const float* DT = (const float*)(c.a->ws + S_DT);
    const int l = s.dir == 0 ? c.lane : 63 - c.lane, h = s.single ? s.h0 : 2 * s.hp + hw;
    return DT[(size_t)(s.t0 + l) * 64 + s.dir * NH + h];
}
__device__ __forceinline__ void scan_dtcs(const Ctx& c, const ScanStep& s, int hw, int j, float raw, float* sm) {
    const int lane = c.lane, l = s.dir == 0 ? lane : 63 - lane, h = s.single ? s.h0 : 2 * s.hp + hw;
    const float Aneg = -__expf(c.a->in[13][(j * 2 + s.dir) * NH + h]);
    raw += c.a->in[12][(j * 2 + s.dir) * NH + h];
    const float dt = raw > 20.f ? raw : __logf(1.0f + __expf(raw));
    float cs = dt * Aneg;
#pragma unroll
    for (int o = 1; o < 64; o <<= 1) { const float u = __shfl_up(cs, o); if (lane >= o) cs += u; }
    sm[l] = dt; sm[64 + l] = cs;
    if (lane == 63) sm[128] = cs;
}

__device__ __forceinline__ void phase_scan_pipe(const Ctx& c, int j) {
    const Args __attribute__((address_space(4)))& a = *c.a;
    const bf16_t* Z = (const bf16_t*)(a.ws + S_Z);
    bf16_t* YTMP = (bf16_t*)(a.ws + S_RAW);
    bf16_t* YG = (bf16_t*)(a.ws + S_YG);
    float* SSQ = (float*)(a.ws + S_SSQ);
    const int hw = c.wid >> 2, w = c.wid & 3;
    char* lds = c.lds;
    char* XWp = lds + SCN_XW + hw * XW_BYTES; char* HTp = lds + SCN_HT + hw * HT_BYTES;

    ScanIter it{c.vb, c.G, 0, 0, 0};
    ScanStep cur, nxt, nx2;
    it.get(cur); it.advance(); it.get(nxt); it.advance(); it.get(nx2);
    if (!cur.valid) return;
    scan_issue_tiles(c, cur, 0);
    float raw_n1 = 0.f;
    if (w == 0 && !(cur.single && hw == 1)) {
        const float r0 = scan_load_dt(c, cur, hw);
        if (nxt.valid) raw_n1 = scan_load_dt(c, nxt, hw);
        scan_dtcs(c, cur, hw, j, r0, (float*)(lds + SCN_SM + (0 * 2 + hw) * 1024));
    }
    f32x4 S[4][2];
#pragma unroll
    for (int pb = 0; pb < 4; ++pb)
#pragma unroll
        for (int nbi = 0; nbi < 2; ++nbi) S[pb][nbi] = (f32x4){0.f, 0.f, 0.f, 0.f};

#pragma unroll 1
    for (int s = 0; cur.valid; ++s) {
        int lane = c.lane; asm volatile("" : "+v"(lane));
        const int fr = lane & 15, fq = lane >> 4;
        const int b = s & 1;
        char* TB_ = lds + b * SCB;
        char* XSp = TB_ + SB_XS + hw * 8192;
        const float* sm_dt = (const float*)(lds + SCN_SM + (b * 2 + hw) * 1024);
        const float* sm_cs = sm_dt + 64;
        const bool is_lat = cur.seq >= 32;
        const bool active = !(cur.single && hw == 1);
        const int dir = cur.dir, t0 = cur.t0, h = cur.single ? cur.h0 : 2 * cur.hp + hw;
        asm volatile("s_waitcnt vmcnt(0)" ::: "memory");
        __syncthreads();
        if (nxt.valid) scan_issue_tiles(c, nxt, b ^ 1);
        float raw_n2 = 0.f;
        if (w == 0 && nx2.valid && !(nx2.single && hw == 1)) raw_n2 = scan_load_dt(c, nx2, hw);
        u32x2 yt[4], zz[4]; f32x4 nwv[4]; float Dh = 0.f;
        const int tok = t0 + w * 16 + fr;
        if (dir == 1 && active) {
            Dh = a.in[14][j * NH + h];
            const float* normw = a.in[15] + (size_t)j * DI + h * 64;
#pragma unroll
            for (int pb = 0; pb < 4; ++pb) {
                const int p0 = pb * 16 + fq * 4;
                yt[pb] = *(const u32x2*)(YTMP + (size_t)tok * DI + h * 64 + p0);
                zz[pb] = *(const u32x2*)(Z + (size_t)tok * DI + h * 64 + p0);
                nwv[pb] = *(const f32x4*)(normw + p0);
            }
        }
        bool has_h = is_lat || cur.ci > 0;
        if (cur.ci == 0) {
            if (is_lat) {
                if (active) {
                const float* sp = a.in[2] + ((size_t)(((cur.seq - 32) * 2 + j) * 2 + dir) * NH + h) * 8192;
#pragma unroll
                for (int pb = 0; pb < 4; ++pb)
#pragma unroll
                    for (int nbi = 0; nbi < 2; ++nbi) {
                        const int n = (2 * w + nbi) * 16 + fr, p0 = pb * 16 + fq * 4;
#pragma unroll
                        for (int r = 0; r < 4; ++r) S[pb][nbi][r] = sp[(p0 + r) * 128 + n];
                        u32x2 v; v.x = pk2(S[pb][nbi][0], S[pb][nbi][1]); v.y = pk2(S[pb][nbi][2], S[pb][nbi][3]);
                        *(u32x2*)(HTp + offP(n, p0)) = v;
                    }
                }
                __syncthreads();
            } else {
#pragma unroll
                for (int pb = 0; pb < 4; ++pb)
#pragma unroll
                    for (int nbi = 0; nbi < 2; ++nbi) S[pb][nbi] = (f32x4){0.f, 0.f, 0.f, 0.f};
            }
        }
        float tot = 0.f;
        if (active) {
        tot = sm_dt[128];
        {
            const int tl = c.tid & 255, l = tl >> 2, c0 = (tl & 3) * 16;
            const float sc = __expf(tot - sm_cs[l]) * sm_dt[l];
#pragma unroll
            for (int q = 0; q < 2; ++q) {
                const u32x4 v = *(const u32x4*)(XSp + offX(l, c0 + q * 8));
                u32x4 r;
#pragma unroll
                for (int e = 0; e < 4; ++e) r[e] = pk2(bflo(v[e]) * sc, bfhi(v[e]) * sc);
                *(u32x4*)(XWp + offP(l, c0 + q * 8)) = r;
            }
        }
        bf16x8 cf[4];
#pragma unroll
        for (int kk = 0; kk < 4; ++kk) cf[kk] = *(const bf16x8*)(TB_ + SB_CS + off256(w * 16 + fr, kk * 32 + fq * 8));
        const float csl = sm_cs[w * 16 + fr];
        f32x4 yacc[4];
#pragma unroll
        for (int pb = 0; pb < 4; ++pb) yacc[pb] = (f32x4){0.f, 0.f, 0.f, 0.f};
        if (has_h) {
            bf16x8 hf[2][4];
#pragma unroll
            for (int pb = 0; pb < 4; ++pb) hf[0][pb] = tr_frag<2>(HTp, fq * 8, fq * 8 + 4, pb * 16, lane);
#pragma unroll
            for (int kk = 0; kk < 4; ++kk) {
                if (kk < 3) {
#pragma unroll
                    for (int pb = 0; pb < 4; ++pb) hf[(kk + 1) & 1][pb] = tr_frag<2>(HTp, (kk + 1) * 32 + fq * 8, (kk + 1) * 32 + fq * 8 + 4, pb * 16, lane);
                }
                __builtin_amdgcn_sched_barrier(0);
#pragma unroll
                for (int pb = 0; pb < 4; ++pb) yacc[pb] = __builtin_amdgcn_mfma_f32_16x16x32_bf16(hf[kk & 1][pb], cf[kk], yacc[pb], 0, 0, 0);
            }
            const float e = __expf(csl);
#pragma unroll
            for (int pb = 0; pb < 4; ++pb) yacc[pb] = yacc[pb] * e;
        }
#pragma unroll
        for (int kk2 = 0; kk2 < 2; ++kk2) {
            const bool need = dir == 0 ? (2 * kk2 <= w) : (2 * kk2 + 1 >= w);
            if (need) {
                unsigned m[4];
                bf16x8 bfg[2][4];
                f32x4 gg[2];
#pragma unroll
                for (int half = 0; half < 2; ++half)
#pragma unroll
                    for (int kk = 0; kk < 4; ++kk) bfg[half][kk] = *(const bf16x8*)(TB_ + SB_BS + off256((2 * kk2 + half) * 16 + fr, kk * 32 + fq * 8));
                bf16x8 xf[4];
#pragma unroll
                for (int pb = 0; pb < 4; ++pb) xf[pb] = tr_frag<0>(XSp, 32 * kk2 + 4 * fq, 32 * kk2 + 16 + 4 * fq, pb * 16, lane);
                __builtin_amdgcn_sched_barrier(0);
                gg[0] = (f32x4){0.f, 0.f, 0.f, 0.f}; gg[1] = (f32x4){0.f, 0.f, 0.f, 0.f};
#pragma unroll
                for (int kk = 0; kk < 4; ++kk)
#pragma unroll
                    for (int half = 0; half < 2; ++half) gg[half] = __builtin_amdgcn_mfma_f32_16x16x32_bf16(bfg[half][kk], cf[kk], gg[half], 0, 0, 0);
#pragma unroll
                for (int half = 0; half < 2; ++half) {
                    const int sb = 2 * kk2 + half;
                    const f32x4 gacc = gg[half];
                    const f32x4 css = *(const f32x4*)(sm_cs + sb * 16 + fq * 4);
                    const f32x4 dts = *(const f32x4*)(sm_dt + sb * 16 + fq * 4);
                    float v[4];
#pragma unroll
                    for (int r = 0; r < 4; ++r) {
                        const int si = sb * 16 + fq * 4 + r, l = w * 16 + fr;
                        const bool valid = dir == 0 ? (si <= l) : (si >= l);
                        v[r] = valid ? gacc[r] * __expf(csl - css[r]) * dts[r] : 0.f;
                    }
                    m[half * 2 + 0] = pk2(v[0], v[1]); m[half * 2 + 1] = pk2(v[2], v[3]);
                }
                union { unsigned u[4]; bf16x8 v; } mf; mf.u[0] = m[0]; mf.u[1] = m[1]; mf.u[2] = m[2]; mf.u[3] = m[3];
#pragma unroll
                for (int pb = 0; pb < 4; ++pb) yacc[pb] = __builtin_amdgcn_mfma_f32_16x16x32_bf16(xf[pb], mf.v, yacc[pb], 0, 0, 0);
            }
        }
        {
            const int l = w * 16 + fr;
            if (dir == 0) {
                u32x2 v[4];
#pragma unroll
                for (int pb = 0; pb < 4; ++pb) { v[pb].x = pk2(yacc[pb][0], yacc[pb][1]); v[pb].y = pk2(yacc[pb][2], yacc[pb][3]); }
#pragma unroll
                for (int p = 0; p < 2; ++p) {
                    const u32x4 o = pair16(v[2 * p], v[2 * p + 1]);
                    *(u32x4*)(YTMP + (size_t)tok * DI + h * 64 + (2 * p + (fq & 1)) * 16 + (fq & 2) * 4) = o;
                }
            } else {
                float ss = 0.f;
                u32x2 v[4];
#pragma unroll
                for (int pb = 0; pb < 4; ++pb) {
                    const int p0 = pb * 16 + fq * 4;
                    const u32x2 xx = *(const u32x2*)(XSp + offX(l, p0));
                    const f32x4 nw = nwv[pb];
                    float y[4];
                    y[0] = yacc[pb][0] + bflo(yt[pb].x) + Dh * bflo(xx.x); y[1] = yacc[pb][1] + bfhi(yt[pb].x) + Dh * bfhi(xx.x);
                    y[2] = yacc[pb][2] + bflo(yt[pb].y) + Dh * bflo(xx.y); y[3] = yacc[pb][3] + bfhi(yt[pb].y) + Dh * bfhi(xx.y);
                    y[0] *= silu_f(bflo(zz[pb].x)); y[1] *= silu_f(bfhi(zz[pb].x)); y[2] *= silu_f(bflo(zz[pb].y)); y[3] *= silu_f(bfhi(zz[pb].y));
                    ss += y[0] * y[0] + y[1] * y[1] + y[2] * y[2] + y[3] * y[3];
                    v[pb].x = pk2(y[0] * nw[0], y[1] * nw[1]); v[pb].y = pk2(y[2] * nw[2], y[3] * nw[3]);
                }
#pragma unroll
                for (int p = 0; p < 2; ++p) {
                    const u32x4 o = pair16(v[2 * p], v[2 * p + 1]);
                    *(u32x4*)(YG + (size_t)tok * DI + h * 64 + (2 * p + (fq & 1)) * 16 + (fq & 2) * 4) = o;
                }
                ss += __shfl_xor(ss, 16); ss += __shfl_xor(ss, 32);
                if (fq == 0) SSQ[(size_t)tok * NH + h] = ss;
            }
        }
        }
        __syncthreads();
        if (active) {
            const float et = __expf(tot);
#pragma unroll
            for (int pb = 0; pb < 4; ++pb)
#pragma unroll
                for (int nbi = 0; nbi < 2; ++nbi) S[pb][nbi] = S[pb][nbi] * et;
            bf16x8 bq[2][2], xa[2][4];
#pragma unroll
            for (int kk = 0; kk < 2; ++kk) {
#pragma unroll
                for (int nbi = 0; nbi < 2; ++nbi) bq[kk][nbi] = tr_frag<1>(TB_ + SB_BS, kk * 32 + fq * 8, kk * 32 + fq * 8 + 4, (2 * w + nbi) * 16, lane);
#pragma unroll
                for (int pb = 0; pb < 4; ++pb) xa[kk][pb] = tr_frag<2>(XWp, kk * 32 + fq * 8, kk * 32 + fq * 8 + 4, pb * 16, lane);
            }
            __builtin_amdgcn_sched_barrier(0);
#pragma unroll
            for (int kk = 0; kk < 2; ++kk)
#pragma unroll
                for (int pb = 0; pb < 4; ++pb)
#pragma unroll
                    for (int nbi = 0; nbi < 2; ++nbi) S[pb][nbi] = __builtin_amdgcn_mfma_f32_16x16x32_bf16(xa[kk][pb], bq[kk][nbi], S[pb][nbi], 0, 0, 0);
#pragma unroll
            for (int pb = 0; pb < 4; ++pb)
#pragma unroll
                for (int nbi = 0; nbi < 2; ++nbi) {
                    const int n = (2 * w + nbi) * 16 + fr, p0 = pb * 16 + fq * 4;
                    u32x2 v; v.x = pk2(S[pb][nbi][0], S[pb][nbi][1]); v.y = pk2(S[pb][nbi][2], S[pb][nbi][3]);
                    *(u32x2*)(HTp + offP(n, p0)) = v;
                }
        }
        if (active && !is_lat && cur.ci == cur.nch - 1) {
            float* op = a.out + (size_t)NTOK * D + ((size_t)((cur.seq * 2 + j) * 2 + dir) * NH + h) * 8192;
#pragma unroll
            for (int pb = 0; pb < 4; ++pb)
#pragma unroll
                for (int nbi = 0; nbi < 2; ++nbi) {
                    const int n = (2 * w + nbi) * 16 + fr, p0 = pb * 16 + fq * 4;
#pragma unroll
                    for (int r = 0; r < 4; ++r) op[(p0 + r) * 128 + n] = S[pb][nbi][r];
                }
        }
        if (w == 0 && nxt.valid && !(nxt.single && hw == 1)) scan_dtcs(c, nxt, hw, j, raw_n1, (float*)(lds + SCN_SM + ((b ^ 1) * 2 + hw) * 1024));
        raw_n1 = raw_n2;
        cur = nxt; nxt = nx2; it.advance(); it.get(nx2);
    }
}

#if NAIVE_SCAN
__device__ __forceinline__ void scan_unit_naive(const Ctx& c, int j, int seq, int h) {
    const Args __attribute__((address_space(4)))& a = *c.a;
    const bf16_t* XBC = (const bf16_t*)(a.ws + S_XBC);
    const bf16_t* Z = (const bf16_t*)(a.ws + S_Z);
    const float* DT = (const float*)(a.ws + S_DT);
    bf16_t* YTMP = (bf16_t*)(a.ws + S_RAW);
    bf16_t* YG = (bf16_t*)(a.ws + S_YG);
    float* SSQ = (float*)(a.ws + S_SSQ);
    const bool is_lat = seq >= 32;
    const int tok0 = is_lat ? NCTX + (seq - 32) * 1024 : seq * 256;
    const int L = is_lat ? 1024 : 256;
    const int g = h >> 3, p = c.tid >> 2, nq = (c.tid & 3) * 32;
    const float Dh = a.in[14][j * NH + h];
    const float nw = a.in[15][(size_t)j * DI + h * 64 + p];
    float* red = (float*)c.lds;
    for (int dir = 0; dir < 2; ++dir) {
        const float Aneg = -__expf(a.in[13][(j * 2 + dir) * NH + h]);
        const float dtb = a.in[12][(j * 2 + dir) * NH + h];
        float hs[32];
        if (is_lat) { const float* sp = a.in[2] + ((size_t)(((seq - 32) * 2 + j) * 2 + dir) * NH + h) * 8192 + p * 128 + nq;
#pragma unroll
            for (int e = 0; e < 32; ++e) hs[e] = sp[e]; }
        else {
#pragma unroll
            for (int e = 0; e < 32; ++e) hs[e] = 0.f; }
        asm volatile("s_waitcnt vmcnt(0)" ::: "memory"); __syncthreads();
        for (int ti = 0; ti < L; ++ti) {
            const int tok = tok0 + (dir == 0 ? ti : L - 1 - ti);
            const float raw = DT[(size_t)tok * 64 + dir * NH + h] + dtb;
            const float dt = raw > 20.f ? raw : log1pf(__expf(raw));
            const float dec = __expf(dt * Aneg);
            const float xv = bflo((unsigned)XBC[(size_t)tok * DXBC + h * 64 + p]);
            const bf16_t* Bp = XBC + (size_t)tok * DXBC + DI + g * 128 + nq;
            const bf16_t* Cp = XBC + (size_t)tok * DXBC + DI + 512 + g * 128 + nq;
            float y = 0.f;
#pragma unroll
            for (int e = 0; e < 32; ++e) { hs[e] = hs[e] * dec + dt * xv * bflo((unsigned)Bp[e]); y += bflo((unsigned)Cp[e]) * hs[e]; }
            y += __shfl_xor(y, 1); y += __shfl_xor(y, 2);
            if (dir == 0) { if ((c.tid & 3) == 0) YTMP[(size_t)tok * DI + h * 64 + p] = (bf16_t)(pk2(y, 0.f) & 0xffff); }
            else {
                const float yt = bflo((unsigned)YTMP[(size_t)tok * DI + h * 64 + p]);
                const float zz = bflo((unsigned)Z[(size_t)tok * DI + h * 64 + p]);
                float yy = (y + yt + Dh * xv) * silu_f(zz);
                __syncthreads();
                if ((c.tid & 3) == 0) { red[p] = yy * yy; YG[(size_t)tok * DI + h * 64 + p] = (bf16_t)(pk2(yy * nw, 0.f) & 0xffff); }
                __syncthreads();
                if (c.tid == 0) { float s = 0.f; for (int e = 0; e < 64; ++e) s += red[e]; SSQ[(size_t)tok * NH + h] = s; }
            }
        }
        if (!is_lat) { float* op = a.out + (size_t)NTOK * D + ((size_t)((seq * 2 + j) * 2 + dir) * NH + h) * 8192 + p * 128 + nq;
#pragma unroll
            for (int e = 0; e < 32; ++e) op[e] = hs[e]; }
    }
}
#endif
__device__ __forceinline__ void phase_scan(const Ctx& c, int j) {
#if NAIVE_SCAN
    for (int u = c.vb; u < 1088; u += c.G) { if (u < 64) scan_unit_naive(c, j, 32 + (u >> 5), u & 31); else scan_unit_naive(c, j, (u - 64) >> 5, (u - 64) & 31); }
    return;
#endif
    phase_scan_pipe(c, j);
}

typedef const Args __attribute__((address_space(4)))* ArgsP;
#if 0
#define LB_WAVES 1
#else
#define LB_WAVES 2
#endif
__global__ void __launch_bounds__(NTHR, LB_WAVES) fwd_kernel(Args args) {
    extern __shared__ __attribute__((aligned(16))) char lds[];
    volatile LAS unsigned* st = (volatile LAS unsigned*)(lds + LDS_BYTES - 16);
    if (threadIdx.x == 0) { st[0] = 0u; st[1] = 0u; }
    __syncthreads();
    const int ph_lo = args.ph_lo, ph_hi = args.ph_hi;
    const bool multi = (ph_hi - ph_lo) > 1;
    XcdBarrier bar; bar.bar = (unsigned*)(args.ws + WS_CTL); bar.x = 0; bar.st = st;
    if (multi) bar = xcd_barrier_post((unsigned*)(args.ws + WS_CTL), st);

    int rep = 0;
#pragma unroll 1
    for (int ph = ph_lo; ph < ph_hi; ++ph) {
        ArgsP ap = (ArgsP)__builtin_amdgcn_kernarg_segment_ptr();
        asm volatile("" : "+s"(ap));
        int tid = threadIdx.x;
        asm volatile("" : "+v"(tid));
        Ctx c;
        c.lds = lds; c.tid = tid; c.lane = tid & 63; c.wid = __builtin_amdgcn_readfirstlane(tid >> 6);
        c.G = gridDim.x; c.vb = (c.G % 8 == 0) ? (int)(blockIdx.x % 8) * (c.G / 8) + (int)(blockIdx.x / 8) : (int)blockIdx.x;
        c.a = ap;
        unsigned char* ws = ap->ws;
        const float* MOD = (const float*)(ws + WS_MOD);

        int kind = 0;
        if (ph == 0) { if (PH_ON(0)) phase_prep(c); }
        else if (ph == 1) { kind = 12; phase_prep2(c); }
        else if (ph == NPHASE - 1) { kind = 10; if (PH_ON(1)) phase_norm(c, ap->in[21], nullptr, 0, 0, true); }
        else {
            int layer, sub;
            if (ph <= 7) { layer = 0; sub = ph - 2; } else if (ph <= 12) { layer = 1; sub = ph - 8; } else if (ph <= 18) { layer = 2; sub = ph - 13; } else { layer = 3; sub = ph - 19; }
            const int j = layer >> 1;
            const float* mod = MOD + (size_t)layer * 3 * 6144;
            const bool ssd = (layer & 1) == 0;
            const int nmix = ssd ? 4 : 3;
            if (sub < nmix - 1) kind = ssd ? (sub == 0 ? 2 : sub == 1 ? 3 : 4) : (sub == 0 ? 6 : 7);
            else if (sub == nmix) kind = 8;
            else kind = 5;

            if (kind == 2) { if (PH_ON(2)) phase_inproj(c, j); }
            else if (kind == 3) { if (PH_ON(3)) phase_conv(c, j); }
            else if (kind == 4) { if (PH_ON(4)) phase_scan(c, j); }
            else if (kind == 6) { if (PH_ON(6)) phase_f1(c, j); }
            else if (kind == 7) { if (PH_ON(7)) phase_f2(c); }
            else if (kind == 8) { if (PH_ON(8)) phase_mlp_up(c, layer); }
            else {
                if (PH_ON(5)) {
                    const bf16_t* WT; const bf16_t* Act; int K; const float* gate; const float* bias = nullptr; const float* ssq = nullptr;
                    const float* nw_next; const float* scale_next;
                    if (sub == nmix - 1) {
                        gate = mod + 2048; nw_next = ap->in[8] + layer * D; scale_next = mod + 4096;
                        if (ssd) { WT = (const bf16_t*)(ws + WS_WOUT) + (size_t)j * D * DI; Act = (const bf16_t*)(ws + S_YG); K = DI; ssq = (const float*)(ws + S_SSQ); }
                        else { WT = (const bf16_t*)(ws + WS_WFNO) + (size_t)j * D * D; Act = (const bf16_t*)(ws + S_F); K = D; bias = ap->in[18] + j * D; }
                    } else {
                        gate = mod + 5120; WT = (const bf16_t*)(ws + WS_W2) + (size_t)layer * D * DFF; Act = (const bf16_t*)(ws + S_HID); K = DFF;
                        if (layer < 3) { nw_next = ap->in[7] + (layer + 1) * D; scale_next = mod + 3 * 6144 + 1024; } else { nw_next = nullptr; scale_next = nullptr; }
                    }
                    if (rep > 0) { gate = (const float*)(ws + WS_ZERO); }
                    phase_resid_gemm(c, WT, Act, K, gate, bias, ssq, nw_next, scale_next, layer == 0 && sub == nmix - 1 && rep == 0);
                }
            }
        }
        if (REP_KIND == 9) { for (int r = 0; r < REP_N; ++r) if (multi) xcd_barrier(bar); }
        if (REP_N > 0 && kind == REP_KIND && rep < REP_N) { ++rep; --ph; if (multi) xcd_barrier(bar); continue; }
        rep = 0;
        if (REP_KIND == 11 && ph == NPHASE - 1) { for (int r = 0; r < REP_N; ++r) { if (multi) xcd_barrier(bar); phase_bench(c); } }
        if (ph + 1 < ph_hi) xcd_barrier(bar);
    }
}

extern "C" void kernel_launch(void* const* d_in, const int* in_sizes, int n_in, void* d_out, int out_size, void* d_ws, size_t ws_size, hipStream_t stream) {
    static int grid = 0;
    if (grid == 0) {
        int dev = 0, cus = 0;
        if (hipGetDevice(&dev) != hipSuccess || hipDeviceGetAttribute(&cus, hipDeviceAttributeMultiprocessorCount, dev) != hipSuccess || cus <= 0) { fprintf(stderr, "kernel_launch: device query failed\n"); grid = -1; return; }
        if (hipFuncSetAttribute((const void*)fwd_kernel, hipFuncAttributeMaxDynamicSharedMemorySize, LDS_BYTES) != hipSuccess) { fprintf(stderr, "kernel_launch: hipFuncSetAttribute failed\n"); }
        (void)hipGetLastError();
        if (ws_size < WS_END) fprintf(stderr, "kernel_launch: workspace too small: %zu < %zu\n", ws_size, (size_t)WS_END);
        grid = cus;
    }
    if (grid < 0) return;
    (void)hipMemsetAsync((char*)d_ws + WS_CTL, 0, CTL_BYTES, stream);
    Args a{};
    for (int i = 0; i < 22; ++i) a.in[i] = (const float*)d_in[i];
    a.out = (float*)d_out; a.ws = (unsigned char*)d_ws;
#if N_LAUNCH_MODE == 1
    a.ph_lo = 0; a.ph_hi = NPHASE;
    hipLaunchKernelGGL(fwd_kernel, dim3(grid), dim3(NTHR), LDS_BYTES, stream, a);
#else
    for (int ph = 0; ph < NPHASE; ++ph) {
        a.ph_lo = ph; a.ph_hi = ph + 1;
        hipLaunchKernelGGL(fwd_kernel, dim3(grid), dim3(NTHR), LDS_BYTES, stream, a);
    }
#endif
}
```

```cpp
#include <hip/hip_runtime.h>
#include <stdint.h>
#include <stdio.h>

#ifndef PH_MASK
#define PH_MASK 0xFFFF
#endif
#define PH_ON(k) ((PH_MASK >> (k)) & 1)
#ifndef NAIVE_GEMM
#define NAIVE_GEMM 0
#endif
#define GN(k) ((NAIVE_GEMM >> (k)) & 1)
#ifndef NAIVE_SCAN
#define NAIVE_SCAN 0
#endif
#ifndef REP_KIND
#define REP_KIND -1
#endif
#ifndef REP_N
#define REP_N 0
#endif
#ifndef GEMM_INTERLEAVE
#define GEMM_INTERLEAVE 0
#endif
#ifndef GEMM_SETPRIO
#define GEMM_SETPRIO 0
#endif
#ifndef N_LAUNCH_MODE
#define N_LAUNCH_MODE 1
#endif

typedef unsigned short bf16_t;
typedef short bf16x8 __attribute__((ext_vector_type(8)));
typedef short bf16x4 __attribute__((ext_vector_type(4)));
typedef float f32x4 __attribute__((ext_vector_type(4)));
typedef unsigned u32x4 __attribute__((ext_vector_type(4)));
typedef unsigned u32x2 __attribute__((ext_vector_type(2)));
#define LAS __attribute__((address_space(3)))

constexpr int D = 1024, NCTX = 8192, NLAT = 2048, NTOK = 10240;
constexpr int DI = 2048, DXBC = 3072, DPROJ = 5184, NZX = 5120, NH = 32, DFF = 4096;
constexpr float EPS = 1e-6f;
constexpr int NPHASE = 25;

constexpr size_t al256(size_t x) { return (x + 255) & ~(size_t)255; }
constexpr size_t WS_CTL  = 0;
constexpr size_t CTL_BYTES = 65536 + 81920;
constexpr size_t WS_ZERO = 65536;
constexpr size_t WS_MOD  = WS_CTL + CTL_BYTES;
constexpr size_t WS_SWIN = al256(WS_MOD + 4 * 3 * 6144 * 4);
constexpr size_t WS_SWUP = WS_SWIN + 2 * 3 * DPROJ * 4;
constexpr size_t WS_SWF1 = WS_SWUP + 4 * 3 * DFF * 4;
constexpr size_t WS_RSS  = al256(WS_SWF1 + 2 * 3 * 2048 * 4);
constexpr size_t WS_WIN  = al256(WS_RSS + (size_t)NTOK * 16 * 4);
constexpr size_t WS_WOUT = WS_WIN + (size_t)2 * DPROJ * D * 2;
constexpr size_t WS_WFNO = WS_WOUT + (size_t)2 * D * DI * 2;
constexpr size_t WS_W1   = WS_WFNO + (size_t)2 * D * D * 2;
constexpr size_t WS_W2   = WS_W1 + (size_t)4 * DFF * D * 2;
constexpr size_t WS_T1   = WS_W2 + (size_t)4 * DFF * D * 2;
constexpr size_t WS_T2C  = WS_T1 + (size_t)512 * 256 * 2;
constexpr size_t WS_T2L  = WS_T2C + (size_t)256 * 512 * 2;
constexpr size_t WS_H    = WS_T2L + (size_t)1024 * 2048 * 2;
constexpr size_t WS_S    = WS_H + (size_t)NTOK * D * 2;
constexpr size_t S_Z     = WS_S;
constexpr size_t S_XBC   = S_Z + (size_t)NTOK * DI * 2;
constexpr size_t S_DT    = S_XBC + (size_t)NTOK * DXBC * 2;
constexpr size_t S_SSQ   = S_DT + (size_t)NTOK * 64 * 4;
constexpr size_t S_YG    = S_SSQ + (size_t)NTOK * 32 * 4;
constexpr size_t S_RAW   = S_YG + (size_t)NTOK * DI * 2;
constexpr size_t WS_END  = S_RAW + (size_t)NTOK * DXBC * 2;
constexpr size_t S_HID   = WS_S;
constexpr size_t S_UVT   = WS_S;
constexpr size_t S_F     = WS_S + (size_t)NTOK * 2048 * 2;

constexpr int LDS_BYTES = 163840;
constexpr int NTHR = 512, NWAVE = 8;

typedef __bf16 bf16x2_t __attribute__((ext_vector_type(2)));
typedef float f32x2_t __attribute__((ext_vector_type(2)));
__device__ __forceinline__ unsigned pk2(float lo, float hi) { const f32x2_t f = {lo, hi}; return __builtin_bit_cast(unsigned, __builtin_convertvector(f, bf16x2_t)); }
__device__ __forceinline__ float bflo(unsigned u) { return __uint_as_float(u << 16); }
__device__ __forceinline__ float bfhi(unsigned u) { return __uint_as_float(u & 0xffff0000u); }
__device__ __forceinline__ float wave_sum(float v) {
#pragma unroll
    for (int o = 1; o < 64; o <<= 1) v += __shfl_xor(v, o);
    return v;
}
__device__ __forceinline__ float silu_f(float x) { return x * __builtin_amdgcn_rcpf(1.0f + __expf(-x)); }
__device__ __forceinline__ int cond_of(int tok) { return tok < NCTX ? 0 : (tok < NCTX + 1024 ? 1 : 2); }

#define XB_TMO      128
#define XB_XCNT(j)  (256  + 64 * (j))
#define XB_XSUB(j)  (1280 + 64 * (j))
#define XB_XGEN(j)  (2304 + 64 * (j))
#define XB_TOP      3328
#define XB_TOPGEN   3392
#define XCD_BAR_WORDS 3456
#define XB_SPIN_CAP (1u << 20)
__device__ __forceinline__ unsigned xb_ld(unsigned* p)              { return __hip_atomic_load(p, __ATOMIC_RELAXED, __HIP_MEMORY_SCOPE_AGENT); }
__device__ __forceinline__ unsigned xb_add(unsigned* p, unsigned v) { return __hip_atomic_fetch_add(p, v, __ATOMIC_RELAXED, __HIP_MEMORY_SCOPE_AGENT); }
__device__ __forceinline__ unsigned xb_xcc_id() { return (unsigned)__builtin_amdgcn_s_getreg((3 << 11) | 20) & 0xFu; }
#define XB_SPIN(cond, bar) do { unsigned _sp = 0; while (cond) { __builtin_amdgcn_s_sleep(1); \
    if ((++_sp & 255u) == 0u) { if (xb_ld(&(bar)[XB_TMO])) break; if (_sp > XB_SPIN_CAP) { atomicAdd(&(bar)[XB_TMO], 1u); break; } } } } while (0)
struct XcdBarrier { unsigned* bar; unsigned x; volatile LAS unsigned* st; };
__device__ __forceinline__ XcdBarrier xcd_barrier_post(unsigned* bar, volatile LAS unsigned* st) {
    XcdBarrier b; b.bar = bar; b.x = xb_xcc_id(); b.st = st;
    if (threadIdx.x == 0) (void)xb_add(&bar[XB_XCNT(b.x)], 1u);
    return b;
}
__device__ __forceinline__ void xcd_barrier_complete(unsigned* bar, unsigned x, unsigned& nloc, unsigned& nx) {
    const unsigned G = gridDim.x * gridDim.y * gridDim.z;
    unsigned sum, cnt, mine, sp = 0u;
    for (;;) {
        sum = 0u; cnt = 0u; mine = 0u;
#pragma unroll
        for (unsigned j = 0; j < 16; ++j) { const unsigned c = xb_ld(&bar[XB_XCNT(j)]); sum += c; cnt += (c > 0u) ? 1u : 0u; mine = (j == x) ? c : mine; }
        if (sum == G) break;
        __builtin_amdgcn_s_sleep(1);
        if ((++sp & 255u) == 0u) { if (xb_ld(&bar[XB_TMO])) break; if (sp > XB_SPIN_CAP) { atomicAdd(&bar[XB_TMO], 1u); break; } }
    }
    nloc = mine > 0u ? mine : 1u; nx = cnt > 0u ? cnt : 1u;
}
__device__ __forceinline__ void xcd_barrier(const XcdBarrier& b) {
    asm volatile("s_waitcnt vmcnt(0)" ::: "memory");
    __syncthreads();
    if (threadIdx.x == 0) {
        unsigned* bar = b.bar;
        __builtin_amdgcn_s_waitcnt(0);
        unsigned nloc = b.st[0], nx = b.st[1];
        if (nloc == 0u) { xcd_barrier_complete(bar, b.x, nloc, nx); b.st[0] = nloc; b.st[1] = nx; }
        const unsigned old = xb_add(&bar[XB_XSUB(b.x)], 1u);
        const unsigned gen = old / nloc;
        if (old + 1u == (gen + 1u) * nloc) {
            __builtin_amdgcn_fence(__ATOMIC_RELEASE, "agent");
            asm volatile("s_waitcnt vmcnt(0)" ::: "memory");
            const unsigned og = xb_add(&bar[XB_TOP], 1u);
            const unsigned tg = og / nx;
            if (og + 1u == (tg + 1u) * nx) xb_add(&bar[XB_TOPGEN], 1u);
            else XB_SPIN(xb_ld(&bar[XB_TOPGEN]) == tg, bar);
            __builtin_amdgcn_fence(__ATOMIC_ACQUIRE, "agent");
            xb_add(&bar[XB_XGEN(b.x)], 1u);
            asm volatile("s_waitcnt vmcnt(0)" ::: "memory");
        } else {
            XB_SPIN(xb_ld(&bar[XB_XGEN(b.x)]) == gen, bar);
            __builtin_amdgcn_fence(__ATOMIC_ACQUIRE, "agent");
            asm volatile("s_waitcnt vmcnt(0)" ::: "memory");
        }
    }
    __syncthreads();
}

struct Args {
    const float* in[22];
    float* out;
    unsigned char* ws;
    int ph_lo, ph_hi;
};

struct Ctx {
    char* lds;
    int tid, lane, wid;
    int vb, G;
    const Args __attribute__((address_space(4)))* a;
};

template <int TB> struct GT { static constexpr int ROWS = 256 + 32 * TB, STAGE = ROWS * 128, NI = ROWS / 8; };

template <int TB>
__device__ __forceinline__ void gemm_stage(char* st, const bf16_t* Ag, int lda, const bf16_t* Bg, int ldb, int k0, int wid, int lane) {
    constexpr int NI = GT<TB>::NI;
    const int rsub = lane >> 3, lch = (lane & 7) ^ rsub;
#pragma unroll
    for (int i = 0; i < (NI + 7) / 8; ++i) {
        const int q = wid + 8 * i;
        if (q < NI) {
            const int row = q * 8 + rsub;
            const bf16_t* src = (q < 32) ? (Ag + (size_t)row * lda + k0 + lch * 8) : (Bg + (size_t)(row - 256) * ldb + k0 + lch * 8);
            __builtin_amdgcn_global_load_lds((const unsigned*)src, (LAS unsigned*)(st + q * 1024 + lane * 16), 16, 0, 0);
        }
    }
}
__device__ __forceinline__ bf16x8 frag128(const char* tile, int row, int chunk) {
    return *(const bf16x8*)(tile + row * 128 + ((chunk ^ (row & 7)) << 4));
}

struct NoPre { __device__ __forceinline__ void operator()() const {} };
template <int TB, bool NAIVE, class Epi, class Pre = NoPre>
__device__ __forceinline__ void gemm_tile(const Ctx& c, const bf16_t* Ag, int lda, const bf16_t* Bg, int ldb, int K, int a0, int b0, const Epi& epi, const Pre& pre = Pre(),
                                          bool prefetched = false, const bf16_t* An = nullptr, const bf16_t* Bn = nullptr) {
    constexpr int STAGE = GT<TB>::STAGE;
    const int wr = c.wid >> 1, wc = c.wid & 1, fr = c.lane & 15, fq = c.lane >> 4;
    f32x4 acc[4][TB];
#pragma unroll
    for (int i = 0; i < 4; ++i)
#pragma unroll
        for (int j = 0; j < TB; ++j) acc[i][j] = (f32x4){0.f, 0.f, 0.f, 0.f};
    if (NAIVE) {
        __syncthreads(); pre(); __syncthreads();
        const bf16_t* ar = Ag + (size_t)(wr * 64 + fq * 4) * lda;
        const bf16_t* br = Bg + (size_t)(wc * 16 * TB + fr) * ldb;
#pragma unroll
        for (int j = 0; j < TB; ++j) {
#pragma unroll 1
            for (int k = 0; k < K; k += 8) {
                float bv[8];
                { const u32x4 v = *(const u32x4*)(br + (size_t)(j * 16) * ldb + k);
#pragma unroll
                  for (int e = 0; e < 4; ++e) { bv[2 * e] = bflo(v[e]); bv[2 * e + 1] = bfhi(v[e]); } }
#pragma unroll
                for (int i = 0; i < 4; ++i)
#pragma unroll
                    for (int r = 0; r < 4; ++r) {
                        const u32x4 v = *(const u32x4*)(ar + (size_t)(i * 16 + r) * lda + k);
#pragma unroll
                        for (int e = 0; e < 4; ++e) acc[i][j][r] += bflo(v[e]) * bv[2 * e] + bfhi(v[e]) * bv[2 * e + 1];
                    }
                asm volatile("" ::: "memory");
            }
        }
        epi(acc, a0 + wr * 64, b0 + wc * (16 * TB), fr, fq);
        return;
    }
    const int nt = K >> 6;
    __syncthreads();
    if (!prefetched) gemm_stage<TB>(c.lds, Ag, lda, Bg, ldb, 0, c.wid, c.lane);
    pre();
    for (int t = 0; t < nt; ++t) {
        asm volatile("s_waitcnt vmcnt(0)" ::: "memory");
        __syncthreads();
        const char* cur = c.lds + (t & 1) * STAGE;
        if (t + 1 < nt) gemm_stage<TB>(c.lds + ((t + 1) & 1) * STAGE, Ag, lda, Bg, ldb, (t + 1) << 6, c.wid, c.lane);
        else if (An) gemm_stage<TB>(c.lds, An, lda, Bn, ldb, 0, c.wid, c.lane);
#pragma unroll
        for (int kk = 0; kk < 2; ++kk) {
            bf16x8 af[4], bfr[TB];
#pragma unroll
            for (int i = 0; i < 4; ++i) af[i] = frag128(cur, wr * 64 + i * 16 + fr, kk * 4 + fq);
#pragma unroll
            for (int j = 0; j < TB; ++j) bfr[j] = frag128(cur, 256 + wc * (16 * TB) + j * 16 + fr, kk * 4 + fq);
#pragma unroll
            for (int i = 0; i < 4; ++i)
#pragma unroll
                for (int j = 0; j < TB; ++j) acc[i][j] = __builtin_amdgcn_mfma_f32_16x16x32_bf16(af[i], bfr[j], acc[i][j], 0, 0, 0);
        }
    }
    epi(acc, a0 + wr * 64, b0 + wc * (16 * TB), fr, fq);
}

template <int TB, class Prob, int BENCH = 0>
__device__ __forceinline__ void gemm_stream(const Ctx& c, const Prob& P) {
    constexpr int STAGE = GT<TB>::STAGE, NI = GT<TB>::NI;
    constexpr int NSLOT = (NI + 7) / 8;
    const int wr = c.wid >> 1, wc = c.wid & 1, fr = c.lane & 15, fq = c.lane >> 4;
    const int n = P.count();
    if (n <= 0) return;
    f32x4 acc[4][TB];
#pragma unroll
    for (int i = 0; i < 4; ++i)
#pragma unroll
        for (int j = 0; j < TB; ++j) acc[i][j] = (f32x4){0.f, 0.f, 0.f, 0.f};
    const int KT = P.K >> 6;
    const int total = n * KT;
    const int rsub = c.lane >> 3, lch = (c.lane & 7) ^ rsub;
    unsigned voff[NSLOT]; int qs[NSLOT];
#pragma unroll
    for (int s = 0; s < NSLOT; ++s) {
        const int q = (c.wid + 8 * s < NI) ? c.wid + 8 * s : NI - 1;
        qs[s] = q;
        voff[s] = (unsigned)(((s < 4) ? ((q * 8 + rsub) * P.lda + lch * 8) : ((q * 8 + rsub - 256) * P.ldb + lch * 8)) * 2);
    }
    const bf16_t* Acur; const bf16_t* Bcur;
    int li = 0, lk = 0;
    P.tile(0, Acur, Bcur);
    constexpr int Q0 = (NSLOT + 3) / 4, Q1 = Q0 + (NSLOT + 2) / 4, Q2 = Q1 + (NSLOT + 1) / 4;
    constexpr int S1 = Q1;
    auto issue_part = [&](int stage, int s0, int s1) {
        char* st = c.lds + stage * STAGE;
#pragma unroll
        for (int s = 0; s < NSLOT; ++s) {
            if (s >= s0 && s < s1) {
                const char* ub = (const char*)(((s < 4) ? Acur : Bcur) + lk * 64);
                __builtin_amdgcn_global_load_lds((const unsigned*)(ub + voff[s]), (LAS unsigned*)(st + qs[s] * 1024), 16, 0, 0);
            }
        }
    };
    auto issue = [&](int stage) { issue_part(stage, 0, NSLOT); };
    auto advance = [&]() { if (++lk == KT) { lk = 0; if (li + 1 < n) { ++li; P.tile(li, Acur, Bcur); } } };
    asm volatile("s_waitcnt vmcnt(0)" ::: "memory");
    __builtin_amdgcn_s_barrier();
    asm volatile("" ::: "memory");
    issue(0); advance(); issue(1); advance();
    P.pre_all();
    int ci = 0, ck = 0, stg = 0;
#define GEMM_WAIT_ONE_STAGE() do { if (BENCH == 1) { asm volatile("s_waitcnt vmcnt(0)" ::: "memory"); } \
        else if (after_epi) { asm volatile("s_waitcnt vmcnt(%0)" :: "n"(S1 + Prob::EPI_STORES) : "memory"); } \
        else { asm volatile("s_waitcnt vmcnt(%0)" :: "n"(S1) : "memory"); } } while (0)
    bool after_epi = false;
#define GEMM_BAR() do { asm volatile("" ::: "memory"); __builtin_amdgcn_s_barrier(); asm volatile("" ::: "memory"); } while (0)
#define GEMM_LOADF(dst, stage_ptr, kk) do { \
        _Pragma("unroll") for (int i = 0; i < 4; ++i) dst.a[i] = frag128(stage_ptr, wr * 64 + i * 16 + fr, (kk) * 4 + fq); \
        _Pragma("unroll") for (int jj = 0; jj < TB; ++jj) dst.b[jj] = frag128(stage_ptr, 256 + wc * (16 * TB) + jj * 16 + fr, (kk) * 4 + fq); } while (0)
#define GEMM_MMA(src_) do { \
        _Pragma("unroll") for (int i = 0; i < 4; ++i) \
        _Pragma("unroll") for (int jj = 0; jj < TB; ++jj) acc[i][jj] = __builtin_amdgcn_mfma_f32_16x16x32_bf16(src_.a[i], src_.b[jj], acc[i][jj], 0, 0, 0); } while (0)
    struct Frags { bf16x8 a[4]; bf16x8 b[TB]; };
    Frags f0, f1;
    if (BENCH == 1) { asm volatile("s_waitcnt vmcnt(0)" ::: "memory"); } else { asm volatile("s_waitcnt vmcnt(%0)" :: "n"(NSLOT) : "memory"); }
    GEMM_BAR();
    GEMM_LOADF(f0, c.lds, 0);
    f32x4 sw[4];
#pragma unroll
    for (int i = 0; i < 4; ++i) sw[i] = (f32x4){0.f, 0.f, 0.f, 0.f};
#pragma unroll 1
    for (int gs = 0; gs < total; ++gs) {
        const char* cur = c.lds + stg * STAGE;
        const int nst1 = stg == 2 ? 0 : stg + 1;
        if (ck == KT - 1) P.preload(ci, sw, wr, fq);
        if (BENCH != 2) GEMM_LOADF(f1, cur, 1);
        const int nst2 = stg == 0 ? 2 : stg - 1;
        if (BENCH != 1) issue_part(nst2, 0, Q0);
        if (BENCH != 2) GEMM_MMA(f0);
#if GEMM_INTERLEAVE
        __builtin_amdgcn_sched_group_barrier(0x100, 4 + TB, 0);
#pragma unroll
        for (int s = 0; s < NSLOT; ++s) {
            __builtin_amdgcn_sched_group_barrier(0x008, 2, 0);
            __builtin_amdgcn_sched_group_barrier(0x006, 6, 0);
            __builtin_amdgcn_sched_group_barrier(0x010, 1, 0);
        }
        __builtin_amdgcn_sched_group_barrier(0x008, 4 * TB - 2 * NSLOT, 0);
#endif
        if (BENCH != 1) issue_part(nst2, Q0, Q1);
        GEMM_WAIT_ONE_STAGE();
        after_epi = false;
        asm volatile("s_waitcnt lgkmcnt(0)" ::: "memory");
        GEMM_BAR();
        if (BENCH != 1) issue_part(nst2, Q1, Q2);
        if (BENCH != 2) GEMM_LOADF(f0, c.lds + nst1 * STAGE, 0);
#if GEMM_SETPRIO
        __builtin_amdgcn_s_setprio(1);
#endif
        if (BENCH != 2) GEMM_MMA(f1);
#if GEMM_SETPRIO
        __builtin_amdgcn_s_setprio(0);
#endif
        if (BENCH != 1) issue_part(nst2, Q2, NSLOT);
        stg = nst1;
        advance();
        if (++ck == KT) {
            P.epilogue(ci, acc, sw, wr, wc, fr, fq);
#pragma unroll
            for (int i = 0; i < 4; ++i)
#pragma unroll
                for (int j = 0; j < TB; ++j) acc[i][j] = (f32x4){0.f, 0.f, 0.f, 0.f};
            ck = 0; ++ci;
            after_epi = true;
        }
    }
    asm volatile("s_waitcnt vmcnt(0)" ::: "memory");
    GEMM_BAR();
#undef GEMM_WAIT_ONE_STAGE
#undef GEMM_BAR
#undef GEMM_LOADF
#undef GEMM_MMA
}

__device__ __forceinline__ u32x4 pair16(const u32x2& a, const u32x2& b) {
    const auto sx = __builtin_amdgcn_permlane16_swap(a.x, b.x, false, false);
    const auto sy = __builtin_amdgcn_permlane16_swap(a.y, b.y, false, false);
    return (u32x4){sx[0], sy[0], sx[1], sy[1]};
}
struct EpiInProj {
    bf16_t* Z; bf16_t* RAW; const float* rsx  ; int tok_base; const float* SW  ; bool uni  ;
    __device__ __forceinline__ void operator()(f32x4 (&acc)[4][5], const f32x4 (&swp)[4], int ab, int bb, int fr, int fq) const {
#pragma unroll
        for (int j = 0; j < 5; ++j) {
            const int tok = bb + j * 16 + fr;
            const float rs = rsx[tok - tok_base];
            const float* sw = SW + cond_of(tok) * DPROJ;
            u32x2 v[4];
#pragma unroll
            for (int i = 0; i < 4; ++i) {
                const int n = ab + i * 16 + fq * 4;
                const f32x4 o = acc[i][j] * rs + (uni ? swp[i] : *(const f32x4*)(sw + n));
                v[i].x = pk2(o[0], o[1]); v[i].y = pk2(o[2], o[3]);
            }
#pragma unroll
            for (int p = 0; p < 2; ++p) {
                const u32x4 o = pair16(v[2 * p], v[2 * p + 1]);
                const int n = ab + (2 * p + (fq & 1)) * 16 + (fq & 2) * 4;
                bf16_t* dst = (n < DI) ? (Z + (size_t)tok * DI + n) : (RAW + (size_t)tok * DXBC + (n - DI));
                *(u32x4*)dst = o;
            }
        }
    }
};
struct EpiResid {
    float* X; const float* gate  ; const float* bias; const float* rs_lds  ; int tok_base;
    const float* Xin0; const float* Xin1;
    bf16_t* XG  ; const float* nw_next; const float* scale_next  ; float* RSS; const float* zeros  ;
    __device__ __forceinline__ void operator()(f32x4 (&acc)[4][5], int ab, int bb, int fr, int fq) const {
        const int slot = (ab >> 6);
        const bool uni = cond_of(bb) == cond_of(bb + 79);
        const int nb = ab + fq * 4;
        f32x4 gvv[4], bvv[4], gnn[4];
        auto load_vecs = [&](int cd) {
            const float* gp = gate + cd * 6144 + nb;
            const float* bp = (bias ? bias : zeros) + nb;
            const float* np = (XG ? nw_next : zeros) + nb;
            const float* sp = (XG ? scale_next + cd * 6144 : zeros) + nb;
            f32x4 t0[4], t1[4];
#pragma unroll
            for (int i = 0; i < 4; ++i) { gvv[i] = *(const f32x4*)(gp + i * 16); bvv[i] = *(const f32x4*)(bp + i * 16); t0[i] = *(const f32x4*)(np + i * 16); t1[i] = *(const f32x4*)(sp + i * 16); }
#pragma unroll
            for (int i = 0; i < 4; ++i) gnn[i] = t0[i] * (t1[i] + 1.0f);
        };
        if (uni) load_vecs(cond_of(bb));
        auto xrow = [&](int tok) -> const float* { return (Xin0 ? (tok < NCTX ? Xin0 + (size_t)tok * D : Xin1 + (size_t)(tok - NCTX) * D) : X + (size_t)tok * D) + nb; };
        f32x4 xv[4];
#pragma unroll
        for (int j = 0; j < 5; ++j) {
            const int tok = bb + j * 16 + fr;
            { const float* p = xrow(tok);
#pragma unroll
              for (int i = 0; i < 4; ++i) xv[i] = *(const f32x4*)(p + i * 16); }
            const float rs = rs_lds ? rs_lds[tok - tok_base] : 1.0f;
            if (!uni) load_vecs(cond_of(tok));
            float ss = 0.f;
            u32x2 xgv[4];
            float* xo = X + (size_t)tok * D + nb;
#pragma unroll
            for (int i = 0; i < 4; ++i) {
                const f32x4 x2 = xv[i] + gvv[i] * (acc[i][j] * rs + bvv[i]);
                *(f32x4*)(xo + i * 16) = x2;
                ss += x2[0] * x2[0] + x2[1] * x2[1] + x2[2] * x2[2] + x2[3] * x2[3];
                const f32x4 o = x2 * gnn[i];
                xgv[i].x = pk2(o[0], o[1]); xgv[i].y = pk2(o[2], o[3]);
            }
            if (XG) {
#pragma unroll
                for (int p = 0; p < 2; ++p) {
                    const u32x4 o = pair16(xgv[2 * p], xgv[2 * p + 1]);
                    *(u32x4*)(XG + (size_t)tok * D + ab + (2 * p + (fq & 1)) * 16 + (fq & 2) * 4) = o;
                }
                ss += __shfl_xor(ss, 16); ss += __shfl_xor(ss, 32);
                if (fq == 0) RSS[(size_t)tok * 16 + slot] = ss;
            }
        }
    }
};
struct EpiMlpUp {
    bf16_t* HID; const float* rsx; int tok_base; const float* SW  ; bool uni;
    __device__ __forceinline__ void operator()(f32x4 (&acc)[4][5], const f32x4 (&swp)[4], int ab, int bb, int fr, int fq) const {
#pragma unroll
        for (int j = 0; j < 5; ++j) {
            const int tok = bb + j * 16 + fr;
            const float rs = rsx[tok - tok_base];
            const float* sw = SW + cond_of(tok) * DFF;
            u32x2 v[4];
#pragma unroll
            for (int i = 0; i < 4; ++i) {
                const int n = ab + i * 16 + fq * 4;
                f32x4 a = acc[i][j] * rs + (uni ? swp[i] : *(const f32x4*)(sw + n));
                a[0] = fmaxf(a[0], 0.f); a[1] = fmaxf(a[1], 0.f); a[2] = fmaxf(a[2], 0.f); a[3] = fmaxf(a[3], 0.f);
                v[i].x = pk2(a[0] * a[0], a[1] * a[1]); v[i].y = pk2(a[2] * a[2], a[3] * a[3]);
            }
#pragma unroll
            for (int p = 0; p < 2; ++p) {
                const u32x4 o = pair16(v[2 * p], v[2 * p + 1]);
                *(u32x4*)(HID + (size_t)tok * DFF + ab + (2 * p + (fq & 1)) * 16 + (fq & 2) * 4) = o;
            }
        }
    }
};
struct EpiDt {
    float* DT; const float* rsx; int tok_base; const float* SW  ;
    __device__ __forceinline__ void operator()(f32x4 (&acc)[4][2], int ab, int bb, int fr, int fq) const {
        float swv[2][3];
#pragma unroll
        for (int j = 0; j < 2; ++j)
#pragma unroll
            for (int cd = 0; cd < 3; ++cd) swv[j][cd] = SW[cd * DPROJ + NZX + bb + j * 16 + fr];
#pragma unroll
        for (int j = 0; j < 2; ++j) {
            const int col = bb + j * 16 + fr;
#pragma unroll
            for (int i = 0; i < 4; ++i) {
                const int tok = ab + i * 16 + fq * 4;
#pragma unroll
                for (int r = 0; r < 4; ++r) {
                    const int cd = cond_of(tok + r);
                    const float sw = cd == 0 ? swv[j][0] : (cd == 1 ? swv[j][1] : swv[j][2]);
                    DT[(size_t)(tok + r) * 64 + col] = acc[i][j][r] * rsx[tok + r - tok_base] + sw;
                }
            }
        }
    }
};
struct EpiF1 {
    bf16_t* UVT; int g; const float* rsx; int tok_base; const float* SW  ;
    __device__ __forceinline__ void operator()(f32x4 (&acc)[4][4], int ab, int bb, int fr, int fq) const {
        float swv[4];
#pragma unroll
        for (int j = 0; j < 4; ++j) swv[j] = SW[cond_of(ab) * 2048 + g * 512 + bb + j * 16 + fr];
#pragma unroll
        for (int j = 0; j < 4; ++j) {
            const int nn = bb + j * 16 + fr, part = nn >> 8, ch = g * 256 + (nn & 255);
#pragma unroll
            for (int i = 0; i < 4; ++i) {
                const int tok = ab + i * 16 + fq * 4;
                const float sw = swv[j];
                bf16_t* dst;
                if (tok < NCTX) { const int s = tok >> 8, l = tok & 255; dst = UVT + ((size_t)(s * 1024 + ch) * 512 + part * 256 + l); }
                else { const int tt = tok - NCTX, s = tt >> 10, l = tt & 1023; dst = UVT + (size_t)NCTX * 2048 + ((size_t)(s * 1024 + ch) * 2048 + part * 1024 + l); }
                const f32x4 r4 = *(const f32x4*)(rsx + tok - tok_base);
                const f32x4 o = acc[i][j] * r4 + sw;
                u32x2 v; v.x = pk2(o[0], o[1]); v.y = pk2(o[2], o[3]);
                *(u32x2*)dst = v;
            }
        }
    }
};
template <int TB> struct EpiF2 {
    bf16_t* F; int tok0;
    __device__ __forceinline__ void operator()(f32x4 (&acc)[4][TB], int ab, int bb, int fr, int fq) const {
#pragma unroll
        for (int j = 0; j < TB; ++j) {
            const int tok = tok0 + bb + j * 16 + fr;
#pragma unroll
            for (int i = 0; i < 4; ++i) {
                const int n = ab + i * 16 + fq * 4;
                u32x2 v; v.x = pk2(acc[i][j][0], acc[i][j][1]); v.y = pk2(acc[i][j][2], acc[i][j][3]);
                *(u32x2*)(F + (size_t)tok * D + n) = v;
            }
        }
    }
};

struct TrItem { const float* W; bf16_t* WT; int K, N, k0, n0; };
__device__ __forceinline__ TrItem transpose_decode(const Ctx& c, int r) {
    const Args __attribute__((address_space(4)))& a = *c.a;
    constexpr int I_WIN = 8 * 81, I_WOUT = 16 * 16, I_FNO = 8 * 16, I_W1 = 8 * 64, I_W2 = 32 * 16;
    TrItem t; int item;
    if (r < 2 * I_WIN) { const int j = r / I_WIN; t.W = a.in[9] + (size_t)j * D * DPROJ; t.K = D; t.N = DPROJ; t.WT = (bf16_t*)(a.ws + WS_WIN) + (size_t)j * DPROJ * D; item = r - j * I_WIN; }
    else if ((r -= 2 * I_WIN) < 2 * I_WOUT) { const int j = r / I_WOUT; t.W = a.in[16] + (size_t)j * DI * D; t.K = DI; t.N = D; t.WT = (bf16_t*)(a.ws + WS_WOUT) + (size_t)j * D * DI; item = r - j * I_WOUT; }
    else if ((r -= 2 * I_WOUT) < 2 * I_FNO) { const int j = r / I_FNO; t.W = a.in[17] + (size_t)j * D * D; t.K = D; t.N = D; t.WT = (bf16_t*)(a.ws + WS_WFNO) + (size_t)j * D * D; item = r - j * I_FNO; }
    else if ((r -= 2 * I_FNO) < 4 * I_W1) { const int j = r / I_W1; t.W = a.in[19] + (size_t)j * D * DFF; t.K = D; t.N = DFF; t.WT = (bf16_t*)(a.ws + WS_W1) + (size_t)j * DFF * D; item = r - j * I_W1; }
    else { r -= 4 * I_W1; const int j = r / I_W2; t.W = a.in[20] + (size_t)j * DFF * D; t.K = DFF; t.N = D; t.WT = (bf16_t*)(a.ws + WS_W2) + (size_t)j * D * DFF; item = r - j * I_W2; }
    const int nb = t.N >> 6, kb = item / nb, nbi = item - kb * nb;
    t.k0 = kb * 128; t.n0 = nbi * 64;
    return t;
}
__device__ __forceinline__ void transpose_load(const Ctx& c, const TrItem& t, f32x4 (&v)[4]) {
    const int cl = c.tid & 15, rl = c.tid >> 4;
#pragma unroll
    for (int p = 0; p < 4; ++p) v[p] = *(const f32x4*)(t.W + (size_t)(t.k0 + p * 32 + rl) * t.N + t.n0 + cl * 4);
}
__device__ __forceinline__ void transpose_finish(const Ctx& c, const TrItem& t, const f32x4 (&v)[4]) {
    float* tile = (float*)c.lds;
    const int cl = c.tid & 15, rl = c.tid >> 4;
    __syncthreads();
#pragma unroll
    for (int p = 0; p < 4; ++p) { const int k = p * 32 + rl; tile[k * 65 + cl * 4 + 0] = v[p][0]; tile[k * 65 + cl * 4 + 1] = v[p][1]; tile[k * 65 + cl * 4 + 2] = v[p][2]; tile[k * 65 + cl * 4 + 3] = v[p][3]; }
    __syncthreads();
#pragma unroll
    for (int p = 0; p < 2; ++p) {
        const int idx = c.tid + p * NTHR, n = idx >> 4, kc = idx & 15;
        const float* s = tile + (kc * 8) * 65 + n;
        u32x4 o; o.x = pk2(s[0], s[65]); o.y = pk2(s[2 * 65], s[3 * 65]); o.z = pk2(s[4 * 65], s[5 * 65]); o.w = pk2(s[6 * 65], s[7 * 65]);
        *(u32x4*)(t.WT + (size_t)(t.n0 + n) * t.K + t.k0 + kc * 8) = o;
    }
}

__device__ __forceinline__ void ada_item(const Ctx& c, int item) {
    const Args __attribute__((address_space(4)))& a = *c.a;
    const int layer = item / 96, cg = item - layer * 96, n0 = cg * 64;
    const float* W = a.in[5] + (size_t)layer * D * 6144;
    const float* sc = (const float*)(c.lds + 40960);
    float* red = (float*)c.lds;
    const int cl = c.tid & 15, kl = c.tid >> 4;
    f32x4 a0 = {0, 0, 0, 0}, a1 = {0, 0, 0, 0}, a2 = {0, 0, 0, 0};
#pragma unroll 8
    for (int it = 0; it < 32; ++it) {
        const int k = it * 32 + kl;
        const f32x4 w = *(const f32x4*)(W + (size_t)k * 6144 + n0 + cl * 4);
        a0 += w * sc[k]; a1 += w * sc[1024 + k]; a2 += w * sc[2048 + k];
    }
    __syncthreads();
    *(f32x4*)(red + (kl * 3 + 0) * 64 + cl * 4) = a0;
    *(f32x4*)(red + (kl * 3 + 1) * 64 + cl * 4) = a1;
    *(f32x4*)(red + (kl * 3 + 2) * 64 + cl * 4) = a2;
    __syncthreads();
    if (c.tid < 192) {
        const int cond = c.tid >> 6, col = c.tid & 63;
        float s = 0.f;
#pragma unroll
        for (int k = 0; k < 32; ++k) s += red[(k * 3 + cond) * 64 + col];
        s += a.in[6][layer * 6144 + n0 + col];
        ((float*)(a.ws + WS_MOD))[(layer * 3 + cond) * 6144 + n0 + col] = s;
    }
}

__device__ __forceinline__ void phase_prep(const Ctx& c) {
    const Args __attribute__((address_space(4)))& a = *c.a;
    {
        float* sc = (float*)(c.lds + 40960);
        for (int i = c.tid; i < 3072; i += NTHR) {
            const int cond = i >> 10, k = i & 1023;
            const float v = cond == 0 ? a.in[4][k] : a.in[3][(cond - 1) * 1024 + k];
            sc[i] = silu_f(v);
        }
        __syncthreads();
    }
    constexpr int I_ADA = 384;
    constexpr int I_TR = 2 * 8 * 81 + 2 * 16 * 16 + 2 * 8 * 16 + 4 * 8 * 64 + 4 * 32 * 16;
    constexpr int I_TB = 32 + 32 + 512;
    for (int it = c.vb; it < I_ADA; it += c.G) ada_item(c, it);
    {
        int it = c.vb;
        if (it < I_TR) {
            TrItem cur = transpose_decode(c, it);
            f32x4 v[4]; transpose_load(c, cur, v);
            for (;;) {
                const int nit = it + c.G;
                TrItem nxt = cur; f32x4 vn[4];
                const bool has = nit < I_TR;
                if (has) { nxt = transpose_decode(c, nit); transpose_load(c, nxt, vn); }
                transpose_finish(c, cur, v);
                if (!has) break;
                cur = nxt; it = nit;
#pragma unroll
                for (int p = 0; p < 4; ++p) v[p] = vn[p];
            }
        }
    }
    for (int r = c.vb; r < I_TB; r += c.G) {
#pragma unroll 4
        for (int e = 0; e < 8; ++e) {
            int idx = r * 4096 + e * NTHR + c.tid;
            if (idx < 131072) {
                const int nn = idx >> 8, cc = idx & 255, m = nn & 255, ph = (m * cc) & 255;
                const float ang = (float)ph * (1.0f / 128.0f);
                const float v = nn < 256 ? cospif(ang) : sinpif(ang);
                ((bf16_t*)(a.ws + WS_T1))[idx] = (bf16_t)(pk2(v, 0.f) & 0xffff);
            } else if (idx < 262144) {
                idx -= 131072;
                const int k = idx >> 9, k2 = idx & 511, l = k2 & 255, ph = (k * l) & 255;
                const float ang = (float)ph * (1.0f / 128.0f);
                const float v = (k2 < 256 ? cospif(ang) : -sinpif(ang)) * (1.0f / 256.0f);
                ((bf16_t*)(a.ws + WS_T2C))[idx] = (bf16_t)(pk2(v, 0.f) & 0xffff);
            } else {
                idx -= 262144;
                const int k = idx >> 11, k2 = idx & 2047, l = k2 & 1023, ph = (k * l) & 1023;
                const float ang = (float)ph * (1.0f / 512.0f);
                const float v = (k2 < 1024 ? cospif(ang) : -sinpif(ang)) * (1.0f / 512.0f);
                ((bf16_t*)(a.ws + WS_T2L))[idx] = (bf16_t)(pk2(v, 0.f) & 0xffff);
            }
        }
    }
}

__device__ __forceinline__ void phase_prep2(const Ctx& c) {
    const Args __attribute__((address_space(4)))& a = *c.a;
    const float* MOD = (const float*)(a.ws + WS_MOD);
    float* sh = (float*)c.lds;
    const int gw = c.vb * NWAVE + c.wid, NGW = c.G * NWAVE;
#pragma unroll 1
    for (int v = 0; v < 8; ++v) {
        const int layer = v >> 1, mlp = v & 1, jj = layer >> 1, fnet = (layer & 1) && !mlp;
        __syncthreads();
        { float tv[6];
#pragma unroll
          for (int u = 0; u < 6; ++u) { const int i = c.tid + u * NTHR; tv[u] = MOD[(size_t)(layer * 3 + (i >> 10)) * 6144 + (mlp ? 3072 : 0) + (i & 1023)]; }
#pragma unroll
          for (int u = 0; u < 6; ++u) sh[c.tid + u * NTHR] = tv[u]; }
        __syncthreads();
        const bf16_t* W; float* out; int N, ostride;
        if (mlp) { W = (const bf16_t*)(a.ws + WS_W1) + (size_t)layer * DFF * D; N = DFF; out = (float*)(a.ws + WS_SWUP) + (size_t)layer * 3 * DFF; ostride = DFF; }
        else if (fnet) { W = (const bf16_t*)(a.ws + WS_T1); N = 2048; out = (float*)(a.ws + WS_SWF1) + (size_t)jj * 3 * 2048; ostride = 2048; }
        else { W = (const bf16_t*)(a.ws + WS_WIN) + (size_t)jj * DPROJ * D; N = DPROJ; out = (float*)(a.ws + WS_SWIN) + (size_t)jj * 3 * DPROJ; ostride = DPROJ; }
        for (int n = gw; n < N; n += NGW) {
            float s0 = 0.f, s1 = 0.f, s2 = 0.f;
            if (fnet) {
                const int g = n >> 9, nn = n & 511;
                if (c.lane < 32) {
                    const u32x4 w = *(const u32x4*)(W + (size_t)nn * 256 + c.lane * 8);
                    const int k = g * 256 + c.lane * 8;
#pragma unroll
                    for (int e = 0; e < 4; ++e) {
                        const float wl = bflo(w[e]), wh = bfhi(w[e]);
                        s0 += wl * sh[k + 2 * e] + wh * sh[k + 2 * e + 1];
                        s1 += wl * sh[1024 + k + 2 * e] + wh * sh[1024 + k + 2 * e + 1];
                        s2 += wl * sh[2048 + k + 2 * e] + wh * sh[2048 + k + 2 * e + 1];
                    }
                }
            } else {
#pragma unroll
                for (int p = 0; p < 2; ++p) {
                    const int k = p * 512 + c.lane * 8;
                    const u32x4 w = *(const u32x4*)(W + (size_t)n * D + k);
#pragma unroll
                    for (int e = 0; e < 4; ++e) {
                        const float wl = bflo(w[e]), wh = bfhi(w[e]);
                        s0 += wl * sh[k + 2 * e] + wh * sh[k + 2 * e + 1];
                        s1 += wl * sh[1024 + k + 2 * e] + wh * sh[1024 + k + 2 * e + 1];
                        s2 += wl * sh[2048 + k + 2 * e] + wh * sh[2048 + k + 2 * e + 1];
                    }
                }
            }
            s0 = wave_sum(s0); s1 = wave_sum(s1); s2 = wave_sum(s2);
            if (c.lane == 0) { out[n] = s0; out[ostride + n] = s1; out[2 * ostride + n] = s2; }
        }
    }
    {
        bf16_t* XG = (bf16_t*)(a.ws + WS_H);
        float* RSS = (float*)(a.ws + WS_RSS);
        const float* nw = a.in[7];
        f32x4 nwv[4];
#pragma unroll
        for (int q = 0; q < 4; ++q) nwv[q] = *(const f32x4*)(nw + q * 256 + c.lane * 4);
#pragma unroll 1
        for (int row0 = gw; row0 < NTOK; row0 += 5 * NGW) {
        f32x4 xv[5][4];
#pragma unroll
        for (int k = 0; k < 5; ++k) {
            const int rowu = row0 + k * NGW, row = rowu < NTOK ? rowu : NTOK - 1;
            const float* xr = row < NCTX ? a.in[0] + (size_t)row * D : a.in[1] + (size_t)(row - NCTX) * D;
#pragma unroll
            for (int q = 0; q < 4; ++q) xv[k][q] = *(const f32x4*)(xr + q * 256 + c.lane * 4);
        }
#pragma unroll
        for (int k = 0; k < 5; ++k) {
            const int row = row0 + k * NGW;
            if (row >= NTOK) break;
            const float* m = MOD + (size_t)cond_of(row) * 6144 + 1024;
            float ss = 0.f;
            f32x4 mv[4];
#pragma unroll
            for (int q = 0; q < 4; ++q) mv[q] = *(const f32x4*)(m + q * 256 + c.lane * 4);
#pragma unroll
            for (int q = 0; q < 4; ++q) {
                const int col = q * 256 + c.lane * 4;
                const f32x4 v = xv[k][q];
                ss += v[0] * v[0] + v[1] * v[1] + v[2] * v[2] + v[3] * v[3];
                const f32x4 o = v * nwv[q] * (mv[q] + 1.0f);
                u32x2 w; w.x = pk2(o[0], o[1]); w.y = pk2(o[2], o[3]);
                *(u32x2*)(XG + (size_t)row * D + col) = w;
            }
            ss = wave_sum(ss);
            if (c.lane < 16) RSS[(size_t)row * 16 + c.lane] = c.lane == 0 ? ss : 0.f;
        }
        }
    }
}

__device__ __forceinline__ void phase_norm(const Ctx& c, const float* nw, const float* mod  , int off_shift, int off_scale, bool final_norm) {
    const Args __attribute__((address_space(4)))& a = *c.a;
    const int gw = c.vb * NWAVE + c.wid, NGW = c.G * NWAVE;
    bf16_t* H = (bf16_t*)(a.ws + WS_H);
    f32x4 wfin[4];
#pragma unroll
    for (int j = 0; j < 4; ++j) wfin[j] = *(const f32x4*)(nw + j * 256 + c.lane * 4);
    for (int row = gw; row < NTOK; row += NGW) {
        float* xr = a.out + (size_t)row * D;
        f32x4 v[4]; float ss = 0.f;
#pragma unroll
        for (int j = 0; j < 4; ++j) { v[j] = *(const f32x4*)(xr + j * 256 + c.lane * 4); ss += v[j][0] * v[j][0] + v[j][1] * v[j][1] + v[j][2] * v[j][2] + v[j][3] * v[j][3]; }
        ss = wave_sum(ss);
        const float rstd = rsqrtf(ss * (1.0f / D) + EPS);
        if (final_norm) {
#pragma unroll
            for (int j = 0; j < 4; ++j) *(f32x4*)(xr + j * 256 + c.lane * 4) = v[j] * rstd * wfin[j];
        } else {
            const float* m = mod + cond_of(row) * 6144;
#pragma unroll
            for (int j = 0; j < 4; ++j) {
                const int col = j * 256 + c.lane * 4;
                const f32x4 w = *(const f32x4*)(nw + col), sc = *(const f32x4*)(m + off_scale + col), sh = *(const f32x4*)(m + off_shift + col);
                const f32x4 h = v[j] * rstd * w * (sc + 1.0f) + sh;
                u32x2 o; o.x = pk2(h[0], h[1]); o.y = pk2(h[2], h[3]);
                *(u32x2*)(H + (size_t)row * D + col) = o;
            }
        }
    }
}

constexpr int RS_OFF = 3 * GT<5>::STAGE;
struct FillRstd { float* tab; const float* RSS; int tok0, ntok, tid;
    __device__ __forceinline__ void operator()() const {
        if (tid < ntok) {
            const float* p = RSS + (size_t)(tok0 + tid) * 16;
            float s = 0.f;
#pragma unroll
            for (int q = 0; q < 4; ++q) { const f32x4 v = *(const f32x4*)(p + q * 4); s += (v[0] + v[1]) + (v[2] + v[3]); }
            tab[tid] = rsqrtf(s * (1.0f / D) + EPS);
        }
    }
};
__device__ __forceinline__ FillRstd fill_rstd(const Ctx& c, int tok0, int ntok) { return FillRstd{(float*)(c.lds + RS_OFF), (const float*)(c.a->ws + WS_RSS), tok0, ntok, c.tid}; }
__device__ __forceinline__ void rstd_table_one(const Ctx& c, int i, int ntok, int tok0) {
    float* tab = (float*)(c.lds + RS_OFF);
    const float* RSS = (const float*)(c.a->ws + WS_RSS);
    if (c.tid < ntok) {
        const float* p = RSS + (size_t)(tok0 + c.tid) * 16;
        float s = 0.f;
#pragma unroll
        for (int q = 0; q < 4; ++q) { const f32x4 v = *(const f32x4*)(p + q * 4); s += (v[0] + v[1]) + (v[2] + v[3]); }
        tab[i * ntok + c.tid] = rsqrtf(s * (1.0f / D) + EPS);
    }
}
__device__ __forceinline__ void rstd_tables(const Ctx& c, int n, int ntok, int first, int stride, int toks_per_rt, int shift_rt  ) {
    float* tab = (float*)(c.lds + RS_OFF);
    const float* RSS = (const float*)(c.a->ws + WS_RSS);
    for (int i = 0; i < n; ++i) {
        const int t = first + i * stride, rt = shift_rt < 0 ? t / (-shift_rt) : (t >> shift_rt);
        if (c.tid < ntok) {
            const float* p = RSS + (size_t)(rt * toks_per_rt + c.tid) * 16;
            float s = 0.f;
#pragma unroll
            for (int q = 0; q < 4; ++q) { const f32x4 v = *(const f32x4*)(p + q * 4); s += (v[0] + v[1]) + (v[2] + v[3]); }
            tab[i * ntok + c.tid] = rsqrtf(s * (1.0f / D) + EPS);
        }
    }
}
__device__ __forceinline__ void patch_tile(const Ctx& c, int i, int NC, int& rt, int& ct) {
    if (c.G == 256) { const int x = c.vb >> 5, l = c.vb & 31, p = i * 8 + x, PC = NC >> 2, pr = p / PC, pc = p - pr * PC; rt = pr * 8 + (l >> 2); ct = pc * 4 + (l & 3); }
    else { const int t = c.vb + i * c.G; rt = t / NC; ct = t - rt * NC; }
}
struct ProbInProj {
    static constexpr int EPI_STORES = 10;
    const Ctx* c; const bf16_t* W; const bf16_t* XG; int lda, ldb, K; int j;
    static constexpr int NC = NZX / 256, NT = (NTOK / 160) * NC;
    __device__ __forceinline__ int count() const { return (NT - c->vb + c->G - 1) / c->G; }
    __device__ __forceinline__ void tile(int i, const bf16_t*& A, const bf16_t*& B) const { int rt, ct; patch_tile(*c, i, NC, rt, ct); A = W + (size_t)ct * 256 * D; B = XG + (size_t)rt * 160 * D; }
    __device__ __forceinline__ void pre_all() const { const int n = count(); for (int i = 0; i < n; ++i) { int rt, ct; patch_tile(*c, i, NC, rt, ct); rstd_table_one(*c, i, 160, rt * 160); } }
    __device__ __forceinline__ void preload(int i, f32x4 (&sw)[4], int wr, int fq) const {
        int rt, ct; patch_tile(*c, i, NC, rt, ct);
        if (cond_of(rt * 160) == cond_of(rt * 160 + 159)) {
            const float* p = (const float*)(c->a->ws + WS_SWIN) + (size_t)j * 3 * DPROJ + cond_of(rt * 160) * DPROJ + ct * 256 + wr * 64 + fq * 4;
#pragma unroll
            for (int q = 0; q < 4; ++q) sw[q] = *(const f32x4*)(p + q * 16);
        }
    }
    __device__ __forceinline__ void epilogue(int i, f32x4 (&acc)[4][5], const f32x4 (&sw)[4], int wr, int wc, int fr, int fq) const {
        int rt, ct; patch_tile(*c, i, NC, rt, ct); unsigned char* ws = c->a->ws;
        EpiInProj e{(bf16_t*)(ws + S_Z), (bf16_t*)(ws + S_RAW), (const float*)(c->lds + RS_OFF) + i * 160, rt * 160, (const float*)(ws + WS_SWIN) + (size_t)j * 3 * DPROJ, cond_of(rt * 160) == cond_of(rt * 160 + 159)};
        e(acc, sw, ct * 256 + wr * 64, rt * 160 + wc * 80, fr, fq);
    }
};
__device__ __forceinline__ void phase_inproj(const Ctx& c, int j) {
    ProbInProj P{&c, (const bf16_t*)(c.a->ws + WS_WIN) + (size_t)j * DPROJ * D, (const bf16_t*)(c.a->ws + WS_H), D, D, D, j};
    gemm_stream<5>(c, P);
}
struct ProbMlpUp {
    static constexpr int EPI_STORES = 10;
    const Ctx* c; const bf16_t* W; const bf16_t* XG; int lda, ldb, K; int layer;
    static constexpr int NC = DFF / 256, NT = (NTOK / 160) * NC;
    __device__ __forceinline__ int count() const { return (NT - c->vb + c->G - 1) / c->G; }
    __device__ __forceinline__ void tile(int i, const bf16_t*& A, const bf16_t*& B) const { int rt, ct; patch_tile(*c, i, NC, rt, ct); A = W + (size_t)ct * 256 * D; B = XG + (size_t)rt * 160 * D; }
    __device__ __forceinline__ void pre_all() const { const int n = count(); for (int i = 0; i < n; ++i) { int rt, ct; patch_tile(*c, i, NC, rt, ct); rstd_table_one(*c, i, 160, rt * 160); } }
    __device__ __forceinline__ void preload(int i, f32x4 (&sw)[4], int wr, int fq) const {
        int rt, ct; patch_tile(*c, i, NC, rt, ct);
        if (cond_of(rt * 160) == cond_of(rt * 160 + 159)) {
            const float* p = (const float*)(c->a->ws + WS_SWUP) + (size_t)layer * 3 * DFF + cond_of(rt * 160) * DFF + ct * 256 + wr * 64 + fq * 4;
#pragma unroll
            for (int q = 0; q < 4; ++q) sw[q] = *(const f32x4*)(p + q * 16);
        }
    }
    __device__ __forceinline__ void epilogue(int i, f32x4 (&acc)[4][5], const f32x4 (&sw)[4], int wr, int wc, int fr, int fq) const {
        int rt, ct; patch_tile(*c, i, NC, rt, ct); unsigned char* ws = c->a->ws;
        EpiMlpUp e{(bf16_t*)(ws + S_HID), (const float*)(c->lds + RS_OFF) + i * 160, rt * 160, (const float*)(ws + WS_SWUP) + (size_t)layer * 3 * DFF, cond_of(rt * 160) == cond_of(rt * 160 + 159)};
        e(acc, sw, ct * 256 + wr * 64, rt * 160 + wc * 80, fr, fq);
    }
};
__device__ __forceinline__ void phase_mlp_up(const Ctx& c, int layer) {
    ProbMlpUp P{&c, (const bf16_t*)(c.a->ws + WS_W1) + (size_t)layer * DFF * D, (const bf16_t*)(c.a->ws + WS_H), D, D, D, layer};
    gemm_stream<5>(c, P);
}
#ifndef BENCH_MODE
#define BENCH_MODE 0
#endif
__device__ __forceinline__ void phase_bench(const Ctx& c) {
    ProbMlpUp P{&c, (const bf16_t*)(c.a->ws + WS_W1), (const bf16_t*)(c.a->ws + WS_H), D, D, D, 0};
    gemm_stream<5, ProbMlpUp, BENCH_MODE>(c, P);
}
struct ProbResid {
    static constexpr int EPI_STORES = 0;
    const Ctx* c; const bf16_t* WT; const bf16_t* Act; int lda, ldb, K; const float* gate; const float* bias; const float* ssq; const float* nw_next; const float* scale_next; bool first;
    static constexpr int NC = D / 256, NT = (NTOK / 160) * NC;
    __device__ __forceinline__ int count() const { return (NT - c->vb + c->G - 1) / c->G; }
    __device__ __forceinline__ void tile(int i, const bf16_t*& A, const bf16_t*& B) const { const int t = c->vb + i * c->G, rt = t / NC, ct = t - rt * NC; A = WT + (size_t)ct * 256 * K; B = Act + (size_t)rt * 160 * K; }
    __device__ __forceinline__ void pre_all() const {
        if (!ssq) return;
        float* tab = (float*)(c->lds + RS_OFF);
        const int n = count();
        for (int i = 0; i < n; ++i) {
            const int t = c->vb + i * c->G, rt = t / NC;
            if (c->tid < 160) {
                const float* p = ssq + (size_t)(rt * 160 + c->tid) * 32;
                float s = 0.f;
#pragma unroll
                for (int q = 0; q < 8; ++q) { const f32x4 v = *(const f32x4*)(p + q * 4); s += v[0] + v[1] + v[2] + v[3]; }
                tab[i * 160 + c->tid] = rsqrtf(s * (1.0f / DI) + EPS);
            }
        }
    }
    __device__ __forceinline__ void preload(int, f32x4 (&)[4], int, int) const {}
    __device__ __forceinline__ void epilogue(int i, f32x4 (&acc)[4][5], const f32x4 (&)[4], int wr, int wc, int fr, int fq) const {
        const int t = c->vb + i * c->G, rt = t / NC, ct = t - rt * NC; unsigned char* ws = c->a->ws;
        EpiResid e{c->a->out, gate, bias, ssq ? (const float*)(c->lds + RS_OFF) + i * 160 : nullptr, rt * 160, first ? c->a->in[0] : nullptr, first ? c->a->in[1] : nullptr, nw_next ? (bf16_t*)(ws + WS_H) : nullptr, nw_next, scale_next, (float*)(ws + WS_RSS), (const float*)(ws + WS_ZERO)};
        e(acc, ct * 256 + wr * 64, rt * 160 + wc * 80, fr, fq);
    }
};
__device__ __forceinline__ void phase_resid_gemm(const Ctx& c, const bf16_t* WT, const bf16_t* Act, int K, const float* gate, const float* bias, const float* ssq, const float* nw_next, const float* scale_next, bool first) {
    ProbResid P{&c, WT, Act, K, K, K, gate, bias, ssq, nw_next, scale_next, first};
    gemm_stream<5>(c, P);
}
struct ProbF1 {
    static constexpr int EPI_STORES = 16;
    const Ctx* c; const bf16_t* XG; const bf16_t* T1; int lda, ldb, K; int j;
    static constexpr int NT = (NTOK / 256) * 16;
    __device__ __forceinline__ int count() const { return (NT - c->vb + c->G - 1) / c->G; }
    __device__ __forceinline__ void tile(int i, const bf16_t*& A, const bf16_t*& B) const { const int t = c->vb + i * c->G, rt = t >> 4, g = (t >> 2) & 3, ct = t & 3; A = XG + (size_t)rt * 256 * D + g * 256; B = T1 + (size_t)ct * 128 * 256; }
    __device__ __forceinline__ void pre_all() const { rstd_tables(*c, count(), 256, c->vb, c->G, 256, 4); }
    __device__ __forceinline__ void preload(int, f32x4 (&)[4], int, int) const {}
    __device__ __forceinline__ void epilogue(int i, f32x4 (&acc)[4][4], const f32x4 (&)[4], int wr, int wc, int fr, int fq) const {
        const int t = c->vb + i * c->G, rt = t >> 4, g = (t >> 2) & 3, ct = t & 3; unsigned char* ws = c->a->ws;
        EpiF1 e{(bf16_t*)(ws + S_UVT), g, (const float*)(c->lds + RS_OFF) + i * 256, rt * 256, (const float*)(ws + WS_SWF1) + (size_t)j * 3 * 2048};
        e(acc, rt * 256 + wr * 64, ct * 128 + wc * 64, fr, fq);
    }
};
__device__ __forceinline__ void phase_f1(const Ctx& c, int j) {
    ProbF1 P{&c, (const bf16_t*)(c.a->ws + WS_H), (const bf16_t*)(c.a->ws + WS_T1), D, 256, 256, j};
    gemm_stream<4>(c, P);
}
struct ProbF2L {
    static constexpr int EPI_STORES = 0;
    const Ctx* c; const bf16_t* UVT; const bf16_t* T2; bf16_t* F; int lda, ldb, K;
    __device__ __forceinline__ int count() const { return c->vb < 128 ? 1 : 0; }
    __device__ __forceinline__ void tile(int i, const bf16_t*& A, const bf16_t*& B) const { const int t = c->vb, s = t >> 6, nt = (t >> 4) & 3, kt = t & 15; A = UVT + (size_t)NCTX * 2048 + ((size_t)s * 1024 + nt * 256) * 2048; B = T2 + (size_t)kt * 64 * 2048; }
    __device__ __forceinline__ void pre_all() const {}
    __device__ __forceinline__ void preload(int, f32x4 (&)[4], int, int) const {}
    __device__ __forceinline__ void epilogue(int i, f32x4 (&acc)[4][2], const f32x4 (&)[4], int wr, int wc, int fr, int fq) const { const int t = c->vb, s = t >> 6, nt = (t >> 4) & 3, kt = t & 15; EpiF2<2> e{F, NCTX + s * 1024}; e(acc, nt * 256 + wr * 64, kt * 64 + wc * 32, fr, fq); }
};
struct ProbF2C {
    static constexpr int EPI_STORES = 16;
    const Ctx* c; const bf16_t* UVT; const bf16_t* T2; bf16_t* F; int lda, ldb, K; int first, stride;
    __device__ __forceinline__ int count() const { return (256 - first + stride - 1) / stride; }
    __device__ __forceinline__ void tile(int i, const bf16_t*& A, const bf16_t*& B) const { const int u = first + i * stride, s = u >> 3, nt = (u >> 1) & 3, kt = u & 1; A = UVT + ((size_t)s * 1024 + nt * 256) * 512; B = T2 + (size_t)kt * 128 * 512; }
    __device__ __forceinline__ void pre_all() const {}
    __device__ __forceinline__ void preload(int, f32x4 (&)[4], int, int) const {}
    __device__ __forceinline__ void epilogue(int i, f32x4 (&acc)[4][4], const f32x4 (&)[4], int wr, int wc, int fr, int fq) const { const int u = first + i * stride, s = u >> 3, nt = (u >> 1) & 3, kt = u & 1; EpiF2<4> e{F, s * 256}; e(acc, nt * 256 + wr * 64, kt * 128 + wc * 64, fr, fq); }
};
__device__ __forceinline__ void phase_f2(const Ctx& c) {
    unsigned char* ws = c.a->ws;
    const int half = c.G >> 1;
    if (c.vb < half) { ProbF2L P{&c, (const bf16_t*)(ws + S_UVT), (const bf16_t*)(ws + WS_T2L), (bf16_t*)(ws + S_F), 2048, 2048, 2048}; gemm_stream<2>(c, P); }
    else { ProbF2C P{&c, (const bf16_t*)(ws + S_UVT), (const bf16_t*)(ws + WS_T2C), (bf16_t*)(ws + S_F), 512, 512, 512, c.vb - half, c.G - half}; gemm_stream<4>(c, P); }
}

struct ProbDt {
    static constexpr int EPI_STORES = 0;
    const Ctx* c; const bf16_t* XG; const bf16_t* W; int lda, ldb, K; int j;
    __device__ __forceinline__ int count() const { return (NTOK / 256 - c->vb + c->G - 1) / c->G; }
    __device__ __forceinline__ void tile(int i, const bf16_t*& A, const bf16_t*& B) const { const int t = c->vb + i * c->G; A = XG + (size_t)t * 256 * D; B = W; }
    __device__ __forceinline__ void pre_all() const { rstd_tables(*c, count(), 256, c->vb, c->G, 256, 0); }
    __device__ __forceinline__ void preload(int, f32x4 (&)[4], int, int) const {}
    __device__ __forceinline__ void epilogue(int i, f32x4 (&acc)[4][2], const f32x4 (&)[4], int wr, int wc, int fr, int fq) const {
        const int t = c->vb + i * c->G; unsigned char* ws = c->a->ws;
        EpiDt e{(float*)(ws + S_DT), (const float*)(c->lds + RS_OFF) + i * 256, t * 256, (const float*)(ws + WS_SWIN) + (size_t)j * 3 * DPROJ};
        e(acc, t * 256 + wr * 64, wc * 32, fr, fq);
    }
};
__device__ __forceinline__ void phase_conv(const Ctx& c, int j) {
    const Args __attribute__((address_space(4)))& a = *c.a;
    {
        ProbDt P{&c, (const bf16_t*)(a.ws + WS_H), (const bf16_t*)(a.ws + WS_WIN) + (size_t)j * DPROJ * D + (size_t)NZX * D, D, D, D, j};
        gemm_stream<2>(c, P);
    }
    const bf16_t* RAW = (const bf16_t*)(a.ws + S_RAW);
    bf16_t* XBC = (bf16_t*)(a.ws + S_XBC);
    const float* cw = a.in[10] + (size_t)j * 3 * DXBC;
    const float* cb = a.in[11] + (size_t)j * DXBC;
    constexpr int NIT = (NTOK / 64) * 3;
    for (int it = c.G - 1 - c.vb; it < NIT; it += c.G) {
        const int tg = it / 3, third = it - tg * 3;
        const int ch = third * 1024 + (c.tid & 127) * 8;
        const int r0 = tg * 64 + (c.tid >> 7) * 16;
        float w0[8], w1[8], w2[8], bb[8];
#pragma unroll
        for (int q = 0; q < 2; ++q) {
            const f32x4 t0 = *(const f32x4*)(cw + ch + q * 4), t1 = *(const f32x4*)(cw + DXBC + ch + q * 4), t2 = *(const f32x4*)(cw + 2 * DXBC + ch + q * 4), t3 = *(const f32x4*)(cb + ch + q * 4);
#pragma unroll
            for (int e = 0; e < 4; ++e) { w0[q * 4 + e] = t0[e]; w1[q * 4 + e] = t1[e]; w2[q * 4 + e] = t2[e]; bb[q * 4 + e] = t3[e]; }
        }
        const int seg = r0 < NCTX ? 256 : 64;
        u32x4 rows[18];
        {
            const int tl = (r0 % seg) != 0 ? r0 - 1 : r0, th = ((r0 + 16) % seg) != 0 ? r0 + 16 : r0 + 15;
            rows[0] = *(const u32x4*)(RAW + (size_t)tl * DXBC + ch);
#pragma unroll
            for (int r = 0; r < 16; ++r) rows[r + 1] = *(const u32x4*)(RAW + (size_t)(r0 + r) * DXBC + ch);
            rows[17] = *(const u32x4*)(RAW + (size_t)th * DXBC + ch);
            if ((r0 % seg) == 0) rows[0] = (u32x4){0, 0, 0, 0};
            if (((r0 + 16) % seg) == 0) rows[17] = (u32x4){0, 0, 0, 0};
        }
#pragma unroll
        for (int r = 0; r < 16; ++r) {
            const int t = r0 + r;
            const u32x4 prev = rows[r], cur = rows[r + 1], nxt = rows[r + 2];
            u32x4 o;
#pragma unroll
            for (int e = 0; e < 4; ++e) {
                const float lo = bb[2 * e] + w0[2 * e] * bflo(prev[e]) + w1[2 * e] * bflo(cur[e]) + w2[2 * e] * bflo(nxt[e]);
                const float hi = bb[2 * e + 1] + w0[2 * e + 1] * bfhi(prev[e]) + w1[2 * e + 1] * bfhi(cur[e]) + w2[2 * e + 1] * bfhi(nxt[e]);
                o[e] = pk2(silu_f(lo), silu_f(hi));
            }
            *(u32x4*)(XBC + (size_t)t * DXBC + ch) = o;
        }
    }
}

constexpr int SC_XS = 0, SC_XW = 16384, SC_BS = 32768, SC_CS = 49152, SC_HT = 65536, SC_SM = 98304;
__device__ __forceinline__ int off128(int row, int col) { return row * 128 + ((((col >> 3) ^ (row & 7))) << 4) + (col & 7) * 2; }
__device__ __forceinline__ int off256(int row, int col) { return row * 256 + ((((col >> 3) ^ (row & 15))) << 4) + (col & 7) * 2; }
__device__ __forceinline__ int offX(int row, int col) { return row * 128 + col * 2; }
__device__ __forceinline__ int offP(int row, int col) { return row * 144 + col * 2; }
template <int LAY>
__device__ __forceinline__ bf16x8 tr_frag(const char* tile, int r0, int r1, int col0, int lane) {
    const int i = lane & 15, q = i >> 2, cc = col0 + (i & 3) * 4;
    const int o0 = LAY == 1 ? off256(r0 + q, cc) : LAY == 2 ? offP(r0 + q, cc) : offX(r0 + q, cc);
    const int o1 = LAY == 1 ? off256(r1 + q, cc) : LAY == 2 ? offP(r1 + q, cc) : offX(r1 + q, cc);
    const bf16x4 lo = __builtin_amdgcn_ds_read_tr16_b64_v4i16((LAS bf16x4*)(tile + o0));
    const bf16x4 hi = __builtin_amdgcn_ds_read_tr16_b64_v4i16((LAS bf16x4*)(tile + o1));
    return __builtin_shufflevector(lo, hi, 0, 1, 2, 3, 4, 5, 6, 7);
}

struct ScanStep { int seq, hp, dir, ci, nch, t0, valid, single, h0; };
struct ScanIter {
    int vb, G, k, dir, ci;
    __device__ __forceinline__ void get(ScanStep& s) const {
        int seq, hp, ok, single = 0, h0 = 0;
        if (vb < 64) { seq = 32 + (vb >> 5); h0 = vb & 31; hp = h0 >> 1; single = 1; ok = (k == 0); }
        else { const int u = (vb - 64) + k * (G - 64); seq = u >> 4; hp = u & 15; ok = (u < 512); }
        const bool lat = seq >= 32;
        s.seq = seq; s.hp = hp; s.dir = dir; s.ci = ci; s.nch = lat ? 16 : 4; s.valid = ok; s.single = single; s.h0 = h0;
        const int tok0 = lat ? NCTX + (seq - 32) * 1024 : seq * 256;
        const int ch = dir == 0 ? ci : s.nch - 1 - ci;
        s.t0 = tok0 + ch * 64;
    }
    __device__ __forceinline__ void advance() {
        int seq; if (vb < 64) seq = 32; else seq = 0;
        const int nch = seq >= 32 ? 16 : 4;
        if (++ci == nch) { ci = 0; if (++dir == 2) { dir = 0; ++k; } }
    }
};
constexpr int SCB = 49152;
constexpr int SB_XS = 0, SB_BS = 16384, SB_CS = 32768;
constexpr int XW_BYTES = 64 * 144, HT_BYTES = 128 * 144;
constexpr int SCN_XW = 2 * SCB, SCN_HT = SCN_XW + 2 * XW_BYTES, SCN_SM = SCN_HT + 2 * HT_BYTES;

__device__ __forceinline__ void scan_issue_tiles(const Ctx& c, const ScanStep& s, int buf) {
    const bf16_t* XBC = (const bf16_t*)(c.a->ws + S_XBC);
    char* base = c.lds + buf * SCB;
    const int lane = c.lane, w8 = c.wid, g = s.hp >> 2;
#pragma unroll
    for (int hh = 0; hh < 2; ++hh) {
        if (hh == 1 && s.single) break;
        const int q = w8, row = q * 8 + (lane >> 3), lch = lane & 7, hd = s.single ? s.h0 : 2 * s.hp + hh;
        __builtin_amdgcn_global_load_lds((const unsigned*)(XBC + (size_t)(s.t0 + row) * DXBC + hd * 64 + lch * 8), (LAS unsigned*)(base + SB_XS + hh * 8192 + q * 1024 + lane * 16), 16, 0, 0);
    }
#pragma unroll
    for (int i = 0; i < 2; ++i) {
        const int q = w8 + 8 * i, row = q * 4 + (lane >> 4), lch = (lane & 15) ^ (row & 15);
        __builtin_amdgcn_global_load_lds((const unsigned*)(XBC + (size_t)(s.t0 + row) * DXBC + DI + g * 128 + lch * 8), (LAS unsigned*)(base + SB_BS + q * 1024 + lane * 16), 16, 0, 0);
        __builtin_amdgcn_global_load_lds((const unsigned*)(XBC + (size_t)(s.t0 + row) * DXBC + DI + 512 + g * 128 + lch * 8), (LAS unsigned*)(base + SB_CS + q * 1024 + lane * 16), 16, 0, 0);
    }
}
__device__ __forceinline__ float scan_load_dt(const Ctx& c, const ScanStep& s, int hw) {
    const float* DT = (const float*)(c.a->ws + S_DT);
    const int l = s.dir == 0 ? c.lane : 63 - c.lane, h = s.single ? s.h0 : 2 * s.hp + hw;
    return DT[(size_t)(s.t0 + l) * 64 + s.dir * NH + h];
}
__device__ __forceinline__ void scan_dtcs(const Ctx& c, const ScanStep& s, int hw, int j, float raw, float* sm) {
    const int lane = c.lane, l = s.dir == 0 ? lane : 63 - lane, h = s.single ? s.h0 : 2 * s.hp + hw;
    const float Aneg = -__expf(c.a->in[13][(j * 2 + s.dir) * NH + h]);
    raw += c.a->in[12][(j * 2 + s.dir) * NH + h];
    const float dt = raw > 20.f ? raw : __logf(1.0f + __expf(raw));
    float cs = dt * Aneg;
#pragma unroll
    for (int o = 1; o < 64; o <<= 1) { const float u = __shfl_up(cs, o); if (lane >= o) cs += u; }
    sm[l] = dt; sm[64 + l] = cs;
    if (lane == 63) sm[128] = cs;
}

__device__ __forceinline__ void phase_scan_pipe(const Ctx& c, int j) {
    const Args __attribute__((address_space(4)))& a = *c.a;
    const bf16_t* Z = (const bf16_t*)(a.ws + S_Z);
    bf16_t* YTMP = (bf16_t*)(a.ws + S_RAW);
    bf16_t* YG = (bf16_t*)(a.ws + S_YG);
    float* SSQ = (float*)(a.ws + S_SSQ);
    const int hw = c.wid >> 2, w = c.wid & 3;
    char* lds = c.lds;
    char* XWp = lds + SCN_XW + hw * XW_BYTES; char* HTp = lds + SCN_HT + hw * HT_BYTES;

    ScanIter it{c.vb, c.G, 0, 0, 0};
    ScanStep cur, nxt, nx2;
    it.get(cur); it.advance(); it.get(nxt); it.advance(); it.get(nx2);
    if (!cur.valid) return;
    scan_issue_tiles(c, cur, 0);
    float raw_n1 = 0.f;
    if (w == 0 && !(cur.single && hw == 1)) {
        const float r0 = scan_load_dt(c, cur, hw);
        if (nxt.valid) raw_n1 = scan_load_dt(c, nxt, hw);
        scan_dtcs(c, cur, hw, j, r0, (float*)(lds + SCN_SM + (0 * 2 + hw) * 1024));
    }
    f32x4 S[4][2];
#pragma unroll
    for (int pb = 0; pb < 4; ++pb)
#pragma unroll
        for (int nbi = 0; nbi < 2; ++nbi) S[pb][nbi] = (f32x4){0.f, 0.f, 0.f, 0.f};

#pragma unroll 1
    for (int s = 0; cur.valid; ++s) {
        int lane = c.lane; asm volatile("" : "+v"(lane));
        const int fr = lane & 15, fq = lane >> 4;
        const int b = s & 1;
        char* TB_ = lds + b * SCB;
        char* XSp = TB_ + SB_XS + hw * 8192;
        const float* sm_dt = (const float*)(lds + SCN_SM + (b * 2 + hw) * 1024);
        const float* sm_cs = sm_dt + 64;
        const bool is_lat = cur.seq >= 32;
        const bool active = !(cur.single && hw == 1);
        const int dir = cur.dir, t0 = cur.t0, h = cur.single ? cur.h0 : 2 * cur.hp + hw;
        asm volatile("s_waitcnt vmcnt(0)" ::: "memory");
        __syncthreads();
        if (nxt.valid) scan_issue_tiles(c, nxt, b ^ 1);
        float raw_n2 = 0.f;
        if (w == 0 && nx2.valid && !(nx2.single && hw == 1)) raw_n2 = scan_load_dt(c, nx2, hw);
        u32x2 yt[4], zz[4]; f32x4 nwv[4]; float Dh = 0.f;
        const int tok = t0 + w * 16 + fr;
        if (dir == 1 && active) {
            Dh = a.in[14][j * NH + h];
            const float* normw = a.in[15] + (size_t)j * DI + h * 64;
#pragma unroll
            for (int pb = 0; pb < 4; ++pb) {
                const int p0 = pb * 16 + fq * 4;
                yt[pb] = *(const u32x2*)(YTMP + (size_t)tok * DI + h * 64 + p0);
                zz[pb] = *(const u32x2*)(Z + (size_t)tok * DI + h * 64 + p0);
                nwv[pb] = *(const f32x4*)(normw + p0);
            }
        }
        bool has_h = is_lat || cur.ci > 0;
        if (cur.ci == 0) {
            if (is_lat) {
                if (active) {
                const float* sp = a.in[2] + ((size_t)(((cur.seq - 32) * 2 + j) * 2 + dir) * NH + h) * 8192;
#pragma unroll
                for (int pb = 0; pb < 4; ++pb)
#pragma unroll
                    for (int nbi = 0; nbi < 2; ++nbi) {
                        const int n = (2 * w + nbi) * 16 + fr, p0 = pb * 16 + fq * 4;
#pragma unroll
                        for (int r = 0; r < 4; ++r) S[pb][nbi][r] = sp[(p0 + r) * 128 + n];
                        u32x2 v; v.x = pk2(S[pb][nbi][0], S[pb][nbi][1]); v.y = pk2(S[pb][nbi][2], S[pb][nbi][3]);
                        *(u32x2*)(HTp + offP(n, p0)) = v;
                    }
                }
                __syncthreads();
            } else {
#pragma unroll
                for (int pb = 0; pb < 4; ++pb)
#pragma unroll
                    for (int nbi = 0; nbi < 2; ++nbi) S[pb][nbi] = (f32x4){0.f, 0.f, 0.f, 0.f};
            }
        }
        float tot = 0.f;
        if (active) {
        tot = sm_dt[128];
        {
            const int tl = c.tid & 255, l = tl >> 2, c0 = (tl & 3) * 16;
            const float sc = __expf(tot - sm_cs[l]) * sm_dt[l];
#pragma unroll
            for (int q = 0; q < 2; ++q) {
                const u32x4 v = *(const u32x4*)(XSp + offX(l, c0 + q * 8));
                u32x4 r;
#pragma unroll
                for (int e = 0; e < 4; ++e) r[e] = pk2(bflo(v[e]) * sc, bfhi(v[e]) * sc);
                *(u32x4*)(XWp + offP(l, c0 + q * 8)) = r;
            }
        }
        bf16x8 cf[4];
#pragma unroll
        for (int kk = 0; kk < 4; ++kk) cf[kk] = *(const bf16x8*)(TB_ + SB_CS + off256(w * 16 + fr, kk * 32 + fq * 8));
        const float csl = sm_cs[w * 16 + fr];
        f32x4 yacc[4];
#pragma unroll
        for (int pb = 0; pb < 4; ++pb) yacc[pb] = (f32x4){0.f, 0.f, 0.f, 0.f};
        if (has_h) {
            bf16x8 hf[2][4];
#pragma unroll
            for (int pb = 0; pb < 4; ++pb) hf[0][pb] = tr_frag<2>(HTp, fq * 8, fq * 8 + 4, pb * 16, lane);
#pragma unroll
            for (int kk = 0; kk < 4; ++kk) {
                if (kk < 3) {
#pragma unroll
                    for (int pb = 0; pb < 4; ++pb) hf[(kk + 1) & 1][pb] = tr_frag<2>(HTp, (kk + 1) * 32 + fq * 8, (kk + 1) * 32 + fq * 8 + 4, pb * 16, lane);
                }
                __builtin_amdgcn_sched_barrier(0);
#pragma unroll
                for (int pb = 0; pb < 4; ++pb) yacc[pb] = __builtin_amdgcn_mfma_f32_16x16x32_bf16(hf[kk & 1][pb], cf[kk], yacc[pb], 0, 0, 0);
            }
            const float e = __expf(csl);
#pragma unroll
            for (int pb = 0; pb < 4; ++pb) yacc[pb] = yacc[pb] * e;
        }
#pragma unroll
        for (int kk2 = 0; kk2 < 2; ++kk2) {
            const bool need = dir == 0 ? (2 * kk2 <= w) : (2 * kk2 + 1 >= w);
            if (need) {
                unsigned m[4];
                bf16x8 bfg[2][4];
                f32x4 gg[2];
#pragma unroll
                for (int half = 0; half < 2; ++half)
#pragma unroll
                    for (int kk = 0; kk < 4; ++kk) bfg[half][kk] = *(const bf16x8*)(TB_ + SB_BS + off256((2 * kk2 + half) * 16 + fr, kk * 32 + fq * 8));
                bf16x8 xf[4];
#pragma unroll
                for (int pb = 0; pb < 4; ++pb) xf[pb] = tr_frag<0>(XSp, 32 * kk2 + 4 * fq, 32 * kk2 + 16 + 4 * fq, pb * 16, lane);
                __builtin_amdgcn_sched_barrier(0);
                gg[0] = (f32x4){0.f, 0.f, 0.f, 0.f}; gg[1] = (f32x4){0.f, 0.f, 0.f, 0.f};
#pragma unroll
                for (int kk = 0; kk < 4; ++kk)
#pragma unroll
                    for (int half = 0; half < 2; ++half) gg[half] = __builtin_amdgcn_mfma_f32_16x16x32_bf16(bfg[half][kk], cf[kk], gg[half], 0, 0, 0);
#pragma unroll
                for (int half = 0; half < 2; ++half) {
                    const int sb = 2 * kk2 + half;
                    const f32x4 gacc = gg[half];
                    const f32x4 css = *(const f32x4*)(sm_cs + sb * 16 + fq * 4);
                    const f32x4 dts = *(const f32x4*)(sm_dt + sb * 16 + fq * 4);
                    float v[4];
#pragma unroll
                    for (int r = 0; r < 4; ++r) {
                        const int si = sb * 16 + fq * 4 + r, l = w * 16 + fr;
                        const bool valid = dir == 0 ? (si <= l) : (si >= l);
                        v[r] = valid ? gacc[r] * __expf(csl - css[r]) * dts[r] : 0.f;
                    }
                    m[half * 2 + 0] = pk2(v[0], v[1]); m[half * 2 + 1] = pk2(v[2], v[3]);
                }
                union { unsigned u[4]; bf16x8 v; } mf; mf.u[0] = m[0]; mf.u[1] = m[1]; mf.u[2] = m[2]; mf.u[3] = m[3];
#pragma unroll
                for (int pb = 0; pb < 4; ++pb) yacc[pb] = __builtin_amdgcn_mfma_f32_16x16x32_bf16(xf[pb], mf.v, yacc[pb], 0, 0, 0);
            }
        }
        {
            const int l = w * 16 + fr;
            if (dir == 0) {
                u32x2 v[4];
#pragma unroll
                for (int pb = 0; pb < 4; ++pb) { v[pb].x = pk2(yacc[pb][0], yacc[pb][1]); v[pb].y = pk2(yacc[pb][2], yacc[pb][3]); }
#pragma unroll
                for (int p = 0; p < 2; ++p) {
                    const u32x4 o = pair16(v[2 * p], v[2 * p + 1]);
                    *(u32x4*)(YTMP + (size_t)tok * DI + h * 64 + (2 * p + (fq & 1)) * 16 + (fq & 2) * 4) = o;
                }
            } else {
                float ss = 0.f;
                u32x2 v[4];
#pragma unroll
                for (int pb = 0; pb < 4; ++pb) {
                    const int p0 = pb * 16 + fq * 4;
                    const u32x2 xx = *(const u32x2*)(XSp + offX(l, p0));
                    const f32x4 nw = nwv[pb];
                    float y[4];
                    y[0] = yacc[pb][0] + bflo(yt[pb].x) + Dh * bflo(xx.x); y[1] = yacc[pb][1] + bfhi(yt[pb].x) + Dh * bfhi(xx.x);
                    y[2] = yacc[pb][2] + bflo(yt[pb].y) + Dh * bflo(xx.y); y[3] = yacc[pb][3] + bfhi(yt[pb].y) + Dh * bfhi(xx.y);
                    y[0] *= silu_f(bflo(zz[pb].x)); y[1] *= silu_f(bfhi(zz[pb].x)); y[2] *= silu_f(bflo(zz[pb].y)); y[3] *= silu_f(bfhi(zz[pb].y));
                    ss += y[0] * y[0] + y[1] * y[1] + y[2] * y[2] + y[3] * y[3];
                    v[pb].x = pk2(y[0] * nw[0], y[1] * nw[1]); v[pb].y = pk2(y[2] * nw[2], y[3] * nw[3]);
                }
#pragma unroll
                for (int p = 0; p < 2; ++p) {
                    const u32x4 o = pair16(v[2 * p], v[2 * p + 1]);
                    *(u32x4*)(YG + (size_t)tok * DI + h * 64 + (2 * p + (fq & 1)) * 16 + (fq & 2) * 4) = o;
                }
                ss += __shfl_xor(ss, 16); ss += __shfl_xor(ss, 32);
                if (fq == 0) SSQ[(size_t)tok * NH + h] = ss;
            }
        }
        }
        __syncthreads();
        if (active) {
            const float et = __expf(tot);
#pragma unroll
            for (int pb = 0; pb < 4; ++pb)
#pragma unroll
                for (int nbi = 0; nbi < 2; ++nbi) S[pb][nbi] = S[pb][nbi] * et;
            bf16x8 bq[2][2], xa[2][4];
#pragma unroll
            for (int kk = 0; kk < 2; ++kk) {
#pragma unroll
                for (int nbi = 0; nbi < 2; ++nbi) bq[kk][nbi] = tr_frag<1>(TB_ + SB_BS, kk * 32 + fq * 8, kk * 32 + fq * 8 + 4, (2 * w + nbi) * 16, lane);
#pragma unroll
                for (int pb = 0; pb < 4; ++pb) xa[kk][pb] = tr_frag<2>(XWp, kk * 32 + fq * 8, kk * 32 + fq * 8 + 4, pb * 16, lane);
            }
            __builtin_amdgcn_sched_barrier(0);
#pragma unroll
            for (int kk = 0; kk < 2; ++kk)
#pragma unroll
                for (int pb = 0; pb < 4; ++pb)
#pragma unroll
                    for (int nbi = 0; nbi < 2; ++nbi) S[pb][nbi] = __builtin_amdgcn_mfma_f32_16x16x32_bf16(xa[kk][pb], bq[kk][nbi], S[pb][nbi], 0, 0, 0);
#pragma unroll
            for (int pb = 0; pb < 4; ++pb)
#pragma unroll
                for (int nbi = 0; nbi < 2; ++nbi) {
                    const int n = (2 * w + nbi) * 16 + fr, p0 = pb * 16 + fq * 4;
                    u32x2 v; v.x = pk2(S[pb][nbi][0], S[pb][nbi][1]); v.y = pk2(S[pb][nbi][2], S[pb][nbi][3]);
                    *(u32x2*)(HTp + offP(n, p0)) = v;
                }
        }
        if (active && !is_lat && cur.ci == cur.nch - 1) {
            float* op = a.out + (size_t)NTOK * D + ((size_t)((cur.seq * 2 + j) * 2 + dir) * NH + h) * 8192;
#pragma unroll
            for (int pb = 0; pb < 4; ++pb)
#pragma unroll
                for (int nbi = 0; nbi < 2; ++nbi) {
                    const int n = (2 * w + nbi) * 16 + fr, p0 = pb * 16 + fq * 4;
#pragma unroll
                    for (int r = 0; r < 4; ++r) op[(p0 + r) * 128 + n] = S[pb][nbi][r];
                }
        }
        if (w == 0 && nxt.valid && !(nxt.single && hw == 1)) scan_dtcs(c, nxt, hw, j, raw_n1, (float*)(lds + SCN_SM + ((b ^ 1) * 2 + hw) * 1024));
        raw_n1 = raw_n2;
        cur = nxt; nxt = nx2; it.advance(); it.get(nx2);
    }
}

#if NAIVE_SCAN
__device__ __forceinline__ void scan_unit_naive(const Ctx& c, int j, int seq, int h) {
    const Args __attribute__((address_space(4)))& a = *c.a;
    const bf16_t* XBC = (const bf16_t*)(a.ws + S_XBC);
    const bf16_t* Z = (const bf16_t*)(a.ws + S_Z);
    const float* DT = (const float*)(a.ws + S_DT);
    bf16_t* YTMP = (bf16_t*)(a.ws + S_RAW);
    bf16_t* YG = (bf16_t*)(a.ws + S_YG);
    float* SSQ = (float*)(a.ws + S_SSQ);
    const bool is_lat = seq >= 32;
    const int tok0 = is_lat ? NCTX + (seq - 32) * 1024 : seq * 256;
    const int L = is_lat ? 1024 : 256;
    const int g = h >> 3, p = c.tid >> 2, nq = (c.tid & 3) * 32;
    const float Dh = a.in[14][j * NH + h];
    const float nw = a.in[15][(size_t)j * DI + h * 64 + p];
    float* red = (float*)c.lds;
    for (int dir = 0; dir < 2; ++dir) {
        const float Aneg = -__expf(a.in[13][(j * 2 + dir) * NH + h]);
        const float dtb = a.in[12][(j * 2 + dir) * NH + h];
        float hs[32];
        if (is_lat) { const float* sp = a.in[2] + ((size_t)(((seq - 32) * 2 + j) * 2 + dir) * NH + h) * 8192 + p * 128 + nq;
#pragma unroll
            for (int e = 0; e < 32; ++e) hs[e] = sp[e]; }
        else {
#pragma unroll
            for (int e = 0; e < 32; ++e) hs[e] = 0.f; }
        asm volatile("s_waitcnt vmcnt(0)" ::: "memory"); __syncthreads();
        for (int ti = 0; ti < L; ++ti) {
            const int tok = tok0 + (dir == 0 ? ti : L - 1 - ti);
            const float raw = DT[(size_t)tok * 64 + dir * NH + h] + dtb;
            const float dt = raw > 20.f ? raw : log1pf(__expf(raw));
            const float dec = __expf(dt * Aneg);
            const float xv = bflo((unsigned)XBC[(size_t)tok * DXBC + h * 64 + p]);
            const bf16_t* Bp = XBC + (size_t)tok * DXBC + DI + g * 128 + nq;
            const bf16_t* Cp = XBC + (size_t)tok * DXBC + DI + 512 + g * 128 + nq;
            float y = 0.f;
#pragma unroll
            for (int e = 0; e < 32; ++e) { hs[e] = hs[e] * dec + dt * xv * bflo((unsigned)Bp[e]); y += bflo((unsigned)Cp[e]) * hs[e]; }
            y += __shfl_xor(y, 1); y += __shfl_xor(y, 2);
            if (dir == 0) { if ((c.tid & 3) == 0) YTMP[(size_t)tok * DI + h * 64 + p] = (bf16_t)(pk2(y, 0.f) & 0xffff); }
            else {
                const float yt = bflo((unsigned)YTMP[(size_t)tok * DI + h * 64 + p]);
                const float zz = bflo((unsigned)Z[(size_t)tok * DI + h * 64 + p]);
                float yy = (y + yt + Dh * xv) * silu_f(zz);
                __syncthreads();
                if ((c.tid & 3) == 0) { red[p] = yy * yy; YG[(size_t)tok * DI + h * 64 + p] = (bf16_t)(pk2(yy * nw, 0.f) & 0xffff); }
                __syncthreads();
                if (c.tid == 0) { float s = 0.f; for (int e = 0; e < 64; ++e) s += red[e]; SSQ[(size_t)tok * NH + h] = s; }
            }
        }
        if (!is_lat) { float* op = a.out + (size_t)NTOK * D + ((size_t)((seq * 2 + j) * 2 + dir) * NH + h) * 8192 + p * 128 + nq;
#pragma unroll
            for (int e = 0; e < 32; ++e) op[e] = hs[e]; }
    }
}
#endif
__device__ __forceinline__ void phase_scan(const Ctx& c, int j) {
#if NAIVE_SCAN
    for (int u = c.vb; u < 1088; u += c.G) { if (u < 64) scan_unit_naive(c, j, 32 + (u >> 5), u & 31); else scan_unit_naive(c, j, (u - 64) >> 5, (u - 64) & 31); }
    return;
#endif
    phase_scan_pipe(c, j);
}

typedef const Args __attribute__((address_space(4)))* ArgsP;
#if 0
#define LB_WAVES 1
#else
#define LB_WAVES 2
#endif
__global__ void __launch_bounds__(NTHR, LB_WAVES) fwd_kernel(Args args) {
    extern __shared__ __attribute__((aligned(16))) char lds[];
    volatile LAS unsigned* st = (volatile LAS unsigned*)(lds + LDS_BYTES - 16);
    if (threadIdx.x == 0) { st[0] = 0u; st[1] = 0u; }
    __syncthreads();
    const int ph_lo = args.ph_lo, ph_hi = args.ph_hi;
    const bool multi = (ph_hi - ph_lo) > 1;
    XcdBarrier bar; bar.bar = (unsigned*)(args.ws + WS_CTL); bar.x = 0; bar.st = st;
    if (multi) bar = xcd_barrier_post((unsigned*)(args.ws + WS_CTL), st);

    int rep = 0;
#pragma unroll 1
    for (int ph = ph_lo; ph < ph_hi; ++ph) {
        ArgsP ap = (ArgsP)__builtin_amdgcn_kernarg_segment_ptr();
        asm volatile("" : "+s"(ap));
        int tid = threadIdx.x;
        asm volatile("" : "+v"(tid));
        Ctx c;
        c.lds = lds; c.tid = tid; c.lane = tid & 63; c.wid = __builtin_amdgcn_readfirstlane(tid >> 6);
        c.G = gridDim.x; c.vb = (c.G % 8 == 0) ? (int)(blockIdx.x % 8) * (c.G / 8) + (int)(blockIdx.x / 8) : (int)blockIdx.x;
        c.a = ap;
        unsigned char* ws = ap->ws;
        const float* MOD = (const float*)(ws + WS_MOD);

        int kind = 0;
        if (ph == 0) { if (PH_ON(0)) phase_prep(c); }
        else if (ph == 1) { kind = 12; phase_prep2(c); }
        else if (ph == NPHASE - 1) { kind = 10; if (PH_ON(1)) phase_norm(c, ap->in[21], nullptr, 0, 0, true); }
        else {
            int layer, sub;
            if (ph <= 7) { layer = 0; sub = ph - 2; } else if (ph <= 12) { layer = 1; sub = ph - 8; } else if (ph <= 18) { layer = 2; sub = ph - 13; } else { layer = 3; sub = ph - 19; }
            const int j = layer >> 1;
            const float* mod = MOD + (size_t)layer * 3 * 6144;
            const bool ssd = (layer & 1) == 0;
            const int nmix = ssd ? 4 : 3;
            if (sub < nmix - 1) kind = ssd ? (sub == 0 ? 2 : sub == 1 ? 3 : 4) : (sub == 0 ? 6 : 7);
            else if (sub == nmix) kind = 8;
            else kind = 5;

            if (kind == 2) { if (PH_ON(2)) phase_inproj(c, j); }
            else if (kind == 3) { if (PH_ON(3)) phase_conv(c, j); }
            else if (kind == 4) { if (PH_ON(4)) phase_scan(c, j); }
            else if (kind == 6) { if (PH_ON(6)) phase_f1(c, j); }
            else if (kind == 7) { if (PH_ON(7)) phase_f2(c); }
            else if (kind == 8) { if (PH_ON(8)) phase_mlp_up(c, layer); }
            else {
                if (PH_ON(5)) {
                    const bf16_t* WT; const bf16_t* Act; int K; const float* gate; const float* bias = nullptr; const float* ssq = nullptr;
                    const float* nw_next; const float* scale_next;
                    if (sub == nmix - 1) {
                        gate = mod + 2048; nw_next = ap->in[8] + layer * D; scale_next = mod + 4096;
                        if (ssd) { WT = (const bf16_t*)(ws + WS_WOUT) + (size_t)j * D * DI; Act = (const bf16_t*)(ws + S_YG); K = DI; ssq = (const float*)(ws + S_SSQ); }
                        else { WT = (const bf16_t*)(ws + WS_WFNO) + (size_t)j * D * D; Act = (const bf16_t*)(ws + S_F); K = D; bias = ap->in[18] + j * D; }
                    } else {
                        gate = mod + 5120; WT = (const bf16_t*)(ws + WS_W2) + (size_t)layer * D * DFF; Act = (const bf16_t*)(ws + S_HID); K = DFF;
                        if (layer < 3) { nw_next = ap->in[7] + (layer + 1) * D; scale_next = mod + 3 * 6144 + 1024; } else { nw_next = nullptr; scale_next = nullptr; }
                    }
                    if (rep > 0) { gate = (const float*)(ws + WS_ZERO); }
                    phase_resid_gemm(c, WT, Act, K, gate, bias, ssq, nw_next, scale_next, layer == 0 && sub == nmix - 1 && rep == 0);
                }
            }
        }
        if (REP_KIND == 9) { for (int r = 0; r < REP_N; ++r) if (multi) xcd_barrier(bar); }
        if (REP_N > 0 && kind == REP_KIND && rep < REP_N) { ++rep; --ph; if (multi) xcd_barrier(bar); continue; }
        rep = 0;
        if (REP_KIND == 11 && ph == NPHASE - 1) { for (int r = 0; r < REP_N; ++r) { if (multi) xcd_barrier(bar); phase_bench(c); } }
        if (ph + 1 < ph_hi) xcd_barrier(bar);
    }
}

extern "C" void kernel_launch(void* const* d_in, const int* in_sizes, int n_in, void* d_out, int out_size, void* d_ws, size_t ws_size, hipStream_t stream) {
    static int grid = 0;
    if (grid == 0) {
        int dev = 0, cus = 0;
        if (hipGetDevice(&dev) != hipSuccess || hipDeviceGetAttribute(&cus, hipDeviceAttributeMultiprocessorCount, dev) != hipSuccess || cus <= 0) { fprintf(stderr, "kernel_launch: device query failed\n"); grid = -1; return; }
        if (hipFuncSetAttribute((const void*)fwd_kernel, hipFuncAttributeMaxDynamicSharedMemorySize, LDS_BYTES) != hipSuccess) { fprintf(stderr, "kernel_launch: hipFuncSetAttribute failed\n"); }
        (void)hipGetLastError();
        if (ws_size < WS_END) fprintf(stderr, "kernel_launch: workspace too small: %zu < %zu\n", ws_size, (size_t)WS_END);
        grid = cus;
    }
    if (grid < 0) return;
    (void)hipMemsetAsync((char*)d_ws + WS_CTL, 0, CTL_BYTES, stream);
    Args a{};
    for (int i = 0; i < 22; ++i) a.in[i] = (const float*)d_in[i];
    a.out = (float*)d_out; a.ws = (unsigned char*)d_ws;
#if N_LAUNCH_MODE == 1
    a.ph_lo = 0; a.ph_hi = NPHASE;
    hipLaunchKernelGGL(fwd_kernel, dim3(grid), dim3(NTHR), LDS_BYTES, stream, a);
#else
    for (int ph = 0; ph < NPHASE; ++ph) {
        a.ph_lo = ph; a.ph_hi = ph + 1;
        hipLaunchKernelGGL(fwd_kernel, dim3(grid), dim3(NTHR), LDS_BYTES, stream, a);
    }
#endif
}
```

```cpp
#include <hip/hip_runtime.h>
#include <stdint.h>
#include <stdio.h>

#ifndef PH_MASK
#define PH_MASK 0xFFFF
#endif
#define PH_ON(k) ((PH_MASK >> (k)) & 1)
#ifndef NAIVE_GEMM
#define NAIVE_GEMM 0
#endif
#define GN(k) ((NAIVE_GEMM >> (k)) & 1)
#ifndef NAIVE_SCAN
#define NAIVE_SCAN 0
#endif
#ifndef REP_KIND
#define REP_KIND -1
#endif
#ifndef REP_N
#define REP_N 0
#endif
#ifndef GEMM_INTERLEAVE
#define GEMM_INTERLEAVE 0
#endif
#ifndef GEMM_SETPRIO
#define GEMM_SETPRIO 0
#endif
#ifndef N_LAUNCH_MODE
#define N_LAUNCH_MODE 1
#endif

typedef unsigned short bf16_t;
typedef short bf16x8 __attribute__((ext_vector_type(8)));
typedef short bf16x4 __attribute__((ext_vector_type(4)));
typedef float f32x4 __attribute__((ext_vector_type(4)));
typedef unsigned u32x4 __attribute__((ext_vector_type(4)));
typedef unsigned u32x2 __attribute__((ext_vector_type(2)));
#define LAS __attribute__((address_space(3)))

constexpr int D = 1024, NCTX = 8192, NLAT = 2048, NTOK = 10240;
constexpr int DI = 2048, DXBC = 3072, DPROJ = 5184, NZX = 5120, NH = 32, DFF = 4096;
constexpr float EPS = 1e-6f;
constexpr int NPHASE = 25;

constexpr size_t al256(size_t x) { return (x + 255) & ~(size_t)255; }
constexpr size_t WS_CTL  = 0;
constexpr size_t CTL_BYTES = 65536 + 81920;
constexpr size_t WS_ZERO = 65536;
constexpr size_t WS_MOD  = WS_CTL + CTL_BYTES;
constexpr size_t WS_SWIN = al256(WS_MOD + 4 * 3 * 6144 * 4);
constexpr size_t WS_SWUP = WS_SWIN + 2 * 3 * DPROJ * 4;
constexpr size_t WS_SWF1 = WS_SWUP + 4 * 3 * DFF * 4;
constexpr size_t WS_RSS  = al256(WS_SWF1 + 2 * 3 * 2048 * 4);
constexpr size_t WS_WIN  = al256(WS_RSS + (size_t)NTOK * 16 * 4);
constexpr size_t WS_WOUT = WS_WIN + (size_t)2 * DPROJ * D * 2;
constexpr size_t WS_WFNO = WS_WOUT + (size_t)2 * D * DI * 2;
constexpr size_t WS_W1   = WS_WFNO + (size_t)2 * D * D * 2;
constexpr size_t WS_W2   = WS_W1 + (size_t)4 * DFF * D * 2;
constexpr size_t WS_T1   = WS_W2 + (size_t)4 * DFF * D * 2;
constexpr size_t WS_T2C  = WS_T1 + (size_t)512 * 256 * 2;
constexpr size_t WS_T2L  = WS_T2C + (size_t)256 * 512 * 2;
constexpr size_t WS_H    = WS_T2L + (size_t)1024 * 2048 * 2;
constexpr size_t WS_S    = WS_H + (size_t)NTOK * D * 2;
constexpr size_t S_Z     = WS_S;
constexpr size_t S_XBC   = S_Z + (size_t)NTOK * DI * 2;
constexpr size_t S_DT    = S_XBC + (size_t)NTOK * DXBC * 2;
constexpr size_t S_SSQ   = S_DT + (size_t)NTOK * 64 * 4;
constexpr size_t S_YG    = S_SSQ + (size_t)NTOK * 32 * 4;
constexpr size_t S_RAW   = S_YG + (size_t)NTOK * DI * 2;
constexpr size_t WS_END  = S_RAW + (size_t)NTOK * DXBC * 2;
constexpr size_t S_HID   = WS_S;
constexpr size_t S_UVT   = WS_S;
constexpr size_t S_F     = WS_S + (size_t)NTOK * 2048 * 2;

constexpr int LDS_BYTES = 163840;
constexpr int NTHR = 512, NWAVE = 8;

typedef __bf16 bf16x2_t __attribute__((ext_vector_type(2)));
typedef float f32x2_t __attribute__((ext_vector_type(2)));
__device__ __forceinline__ unsigned pk2(float lo, float hi) { const f32x2_t f = {lo, hi}; return __builtin_bit_cast(unsigned, __builtin_convertvector(f, bf16x2_t)); }
__device__ __forceinline__ float bflo(unsigned u) { return __uint_as_float(u << 16); }
__device__ __forceinline__ float bfhi(unsigned u) { return __uint_as_float(u & 0xffff0000u); }
__device__ __forceinline__ float wave_sum(float v) {
#pragma unroll
    for (int o = 1; o < 64; o <<= 1) v += __shfl_xor(v, o);
    return v;
}
__device__ __forceinline__ float silu_f(float x) { return x * __builtin_amdgcn_rcpf(1.0f + __expf(-x)); }
__device__ __forceinline__ int cond_of(int tok) { return tok < NCTX ? 0 : (tok < NCTX + 1024 ? 1 : 2); }

#define XB_TMO      128
#define XB_XCNT(j)  (256  + 64 * (j))
#define XB_XSUB(j)  (1280 + 64 * (j))
#define XB_XGEN(j)  (2304 + 64 * (j))
#define XB_TOP      3328
#define XB_TOPGEN   3392
#define XCD_BAR_WORDS 3456
#define XB_SPIN_CAP (1u << 20)
__device__ __forceinline__ unsigned xb_ld(unsigned* p)              { return __hip_atomic_load(p, __ATOMIC_RELAXED, __HIP_MEMORY_SCOPE_AGENT); }
__device__ __forceinline__ unsigned xb_add(unsigned* p, unsigned v) { return __hip_atomic_fetch_add(p, v, __ATOMIC_RELAXED, __HIP_MEMORY_SCOPE_AGENT); }
__device__ __forceinline__ unsigned xb_xcc_id() { return (unsigned)__builtin_amdgcn_s_getreg((3 << 11) | 20) & 0xFu; }
#define XB_SPIN(cond, bar) do { unsigned _sp = 0; while (cond) { __builtin_amdgcn_s_sleep(1); \
    if ((++_sp & 255u) == 0u) { if (xb_ld(&(bar)[XB_TMO])) break; if (_sp > XB_SPIN_CAP) { atomicAdd(&(bar)[XB_TMO], 1u); break; } } } } while (0)
struct XcdBarrier { unsigned* bar; unsigned x; volatile LAS unsigned* st; };
__device__ __forceinline__ XcdBarrier xcd_barrier_post(unsigned* bar, volatile LAS unsigned* st) {
    XcdBarrier b; b.bar = bar; b.x = xb_xcc_id(); b.st = st;
    if (threadIdx.x == 0) (void)xb_add(&bar[XB_XCNT(b.x)], 1u);
    return b;
}
__device__ __forceinline__ void xcd_barrier_complete(unsigned* bar, unsigned x, unsigned& nloc, unsigned& nx) {
    const unsigned G = gridDim.x * gridDim.y * gridDim.z;
    unsigned sum, cnt, mine, sp = 0u;
    for (;;) {
        sum = 0u; cnt = 0u; mine = 0u;
#pragma unroll
        for (unsigned j = 0; j < 16; ++j) { const unsigned c = xb_ld(&bar[XB_XCNT(j)]); sum += c; cnt += (c > 0u) ? 1u : 0u; mine = (j == x) ? c : mine; }
        if (sum == G) break;
        __builtin_amdgcn_s_sleep(1);
        if ((++sp & 255u) == 0u) { if (xb_ld(&bar[XB_TMO])) break; if (sp > XB_SPIN_CAP) { atomicAdd(&bar[XB_TMO], 1u); break; } }
    }
    nloc = mine > 0u ? mine : 1u; nx = cnt > 0u ? cnt : 1u;
}
__device__ __forceinline__ void xcd_barrier(const XcdBarrier& b) {
    asm volatile("s_waitcnt vmcnt(0)" ::: "memory");
    __syncthreads();
    if (threadIdx.x == 0) {
        unsigned* bar = b.bar;
        __builtin_amdgcn_s_waitcnt(0);
        unsigned nloc = b.st[0], nx = b.st[1];
        if (nloc == 0u) { xcd_barrier_complete(bar, b.x, nloc, nx); b.st[0] = nloc; b.st[1] = nx; }
        const unsigned old = xb_add(&bar[XB_XSUB(b.x)], 1u);
        const unsigned gen = old / nloc;
        if (old + 1u == (gen + 1u) * nloc) {
            __builtin_amdgcn_fence(__ATOMIC_RELEASE, "agent");
            asm volatile("s_waitcnt vmcnt(0)" ::: "memory");
            const unsigned og = xb_add(&bar[XB_TOP], 1u);
            const unsigned tg = og / nx;
            if (og + 1u == (tg + 1u) * nx) xb_add(&bar[XB_TOPGEN], 1u);
            else XB_SPIN(xb_ld(&bar[XB_TOPGEN]) == tg, bar);
            __builtin_amdgcn_fence(__ATOMIC_ACQUIRE, "agent");
            xb_add(&bar[XB_XGEN(b.x)], 1u);
            asm volatile("s_waitcnt vmcnt(0)" ::: "memory");
        } else {
            XB_SPIN(xb_ld(&bar[XB_XGEN(b.x)]) == gen, bar);
            __builtin_amdgcn_fence(__ATOMIC_ACQUIRE, "agent");
            asm volatile("s_waitcnt vmcnt(0)" ::: "memory");
        }
    }
    __syncthreads();
}

struct Args {
    const float* in[22];
    float* out;
    unsigned char* ws;
    int ph_lo, ph_hi;
};

struct Ctx {
    char* lds;
    int tid, lane, wid;
    int vb, G;
    const Args __attribute__((address_space(4)))* a;
};

template <int TB> struct GT { static constexpr int ROWS = 256 + 32 * TB, STAGE = ROWS * 128, NI = ROWS / 8; };

template <int TB>
__device__ __forceinline__ void gemm_stage(char* st, const bf16_t* Ag, int lda, const bf16_t* Bg, int ldb, int k0, int wid, int lane) {
    constexpr int NI = GT<TB>::NI;
    const int rsub = lane >> 3, lch = (lane & 7) ^ rsub;
#pragma unroll
    for (int i = 0; i < (NI + 7) / 8; ++i) {
        const int q = wid + 8 * i;
        if (q < NI) {
            const int row = q * 8 + rsub;
            const bf16_t* src = (q < 32) ? (Ag + (size_t)row * lda + k0 + lch * 8) : (Bg + (size_t)(row - 256) * ldb + k0 + lch * 8);
            __builtin_amdgcn_global_load_lds((const unsigned*)src, (LAS unsigned*)(st + q * 1024 + lane * 16), 16, 0, 0);
        }
    }
}
__device__ __forceinline__ bf16x8 frag128(const char* tile, int row, int chunk) {
    return *(const bf16x8*)(tile + row * 128 + ((chunk ^ (row & 7)) << 4));
}

struct NoPre { __device__ __forceinline__ void operator()() const {} };
template <int TB, bool NAIVE, class Epi, class Pre = NoPre>
__device__ __forceinline__ void gemm_tile(const Ctx& c, const bf16_t* Ag, int lda, const bf16_t* Bg, int ldb, int K, int a0, int b0, const Epi& epi, const Pre& pre = Pre(),
                                          bool prefetched = false, const bf16_t* An = nullptr, const bf16_t* Bn = nullptr) {
    constexpr int STAGE = GT<TB>::STAGE;
    const int wr = c.wid >> 1, wc = c.wid & 1, fr = c.lane & 15, fq = c.lane >> 4;
    f32x4 acc[4][TB];
#pragma unroll
    for (int i = 0; i < 4; ++i)
#pragma unroll
        for (int j = 0; j < TB; ++j) acc[i][j] = (f32x4){0.f, 0.f, 0.f, 0.f};
    if (NAIVE) {
        __syncthreads(); pre(); __syncthreads();
        const bf16_t* ar = Ag + (size_t)(wr * 64 + fq * 4) * lda;
        const bf16_t* br = Bg + (size_t)(wc * 16 * TB + fr) * ldb;
#pragma unroll
        for (int j = 0; j < TB; ++j) {
#pragma unroll 1
            for (int k = 0; k < K; k += 8) {
                float bv[8];
                { const u32x4 v = *(const u32x4*)(br + (size_t)(j * 16) * ldb + k);
#pragma unroll
                  for (int e = 0; e < 4; ++e) { bv[2 * e] = bflo(v[e]); bv[2 * e + 1] = bfhi(v[e]); } }
#pragma unroll
                for (int i = 0; i < 4; ++i)
#pragma unroll
                    for (int r = 0; r < 4; ++r) {
                        const u32x4 v = *(const u32x4*)(ar + (size_t)(i * 16 + r) * lda + k);
#pragma unroll
                        for (int e = 0; e < 4; ++e) acc[i][j][r] += bflo(v[e]) * bv[2 * e] + bfhi(v[e]) * bv[2 * e + 1];
                    }
                asm volatile("" ::: "memory");
            }
        }
        epi(acc, a0 + wr * 64, b0 + wc * (16 * TB), fr, fq);
        return;
    }
    const int nt = K >> 6;
    __syncthreads();
    if (!prefetched) gemm_stage<TB>(c.lds, Ag, lda, Bg, ldb, 0, c.wid, c.lane);
    pre();
    for (int t = 0; t < nt; ++t) {
        asm volatile("s_waitcnt vmcnt(0)" ::: "memory");
        __syncthreads();
        const char* cur = c.lds + (t & 1) * STAGE;
        if (t + 1 < nt) gemm_stage<TB>(c.lds + ((t + 1) & 1) * STAGE, Ag, lda, Bg, ldb, (t + 1) << 6, c.wid, c.lane);
        else if (An) gemm_stage<TB>(c.lds, An, lda, Bn, ldb, 0, c.wid, c.lane);
#pragma unroll
        for (int kk = 0; kk < 2; ++kk) {
            bf16x8 af[4], bfr[TB];
#pragma unroll
            for (int i = 0; i < 4; ++i) af[i] = frag128(cur, wr * 64 + i * 16 + fr, kk * 4 + fq);
#pragma unroll
            for (int j = 0; j < TB; ++j) bfr[j] = frag128(cur, 256 + wc * (16 * TB) + j * 16 + fr, kk * 4 + fq);
#pragma unroll
            for (int i = 0; i < 4; ++i)
#pragma unroll
                for (int j = 0; j < TB; ++j) acc[i][j] = __builtin_amdgcn_mfma_f32_16x16x32_bf16(af[i], bfr[j], acc[i][j], 0, 0, 0);
        }
    }
    epi(acc, a0 + wr * 64, b0 + wc * (16 * TB), fr, fq);
}

template <int TB, class Prob, int BENCH = 0>
__device__ __forceinline__ void gemm_stream(const Ctx& c, const Prob& P) {
    constexpr int STAGE = GT<TB>::STAGE, NI = GT<TB>::NI;
    constexpr int NSLOT = (NI + 7) / 8;
    const int wr = c.wid >> 1, wc = c.wid & 1, fr = c.lane & 15, fq = c.lane >> 4;
    const int n = P.count();
    if (n <= 0) return;
    f32x4 acc[4][TB];
#pragma unroll
    for (int i = 0; i < 4; ++i)
#pragma unroll
        for (int j = 0; j < TB; ++j) acc[i][j] = (f32x4){0.f, 0.f, 0.f, 0.f};
    const int KT = P.K >> 6;
    const int total = n * KT;
    const int rsub = c.lane >> 3, lch = (c.lane & 7) ^ rsub;
    unsigned voff[NSLOT]; int qs[NSLOT];
#pragma unroll
    for (int s = 0; s < NSLOT; ++s) {
        const int q = (c.wid + 8 * s < NI) ? c.wid + 8 * s : NI - 1;
        qs[s] = q;
        voff[s] = (unsigned)(((s < 4) ? ((q * 8 + rsub) * P.lda + lch * 8) : ((q * 8 + rsub - 256) * P.ldb + lch * 8)) * 2);
    }
    const bf16_t* Acur; const bf16_t* Bcur;
    int li = 0, lk = 0;
    P.tile(0, Acur, Bcur);
    constexpr int Q0 = (NSLOT + 3) / 4, Q1 = Q0 + (NSLOT + 2) / 4, Q2 = Q1 + (NSLOT + 1) / 4;
    constexpr int S1 = Q1;
    auto issue_part = [&](int stage, int s0, int s1) {
        char* st = c.lds + stage * STAGE;
#pragma unroll
        for (int s = 0; s < NSLOT; ++s) {
            if (s >= s0 && s < s1) {
                const char* ub = (const char*)(((s < 4) ? Acur : Bcur) + lk * 64);
                asm volatile("" : "+v"(voff[s]));
                __builtin_amdgcn_global_load_lds((const unsigned*)(ub + voff[s]), (LAS unsigned*)(st + qs[s] * 1024), 16, 0, 0);
            }
        }
    };
    auto issue = [&](int stage) { issue_part(stage, 0, NSLOT); };
    auto advance = [&]() { if (++lk == KT) { lk = 0; if (li + 1 < n) { ++li; P.tile(li, Acur, Bcur); } } };
    asm volatile("s_waitcnt vmcnt(0)" ::: "memory");
    __builtin_amdgcn_s_barrier();
    asm volatile("" ::: "memory");
    issue(0); advance(); issue(1); advance();
    P.pre_all();
    int ci = 0, ck = 0, stg = 0;
#define GEMM_WAIT_ONE_STAGE() do { if (BENCH == 1) { asm volatile("s_waitcnt vmcnt(0)" ::: "memory"); } \
        else if (after_epi) { asm volatile("s_waitcnt vmcnt(%0)" :: "n"(S1 + Prob::EPI_STORES) : "memory"); } \
        else { asm volatile("s_waitcnt vmcnt(%0)" :: "n"(S1) : "memory"); } } while (0)
    bool after_epi = false;
#define GEMM_BAR() do { asm volatile("" ::: "memory"); __builtin_amdgcn_s_barrier(); asm volatile("" ::: "memory"); } while (0)
#define GEMM_LOADF(dst, stage_ptr, kk) do { \
        _Pragma("unroll") for (int i = 0; i < 4; ++i) dst.a[i] = frag128(stage_ptr, wr * 64 + i * 16 + fr, (kk) * 4 + fq); \
        _Pragma("unroll") for (int jj = 0; jj < TB; ++jj) dst.b[jj] = frag128(stage_ptr, 256 + wc * (16 * TB) + jj * 16 + fr, (kk) * 4 + fq); } while (0)
#define GEMM_MMA(src_) do { \
        _Pragma("unroll") for (int i = 0; i < 4; ++i) \
        _Pragma("unroll") for (int jj = 0; jj < TB; ++jj) acc[i][jj] = __builtin_amdgcn_mfma_f32_16x16x32_bf16(src_.a[i], src_.b[jj], acc[i][jj], 0, 0, 0); } while (0)
    struct Frags { bf16x8 a[4]; bf16x8 b[TB]; };
    Frags f0, f1;
    if (BENCH == 1) { asm volatile("s_waitcnt vmcnt(0)" ::: "memory"); } else { asm volatile("s_waitcnt vmcnt(%0)" :: "n"(NSLOT) : "memory"); }
    GEMM_BAR();
    GEMM_LOADF(f0, c.lds, 0);
    f32x4 sw[4];
#pragma unroll
    for (int i = 0; i < 4; ++i) sw[i] = (f32x4){0.f, 0.f, 0.f, 0.f};
#pragma unroll 1
    for (int gs = 0; gs < total; ++gs) {
        const char* cur = c.lds + stg * STAGE;
        const int nst1 = stg == 2 ? 0 : stg + 1;
        if (ck == KT - 1) P.preload(ci, sw, wr, fq);
        if (BENCH != 2) GEMM_LOADF(f1, cur, 1);
        const int nst2 = stg == 0 ? 2 : stg - 1;
        if (BENCH != 1) issue_part(nst2, 0, Q0);
        if (BENCH != 2) GEMM_MMA(f0);
#if GEMM_INTERLEAVE
        __builtin_amdgcn_sched_group_barrier(0x100, 4 + TB, 0);
#pragma unroll
        for (int s = 0; s < NSLOT; ++s) {
            __builtin_amdgcn_sched_group_barrier(0x008, 2, 0);
            __builtin_amdgcn_sched_group_barrier(0x006, 6, 0);
            __builtin_amdgcn_sched_group_barrier(0x010, 1, 0);
        }
        __builtin_amdgcn_sched_group_barrier(0x008, 4 * TB - 2 * NSLOT, 0);
#endif
        if (BENCH != 1) issue_part(nst2, Q0, Q1);
        GEMM_WAIT_ONE_STAGE();
        after_epi = false;
        asm volatile("s_waitcnt lgkmcnt(0)" ::: "memory");
        GEMM_BAR();
        if (BENCH != 1) issue_part(nst2, Q1, Q2);
        if (BENCH != 2) GEMM_LOADF(f0, c.lds + nst1 * STAGE, 0);
#if GEMM_SETPRIO
        __builtin_amdgcn_s_setprio(1);
#endif
        if (BENCH != 2) GEMM_MMA(f1);
#if GEMM_SETPRIO
        __builtin_amdgcn_s_setprio(0);
#endif
        if (BENCH != 1) issue_part(nst2, Q2, NSLOT);
        stg = nst1;
        advance();
        if (++ck == KT) {
            P.epilogue(ci, acc, sw, wr, wc, fr, fq);
#pragma unroll
            for (int i = 0; i < 4; ++i)
#pragma unroll
                for (int j = 0; j < TB; ++j) acc[i][j] = (f32x4){0.f, 0.f, 0.f, 0.f};
            ck = 0; ++ci;
            after_epi = true;
        }
    }
    asm volatile("s_waitcnt vmcnt(0)" ::: "memory");
    GEMM_BAR();
#undef GEMM_WAIT_ONE_STAGE
#undef GEMM_BAR
#undef GEMM_LOADF
#undef GEMM_MMA
}

__device__ __forceinline__ u32x4 pair16(const u32x2& a, const u32x2& b) {
    const auto sx = __builtin_amdgcn_permlane16_swap(a.x, b.x, false, false);
    const auto sy = __builtin_amdgcn_permlane16_swap(a.y, b.y, false, false);
    return (u32x4){sx[0], sy[0], sx[1], sy[1]};
}
struct EpiInProj {
    bf16_t* Z; bf16_t* RAW; const float* rsx  ; int tok_base; const float* SW  ; bool uni  ;
    __device__ __forceinline__ void operator()(f32x4 (&acc)[4][5], const f32x4 (&swp)[4], int ab, int bb, int fr, int fq) const {
#pragma unroll
        for (int j = 0; j < 5; ++j) {
            const int tok = bb + j * 16 + fr;
            const float rs = rsx[tok - tok_base];
            const float* sw = SW + cond_of(tok) * DPROJ;
            u32x2 v[4];
#pragma unroll
            for (int i = 0; i < 4; ++i) {
                const int n = ab + i * 16 + fq * 4;
                const f32x4 o = acc[i][j] * rs + (uni ? swp[i] : *(const f32x4*)(sw + n));
                v[i].x = pk2(o[0], o[1]); v[i].y = pk2(o[2], o[3]);
            }
#pragma unroll
            for (int p = 0; p < 2; ++p) {
                const u32x4 o = pair16(v[2 * p], v[2 * p + 1]);
                const int n = ab + (2 * p + (fq & 1)) * 16 + (fq & 2) * 4;
                bf16_t* dst = (n < DI) ? (Z + (size_t)tok * DI + n) : (RAW + (size_t)tok * DXBC + (n - DI));
                *(u32x4*)dst = o;
            }
        }
    }
};
struct EpiResid {
    float* X; const float* gate  ; const float* bias; const float* rs_lds  ; int tok_base;
    const float* Xin0; const float* Xin1;
    bf16_t* XG  ; const float* nw_next; const float* scale_next  ; float* RSS; const float* zeros  ;
    __device__ __forceinline__ void operator()(f32x4 (&acc)[4][5], int ab, int bb, int fr, int fq) const {
        const int slot = (ab >> 6);
        const bool uni = cond_of(bb) == cond_of(bb + 79);
        const int nb = ab + fq * 4;
        f32x4 gvv[4], bvv[4], gnn[4];
        auto load_vecs = [&](int cd) {
            const float* gp = gate + cd * 6144 + nb;
            const float* bp = (bias ? bias : zeros) + nb;
            const float* np = (XG ? nw_next : zeros) + nb;
            const float* sp = (XG ? scale_next + cd * 6144 : zeros) + nb;
            f32x4 t0[4], t1[4];
#pragma unroll
            for (int i = 0; i < 4; ++i) { gvv[i] = *(const f32x4*)(gp + i * 16); bvv[i] = *(const f32x4*)(bp + i * 16); t0[i] = *(const f32x4*)(np + i * 16); t1[i] = *(const f32x4*)(sp + i * 16); }
#pragma unroll
            for (int i = 0; i < 4; ++i) gnn[i] = t0[i] * (t1[i] + 1.0f);
        };
        if (uni) load_vecs(cond_of(bb));
        auto xrow = [&](int tok) -> const float* { return (Xin0 ? (tok < NCTX ? Xin0 + (size_t)tok * D : Xin1 + (size_t)(tok - NCTX) * D) : X + (size_t)tok * D) + nb; };
        f32x4 xv[4];
#pragma unroll
        for (int j = 0; j < 5; ++j) {
            const int tok = bb + j * 16 + fr;
            { const float* p = xrow(tok);
#pragma unroll
              for (int i = 0; i < 4; ++i) xv[i] = *(const f32x4*)(p + i * 16); }
            const float rs = rs_lds ? rs_lds[tok - tok_base] : 1.0f;
            if (!uni) load_vecs(cond_of(tok));
            float ss = 0.f;
            u32x2 xgv[4];
            float* xo = X + (size_t)tok * D + nb;
#pragma unroll
            for (int i = 0; i < 4; ++i) {
                const f32x4 x2 = xv[i] + gvv[i] * (acc[i][j] * rs + bvv[i]);
                *(f32x4*)(xo + i * 16) = x2;
                ss += x2[0] * x2[0] + x2[1] * x2[1] + x2[2] * x2[2] + x2[3] * x2[3];
                const f32x4 o = x2 * gnn[i];
                xgv[i].x = pk2(o[0], o[1]); xgv[i].y = pk2(o[2], o[3]);
            }
            if (XG) {
#pragma unroll
                for (int p = 0; p < 2; ++p) {
                    const u32x4 o = pair16(xgv[2 * p], xgv[2 * p + 1]);
                    *(u32x4*)(XG + (size_t)tok * D + ab + (2 * p + (fq & 1)) * 16 + (fq & 2) * 4) = o;
                }
                ss += __shfl_xor(ss, 16); ss += __shfl_xor(ss, 32);
                if (fq == 0) RSS[(size_t)tok * 16 + slot] = ss;
            }
        }
    }
};
struct EpiMlpUp {
    bf16_t* HID; const float* rsx; int tok_base; const float* SW  ; bool uni;
    __device__ __forceinline__ void operator()(f32x4 (&acc)[4][5], const f32x4 (&swp)[4], int ab, int bb, int fr, int fq) const {
#pragma unroll
        for (int j = 0; j < 5; ++j) {
            const int tok = bb + j * 16 + fr;
            const float rs = rsx[tok - tok_base];
            const float* sw = SW + cond_of(tok) * DFF;
            u32x2 v[4];
#pragma unroll
            for (int i = 0; i < 4; ++i) {
                const int n = ab + i * 16 + fq * 4;
                f32x4 a = acc[i][j] * rs + (uni ? swp[i] : *(const f32x4*)(sw + n));
                a[0] = fmaxf(a[0], 0.f); a[1] = fmaxf(a[1], 0.f); a[2] = fmaxf(a[2], 0.f); a[3] = fmaxf(a[3], 0.f);
                v[i].x = pk2(a[0] * a[0], a[1] * a[1]); v[i].y = pk2(a[2] * a[2], a[3] * a[3]);
            }
#pragma unroll
            for (int p = 0; p < 2; ++p) {
                const u32x4 o = pair16(v[2 * p], v[2 * p + 1]);
                *(u32x4*)(HID + (size_t)tok * DFF + ab + (2 * p + (fq & 1)) * 16 + (fq & 2) * 4) = o;
            }
        }
    }
};
struct EpiDt {
    float* DT; const float* rsx; int tok_base; const float* SW  ;
    __device__ __forceinline__ void operator()(f32x4 (&acc)[4][2], int ab, int bb, int fr, int fq) const {
        float swv[2][3];
#pragma unroll
        for (int j = 0; j < 2; ++j)
#pragma unroll
            for (int cd = 0; cd < 3; ++cd) swv[j][cd] = SW[cd * DPROJ + NZX + bb + j * 16 + fr];
#pragma unroll
        for (int j = 0; j < 2; ++j) {
            const int col = bb + j * 16 + fr;
#pragma unroll
            for (int i = 0; i < 4; ++i) {
                const int tok = ab + i * 16 + fq * 4;
#pragma unroll
                for (int r = 0; r < 4; ++r) {
                    const int cd = cond_of(tok + r);
                    const float sw = cd == 0 ? swv[j][0] : (cd == 1 ? swv[j][1] : swv[j][2]);
                    DT[(size_t)(tok + r) * 64 + col] = acc[i][j][r] * rsx[tok + r - tok_base] + sw;
                }
            }
        }
    }
};
struct EpiF1 {
    bf16_t* UVT; int g; const float* rsx; int tok_base; const float* SW  ;
    __device__ __forceinline__ void operator()(f32x4 (&acc)[4][4], int ab, int bb, int fr, int fq) const {
        float swv[4];
#pragma unroll
        for (int j = 0; j < 4; ++j) swv[j] = SW[cond_of(ab) * 2048 + g * 512 + bb + j * 16 + fr];
#pragma unroll
        for (int j = 0; j < 4; ++j) {
            const int nn = bb + j * 16 + fr, part = nn >> 8, ch = g * 256 + (nn & 255);
#pragma unroll
            for (int i = 0; i < 4; ++i) {
                const int tok = ab + i * 16 + fq * 4;
                const float sw = swv[j];
                bf16_t* dst;
                if (tok < NCTX) { const int s = tok >> 8, l = tok & 255; dst = UVT + ((size_t)(s * 1024 + ch) * 512 + part * 256 + l); }
                else { const int tt = tok - NCTX, s = tt >> 10, l = tt & 1023; dst = UVT + (size_t)NCTX * 2048 + ((size_t)(s * 1024 + ch) * 2048 + part * 1024 + l); }
                const f32x4 r4 = *(const f32x4*)(rsx + tok - tok_base);
                const f32x4 o = acc[i][j] * r4 + sw;
                u32x2 v; v.x = pk2(o[0], o[1]); v.y = pk2(o[2], o[3]);
                *(u32x2*)dst = v;
            }
        }
    }
};
template <int TB> struct EpiF2 {
    bf16_t* F; int tok0;
    __device__ __forceinline__ void operator()(f32x4 (&acc)[4][TB], int ab, int bb, int fr, int fq) const {
#pragma unroll
        for (int j = 0; j < TB; ++j) {
            const int tok = tok0 + bb + j * 16 + fr;
#pragma unroll
            for (int i = 0; i < 4; ++i) {
                const int n = ab + i * 16 + fq * 4;
                u32x2 v; v.x = pk2(acc[i][j][0], acc[i][j][1]); v.y = pk2(acc[i][j][2], acc[i][j][3]);
                *(u32x2*)(F + (size_t)tok * D + n) = v;
            }
        }
    }
};

struct TrItem { const float* W; bf16_t* WT; int K, N, k0, n0; };
__device__ __forceinline__ TrItem transpose_decode(const Ctx& c, int r) {
    const Args __attribute__((address_space(4)))& a = *c.a;
    constexpr int I_WIN = 8 * 81, I_WOUT = 16 * 16, I_FNO = 8 * 16, I_W1 = 8 * 64, I_W2 = 32 * 16;
    TrItem t; int item;
    if (r < 2 * I_WIN) { const int j = r / I_WIN; t.W = a.in[9] + (size_t)j * D * DPROJ; t.K = D; t.N = DPROJ; t.WT = (bf16_t*)(a.ws + WS_WIN) + (size_t)j * DPROJ * D; item = r - j * I_WIN; }
    else if ((r -= 2 * I_WIN) < 2 * I_WOUT) { const int j = r / I_WOUT; t.W = a.in[16] + (size_t)j * DI * D; t.K = DI; t.N = D; t.WT = (bf16_t*)(a.ws + WS_WOUT) + (size_t)j * D * DI; item = r - j * I_WOUT; }
    else if ((r -= 2 * I_WOUT) < 2 * I_FNO) { const int j = r / I_FNO; t.W = a.in[17] + (size_t)j * D * D; t.K = D; t.N = D; t.WT = (bf16_t*)(a.ws + WS_WFNO) + (size_t)j * D * D; item = r - j * I_FNO; }
    else if ((r -= 2 * I_FNO) < 4 * I_W1) { const int j = r / I_W1; t.W = a.in[19] + (size_t)j * D * DFF; t.K = D; t.N = DFF; t.WT = (bf16_t*)(a.ws + WS_W1) + (size_t)j * DFF * D; item = r - j * I_W1; }
    else { r -= 4 * I_W1; const int j = r / I_W2; t.W = a.in[20] + (size_t)j * DFF * D; t.K = DFF; t.N = D; t.WT = (bf16_t*)(a.ws + WS_W2) + (size_t)j * D * DFF; item = r - j * I_W2; }
    const int nb = t.N >> 6, kb = item / nb, nbi = item - kb * nb;
    t.k0 = kb * 128; t.n0 = nbi * 64;
    return t;
}
__device__ __forceinline__ void transpose_load(const Ctx& c, const TrItem& t, f32x4 (&v)[4]) {
    const int cl = c.tid & 15, rl = c.tid >> 4;
#pragma unroll
    for (int p = 0; p < 4; ++p) v[p] = *(const f32x4*)(t.W + (size_t)(t.k0 + p * 32 + rl) * t.N + t.n0 + cl * 4);
}
__device__ __forceinline__ void transpose_finish(const Ctx& c, const TrItem& t, const f32x4 (&v)[4]) {
    float* tile = (float*)c.lds;
    const int cl = c.tid & 15, rl = c.tid >> 4;
    __syncthreads();
#pragma unroll
    for (int p = 0; p < 4; ++p) { const int k = p * 32 + rl; tile[k * 65 + cl * 4 + 0] = v[p][0]; tile[k * 65 + cl * 4 + 1] = v[p][1]; tile[k * 65 + cl * 4 + 2] = v[p][2]; tile[k * 65 + cl * 4 + 3] = v[p][3]; }
    __syncthreads();
#pragma unroll
    for (int p = 0; p < 2; ++p) {
        const int idx = c.tid + p * NTHR, n = idx >> 4, kc = idx & 15;
        const float* s = tile + (kc * 8) * 65 + n;
        u32x4 o; o.x = pk2(s[0], s[65]); o.y = pk2(s[2 * 65], s[3 * 65]); o.z = pk2(s[4 * 65], s[5 * 65]); o.w = pk2(s[6 * 65], s[7 * 65]);
        *(u32x4*)(t.WT + (size_t)(t.n0 + n) * t.K + t.k0 + kc * 8) = o;
    }
}

__device__ __forceinline__ void ada_item(const Ctx& c, int item) {
    const Args __attribute__((address_space(4)))& a = *c.a;
    const int layer = item / 96, cg = item - layer * 96, n0 = cg * 64;
    const float* W = a.in[5] + (size_t)layer * D * 6144;
    const float* sc = (const float*)(c.lds + 40960);
    float* red = (float*)c.lds;
    const int cl = c.tid & 15, kl = c.tid >> 4;
    f32x4 a0 = {0, 0, 0, 0}, a1 = {0, 0, 0, 0}, a2 = {0, 0, 0, 0};
#pragma unroll 8
    for (int it = 0; it < 32; ++it) {
        const int k = it * 32 + kl;
        const f32x4 w = *(const f32x4*)(W + (size_t)k * 6144 + n0 + cl * 4);
        a0 += w * sc[k]; a1 += w * sc[1024 + k]; a2 += w * sc[2048 + k];
    }
    __syncthreads();
    *(f32x4*)(red + (kl * 3 + 0) * 64 + cl * 4) = a0;
    *(f32x4*)(red + (kl * 3 + 1) * 64 + cl * 4) = a1;
    *(f32x4*)(red + (kl * 3 + 2) * 64 + cl * 4) = a2;
    __syncthreads();
    if (c.tid < 192) {
        const int cond = c.tid >> 6, col = c.tid & 63;
        float s = 0.f;
#pragma unroll
        for (int k = 0; k < 32; ++k) s += red[(k * 3 + cond) * 64 + col];
        s += a.in[6][layer * 6144 + n0 + col];
        ((float*)(a.ws + WS_MOD))[(layer * 3 + cond) * 6144 + n0 + col] = s;
    }
}

__device__ __forceinline__ void phase_prep(const Ctx& c) {
    const Args __attribute__((address_space(4)))& a = *c.a;
    {
        float* sc = (float*)(c.lds + 40960);
        for (int i = c.tid; i < 3072; i += NTHR) {
            const int cond = i >> 10, k = i & 1023;
            const float v = cond == 0 ? a.in[4][k] : a.in[3][(cond - 1) * 1024 + k];
            sc[i] = silu_f(v);
        }
        __syncthreads();
    }
    constexpr int I_ADA = 384;
    constexpr int I_TR = 2 * 8 * 81 + 2 * 16 * 16 + 2 * 8 * 16 + 4 * 8 * 64 + 4 * 32 * 16;
    constexpr int I_TB = 32 + 32 + 512;
    for (int it = c.vb; it < I_ADA; it += c.G) ada_item(c, it);
    {
        int it = c.vb;
        if (it < I_TR) {
            TrItem cur = transpose_decode(c, it);
            f32x4 v[4]; transpose_load(c, cur, v);
            for (;;) {
                const int nit = it + c.G;
                TrItem nxt = cur; f32x4 vn[4];
                const bool has = nit < I_TR;
                if (has) { nxt = transpose_decode(c, nit); transpose_load(c, nxt, vn); }
                transpose_finish(c, cur, v);
                if (!has) break;
                cur = nxt; it = nit;
#pragma unroll
                for (int p = 0; p < 4; ++p) v[p] = vn[p];
            }
        }
    }
    for (int r = c.vb; r < I_TB; r += c.G) {
#pragma unroll 4
        for (int e = 0; e < 8; ++e) {
            int idx = r * 4096 + e * NTHR + c.tid;
            if (idx < 131072) {
                const int nn = idx >> 8, cc = idx & 255, m = nn & 255, ph = (m * cc) & 255;
                const float ang = (float)ph * (1.0f / 128.0f);
                const float v = nn < 256 ? cospif(ang) : sinpif(ang);
                ((bf16_t*)(a.ws + WS_T1))[idx] = (bf16_t)(pk2(v, 0.f) & 0xffff);
            } else if (idx < 262144) {
                idx -= 131072;
                const int k = idx >> 9, k2 = idx & 511, l = k2 & 255, ph = (k * l) & 255;
                const float ang = (float)ph * (1.0f / 128.0f);
                const float v = (k2 < 256 ? cospif(ang) : -sinpif(ang)) * (1.0f / 256.0f);
                ((bf16_t*)(a.ws + WS_T2C))[idx] = (bf16_t)(pk2(v, 0.f) & 0xffff);
            } else {
                idx -= 262144;
                const int k = idx >> 11, k2 = idx & 2047, l = k2 & 1023, ph = (k * l) & 1023;
                const float ang = (float)ph * (1.0f / 512.0f);
                const float v = (k2 < 1024 ? cospif(ang) : -sinpif(ang)) * (1.0f / 512.0f);
                ((bf16_t*)(a.ws + WS_T2L))[idx] = (bf16_t)(pk2(v, 0.f) & 0xffff);
            }
        }
    }
}

__device__ __forceinline__ void phase_prep2(const Ctx& c) {
    const Args __attribute__((address_space(4)))& a = *c.a;
    const float* MOD = (const float*)(a.ws + WS_MOD);
    float* sh = (float*)c.lds;
    const int gw = c.vb * NWAVE + c.wid, NGW = c.G * NWAVE;
#pragma unroll 1
    for (int v = 0; v < 8; ++v) {
        const int layer = v >> 1, mlp = v & 1, jj = layer >> 1, fnet = (layer & 1) && !mlp;
        __syncthreads();
        { float tv[6];
#pragma unroll
          for (int u = 0; u < 6; ++u) { const int i = c.tid + u * NTHR; tv[u] = MOD[(size_t)(layer * 3 + (i >> 10)) * 6144 + (mlp ? 3072 : 0) + (i & 1023)]; }
#pragma unroll
          for (int u = 0; u < 6; ++u) sh[c.tid + u * NTHR] = tv[u]; }
        __syncthreads();
        const bf16_t* W; float* out; int N, ostride;
        if (mlp) { W = (const bf16_t*)(a.ws + WS_W1) + (size_t)layer * DFF * D; N = DFF; out = (float*)(a.ws + WS_SWUP) + (size_t)layer * 3 * DFF; ostride = DFF; }
        else if (fnet) { W = (const bf16_t*)(a.ws + WS_T1); N = 2048; out = (float*)(a.ws + WS_SWF1) + (size_t)jj * 3 * 2048; ostride = 2048; }
        else { W = (const bf16_t*)(a.ws + WS_WIN) + (size_t)jj * DPROJ * D; N = DPROJ; out = (float*)(a.ws + WS_SWIN) + (size_t)jj * 3 * DPROJ; ostride = DPROJ; }
        for (int n = gw; n < N; n += NGW) {
            float s0 = 0.f, s1 = 0.f, s2 = 0.f;
            if (fnet) {
                const int g = n >> 9, nn = n & 511;
                if (c.lane < 32) {
                    const u32x4 w = *(const u32x4*)(W + (size_t)nn * 256 + c.lane * 8);
                    const int k = g * 256 + c.lane * 8;
#pragma unroll
                    for (int e = 0; e < 4; ++e) {
                        const float wl = bflo(w[e]), wh = bfhi(w[e]);
                        s0 += wl * sh[k + 2 * e] + wh * sh[k + 2 * e + 1];
                        s1 += wl * sh[1024 + k + 2 * e] + wh * sh[1024 + k + 2 * e + 1];
                        s2 += wl * sh[2048 + k + 2 * e] + wh * sh[2048 + k + 2 * e + 1];
                    }
                }
            } else {
#pragma unroll
                for (int p = 0; p < 2; ++p) {
                    const int k = p * 512 + c.lane * 8;
                    const u32x4 w = *(const u32x4*)(W + (size_t)n * D + k);
#pragma unroll
                    for (int e = 0; e < 4; ++e) {
                        const float wl = bflo(w[e]), wh = bfhi(w[e]);
                        s0 += wl * sh[k + 2 * e] + wh * sh[k + 2 * e + 1];
                        s1 += wl * sh[1024 + k + 2 * e] + wh * sh[1024 + k + 2 * e + 1];
                        s2 += wl * sh[2048 + k + 2 * e] + wh * sh[2048 + k + 2 * e + 1];
                    }
                }
            }
            s0 = wave_sum(s0); s1 = wave_sum(s1); s2 = wave_sum(s2);
            if (c.lane == 0) { out[n] = s0; out[ostride + n] = s1; out[2 * ostride + n] = s2; }
        }
    }
    {
        bf16_t* XG = (bf16_t*)(a.ws + WS_H);
        float* RSS = (float*)(a.ws + WS_RSS);
        const float* nw = a.in[7];
        f32x4 nwv[4];
#pragma unroll
        for (int q = 0; q < 4; ++q) nwv[q] = *(const f32x4*)(nw + q * 256 + c.lane * 4);
#pragma unroll 1
        for (int row0 = gw; row0 < NTOK; row0 += 5 * NGW) {
        f32x4 xv[5][4];
#pragma unroll
        for (int k = 0; k < 5; ++k) {
            const int rowu = row0 + k * NGW, row = rowu < NTOK ? rowu : NTOK - 1;
            const float* xr = row < NCTX ? a.in[0] + (size_t)row * D : a.in[1] + (size_t)(row - NCTX) * D;
#pragma unroll
            for (int q = 0; q < 4; ++q) xv[k][q] = *(const f32x4*)(xr + q * 256 + c.lane * 4);
        }
#pragma unroll
        for (int k = 0; k < 5; ++k) {
            const int row = row0 + k * NGW;
            if (row >= NTOK) break;
            const float* m = MOD + (size_t)cond_of(row) * 6144 + 1024;
            float ss = 0.f;
            f32x4 mv[4];
#pragma unroll
            for (int q = 0; q < 4; ++q) mv[q] = *(const f32x4*)(m + q * 256 + c.lane * 4);
#pragma unroll
            for (int q = 0; q < 4; ++q) {
                const int col = q * 256 + c.lane * 4;
                const f32x4 v = xv[k][q];
                ss += v[0] * v[0] + v[1] * v[1] + v[2] * v[2] + v[3] * v[3];
                const f32x4 o = v * nwv[q] * (mv[q] + 1.0f);
                u32x2 w; w.x = pk2(o[0], o[1]); w.y = pk2(o[2], o[3]);
                *(u32x2*)(XG + (size_t)row * D + col) = w;
            }
            ss = wave_sum(ss);
            if (c.lane < 16) RSS[(size_t)row * 16 + c.lane] = c.lane == 0 ? ss : 0.f;
        }
        }
    }
}

__device__ __forceinline__ void phase_norm(const Ctx& c, const float* nw, const float* mod  , int off_shift, int off_scale, bool final_norm) {
    const Args __attribute__((address_space(4)))& a = *c.a;
    const int gw = c.vb * NWAVE + c.wid, NGW = c.G * NWAVE;
    bf16_t* H = (bf16_t*)(a.ws + WS_H);
    f32x4 wfin[4];
#pragma unroll
    for (int j = 0; j < 4; ++j) wfin[j] = *(const f32x4*)(nw + j * 256 + c.lane * 4);
    for (int row = gw; row < NTOK; row += NGW) {
        float* xr = a.out + (size_t)row * D;
        f32x4 v[4]; float ss = 0.f;
#pragma unroll
        for (int j = 0; j < 4; ++j) { v[j] = *(const f32x4*)(xr + j * 256 + c.lane * 4); ss += v[j][0] * v[j][0] + v[j][1] * v[j][1] + v[j][2] * v[j][2] + v[j][3] * v[j][3]; }
        ss = wave_sum(ss);
        const float rstd = rsqrtf(ss * (1.0f / D) + EPS);
        if (final_norm) {
#pragma unroll
            for (int j = 0; j < 4; ++j) *(f32x4*)(xr + j * 256 + c.lane * 4) = v[j] * rstd * wfin[j];
        } else {
            const float* m = mod + cond_of(row) * 6144;
#pragma unroll
            for (int j = 0; j < 4; ++j) {
                const int col = j * 256 + c.lane * 4;
                const f32x4 w = *(const f32x4*)(nw + col), sc = *(const f32x4*)(m + off_scale + col), sh = *(const f32x4*)(m + off_shift + col);
                const f32x4 h = v[j] * rstd * w * (sc + 1.0f) + sh;
                u32x2 o; o.x = pk2(h[0], h[1]); o.y = pk2(h[2], h[3]);
                *(u32x2*)(H + (size_t)row * D + col) = o;
            }
        }
    }
}

constexpr int RS_OFF = 3 * GT<5>::STAGE;
struct FillRstd { float* tab; const float* RSS; int tok0, ntok, tid;
    __device__ __forceinline__ void operator()() const {
        if (tid < ntok) {
            const float* p = RSS + (size_t)(tok0 + tid) * 16;
            float s = 0.f;
#pragma unroll
            for (int q = 0; q < 4; ++q) { const f32x4 v = *(const f32x4*)(p + q * 4); s += (v[0] + v[1]) + (v[2] + v[3]); }
            tab[tid] = rsqrtf(s * (1.0f / D) + EPS);
        }
    }
};
__device__ __forceinline__ FillRstd fill_rstd(const Ctx& c, int tok0, int ntok) { return FillRstd{(float*)(c.lds + RS_OFF), (const float*)(c.a->ws + WS_RSS), tok0, ntok, c.tid}; }
__device__ __forceinline__ void rstd_table_one(const Ctx& c, int i, int ntok, int tok0) {
    float* tab = (float*)(c.lds + RS_OFF);
    const float* RSS = (const float*)(c.a->ws + WS_RSS);
    if (c.tid < ntok) {
        const float* p = RSS + (size_t)(tok0 + c.tid) * 16;
        float s = 0.f;
#pragma unroll
        for (int q = 0; q < 4; ++q) { const f32x4 v = *(const f32x4*)(p + q * 4); s += (v[0] + v[1]) + (v[2] + v[3]); }
        tab[i * ntok + c.tid] = rsqrtf(s * (1.0f / D) + EPS);
    }
}
__device__ __forceinline__ void rstd_tables(const Ctx& c, int n, int ntok, int first, int stride, int toks_per_rt, int shift_rt  ) {
    float* tab = (float*)(c.lds + RS_OFF);
    const float* RSS = (const float*)(c.a->ws + WS_RSS);
    for (int i = 0; i < n; ++i) {
        const int t = first + i * stride, rt = shift_rt < 0 ? t / (-shift_rt) : (t >> shift_rt);
        if (c.tid < ntok) {
            const float* p = RSS + (size_t)(rt * toks_per_rt + c.tid) * 16;
            float s = 0.f;
#pragma unroll
            for (int q = 0; q < 4; ++q) { const f32x4 v = *(const f32x4*)(p + q * 4); s += (v[0] + v[1]) + (v[2] + v[3]); }
            tab[i * ntok + c.tid] = rsqrtf(s * (1.0f / D) + EPS);
        }
    }
}
__device__ __forceinline__ void patch_tile(const Ctx& c, int i, int NC, int& rt, int& ct) {
    if (c.G == 256) { const int x = c.vb >> 5, l = c.vb & 31, p = i * 8 + x, PC = NC >> 2, pr = p / PC, pc = p - pr * PC; rt = pr * 8 + (l >> 2); ct = pc * 4 + (l & 3); }
    else { const int t = c.vb + i * c.G; rt = t / NC; ct = t - rt * NC; }
}
struct ProbInProj {
    static constexpr int EPI_STORES = 10;
    const Ctx* c; const bf16_t* W; const bf16_t* XG; int lda, ldb, K; int j;
    static constexpr int NC = NZX / 256, NT = (NTOK / 160) * NC;
    __device__ __forceinline__ int count() const { return (NT - c->vb + c->G - 1) / c->G; }
    __device__ __forceinline__ void tile(int i, const bf16_t*& A, const bf16_t*& B) const { int rt, ct; patch_tile(*c, i, NC, rt, ct); A = W + (size_t)ct * 256 * D; B = XG + (size_t)rt * 160 * D; }
    __device__ __forceinline__ void pre_all() const { const int n = count(); for (int i = 0; i < n; ++i) { int rt, ct; patch_tile(*c, i, NC, rt, ct); rstd_table_one(*c, i, 160, rt * 160); } }
    __device__ __forceinline__ void preload(int i, f32x4 (&sw)[4], int wr, int fq) const {
        int rt, ct; patch_tile(*c, i, NC, rt, ct);
        if (cond_of(rt * 160) == cond_of(rt * 160 + 159)) {
            const float* p = (const float*)(c->a->ws + WS_SWIN) + (size_t)j * 3 * DPROJ + cond_of(rt * 160) * DPROJ + ct * 256 + wr * 64 + fq * 4;
#pragma unroll
            for (int q = 0; q < 4; ++q) sw[q] = *(const f32x4*)(p + q * 16);
        }
    }
    __device__ __forceinline__ void epilogue(int i, f32x4 (&acc)[4][5], const f32x4 (&sw)[4], int wr, int wc, int fr, int fq) const {
        int rt, ct; patch_tile(*c, i, NC, rt, ct); unsigned char* ws = c->a->ws;
        EpiInProj e{(bf16_t*)(ws + S_Z), (bf16_t*)(ws + S_RAW), (const float*)(c->lds + RS_OFF) + i * 160, rt * 160, (const float*)(ws + WS_SWIN) + (size_t)j * 3 * DPROJ, cond_of(rt * 160) == cond_of(rt * 160 + 159)};
        e(acc, sw, ct * 256 + wr * 64, rt * 160 + wc * 80, fr, fq);
    }
};
__device__ __forceinline__ void phase_inproj(const Ctx& c, int j) {
    ProbInProj P{&c, (const bf16_t*)(c.a->ws + WS_WIN) + (size_t)j * DPROJ * D, (const bf16_t*)(c.a->ws + WS_H), D, D, D, j};
    gemm_stream<5>(c, P);
}
struct ProbMlpUp {
    static constexpr int EPI_STORES = 10;
    const Ctx* c; const bf16_t* W; const bf16_t* XG; int lda, ldb, K; int layer;
    static constexpr int NC = DFF / 256, NT = (NTOK / 160) * NC;
    __device__ __forceinline__ int count() const { return (NT - c->vb + c->G - 1) / c->G; }
    __device__ __forceinline__ void tile(int i, const bf16_t*& A, const bf16_t*& B) const { int rt, ct; patch_tile(*c, i, NC, rt, ct); A = W + (size_t)ct * 256 * D; B = XG + (size_t)rt * 160 * D; }
    __device__ __forceinline__ void pre_all() const { const int n = count(); for (int i = 0; i < n; ++i) { int rt, ct; patch_tile(*c, i, NC, rt, ct); rstd_table_one(*c, i, 160, rt * 160); } }
    __device__ __forceinline__ void preload(int i, f32x4 (&sw)[4], int wr, int fq) const {
        int rt, ct; patch_tile(*c, i, NC, rt, ct);
        if (cond_of(rt * 160) == cond_of(rt * 160 + 159)) {
            const float* p = (const float*)(c->a->ws + WS_SWUP) + (size_t)layer * 3 * DFF + cond_of(rt * 160) * DFF + ct * 256 + wr * 64 + fq * 4;
#pragma unroll
            for (int q = 0; q < 4; ++q) sw[q] = *(const f32x4*)(p + q * 16);
        }
    }
    __device__ __forceinline__ void epilogue(int i, f32x4 (&acc)[4][5], const f32x4 (&sw)[4], int wr, int wc, int fr, int fq) const {
        int rt, ct; patch_tile(*c, i, NC, rt, ct); unsigned char* ws = c->a->ws;
        EpiMlpUp e{(bf16_t*)(ws + S_HID), (const float*)(c->lds + RS_OFF) + i * 160, rt * 160, (const float*)(ws + WS_SWUP) + (size_t)layer * 3 * DFF, cond_of(rt * 160) == cond_of(rt * 160 + 159)};
        e(acc, sw, ct * 256 + wr * 64, rt * 160 + wc * 80, fr, fq);
    }
};
__device__ __forceinline__ void phase_mlp_up(const Ctx& c, int layer) {
    ProbMlpUp P{&c, (const bf16_t*)(c.a->ws + WS_W1) + (size_t)layer * DFF * D, (const bf16_t*)(c.a->ws + WS_H), D, D, D, layer};
    gemm_stream<5>(c, P);
}
#ifndef BENCH_MODE
#define BENCH_MODE 0
#endif
__device__ __forceinline__ void phase_bench(const Ctx& c) {
    ProbMlpUp P{&c, (const bf16_t*)(c.a->ws + WS_W1), (const bf16_t*)(c.a->ws + WS_H), D, D, D, 0};
    gemm_stream<5, ProbMlpUp, BENCH_MODE>(c, P);
}
struct ProbResid {
    static constexpr int EPI_STORES = 0;
    const Ctx* c; const bf16_t* WT; const bf16_t* Act; int lda, ldb, K; const float* gate; const float* bias; const float* ssq; const float* nw_next; const float* scale_next; bool first;
    static constexpr int NC = D / 256, NT = (NTOK / 160) * NC;
    __device__ __forceinline__ int count() const { return (NT - c->vb + c->G - 1) / c->G; }
    __device__ __forceinline__ void tile(int i, const bf16_t*& A, const bf16_t*& B) const { const int t = c->vb + i * c->G, rt = t / NC, ct = t - rt * NC; A = WT + (size_t)ct * 256 * K; B = Act + (size_t)rt * 160 * K; }
    __device__ __forceinline__ void pre_all() const {
        if (!ssq) return;
        float* tab = (float*)(c->lds + RS_OFF);
        const int n = count();
        for (int i = 0; i < n; ++i) {
            const int t = c->vb + i * c->G, rt = t / NC;
            if (c->tid < 160) {
                const float* p = ssq + (size_t)(rt * 160 + c->tid) * 32;
                float s = 0.f;
#pragma unroll
                for (int q = 0; q < 8; ++q) { const f32x4 v = *(const f32x4*)(p + q * 4); s += v[0] + v[1] + v[2] + v[3]; }
                tab[i * 160 + c->tid] = rsqrtf(s * (1.0f / DI) + EPS);
            }
        }
    }
    __device__ __forceinline__ void preload(int, f32x4 (&)[4], int, int) const {}
    __device__ __forceinline__ void epilogue(int i, f32x4 (&acc)[4][5], const f32x4 (&)[4], int wr, int wc, int fr, int fq) const {
        const int t = c->vb + i * c->G, rt = t / NC, ct = t - rt * NC; unsigned char* ws = c->a->ws;
        EpiResid e{c->a->out, gate, bias, ssq ? (const float*)(c->lds + RS_OFF) + i * 160 : nullptr, rt * 160, first ? c->a->in[0] : nullptr, first ? c->a->in[1] : nullptr, nw_next ? (bf16_t*)(ws + WS_H) : nullptr, nw_next, scale_next, (float*)(ws + WS_RSS), (const float*)(ws + WS_ZERO)};
        e(acc, ct * 256 + wr * 64, rt * 160 + wc * 80, fr, fq);
    }
};
__device__ __forceinline__ void phase_resid_gemm(const Ctx& c, const bf16_t* WT, const bf16_t* Act, int K, const float* gate, const float* bias, const float* ssq, const float* nw_next, const float* scale_next, bool first) {
    ProbResid P{&c, WT, Act, K, K, K, gate, bias, ssq, nw_next, scale_next, first};
    gemm_stream<5>(c, P);
}
struct ProbF1 {
    static constexpr int EPI_STORES = 16;
    const Ctx* c; const bf16_t* XG; const bf16_t* T1; int lda, ldb, K; int j;
    static constexpr int NT = (NTOK / 256) * 16;
    __device__ __forceinline__ int count() const { return (NT - c->vb + c->G - 1) / c->G; }
    __device__ __forceinline__ void tile(int i, const bf16_t*& A, const bf16_t*& B) const { const int t = c->vb + i * c->G, rt = t >> 4, g = (t >> 2) & 3, ct = t & 3; A = XG + (size_t)rt * 256 * D + g * 256; B = T1 + (size_t)ct * 128 * 256; }
    __device__ __forceinline__ void pre_all() const { rstd_tables(*c, count(), 256, c->vb, c->G, 256, 4); }
    __device__ __forceinline__ void preload(int, f32x4 (&)[4], int, int) const {}
    __device__ __forceinline__ void epilogue(int i, f32x4 (&acc)[4][4], const f32x4 (&)[4], int wr, int wc, int fr, int fq) const {
        const int t = c->vb + i * c->G, rt = t >> 4, g = (t >> 2) & 3, ct = t & 3; unsigned char* ws = c->a->ws;
        EpiF1 e{(bf16_t*)(ws + S_UVT), g, (const float*)(c->lds + RS_OFF) + i * 256, rt * 256, (const float*)(ws + WS_SWF1) + (size_t)j * 3 * 2048};
        e(acc, rt * 256 + wr * 64, ct * 128 + wc * 64, fr, fq);
    }
};
__device__ __forceinline__ void phase_f1(const Ctx& c, int j) {
    ProbF1 P{&c, (const bf16_t*)(c.a->ws + WS_H), (const bf16_t*)(c.a->ws + WS_T1), D, 256, 256, j};
    gemm_stream<4>(c, P);
}
struct ProbF2L {
    static constexpr int EPI_STORES = 0;
    const Ctx* c; const bf16_t* UVT; const bf16_t* T2; bf16_t* F; int lda, ldb, K;
    __device__ __forceinline__ int count() const { return c->vb < 128 ? 1 : 0; }
    __device__ __forceinline__ void tile(int i, const bf16_t*& A, const bf16_t*& B) const { const int t = c->vb, s = t >> 6, nt = (t >> 4) & 3, kt = t & 15; A = UVT + (size_t)NCTX * 2048 + ((size_t)s * 1024 + nt * 256) * 2048; B = T2 + (size_t)kt * 64 * 2048; }
    __device__ __forceinline__ void pre_all() const {}
    __device__ __forceinline__ void preload(int, f32x4 (&)[4], int, int) const {}
    __device__ __forceinline__ void epilogue(int i, f32x4 (&acc)[4][2], const f32x4 (&)[4], int wr, int wc, int fr, int fq) const { const int t = c->vb, s = t >> 6, nt = (t >> 4) & 3, kt = t & 15; EpiF2<2> e{F, NCTX + s * 1024}; e(acc, nt * 256 + wr * 64, kt * 64 + wc * 32, fr, fq); }
};
struct ProbF2C {
    static constexpr int EPI_STORES = 16;
    const Ctx* c; const bf16_t* UVT; const bf16_t* T2; bf16_t* F; int lda, ldb, K; int first, stride;
    __device__ __forceinline__ int count() const { return (256 - first + stride - 1) / stride; }
    __device__ __forceinline__ void tile(int i, const bf16_t*& A, const bf16_t*& B) const { const int u = first + i * stride, s = u >> 3, nt = (u >> 1) & 3, kt = u & 1; A = UVT + ((size_t)s * 1024 + nt * 256) * 512; B = T2 + (size_t)kt * 128 * 512; }
    __device__ __forceinline__ void pre_all() const {}
    __device__ __forceinline__ void preload(int, f32x4 (&)[4], int, int) const {}
    __device__ __forceinline__ void epilogue(int i, f32x4 (&acc)[4][4], const f32x4 (&)[4], int wr, int wc, int fr, int fq) const { const int u = first + i * stride, s = u >> 3, nt = (u >> 1) & 3, kt = u & 1; EpiF2<4> e{F, s * 256}; e(acc, nt * 256 + wr * 64, kt * 128 + wc * 64, fr, fq); }
};
__device__ __forceinline__ void phase_f2(const Ctx& c) {
    unsigned char* ws = c.a->ws;
    const int half = c.G >> 1;
    if (c.vb < half) { ProbF2L P{&c, (const bf16_t*)(ws + S_UVT), (const bf16_t*)(ws + WS_T2L), (bf16_t*)(ws + S_F), 2048, 2048, 2048}; gemm_stream<2>(c, P); }
    else { ProbF2C P{&c, (const bf16_t*)(ws + S_UVT), (const bf16_t*)(ws + WS_T2C), (bf16_t*)(ws + S_F), 512, 512, 512, c.vb - half, c.G - half}; gemm_stream<4>(c, P); }
}

struct ProbDt {
    static constexpr int EPI_STORES = 0;
    const Ctx* c; const bf16_t* XG; const bf16_t* W; int lda, ldb, K; int j;
    __device__ __forceinline__ int count() const { return (NTOK / 256 - c->vb + c->G - 1) / c->G; }
    __device__ __forceinline__ void tile(int i, const bf16_t*& A, const bf16_t*& B) const { const int t = c->vb + i * c->G; A = XG + (size_t)t * 256 * D; B = W; }
    __device__ __forceinline__ void pre_all() const { rstd_tables(*c, count(), 256, c->vb, c->G, 256, 0); }
    __device__ __forceinline__ void preload(int, f32x4 (&)[4], int, int) const {}
    __device__ __forceinline__ void epilogue(int i, f32x4 (&acc)[4][2], const f32x4 (&)[4], int wr, int wc, int fr, int fq) const {
        const int t = c->vb + i * c->G; unsigned char* ws = c->a->ws;
        EpiDt e{(float*)(ws + S_DT), (const float*)(c->lds + RS_OFF) + i * 256, t * 256, (const float*)(ws + WS_SWIN) + (size_t)j * 3 * DPROJ};
        e(acc, t * 256 + wr * 64, wc * 32, fr, fq);
    }
};
__device__ __forceinline__ void phase_conv(const Ctx& c, int j) {
    const Args __attribute__((address_space(4)))& a = *c.a;
    {
        ProbDt P{&c, (const bf16_t*)(a.ws + WS_H), (const bf16_t*)(a.ws + WS_WIN) + (size_t)j * DPROJ * D + (size_t)NZX * D, D, D, D, j};
        gemm_stream<2>(c, P);
    }
    const bf16_t* RAW = (const bf16_t*)(a.ws + S_RAW);
    bf16_t* XBC = (bf16_t*)(a.ws + S_XBC);
    const float* cw = a.in[10] + (size_t)j * 3 * DXBC;
    const float* cb = a.in[11] + (size_t)j * DXBC;
    constexpr int NIT = (NTOK / 64) * 3;
    for (int it = c.G - 1 - c.vb; it < NIT; it += c.G) {
        const int tg = it / 3, third = it - tg * 3;
        const int ch = third * 1024 + (c.tid & 127) * 8;
        const int r0 = tg * 64 + (c.tid >> 7) * 16;
        float w0[8], w1[8], w2[8], bb[8];
#pragma unroll
        for (int q = 0; q < 2; ++q) {
            const f32x4 t0 = *(const f32x4*)(cw + ch + q * 4), t1 = *(const f32x4*)(cw + DXBC + ch + q * 4), t2 = *(const f32x4*)(cw + 2 * DXBC + ch + q * 4), t3 = *(const f32x4*)(cb + ch + q * 4);
#pragma unroll
            for (int e = 0; e < 4; ++e) { w0[q * 4 + e] = t0[e]; w1[q * 4 + e] = t1[e]; w2[q * 4 + e] = t2[e]; bb[q * 4 + e] = t3[e]; }
        }
        const int seg = r0 < NCTX ? 256 : 64;
        u32x4 rows[18];
        {
            const int tl = (r0 % seg) != 0 ? r0 - 1 : r0, th = ((r0 + 16) % seg) != 0 ? r0 + 16 : r0 + 15;
            rows[0] = *(const u32x4*)(RAW + (size_t)tl * DXBC + ch);
#pragma unroll
            for (int r = 0; r < 16; ++r) rows[r + 1] = *(const u32x4*)(RAW + (size_t)(r0 + r) * DXBC + ch);
            rows[17] = *(const u32x4*)(RAW + (size_t)th * DXBC + ch);
            if ((r0 % seg) == 0) rows[0] = (u32x4){0, 0, 0, 0};
            if (((r0 + 16) % seg) == 0) rows[17] = (u32x4){0, 0, 0, 0};
        }
#pragma unroll
        for (int r = 0; r < 16; ++r) {
            const int t = r0 + r;
            const u32x4 prev = rows[r], cur = rows[r + 1], nxt = rows[r + 2];
            u32x4 o;
#pragma unroll
            for (int e = 0; e < 4; ++e) {
                const float lo = bb[2 * e] + w0[2 * e] * bflo(prev[e]) + w1[2 * e] * bflo(cur[e]) + w2[2 * e] * bflo(nxt[e]);
                const float hi = bb[2 * e + 1] + w0[2 * e + 1] * bfhi(prev[e]) + w1[2 * e + 1] * bfhi(cur[e]) + w2[2 * e + 1] * bfhi(nxt[e]);
                o[e] = pk2(silu_f(lo), silu_f(hi));
            }
            *(u32x4*)(XBC + (size_t)t * DXBC + ch) = o;
        }
    }
}

constexpr int SC_XS = 0, SC_XW = 16384, SC_BS = 32768, SC_CS = 49152, SC_HT = 65536, SC_SM = 98304;
__device__ __forceinline__ int off128(int row, int col) { return row * 128 + ((((col >> 3) ^ (row & 7))) << 4) + (col & 7) * 2; }
__device__ __forceinline__ int off256(int row, int col) { return row * 256 + ((((col >> 3) ^ (row & 15))) << 4) + (col & 7) * 2; }
__device__ __forceinline__ int offX(int row, int col) { return row * 128 + col * 2; }
__device__ __forceinline__ int offP(int row, int col) { return row * 144 + col * 2; }
template <int LAY>
__device__ __forceinline__ bf16x8 tr_frag(const char* tile, int r0, int r1, int col0, int lane) {
    const int i = lane & 15, q = i >> 2, cc = col0 + (i & 3) * 4;
    const int o0 = LAY == 1 ? off256(r0 + q, cc) : LAY == 2 ? offP(r0 + q, cc) : offX(r0 + q, cc);
    const int o1 = LAY == 1 ? off256(r1 + q, cc) : LAY == 2 ? offP(r1 + q, cc) : offX(r1 + q, cc);
    const bf16x4 lo = __builtin_amdgcn_ds_read_tr16_b64_v4i16((LAS bf16x4*)(tile + o0));
    const bf16x4 hi = __builtin_amdgcn_ds_read_tr16_b64_v4i16((LAS bf16x4*)(tile + o1));
    return __builtin_shufflevector(lo, hi, 0, 1, 2, 3, 4, 5, 6, 7);
}

struct ScanStep { int seq, hp, dir, ci, nch, t0, valid, single, h0; };
struct ScanIter {
    int vb, G, k, dir, ci;
    __device__ __forceinline__ void get(ScanStep& s) const {
        int seq, hp, ok, single = 0, h0 = 0;
        if (vb < 64) { seq = 32 + (vb >> 5); h0 = vb & 31; hp = h0 >> 1; single = 1; ok = (k == 0); }
        else { const int u = (vb - 64) + k * (G - 64); seq = u >> 4; hp = u & 15; ok = (u < 512); }
        const bool lat = seq >= 32;
        s.seq = seq; s.hp = hp; s.dir = dir; s.ci = ci; s.nch = lat ? 16 : 4; s.valid = ok; s.single = single; s.h0 = h0;
        const int tok0 = lat ? NCTX + (seq - 32) * 1024 : seq * 256;
        const int ch = dir == 0 ? ci : s.nch - 1 - ci;
        s.t0 = tok0 + ch * 64;
    }
    __device__ __forceinline__ void advance() {
        int seq; if (vb < 64) seq = 32; else seq = 0;
        const int nch = seq >= 32 ? 16 : 4;
        if (++ci == nch) { ci = 0; if (++dir == 2) { dir = 0; ++k; } }
    }
};
constexpr int SCB = 49152;
constexpr int SB_XS = 0, SB_BS = 16384, SB_CS = 32768;
constexpr int XW_BYTES = 64 * 144, HT_BYTES = 128 * 144;
constexpr int SCN_XW = 2 * SCB, SCN_HT = SCN_XW + 2 * XW_BYTES, SCN_SM = SCN_HT + 2 * HT_BYTES;

__device__ __forceinline__ void scan_issue_tiles(const Ctx& c, const ScanStep& s, int buf) {
    const bf16_t* XBC = (const bf16_t*)(c.a->ws + S_XBC);
    char* base = c.lds + buf * SCB;
    const int lane = c.lane, w8 = c.wid, g = s.hp >> 2;
#pragma unroll
    for (int hh = 0; hh < 2; ++hh) {
        if (hh == 1 && s.single) break;
        const int q = w8, row = q * 8 + (lane >> 3), lch = lane & 7, hd = s.single ? s.h0 : 2 * s.hp + hh;
        __builtin_amdgcn_global_load_lds((const unsigned*)(XBC + (size_t)(s.t0 + row) * DXBC + hd * 64 + lch * 8), (LAS unsigned*)(base + SB_XS + hh * 8192 + q * 1024 + lane * 16), 16, 0, 0);
    }
#pragma unroll
    for (int i = 0; i < 2; ++i) {
        const int q = w8 + 8 * i, row = q * 4 + (lane >> 4), lch = (lane & 15) ^ (row & 15);
        __builtin_amdgcn_global_load_lds((const unsigned*)(XBC + (size_t)(s.t0 + row) * DXBC + DI + g * 128 + lch * 8), (LAS unsigned*)(base + SB_BS + q * 1024 + lane * 16), 16, 0, 0);
        __builtin_amdgcn_global_load_lds((const unsigned*)(XBC + (size_t)(s.t0 + row) * DXBC + DI + 512 + g * 128 + lch * 8), (LAS unsigned*)(base + SB_CS + q * 1024 + lane * 16), 16, 0, 0);
    }
}
__device__ __forceinline__ float scan_load_dt(const Ctx& c, const ScanStep& s, int hw) {
    const float* DT = (const float*)(c.a->ws + S_DT);
    const int l = s.dir == 0 ? c.lane : 63 - c.lane, h = s.single ? s.h0 : 2 * s.hp + hw;
    return DT[(size_t)(s.t0 + l) * 64 + s.dir * NH + h];
}
__device__ __forceinline__ void scan_dtcs(const Ctx& c, const ScanStep& s, int hw, int j, float raw, float* sm) {
    const int lane = c.lane, l = s.dir == 0 ? lane : 63 - lane, h = s.single ? s.h0 : 2 * s.hp + hw;
    const float Aneg = -__expf(c.a->in[13][(j * 2 + s.dir) * NH + h]);
    raw += c.a->in[12][(j * 2 + s.dir) * NH + h];
    const float dt = raw > 20.f ? raw : __logf(1.0f + __expf(raw));
    float cs = dt * Aneg;
#pragma unroll
    for (int o = 1; o < 64; o <<= 1) { const float u = __shfl_up(cs, o); if (lane >= o) cs += u; }
    sm[l] = dt; sm[64 + l] = cs;
    if (lane == 63) sm[128] = cs;
}

__device__ __forceinline__ void phase_scan_pipe(const Ctx& c, int j) {
    const Args __attribute__((address_space(4)))& a = *c.a;
    const bf16_t* Z = (const bf16_t*)(a.ws + S_Z);
    bf16_t* YTMP = (bf16_t*)(a.ws + S_RAW);
    bf16_t* YG = (bf16_t*)(a.ws + S_YG);
    float* SSQ = (float*)(a.ws + S_SSQ);
    const int hw = c.wid >> 2, w = c.wid & 3;
    char* lds = c.lds;
    char* XWp = lds + SCN_XW + hw * XW_BYTES; char* HTp = lds + SCN_HT + hw * HT_BYTES;

    ScanIter it{c.vb, c.G, 0, 0, 0};
    ScanStep cur, nxt, nx2;
    it.get(cur); it.advance(); it.get(nxt); it.advance(); it.get(nx2);
    if (!cur.valid) return;
    scan_issue_tiles(c, cur, 0);
    float raw_n1 = 0.f;
    if (w == 0 && !(cur.single && hw == 1)) {
        const float r0 = scan_load_dt(c, cur, hw);
        if (nxt.valid) raw_n1 = scan_load_dt(c, nxt, hw);
        scan_dtcs(c, cur, hw, j, r0, (float*)(lds + SCN_SM + (0 * 2 + hw) * 1024));
    }
    f32x4 S[4][2];
#pragma unroll
    for (int pb = 0; pb < 4; ++pb)
#pragma unroll
        for (int nbi = 0; nbi < 2; ++nbi) S[pb][nbi] = (f32x4){0.f, 0.f, 0.f, 0.f};

#pragma unroll 1
    for (int s = 0; cur.valid; ++s) {
        int lane = c.lane; asm volatile("" : "+v"(lane));
        const int fr = lane & 15, fq = lane >> 4;
        const int b = s & 1;
        char* TB_ = lds + b * SCB;
        char* XSp = TB_ + SB_XS + hw * 8192;
        const float* sm_dt = (const float*)(lds + SCN_SM + (b * 2 + hw) * 1024);
        const float* sm_cs = sm_dt + 64;
        const bool is_lat = cur.seq >= 32;
        const bool active = !(cur.single && hw == 1);
        const int dir = cur.dir, t0 = cur.t0, h = cur.single ? cur.h0 : 2 * cur.hp + hw;
        asm volatile("s_waitcnt vmcnt(0)" ::: "memory");
        __syncthreads();
        if (nxt.valid) scan_issue_tiles(c, nxt, b ^ 1);
        float raw_n2 = 0.f;
        if (w == 0 && nx2.valid && !(nx2.single && hw == 1)) raw_n2 = scan_load_dt(c, nx2, hw);
        u32x2 yt[4], zz[4]; f32x4 nwv[4]; float Dh = 0.f;
        const int tok = t0 + w * 16 + fr;
        if (dir == 1 && active) {
            Dh = a.in[14][j * NH + h];
            const float* normw = a.in[15] + (size_t)j * DI + h * 64;
#pragma unroll
            for (int pb = 0; pb < 4; ++pb) {
                const int p0 = pb * 16 + fq * 4;
                yt[pb] = *(const u32x2*)(YTMP + (size_t)tok * DI + h * 64 + p0);
                zz[pb] = *(const u32x2*)(Z + (size_t)tok * DI + h * 64 + p0);
                nwv[pb] = *(const f32x4*)(normw + p0);
            }
        }
        bool has_h = is_lat || cur.ci > 0;
        if (cur.ci == 0) {
            if (is_lat) {
                if (active) {
                const float* sp = a.in[2] + ((size_t)(((cur.seq - 32) * 2 + j) * 2 + dir) * NH + h) * 8192;
#pragma unroll
                for (int pb = 0; pb < 4; ++pb)
#pragma unroll
                    for (int nbi = 0; nbi < 2; ++nbi) {
                        const int n = (2 * w + nbi) * 16 + fr, p0 = pb * 16 + fq * 4;
#pragma unroll
                        for (int r = 0; r < 4; ++r) S[pb][nbi][r] = sp[(p0 + r) * 128 + n];
                        u32x2 v; v.x = pk2(S[pb][nbi][0], S[pb][nbi][1]); v.y = pk2(S[pb][nbi][2], S[pb][nbi][3]);
                        *(u32x2*)(HTp + offP(n, p0)) = v;
                    }
                }
                __syncthreads();
            } else {
#pragma unroll
                for (int pb = 0; pb < 4; ++pb)
#pragma unroll
                    for (int nbi = 0; nbi < 2; ++nbi) S[pb][nbi] = (f32x4){0.f, 0.f, 0.f, 0.f};
            }
        }
        float tot = 0.f;
        if (active) {
        tot = sm_dt[128];
        {
            const int tl = c.tid & 255, l = tl >> 2, c0 = (tl & 3) * 16;
            const float sc = __expf(tot - sm_cs[l]) * sm_dt[l];
#pragma unroll
            for (int q = 0; q < 2; ++q) {
                const u32x4 v = *(const u32x4*)(XSp + offX(l, c0 + q * 8));
                u32x4 r;
#pragma unroll
                for (int e = 0; e < 4; ++e) r[e] = pk2(bflo(v[e]) * sc, bfhi(v[e]) * sc);
                *(u32x4*)(XWp + offP(l, c0 + q * 8)) = r;
            }
        }
        bf16x8 cf[4];
#pragma unroll
        for (int kk = 0; kk < 4; ++kk) cf[kk] = *(const bf16x8*)(TB_ + SB_CS + off256(w * 16 + fr, kk * 32 + fq * 8));
        const float csl = sm_cs[w * 16 + fr];
        f32x4 yacc[4];
#pragma unroll
        for (int pb = 0; pb < 4; ++pb) yacc[pb] = (f32x4){0.f, 0.f, 0.f, 0.f};
        if (has_h) {
            bf16x8 hf[2][4];
#pragma unroll
            for (int pb = 0; pb < 4; ++pb) hf[0][pb] = tr_frag<2>(HTp, fq * 8, fq * 8 + 4, pb * 16, lane);
#pragma unroll
            for (int kk = 0; kk < 4; ++kk) {
                if (kk < 3) {
#pragma unroll
                    for (int pb = 0; pb < 4; ++pb) hf[(kk + 1) & 1][pb] = tr_frag<2>(HTp, (kk + 1) * 32 + fq * 8, (kk + 1) * 32 + fq * 8 + 4, pb * 16, lane);
                }
                __builtin_amdgcn_sched_barrier(0);
#pragma unroll
                for (int pb = 0; pb < 4; ++pb) yacc[pb] = __builtin_amdgcn_mfma_f32_16x16x32_bf16(hf[kk & 1][pb], cf[kk], yacc[pb], 0, 0, 0);
            }
            const float e = __expf(csl);
#pragma unroll
            for (int pb = 0; pb < 4; ++pb) yacc[pb] = yacc[pb] * e;
        }
#pragma unroll
        for (int kk2 = 0; kk2 < 2; ++kk2) {
            const bool need = dir == 0 ? (2 * kk2 <= w) : (2 * kk2 + 1 >= w);
            if (need) {
                unsigned m[4];
                bf16x8 bfg[2][4];
                f32x4 gg[2];
#pragma unroll
                for (int half = 0; half < 2; ++half)
#pragma unroll
                    for (int kk = 0; kk < 4; ++kk) bfg[half][kk] = *(const bf16x8*)(TB_ + SB_BS + off256((2 * kk2 + half) * 16 + fr, kk * 32 + fq * 8));
                bf16x8 xf[4];
#pragma unroll
                for (int pb = 0; pb < 4; ++pb) xf[pb] = tr_frag<0>(XSp, 32 * kk2 + 4 * fq, 32 * kk2 + 16 + 4 * fq, pb * 16, lane);
                __builtin_amdgcn_sched_barrier(0);
                gg[0] = (f32x4){0.f, 0.f, 0.f, 0.f}; gg[1] = (f32x4){0.f, 0.f, 0.f, 0.f};
#pragma unroll
                for (int kk = 0; kk < 4; ++kk)
#pragma unroll
                    for (int half = 0; half < 2; ++half) gg[half] = __builtin_amdgcn_mfma_f32_16x16x32_bf16(bfg[half][kk], cf[kk], gg[half], 0, 0, 0);
#pragma unroll
                for (int half = 0; half < 2; ++half) {
                    const int sb = 2 * kk2 + half;
                    const f32x4 gacc = gg[half];
                    const f32x4 css = *(const f32x4*)(sm_cs + sb * 16 + fq * 4);
                    const f32x4 dts = *(const f32x4*)(sm_dt + sb * 16 + fq * 4);
                    float v[4];
#pragma unroll
                    for (int r = 0; r < 4; ++r) {
                        const int si = sb * 16 + fq * 4 + r, l = w * 16 + fr;
                        const bool valid = dir == 0 ? (si <= l) : (si >= l);
                        v[r] = valid ? gacc[r] * __expf(csl - css[r]) * dts[r] : 0.f;
                    }
                    m[half * 2 + 0] = pk2(v[0], v[1]); m[half * 2 + 1] = pk2(v[2], v[3]);
                }
                union { unsigned u[4]; bf16x8 v; } mf; mf.u[0] = m[0]; mf.u[1] = m[1]; mf.u[2] = m[2]; mf.u[3] = m[3];
#pragma unroll
                for (int pb = 0; pb < 4; ++pb) yacc[pb] = __builtin_amdgcn_mfma_f32_16x16x32_bf16(xf[pb], mf.v, yacc[pb], 0, 0, 0);
            }
        }
        {
            const int l = w * 16 + fr;
            if (dir == 0) {
                u32x2 v[4];
#pragma unroll
                for (int pb = 0; pb < 4; ++pb) { v[pb].x = pk2(yacc[pb][0], yacc[pb][1]); v[pb].y = pk2(yacc[pb][2], yacc[pb][3]); }
#pragma unroll
                for (int p = 0; p < 2; ++p) {
                    const u32x4 o = pair16(v[2 * p], v[2 * p + 1]);
                    *(u32x4*)(YTMP + (size_t)tok * DI + h * 64 + (2 * p + (fq & 1)) * 16 + (fq & 2) * 4) = o;
                }
            } else {
                float ss = 0.f;
                u32x2 v[4];
#pragma unroll
                for (int pb = 0; pb < 4; ++pb) {
                    const int p0 = pb * 16 + fq * 4;
                    const u32x2 xx = *(const u32x2*)(XSp + offX(l, p0));
                    const f32x4 nw = nwv[pb];
                    float y[4];
                    y[0] = yacc[pb][0] + bflo(yt[pb].x) + Dh * bflo(xx.x); y[1] = yacc[pb][1] + bfhi(yt[pb].x) + Dh * bfhi(xx.x);
                    y[2] = yacc[pb][2] + bflo(yt[pb].y) + Dh * bflo(xx.y); y[3] = yacc[pb][3] + bfhi(yt[pb].y) + Dh * bfhi(xx.y);
                    y[0] *= silu_f(bflo(zz[pb].x)); y[1] *= silu_f(bfhi(zz[pb].x)); y[2] *= silu_f(bflo(zz[pb].y)); y[3] *= silu_f(bfhi(zz[pb].y));
                    ss += y[0] * y[0] + y[1] * y[1] + y[2] * y[2] + y[3] * y[3];
                    v[pb].x = pk2(y[0] * nw[0], y[1] * nw[1]); v[pb].y = pk2(y[2] * nw[2], y[3] * nw[3]);
                }
#pragma unroll
                for (int p = 0; p < 2; ++p) {
                    const u32x4 o = pair16(v[2 * p], v[2 * p + 1]);
                    *(u32x4*)(YG + (size_t)tok * DI + h * 64 + (2 * p + (fq & 1)) * 16 + (fq & 2) * 4) = o;
                }
                ss += __shfl_xor(ss, 16); ss += __shfl_xor(ss, 32);
                if (fq == 0) SSQ[(size_t)tok * NH + h] = ss;
            }
        }
        }
        __syncthreads();
        if (active) {
            const float et = __expf(tot);
#pragma unroll
            for (int pb = 0; pb < 4; ++pb)
#pragma unroll
                for (int nbi = 0; nbi < 2; ++nbi) S[pb][nbi] = S[pb][nbi] * et;
            bf16x8 bq[2][2], xa[2][4];
#pragma unroll
            for (int kk = 0; kk < 2; ++kk) {
#pragma unroll
                for (int nbi = 0; nbi < 2; ++nbi) bq[kk][nbi] = tr_frag<1>(TB_ + SB_BS, kk * 32 + fq * 8, kk * 32 + fq * 8 + 4, (2 * w + nbi) * 16, lane);
#pragma unroll
                for (int pb = 0; pb < 4; ++pb) xa[kk][pb] = tr_frag<2>(XWp, kk * 32 + fq * 8, kk * 32 + fq * 8 + 4, pb * 16, lane);
            }
            __builtin_amdgcn_sched_barrier(0);
#pragma unroll
            for (int kk = 0; kk < 2; ++kk)
#pragma unroll
                for (int pb = 0; pb < 4; ++pb)
#pragma unroll
                    for (int nbi = 0; nbi < 2; ++nbi) S[pb][nbi] = __builtin_amdgcn_mfma_f32_16x16x32_bf16(xa[kk][pb], bq[kk][nbi], S[pb][nbi], 0, 0, 0);
#pragma unroll
            for (int pb = 0; pb < 4; ++pb)
#pragma unroll
                for (int nbi = 0; nbi < 2; ++nbi) {
                    const int n = (2 * w + nbi) * 16 + fr, p0 = pb * 16 + fq * 4;
                    u32x2 v; v.x = pk2(S[pb][nbi][0], S[pb][nbi][1]); v.y = pk2(S[pb][nbi][2], S[pb][nbi][3]);
                    *(u32x2*)(HTp + offP(n, p0)) = v;
                }
        }
        if (active && !is_lat && cur.ci == cur.nch - 1) {
            float* op = a.out + (size_t)NTOK * D + ((size_t)((cur.seq * 2 + j) * 2 + dir) * NH + h) * 8192;
#pragma unroll
            for (int pb = 0; pb < 4; ++pb)
#pragma unroll
                for (int nbi = 0; nbi < 2; ++nbi) {
                    const int n = (2 * w + nbi) * 16 + fr, p0 = pb * 16 + fq * 4;
#pragma unroll
                    for (int r = 0; r < 4; ++r) op[(p0 + r) * 128 + n] = S[pb][nbi][r];
                }
        }
        if (w == 0 && nxt.valid && !(nxt.single && hw == 1)) scan_dtcs(c, nxt, hw, j, raw_n1, (float*)(lds + SCN_SM + ((b ^ 1) * 2 + hw) * 1024));
        raw_n1 = raw_n2;
        cur = nxt; nxt = nx2; it.advance(); it.get(nx2);
    }
}

#if NAIVE_SCAN
__device__ __forceinline__ void scan_unit_naive(const Ctx& c, int j, int seq, int h) {
    const Args __attribute__((address_space(4)))& a = *c.a;
    const bf16_t* XBC = (const bf16_t*)(a.ws + S_XBC);
    const bf16_t* Z = (const bf16_t*)(a.ws + S_Z);
    const float* DT = (const float*)(a.ws + S_DT);
    bf16_t* YTMP = (bf16_t*)(a.ws + S_RAW);
    bf16_t* YG = (bf16_t*)(a.ws + S_YG);
    float* SSQ = (float*)(a.ws + S_SSQ);
    const bool is_lat = seq >= 32;
    const int tok0 = is_lat ? NCTX + (seq - 32) * 1024 : seq * 256;
    const int L = is_lat ? 1024 : 256;
    const int g = h >> 3, p = c.tid >> 2, nq = (c.tid & 3) * 32;
    const float Dh = a.in[14][j * NH + h];
    const float nw = a.in[15][(size_t)j * DI + h * 64 + p];
    float* red = (float*)c.lds;
    for (int dir = 0; dir < 2; ++dir) {
        const float Aneg = -__expf(a.in[13][(j * 2 + dir) * NH + h]);
        const float dtb = a.in[12][(j * 2 + dir) * NH + h];
        float hs[32];
        if (is_lat) { const float* sp = a.in[2] + ((size_t)(((seq - 32) * 2 + j) * 2 + dir) * NH + h) * 8192 + p * 128 + nq;
#pragma unroll
            for (int e = 0; e < 32; ++e) hs[e] = sp[e]; }
        else {
#pragma unroll
            for (int e = 0; e < 32; ++e) hs[e] = 0.f; }
        asm volatile("s_waitcnt vmcnt(0)" ::: "memory"); __syncthreads();
        for (int ti = 0; ti < L; ++ti) {
            const int tok = tok0 + (dir == 0 ? ti : L - 1 - ti);
            const float raw = DT[(size_t)tok * 64 + dir * NH + h] + dtb;
            const float dt = raw > 20.f ? raw : log1pf(__expf(raw));
            const float dec = __expf(dt * Aneg);
            const float xv = bflo((unsigned)XBC[(size_t)tok * DXBC + h * 64 + p]);
            const bf16_t* Bp = XBC + (size_t)tok * DXBC + DI + g * 128 + nq;
            const bf16_t* Cp = XBC + (size_t)tok * DXBC + DI + 512 + g * 128 + nq;
            float y = 0.f;
#pragma unroll
            for (int e = 0; e < 32; ++e) { hs[e] = hs[e] * dec + dt * xv * bflo((unsigned)Bp[e]); y += bflo((unsigned)Cp[e]) * hs[e]; }
            y += __shfl_xor(y, 1); y += __shfl_xor(y, 2);
            if (dir == 0) { if ((c.tid & 3) == 0) YTMP[(size_t)tok * DI + h * 64 + p] = (bf16_t)(pk2(y, 0.f) & 0xffff); }
            else {
                const float yt = bflo((unsigned)YTMP[(size_t)tok * DI + h * 64 + p]);
                const float zz = bflo((unsigned)Z[(size_t)tok * DI + h * 64 + p]);
                float yy = (y + yt + Dh * xv) * silu_f(zz);
                __syncthreads();
                if ((c.tid & 3) == 0) { red[p] = yy * yy; YG[(size_t)tok * DI + h * 64 + p] = (bf16_t)(pk2(yy * nw, 0.f) & 0xffff); }
                __syncthreads();
                if (c.tid == 0) { float s = 0.f; for (int e = 0; e < 64; ++e) s += red[e]; SSQ[(size_t)tok * NH + h] = s; }
            }
        }
        if (!is_lat) { float* op = a.out + (size_t)NTOK * D + ((size_t)((seq * 2 + j) * 2 + dir) * NH + h) * 8192 + p * 128 + nq;
#pragma unroll
            for (int e = 0; e < 32; ++e) op[e] = hs[e]; }
    }
}
#endif
__device__ __forceinline__ void phase_scan(const Ctx& c, int j) {
#if NAIVE_SCAN
    for (int u = c.vb; u < 1088; u += c.G) { if (u < 64) scan_unit_naive(c, j, 32 + (u >> 5), u & 31); else scan_unit_naive(c, j, (u - 64) >> 5, (u - 64) & 31); }
    return;
#endif
    phase_scan_pipe(c, j);
}

typedef const Args __attribute__((address_space(4)))* ArgsP;
#if 0
#define LB_WAVES 1
#else
#define LB_WAVES 2
#endif
__global__ void __launch_bounds__(NTHR, LB_WAVES) fwd_kernel(Args args) {
    extern __shared__ __attribute__((aligned(16))) char lds[];
    volatile LAS unsigned* st = (volatile LAS unsigned*)(lds + LDS_BYTES - 16);
    if (threadIdx.x == 0) { st[0] = 0u; st[1] = 0u; }
    __syncthreads();
    const int ph_lo = args.ph_lo, ph_hi = args.ph_hi;
    const bool multi = (ph_hi - ph_lo) > 1;
    XcdBarrier bar; bar.bar = (unsigned*)(args.ws + WS_CTL); bar.x = 0; bar.st = st;
    if (multi) bar = xcd_barrier_post((unsigned*)(args.ws + WS_CTL), st);

    int rep = 0;
#pragma unroll 1
    for (int ph = ph_lo; ph < ph_hi; ++ph) {
        ArgsP ap = (ArgsP)__builtin_amdgcn_kernarg_segment_ptr();
        asm volatile("" : "+s"(ap));
        int tid = threadIdx.x;
        asm volatile("" : "+v"(tid));
        Ctx c;
        c.lds = lds; c.tid = tid; c.lane = tid & 63; c.wid = __builtin_amdgcn_readfirstlane(tid >> 6);
        c.G = gridDim.x; c.vb = (c.G % 8 == 0) ? (int)(blockIdx.x % 8) * (c.G / 8) + (int)(blockIdx.x / 8) : (int)blockIdx.x;
        c.a = ap;
        unsigned char* ws = ap->ws;
        const float* MOD = (const float*)(ws + WS_MOD);

        int kind = 0;
        if (ph == 0) { if (PH_ON(0)) phase_prep(c); }
        else if (ph == 1) { kind = 12; phase_prep2(c); }
        else if (ph == NPHASE - 1) { kind = 10; if (PH_ON(1)) phase_norm(c, ap->in[21], nullptr, 0, 0, true); }
        else {
            int layer, sub;
            if (ph <= 7) { layer = 0; sub = ph - 2; } else if (ph <= 12) { layer = 1; sub = ph - 8; } else if (ph <= 18) { layer = 2; sub = ph - 13; } else { layer = 3; sub = ph - 19; }
            const int j = layer >> 1;
            const float* mod = MOD + (size_t)layer * 3 * 6144;
            const bool ssd = (layer & 1) == 0;
            const int nmix = ssd ? 4 : 3;
            if (sub < nmix - 1) kind = ssd ? (sub == 0 ? 2 : sub == 1 ? 3 : 4) : (sub == 0 ? 6 : 7);
            else if (sub == nmix) kind = 8;
            else kind = 5;

            if (kind == 2) { if (PH_ON(2)) phase_inproj(c, j); }
            else if (kind == 3) { if (PH_ON(3)) phase_conv(c, j); }
            else if (kind == 4) { if (PH_ON(4)) phase_scan(c, j); }
            else if (kind == 6) { if (PH_ON(6)) phase_f1(c, j); }
            else if (kind == 7) { if (PH_ON(7)) phase_f2(c); }
            else if (kind == 8) { if (PH_ON(8)) phase_mlp_up(c, layer); }
            else {
                if (PH_ON(5)) {
                    const bf16_t* WT; const bf16_t* Act; int K; const float* gate; const float* bias = nullptr; const float* ssq = nullptr;
                    const float* nw_next; const float* scale_next;
                    if (sub == nmix - 1) {
                        gate = mod + 2048; nw_next = ap->in[8] + layer * D; scale_next = mod + 4096;
                        if (ssd) { WT = (const bf16_t*)(ws + WS_WOUT) + (size_t)j * D * DI; Act = (const bf16_t*)(ws + S_YG); K = DI; ssq = (const float*)(ws + S_SSQ); }
                        else { WT = (const bf16_t*)(ws + WS_WFNO) + (size_t)j * D * D; Act = (const bf16_t*)(ws + S_F); K = D; bias = ap->in[18] + j * D; }
                    } else {
                        gate = mod + 5120; WT = (const bf16_t*)(ws + WS_W2) + (size_t)layer * D * DFF; Act = (const bf16_t*)(ws + S_HID); K = DFF;
                        if (layer < 3) { nw_next = ap->in[7] + (layer + 1) * D; scale_next = mod + 3 * 6144 + 1024; } else { nw_next = nullptr; scale_next = nullptr; }
                    }
                    if (rep > 0) { gate = (const float*)(ws + WS_ZERO); }
                    phase_resid_gemm(c, WT, Act, K, gate, bias, ssq, nw_next, scale_next, layer == 0 && sub == nmix - 1 && rep == 0);
                }
            }
        }
        if (REP_KIND == 9) { for (int r = 0; r < REP_N; ++r) if (multi) xcd_barrier(bar); }
        if (REP_N > 0 && kind == REP_KIND && rep < REP_N) { ++rep; --ph; if (multi) xcd_barrier(bar); continue; }
        rep = 0;
        if (REP_KIND == 11 && ph == NPHASE - 1) { for (int r = 0; r < REP_N; ++r) { if (multi) xcd_barrier(bar); phase_bench(c); } }
        if (ph + 1 < ph_hi) xcd_barrier(bar);
    }
}

extern "C" void kernel_launch(void* const* d_in, const int* in_sizes, int n_in, void* d_out, int out_size, void* d_ws, size_t ws_size, hipStream_t stream) {
    static int grid = 0;
    if (grid == 0) {
        int dev = 0, cus = 0;
        if (hipGetDevice(&dev) != hipSuccess || hipDeviceGetAttribute(&cus, hipDeviceAttributeMultiprocessorCount, dev) != hipSuccess || cus <= 0) { fprintf(stderr, "kernel_launch: device query failed\n"); grid = -1; return; }
        if (hipFuncSetAttribute((const void*)fwd_kernel, hipFuncAttributeMaxDynamicSharedMemorySize, LDS_BYTES) != hipSuccess) { fprintf(stderr, "kernel_launch: hipFuncSetAttribute failed\n"); }
        (void)hipGetLastError();
        if (ws_size < WS_END) fprintf(stderr, "kernel_launch: workspace too small: %zu < %zu\n", ws_size, (size_t)WS_END);
        grid = cus;
    }
    if (grid < 0) return;
    (void)hipMemsetAsync((char*)d_ws + WS_CTL, 0, CTL_BYTES, stream);
    Args a{};
    for (int i = 0; i < 22; ++i) a.in[i] = (const float*)d_in[i];
    a.out = (float*)d_out; a.ws = (unsigned char*)d_ws;
#if N_LAUNCH_MODE == 1
    a.ph_lo = 0; a.ph_hi = NPHASE;
    hipLaunchKernelGGL(fwd_kernel, dim3(grid), dim3(NTHR), LDS_BYTES, stream, a);
#else
    for (int ph = 0; ph < NPHASE; ++ph) {
        a.ph_lo = ph; a.ph_hi = ph + 1;
        hipLaunchKernelGGL(fwd_kernel, dim3(grid), dim3(NTHR), LDS_BYTES, stream, a);
    }
#endif
}
```
